# Optimizing an MI355X kernel written in HIP

```python
import math
import jax, jax.numpy as jnp
from jax import lax
import numpy as np

D_MODEL = 1024
BATCH = 8
SEQ = 4096
DEPTH = 1

PLE_DIM = 256
ATTN_WIDTH = D_MODEL // 2
CONV_WIDTH = D_MODEL - ATTN_WIDTH
ATTN_HEAD_DIM = 64
N_ATTN_HEADS = ATTN_WIDTH // (2 * ATTN_HEAD_DIM)
ATTN_V_DIM = 2 * ATTN_HEAD_DIM
QK_COLS = N_ATTN_HEADS * 2 * ATTN_HEAD_DIM
V_COLS = N_ATTN_HEADS * ATTN_V_DIM
IN_COLS = 2 * QK_COLS + V_COLS + 2 * CONV_WIDTH
CONV_KERNEL = 31
ROPE_THETA = 10000.0
Q_BLOCK = 128
N_PEER_HEADS = 8
N_KEYS = 128
N_EXPERTS = N_KEYS * N_KEYS
PEER_TOPK = 16
PEER_QUERY_DIM = 256
PEER_HALF = PEER_QUERY_DIM // 2
PEER_CHUNK = 128
EPS = 1e-6

kernel_name = "hymba_conv_diffattn_peer_ple"


def rms_norm(x, g):
    xf = x.astype(jnp.float32)
    y = xf * lax.rsqrt(jnp.mean(xf * xf, axis=-1, keepdims=True) + EPS)
    return (y * g.astype(jnp.float32)).astype(x.dtype)


def layer_norm(x, g, b):
    xf = x.astype(jnp.float32)
    mu = jnp.mean(xf, axis=-1, keepdims=True)
    var = jnp.mean(jnp.square(xf - mu), axis=-1, keepdims=True)
    y = (xf - mu) * lax.rsqrt(var + EPS)
    return (y * g.astype(jnp.float32) + b.astype(jnp.float32)).astype(x.dtype)


def rope(x, pos):
    d = x.shape[-1]
    half = d // 2
    inv_freq = 1.0 / (ROPE_THETA ** (jnp.arange(half, dtype=jnp.float32) * 2.0 / d))
    ang = pos.astype(jnp.float32)[:, None] * inv_freq[None, :]
    cos, sin = jnp.cos(ang), jnp.sin(ang)
    x1, x2 = x[..., :half], x[..., half:]
    return jnp.concatenate([x1 * cos - x2 * sin, x2 * cos + x1 * sin], axis=-1)


def diff_attention(q, k, v, lam, subln_g, lambda_init):
    B, H, _, S, d = q.shape
    pos = jnp.arange(S)
    qf = rope(q.astype(jnp.float32), pos) * (d ** -0.5)
    kf = rope(k.astype(jnp.float32), pos)
    vf = v.astype(jnp.float32)
    nb = S // Q_BLOCK
    qb = jnp.moveaxis(qf.reshape(B, H, 2, nb, Q_BLOCK, d), 3, 0)

    def block(args):
        qblk, i = args
        s = jnp.einsum('bhcqd,bhckd->bhcqk', qblk, kf)
        qpos = i * Q_BLOCK + jnp.arange(Q_BLOCK)
        mask = pos[None, :] <= qpos[:, None]
        s = jnp.where(mask, s, -jnp.inf)
        pr = jax.nn.softmax(s, axis=-1)
        a = pr[:, :, 0] - lam * pr[:, :, 1]
        return jnp.einsum('bhqk,bhkd->bhqd', a, vf)

    out = lax.map(block, (qb, jnp.arange(nb)))
    out = out.transpose(1, 0, 3, 2, 4).reshape(B, S, H, -1)
    out = rms_norm(out, subln_g) * (1.0 - lambda_init)
    return out.reshape(B, S, -1)


def conv_module(cv, cg, w, b, ln_g, ln_b):
    u = cv * jax.nn.sigmoid(cg)
    y = lax.conv_general_dilated(
        u, w[:, None, :].astype(u.dtype), window_strides=(1,),
        padding=[(CONV_KERNEL - 1, 0)], dimension_numbers=('NWC', 'WIO', 'NWC'),
        feature_group_count=CONV_WIDTH) + b
    return jax.nn.silu(layer_norm(y, ln_g, ln_b))


def peer(m, wq, keys, u_tab, v_tab):
    B, S, D = m.shape
    T = B * S
    mf = m.reshape(T, D)
    q = (mf @ wq).reshape(T, N_PEER_HEADS, 2, PEER_HALF)
    s = jnp.einsum('thcd,cnd->thcn', q.astype(jnp.float32), keys.astype(jnp.float32))
    sv, si = lax.top_k(s, PEER_TOPK)
    cand = sv[:, :, 0, :, None] + sv[:, :, 1, None, :]
    cs, ci = lax.top_k(cand.reshape(T, N_PEER_HEADS, PEER_TOPK * PEER_TOPK), PEER_TOPK)
    e1 = jnp.take_along_axis(si[:, :, 0], ci // PEER_TOPK, axis=-1)
    e2 = jnp.take_along_axis(si[:, :, 1], ci % PEER_TOPK, axis=-1)
    hk = N_PEER_HEADS * PEER_TOPK
    experts = (e1 * N_KEYS + e2).reshape(T, hk)
    gates = jax.nn.softmax(cs, axis=-1).reshape(T, hk)
    nc = T // PEER_CHUNK

    def chunk(args):
        xc, ec, gc = args
        u = u_tab[ec]
        a = jnp.einsum('cd,ckd->ck', xc, u).astype(jnp.float32)
        h = jax.nn.gelu(a, approximate=False) * gc
        vv = v_tab[ec]
        return jnp.einsum('ck,ckd->cd', h.astype(vv.dtype), vv)

    y = lax.map(chunk, (mf.reshape(nc, PEER_CHUNK, D), experts.reshape(nc, PEER_CHUNK, hk),
                        gates.reshape(nc, PEER_CHUNK, hk)))
    return y.reshape(B, S, D).astype(m.dtype)


def setup_inputs(seed: int = 0) -> dict:
    key = jax.random.key(seed)
    ks = jax.random.split(key, 24)
    f32 = jnp.float32
    nrm = lambda k, shape, s: jax.random.normal(k, shape, f32) * s
    gain = lambda k, shape: 1.0 + 0.02 * jax.random.normal(k, shape, f32)
    L, D = DEPTH, D_MODEL
    return {
        "x": nrm(ks[0], (BATCH, SEQ, D), 1.0),
        "p": nrm(ks[1], (DEPTH, BATCH, SEQ, PLE_DIM), 1.0),
        "attn_norm_g": gain(ks[2], (L, D)),
        "w_in": nrm(ks[3], (L, D, IN_COLS), D ** -0.5),
        "lambda_q1": nrm(ks[4], (L, ATTN_HEAD_DIM), 0.1),
        "lambda_k1": nrm(ks[5], (L, ATTN_HEAD_DIM), 0.1),
        "lambda_q2": nrm(ks[6], (L, ATTN_HEAD_DIM), 0.1),
        "lambda_k2": nrm(ks[7], (L, ATTN_HEAD_DIM), 0.1),
        "subln_g": gain(ks[8], (L, ATTN_V_DIM)),
        "conv_w": nrm(ks[9], (L, CONV_KERNEL, CONV_WIDTH), CONV_KERNEL ** -0.5),
        "conv_b": nrm(ks[10], (L, CONV_WIDTH), 0.02),
        "conv_ln_g": gain(ks[11], (L, CONV_WIDTH)),
        "conv_ln_b": nrm(ks[12], (L, CONV_WIDTH), 0.02),
        "w_out": nrm(ks[13], (L, D, D), D ** -0.5),
        "ffn_norm_g": gain(ks[14], (L, D)),
        "peer_wq": nrm(ks[15], (L, D, N_PEER_HEADS * PEER_QUERY_DIM), D ** -0.5),
        "peer_keys": nrm(ks[16], (L, 2, N_KEYS, PEER_HALF), PEER_HALF ** -0.5),
        "peer_u": nrm(ks[17], (L, N_EXPERTS, D), D ** -0.5),
        "peer_v": nrm(ks[18], (L, N_EXPERTS, D), N_PEER_HEADS ** -0.5),
        "ple_norm_g": gain(ks[19], (L, D)),
        "ple_w_gate": nrm(ks[20], (L, D, D), D ** -0.5),
        "ple_w_proj": nrm(ks[21], (L, PLE_DIM, D), PLE_DIM ** -0.5),
        "final_norm_g": gain(ks[22], (D,)),
    }


def reference(x, p, attn_norm_g, w_in, lambda_q1, lambda_k1, lambda_q2, lambda_k2, subln_g,
              conv_w, conv_b, conv_ln_g, conv_ln_b, w_out, ffn_norm_g, peer_wq, peer_keys,
              peer_u, peer_v, ple_norm_g, ple_w_gate, ple_w_proj, final_norm_g):
    B, S, D = x.shape
    H, d, dv = N_ATTN_HEADS, ATTN_HEAD_DIM, ATTN_V_DIM
    h = x
    for l in range(DEPTH):
        a = rms_norm(h, attn_norm_g[l])
        z = a @ w_in[l]
        q = z[..., :QK_COLS].reshape(B, S, H, 2, d).transpose(0, 2, 3, 1, 4)
        k = z[..., QK_COLS:2 * QK_COLS].reshape(B, S, H, 2, d).transpose(0, 2, 3, 1, 4)
        v = z[..., 2 * QK_COLS:2 * QK_COLS + V_COLS].reshape(B, S, H, dv).transpose(0, 2, 1, 3)
        c0 = 2 * QK_COLS + V_COLS
        cv = z[..., c0:c0 + CONV_WIDTH]
        cg = z[..., c0 + CONV_WIDTH:]
        lambda_init = 0.8 - 0.6 * math.exp(-0.3 * l)
        lam = (jnp.exp(jnp.sum(lambda_q1[l].astype(jnp.float32) * lambda_k1[l].astype(jnp.float32)))
               - jnp.exp(jnp.sum(lambda_q2[l].astype(jnp.float32) * lambda_k2[l].astype(jnp.float32)))
               + lambda_init)
        attn_out = diff_attention(q, k, v, lam, subln_g[l], lambda_init).astype(h.dtype)
        conv_out = conv_module(cv, cg, conv_w[l], conv_b[l], conv_ln_g[l], conv_ln_b[l]).astype(h.dtype)
        h = h + jnp.concatenate([attn_out, conv_out], axis=-1) @ w_out[l]
        h = h + peer(rms_norm(h, ffn_norm_g[l]), peer_wq[l], peer_keys[l], peer_u[l], peer_v[l])
        e = p[l] @ ple_w_proj[l]
        gate = jax.nn.sigmoid(rms_norm(h, ple_norm_g[l]) @ ple_w_gate[l])
        h = h + e * gate
    return rms_norm(h, final_norm_g)
```

```cpp
#include <hip/hip_runtime.h>
#include <hip/hip_cooperative_groups.h>
#include <cstdio>
#include <cstdint>
namespace cg = cooperative_groups;
namespace pg8 {
#define PG8_LAS __attribute__((address_space(3)))
typedef unsigned short bf16_t;
typedef short bf16x8 __attribute__((ext_vector_type(8)));
typedef float f32x4 __attribute__((ext_vector_type(4)));
typedef unsigned u32x4 __attribute__((ext_vector_type(4)));
constexpr int BM = 256, BK = 64, HALF = 128, HTB = HALF * BK * 2  , STAGE_BYTES = 8 * HTB, NXCD = 8, WGM = 8;

__host__ __device__ __forceinline__ int lds_byte(int r, int c) { const int st = (r >> 4) * 2 + (c >> 5), rr = r & 15, cc = c & 31, ob = rr * 64 + cc * 2; return st * 1024 + (ob ^ (((ob >> 9) & 1) << 5)); }
__host__ __device__ __forceinline__ void stage_rc(int b, int& R, int& C) { const int st = b / 1024, sb = b % 1024, swz = sb ^ (((sb >> 9) & 1) << 5); R = (st >> 1) * 16 + swz / 64; C = (st & 1) * 32 + (swz % 64) / 2; }
__host__ __device__ __forceinline__ int perm32(int rho) { const int n = rho >> 4, i = rho & 15; return 8 * (i >> 2) + 4 * n + (i & 3); }

struct Unit { int pm, pn; };
struct Gemm { const bf16_t* A; const bf16_t* Bt; int M, N, K; };

struct StaticOrder {
    int nM, nN, nwg, G, c;
    __host__ __device__ void init(int M, int N, int G_, int c_) { nM = M / BM; nN = N / BM; nwg = nM * nN; G = G_; c = c_; }
    __host__ __device__ bool next(int i, Unit& u) const {
        const long L = (long)i * G + c; if (L >= nwg) return false;
        int wgid = (int)L; { const int q = nwg / NXCD, r = nwg % NXCD, xcd = wgid % NXCD, off = wgid / NXCD; wgid = (xcd < r ? xcd * (q + 1) : r * (q + 1) + (xcd - r) * q) + off; }
        const int nig = WGM * nN, gid = wgid / nig, fm = gid * WGM, gsz = (nM - fm) < WGM ? (nM - fm) : WGM;
        u.pm = fm + ((wgid % nig) % gsz); u.pn = (wgid % nig) / gsz; return true;
    }
    __device__ __forceinline__ void a_ready(const Unit&) const {}
    __device__ __forceinline__ void done(const Unit&) const {}
};

__device__ __forceinline__ unsigned cvt_pk_bf16(float lo, float hi) { unsigned r; asm volatile("v_cvt_pk_bf16_f32 %0, %1, %2" : "=v"(r) : "v"(lo), "v"(hi)); return r; }
typedef float f32x2 __attribute__((ext_vector_type(2)));
__device__ __forceinline__ f32x2 gelu_pk(f32x2 v) {
    const f32x2 av = __builtin_elementwise_abs(v), d = av * 0.2316418882f + 1.0f;
    f32x2 t; t.x = __builtin_amdgcn_rcpf(d.x); t.y = __builtin_amdgcn_rcpf(d.y);
    f32x2 q = t * 0.5307027145f + (-0.7265760135f); q = q * t + 0.7107068705f; q = q * t + (-0.142248368f); q = q * t + 0.127414796f; q = q * t;
    const f32x2 s = (v * v) * (-0.72134752044f);
    f32x2 e; e.x = __builtin_amdgcn_exp2f(s.x); e.y = __builtin_amdgcn_exp2f(s.y);
    const f32x2 m = v * (q * e), r = v - m;
    f32x2 o; o.x = v.x < 0.f ? m.x : r.x; o.y = v.y < 0.f ? m.y : r.y; return o;
}

template <int ACT  > struct EpiBf16 {
    static constexpr bool PERM = true, AFTER_DRAIN = false; static_assert(ACT == 0 || ACT == 1, "EpiBf16: ACT is 0 (none) or 1 (gelu_pk)");
    bf16_t* O; int ldc; const float* bias; int split_cols; size_t split_stride; float scale0;
    __device__ __forceinline__ void operator()(const f32x4 (&acc)[2][2][4][2], const Unit& u, int wr, int wc, int fr, int fq) const {
        const int row0 = u.pm * BM + wr * 64 + fr; int colt = u.pn * BM; bf16_t* base = O;
        float sc = 1.f; if (split_cols) { const int t = colt / split_cols; base += (size_t)t * split_stride; colt -= t * split_cols; if (t == 0) sc = scale0; }
        const int col0 = colt + wc * 32 + 8 * fq, bcol0 = u.pn * BM + wc * 32 + 8 * fq;
        f32x4 bv[2][2];
#pragma unroll
        for (int bj = 0; bj < 2; ++bj)
#pragma unroll
            for (int n = 0; n < 2; ++n) bv[bj][n] = bias ? *(const f32x4*)(bias + bcol0 + bj * HALF + 4 * n) : (f32x4){0.f, 0.f, 0.f, 0.f};
#pragma unroll
        for (int ai = 0; ai < 2; ++ai)
#pragma unroll
            for (int m = 0; m < 4; ++m) { bf16_t* rowp = base + (size_t)(row0 + ai * HALF + m * 16) * ldc + col0;
#pragma unroll
                for (int bj = 0; bj < 2; ++bj) { f32x4 v0 = acc[ai][bj][m][0] + bv[bj][0], v1 = acc[ai][bj][m][1] + bv[bj][1];
                    if (ACT == 1) { f32x2 a = gelu_pk((f32x2){v0[0], v0[1]}), b = gelu_pk((f32x2){v0[2], v0[3]}), c = gelu_pk((f32x2){v1[0], v1[1]}), d = gelu_pk((f32x2){v1[2], v1[3]});
                        v0 = (f32x4){a.x, a.y, b.x, b.y}; v1 = (f32x4){c.x, c.y, d.x, d.y}; }
                    v0 = v0 * sc; v1 = v1 * sc; u32x4 w; w.x = cvt_pk_bf16(v0[0], v0[1]); w.y = cvt_pk_bf16(v0[2], v0[3]); w.z = cvt_pk_bf16(v1[0], v1[1]); w.w = cvt_pk_bf16(v1[2], v1[3]);
                    *(u32x4*)(rowp + bj * HALF) = w; } }
    }
};
__device__ __forceinline__ float sigmoid_fast(float x) { return __builtin_amdgcn_rcpf(1.0f + __expf(-x)); }
__device__ __forceinline__ f32x4 sigmoid4(f32x4 x) { f32x4 r; r[0] = sigmoid_fast(x[0]); r[1] = sigmoid_fast(x[1]); r[2] = sigmoid_fast(x[2]); r[3] = sigmoid_fast(x[3]); return r; }
__device__ __forceinline__ u32x4 pack8(const f32x4 a, const f32x4 b) { u32x4 w; w.x = cvt_pk_bf16(a[0], a[1]); w.y = cvt_pk_bf16(a[2], a[3]); w.z = cvt_pk_bf16(b[0], b[1]); w.w = cvt_pk_bf16(b[2], b[3]); return w; }
__device__ __forceinline__ float dot4s(const f32x4 a) { return (a[0] * a[0] + a[1] * a[1]) + (a[2] * a[2] + a[3] * a[3]); }

struct EpiIn {
    static constexpr bool PERM = true, AFTER_DRAIN = false;
    bf16_t *Q, *Kk, *V, *U; const float* ropec; const float* ropes; float qscale;
    __device__ __forceinline__ void operator()(const f32x4 (&acc)[2][2][4][2], const Unit& u, int wr, int wc, int fr, int fq) const {
        const int row0 = u.pm * BM + wr * 64 + fr; const int pn = u.pn;
        if (pn < 4) {
            bf16_t* dst = (pn < 2) ? Q : Kk; const float sc = (pn < 2) ? qscale : 1.0f; const int colb = ((pn & 1) * 4 + wc) * 128 + 8 * fq;
#pragma unroll
            for (int ai = 0; ai < 2; ++ai)
#pragma unroll
                for (int m = 0; m < 4; ++m) { const int row = row0 + ai * HALF + m * 16; const int pos = row & 4095;
                    const f32x4 c0 = *(const f32x4*)(ropec + pos * 32 + 8 * fq), c1 = *(const f32x4*)(ropec + pos * 32 + 8 * fq + 4);
                    const f32x4 s0 = *(const f32x4*)(ropes + pos * 32 + 8 * fq), s1 = *(const f32x4*)(ropes + pos * 32 + 8 * fq + 4);
                    const f32x4 x10 = acc[ai][0][m][0], x11 = acc[ai][0][m][1], x20 = acc[ai][1][m][0], x21 = acc[ai][1][m][1];
                    const f32x4 o10 = (x10 * c0 - x20 * s0) * sc, o11 = (x11 * c1 - x21 * s1) * sc, o20 = (x20 * c0 + x10 * s0) * sc, o21 = (x21 * c1 + x11 * s1) * sc;
                    bf16_t* rp = dst + (size_t)row * 1024 + colb; const u32x4 w1 = pack8(o10, o11), w2 = pack8(o20, o21);
                    *(u32x4*)rp = w1; *(u32x4*)(rp + 32) = w2; *(u32x4*)(rp + 64) = w1; *(u32x4*)(rp + 96) = w2; }
        } else if (pn < 6) {
#pragma unroll
            for (int ai = 0; ai < 2; ++ai)
#pragma unroll
                for (int m = 0; m < 4; ++m) { const int row = row0 + ai * HALF + m * 16;
#pragma unroll
                    for (int bj = 0; bj < 2; ++bj) { const int hh = (pn - 4) * 2 + bj, vh = wc >> 1, d = (wc & 1) * 32 + 8 * fq;
                        const u32x4 w = pack8(acc[ai][bj][m][0], acc[ai][bj][m][1]); bf16_t* rp = V + (size_t)row * 1024 + (hh * 4 + vh) * 64 + d; *(u32x4*)rp = w; *(u32x4*)(rp + 128) = w; } }
        } else {
#pragma unroll
            for (int ai = 0; ai < 2; ++ai)
#pragma unroll
                for (int m = 0; m < 4; ++m) { const int row = row0 + ai * HALF + m * 16;
                    const f32x4 u0 = acc[ai][0][m][0] * sigmoid4(acc[ai][1][m][0]), u1 = acc[ai][0][m][1] * sigmoid4(acc[ai][1][m][1]);
                    *(u32x4*)(U + (size_t)row * 512 + (pn - 6) * 128 + wc * 32 + 8 * fq) = pack8(u0, u1); }
        }
    }
};
struct EpiOut {
    static constexpr bool PERM = true, AFTER_DRAIN = false;
    const float* x; float* out; bf16_t* hb; float* ssq;
    __device__ __forceinline__ void operator()(const f32x4 (&acc)[2][2][4][2], const Unit& u, int wr, int wc, int fr, int fq) const {
        const int row0 = u.pm * BM + wr * 64 + fr;
#pragma unroll
        for (int ai = 0; ai < 2; ++ai)
#pragma unroll
            for (int m = 0; m < 4; ++m) { const int row = row0 + ai * HALF + m * 16; float ss = 0.f;
#pragma unroll
                for (int bj = 0; bj < 2; ++bj) { const size_t off = (size_t)row * 1024 + u.pn * BM + bj * HALF + wc * 32 + 8 * fq;
                    const f32x4 h0 = acc[ai][bj][m][0] + *(const f32x4*)(x + off), h1 = acc[ai][bj][m][1] + *(const f32x4*)(x + off + 4);
                    *(f32x4*)(out + off) = h0; *(f32x4*)(out + off + 4) = h1; *(u32x4*)(hb + off) = pack8(h0, h1); ss += dot4s(h0) + dot4s(h1); }
                ss += __shfl_xor(ss, 16); ss += __shfl_xor(ss, 32);
                if (fq == 0) ssq[(size_t)row * 16 + u.pn * 4 + wc] = ss; }
    }
};
struct EpiQ {
    static constexpr bool PERM = true, AFTER_DRAIN = false;
    const float* ssq; bf16_t* qp; float eps;
    __device__ __forceinline__ void operator()(const f32x4 (&acc)[2][2][4][2], const Unit& u, int wr, int wc, int fr, int fq) const {
        const int row0 = u.pm * BM + wr * 64 + fr;
#pragma unroll
        for (int ai = 0; ai < 2; ++ai)
#pragma unroll
            for (int m = 0; m < 4; ++m) { const int row = row0 + ai * HALF + m * 16; const f32x4* sp = (const f32x4*)(ssq + (size_t)row * 16);
                const f32x4 a = sp[0], b = sp[1], c = sp[2], d = sp[3]; const f32x4 t = (a + b) + (c + d);
                const float rstd = rsqrtf(((t[0] + t[1]) + (t[2] + t[3])) * (1.0f / 1024.0f) + eps);
#pragma unroll
                for (int bj = 0; bj < 2; ++bj) *(u32x4*)(qp + (size_t)row * 2048 + u.pn * BM + bj * HALF + wc * 32 + 8 * fq) = pack8(acc[ai][bj][m][0] * rstd, acc[ai][bj][m][1] * rstd); }
    }
};
__device__ __forceinline__ f32x4 bf_lo4(unsigned a, unsigned b) { f32x4 r; r[0] = __uint_as_float(a << 16); r[1] = __uint_as_float(a & 0xffff0000u); r[2] = __uint_as_float(b << 16); r[3] = __uint_as_float(b & 0xffff0000u); return r; }
struct EpiGate {
    static constexpr bool PERM = true, AFTER_DRAIN = false;
    float* out; const bf16_t* e;
    __device__ __forceinline__ void operator()(const f32x4 (&acc)[2][2][4][2], const Unit& u, int wr, int wc, int fr, int fq) const {
        const int row0 = u.pm * BM + wr * 64 + fr;
#pragma unroll
        for (int ai = 0; ai < 2; ++ai)
#pragma unroll
            for (int m = 0; m < 4; ++m) { const int row = row0 + ai * HALF + m * 16;
#pragma unroll
                for (int bj = 0; bj < 2; ++bj) { const size_t off = (size_t)row * 1024 + u.pn * BM + bj * HALF + wc * 32 + 8 * fq;
                    const u32x4 ev = *(const u32x4*)(e + off); const f32x4 e0 = bf_lo4(ev.x, ev.y), e1 = bf_lo4(ev.z, ev.w);
                    const f32x4 h0 = *(const f32x4*)(out + off) + e0 * sigmoid4(acc[ai][bj][m][0]), h1 = *(const f32x4*)(out + off + 4) + e1 * sigmoid4(acc[ai][bj][m][1]);
                    *(f32x4*)(out + off) = h0; *(f32x4*)(out + off + 4) = h1; } }
    }
};
template <class Epi, class Sched, bool ALIGN_EPI = false, bool SP2 = false>
__device__ __forceinline__ void gemm_phase(PG8_LAS unsigned char* lds, const Gemm g, const Sched& S, const Epi& E, const int wid  ) {
    int lane; asm volatile("v_mbcnt_lo_u32_b32 %0, -1, 0\n\tv_mbcnt_hi_u32_b32 %0, -1, %0" : "=v"(lane));
    const int tid = wid * 64 + lane, wr = wid >> 2, wc = wid & 3, fr = lane & 15, fq = lane >> 4;
    const int K = g.K, nt = K / BK;
    unsigned voffA[2], voffB[2];
#pragma unroll
    for (int i = 0; i < 2; ++i) { int R, C; stage_rc(tid * 16 + i * 8192, R, C); const int Rb = Epi::PERM ? ((R & ~31) + perm32(R & 31)) : R;
        voffA[i] = (unsigned)(R * K + C) * 2u; voffB[i] = (unsigned)(Rb * K + C) * 2u; }
    const size_t kstep = (size_t)(BK * 2);
    const size_t hstep = (size_t)HALF * K * 2;
    const size_t tstep = 2 * hstep;
    const unsigned ldsw = (unsigned)wid * 1024u;
    const int aoff = lds_byte(wr * 64 + fr, fq * 8), boff = lds_byte(wc * 32 + fr, fq * 8);
#define PG8_SA(b, h) (((b) * 2 + (h)) * HTB)
#define PG8_SB(b, h) ((4 + (b) * 2 + (h)) * HTB)
#define PG8_STAGE(bufoff, gbase, voff) do { _Pragma("unroll") for (int _i = 0; _i < 2; ++_i) \
        __builtin_amdgcn_global_load_lds((const unsigned*)((const char*)(gbase) + (voff)[_i]), (PG8_LAS unsigned*)(lds + (bufoff) + ldsw + _i * 8192), 16, 0, 0); } while (0)
#define PG8_LDA(dst, b, h) do { _Pragma("unroll") for (int m = 0; m < 4; ++m) _Pragma("unroll") for (int k = 0; k < 2; ++k) dst[m][k] = *(const PG8_LAS bf16x8*)(lds + PG8_SA(b, h) + aoff + m * 2048 + k * 1024); } while (0)
#define PG8_LDB(dst, b, h) do { _Pragma("unroll") for (int n = 0; n < 2; ++n) _Pragma("unroll") for (int k = 0; k < 2; ++k) dst[n][k] = *(const PG8_LAS bf16x8*)(lds + PG8_SB(b, h) + boff + n * 2048 + k * 1024); } while (0)
#define PG8_MMA(ai, bj, At, Bt) do { __builtin_amdgcn_s_setprio(1); _Pragma("unroll") for (int m = 0; m < 4; ++m) _Pragma("unroll") for (int n = 0; n < 2; ++n) _Pragma("unroll") for (int k = 0; k < 2; ++k) \
        acc[ai][bj][m][n] = __builtin_amdgcn_mfma_f32_16x16x32_bf16(Bt[n][k], At[m][k], acc[ai][bj][m][n], 0, 0, 0); __builtin_amdgcn_s_setprio(0); } while (0)
#define PG8_WAIT_V(n) asm volatile("s_waitcnt vmcnt(" #n ")" ::: "memory")
#define PG8_WAIT_L(n) asm volatile("s_waitcnt lgkmcnt(" #n ")" ::: "memory")
#define PG8_BAR __builtin_amdgcn_s_barrier()
#define PG8_SCHED __builtin_amdgcn_sched_barrier(0)
    Unit cur, nxt; int ui = 0;
    if (!S.next(0, cur)) return;
    f32x4 acc[2][2][4][2];
#pragma unroll
    for (int a = 0; a < 2; ++a)
#pragma unroll
        for (int b = 0; b < 2; ++b)
#pragma unroll
            for (int m = 0; m < 4; ++m)
#pragma unroll
                for (int n = 0; n < 2; ++n) acc[a][b][m][n] = (f32x4){0.f, 0.f, 0.f, 0.f};
    bf16x8 At[4][2], B0[2][2], B1[2][2];
    const char* cA = (const char*)g.A + (size_t)cur.pm * tstep; const char* cB = (const char*)g.Bt + (size_t)cur.pn * tstep;
    S.a_ready(cur);
    if constexpr (SP2) {
        PG8_STAGE(PG8_SB(0, 0), cB, voffB); PG8_STAGE(PG8_SB(0, 1), cB + hstep, voffB); PG8_STAGE(PG8_SA(0, 0), cA, voffA); PG8_STAGE(PG8_SA(0, 1), cA + hstep, voffA);
        if (wr == 1) PG8_BAR;
        PG8_WAIT_V(2); PG8_BAR;
        PG8_STAGE(PG8_SB(1, 0), cB + kstep, voffB); PG8_STAGE(PG8_SA(1, 0), cA + kstep, voffA); PG8_STAGE(PG8_SB(1, 1), cB + hstep + kstep, voffB);
        PG8_WAIT_V(6); PG8_BAR;
    } else {
        PG8_STAGE(PG8_SB(0, 0), cB, voffB); PG8_STAGE(PG8_SA(0, 0), cA, voffA); PG8_STAGE(PG8_SB(0, 1), cB + hstep, voffB); PG8_STAGE(PG8_SA(0, 1), cA + hstep, voffA);
        if (wr == 1) PG8_BAR;
        PG8_WAIT_V(4); PG8_BAR;
        PG8_STAGE(PG8_SB(1, 0), cB + kstep, voffB); PG8_STAGE(PG8_SA(1, 0), cA + kstep, voffA); PG8_STAGE(PG8_SB(1, 1), cB + hstep + kstep, voffB);
        PG8_WAIT_V(6); PG8_BAR;
    }
    for (;;) {
        const bool has_next = S.next(ui + 1, nxt);
        const char* nA = has_next ? (const char*)g.A + (size_t)nxt.pm * tstep : cA; const char* nB = has_next ? (const char*)g.Bt + (size_t)nxt.pn * tstep : cB;
        for (int t = 0; t < nt; t += 2) {
            const bool last = (t == nt - 2);
            const char* a1 = cA + (size_t)(t + 1) * kstep;
            const char* a2 = last ? nA : cA + (size_t)(t + 2) * kstep; const char* b2 = last ? nB : cB + (size_t)(t + 2) * kstep;
            const char* a3 = a2 + kstep; const char* b3 = b2 + kstep;
            if (last && has_next) S.a_ready(nxt);
            if constexpr (SP2) {
            PG8_LDB(B0, 0, 0); PG8_LDB(B1, 0, 1); PG8_SCHED; PG8_LDA(At, 0, 0); PG8_STAGE(PG8_SA(1, 1), a1 + hstep, voffA);
            PG8_WAIT_V(8); PG8_WAIT_L(0); PG8_BAR; PG8_MMA(0, 0, At, B0); PG8_MMA(0, 1, At, B1); PG8_BAR; PG8_SCHED;
            PG8_LDA(At, 0, 1); PG8_STAGE(PG8_SB(0, 0), b2, voffB); PG8_STAGE(PG8_SB(0, 1), b2 + hstep, voffB); PG8_STAGE(PG8_SA(0, 0), a2, voffA);
            PG8_WAIT_V(8); PG8_WAIT_L(0); PG8_BAR; PG8_MMA(1, 0, At, B0); PG8_MMA(1, 1, At, B1); PG8_BAR; PG8_SCHED;
            PG8_LDB(B0, 1, 0); PG8_LDB(B1, 1, 1); PG8_SCHED; PG8_LDA(At, 1, 0); PG8_STAGE(PG8_SA(0, 1), a2 + hstep, voffA);
            PG8_WAIT_V(8); PG8_WAIT_L(0); PG8_BAR; PG8_MMA(0, 0, At, B0); PG8_MMA(0, 1, At, B1); PG8_BAR; PG8_SCHED;
            PG8_LDA(At, 1, 1); PG8_STAGE(PG8_SB(1, 0), b3, voffB); PG8_STAGE(PG8_SB(1, 1), b3 + hstep, voffB); PG8_STAGE(PG8_SA(1, 0), a3, voffA);
            PG8_WAIT_V(8); PG8_WAIT_L(0); PG8_BAR; PG8_MMA(1, 0, At, B0); PG8_MMA(1, 1, At, B1); PG8_BAR; PG8_SCHED;
            } else {
            PG8_LDB(B0, 0, 0); PG8_SCHED; PG8_LDA(At, 0, 0); PG8_STAGE(PG8_SA(1, 1), a1 + hstep, voffA);
            PG8_WAIT_L(8); PG8_BAR; PG8_WAIT_L(0); PG8_MMA(0, 0, At, B0); PG8_BAR; PG8_SCHED;
            PG8_LDB(B1, 0, 1); PG8_STAGE(PG8_SB(0, 0), b2, voffB);
            PG8_BAR; PG8_WAIT_L(0); PG8_MMA(0, 1, At, B1); PG8_BAR;
            PG8_LDA(At, 0, 1); PG8_STAGE(PG8_SA(0, 0), a2, voffA);
            PG8_BAR; PG8_WAIT_L(0); PG8_MMA(1, 0, At, B0); PG8_BAR; PG8_SCHED;
            PG8_STAGE(PG8_SB(0, 1), b2 + hstep, voffB);
            PG8_WAIT_V(6); PG8_BAR; PG8_MMA(1, 1, At, B1); PG8_BAR;
            PG8_LDB(B0, 1, 0); PG8_SCHED; PG8_LDA(At, 1, 0); PG8_STAGE(PG8_SA(0, 1), a2 + hstep, voffA);
            PG8_WAIT_L(8); PG8_BAR; PG8_WAIT_L(0); PG8_MMA(0, 0, At, B0); PG8_BAR; PG8_SCHED;
            PG8_LDB(B1, 1, 1); PG8_STAGE(PG8_SB(1, 0), b3, voffB);
            PG8_BAR; PG8_WAIT_L(0); PG8_MMA(0, 1, At, B1); PG8_BAR;
            PG8_LDA(At, 1, 1); PG8_STAGE(PG8_SA(1, 0), a3, voffA);
            PG8_BAR; PG8_WAIT_L(0); PG8_MMA(1, 0, At, B0); PG8_BAR; PG8_SCHED;
            PG8_STAGE(PG8_SB(1, 1), b3 + hstep, voffB);
            PG8_WAIT_V(6); PG8_BAR; PG8_MMA(1, 1, At, B1); PG8_BAR;
            }
        }
        if constexpr (ALIGN_EPI) { if (wr == 0) PG8_BAR; }
        if constexpr (!Epi::AFTER_DRAIN) { E(acc, cur, wr, wc, fr, fq); S.done(cur); }
        if (!has_next) break;
#pragma unroll
        for (int a = 0; a < 2; ++a)
#pragma unroll
            for (int b = 0; b < 2; ++b)
#pragma unroll
                for (int m = 0; m < 4; ++m)
#pragma unroll
                    for (int n = 0; n < 2; ++n) acc[a][b][m][n] = (f32x4){0.f, 0.f, 0.f, 0.f};
        cur = nxt; cA = nA; cB = nB; ++ui;
        if constexpr (ALIGN_EPI) { if (wr == 1) PG8_BAR; }
    }
    PG8_WAIT_V(0);
    if constexpr (!ALIGN_EPI) { if (wr == 0) PG8_BAR; }
    PG8_BAR;
    if constexpr (Epi::AFTER_DRAIN) { E.fused(acc, cur, wr, wc, fr, fq, lds, wid, lane); S.done(cur); }
#undef PG8_SA
#undef PG8_SB
#undef PG8_STAGE
#undef PG8_LDA
#undef PG8_LDB
#undef PG8_MMA
#undef PG8_WAIT_V
#undef PG8_WAIT_L
#undef PG8_BAR
#undef PG8_SCHED
}
}
#include <hip/hip_bf16.h>
#include <cmath>
namespace attn_body {
using bf16=__hip_bfloat16;
using bf16x8=__attribute__((ext_vector_type(8)))short;
using s16x4=__attribute__((ext_vector_type(4)))short;
using f32x16=__attribute__((ext_vector_type(16)))float;
using u32x4=__attribute__((ext_vector_type(4)))unsigned;
constexpr int BATCH=8,NHEAD=16,SEQ=4096,D=64,DM=NHEAD*D;
constexpr int NW=8,QBLK=32,QB=QBLK*NW,KVBLK=64,NQB=SEQ/QB;
constexpr int ATTN_PITCH=DM, ATTN_UNIT_ROWS=QB;
__device__ __forceinline__ int crow(int r,int hi){return (r&3)+8*(r>>2)+4*hi;}
#define SBAR() __builtin_amdgcn_sched_barrier(0)
__device__ __forceinline__ void cmask(f32x16&p0,f32x16&p1,int jb,int qrel,int hi){
  const float NEG=-INFINITY; int kb=64*jb+4*hi;
  #pragma unroll
  for(int r=0;r<16;++r){int kv=kb+(r&3)+8*(r>>2); if(kv>qrel)p0[r]=NEG; if(kv+32>qrel)p1[r]=NEG;}
}

constexpr int NSLOT=3, SLOTB=8192;
constexpr int LDS_K=0, LDS_V=NSLOT*SLOTB, LDS_WS=2*NSLOT*SLOTB, LDS_OST=LDS_WS+NW*64*4, LDS_BYTES=LDS_OST+NW*4096;
constexpr float C2=0.125f*1.4426950408889634f;
__device__ __forceinline__ void glds16(const void*gsrc,unsigned lds_dst){unsigned keep;
  asm volatile("s_mov_b32 %0, m0\n\ts_mov_b32 m0, %2\n\ts_nop 0\n\tglobal_load_lds_dwordx4 %1, off\n\ts_mov_b32 m0, %0":"=&s"(keep):"v"(gsrc),"s"(lds_dst):"memory");}
__device__ __forceinline__ float max3f(float a,float b,float c){float r;asm("v_max3_f32 %0, %1, %2, %3":"=v"(r):"v"(a),"v"(b),"v"(c));return r;}
__device__ __forceinline__ float max2f(float a,float b){float r;asm("v_max_f32_e32 %0, %1, %2":"=v"(r):"v"(a),"v"(b));return r;}
__device__ __forceinline__ float fadd_s(float a,float b){float r;asm("v_add_f32_e32 %0, %1, %2":"=v"(r):"v"(a),"v"(b));return r;}
__device__ __forceinline__ float fsub_s(float a,float b){float r;asm("v_sub_f32_e32 %0, %1, %2":"=v"(r):"v"(a),"v"(b));return r;}
typedef float f32x2_t __attribute__((ext_vector_type(2))); typedef __bf16 bf16x2_t __attribute__((ext_vector_type(2)));
__device__ __forceinline__ unsigned cvtpk_s(float lo,float hi){f32x2_t v={lo,hi};bf16x2_t b=__builtin_convertvector(v,bf16x2_t);return __builtin_bit_cast(unsigned,b);}
#define WAIT_BAR(N) asm volatile("s_waitcnt vmcnt(" #N ") lgkmcnt(0)\n\ts_barrier":::"memory")

__device__ __forceinline__ void qkt(f32x16&p0,f32x16&p1,const char*Kslot,const bf16x8*qr,const f32x16&negm,int r32,int hi){
  const char*kb=Kslot+hi*1024+r32*16;
  #pragma unroll
  for(int d0=0;d0<4;++d0){
    const bf16x8 b0=*reinterpret_cast<const bf16x8*>(kb+d0*2048);
    const bf16x8 b1=*reinterpret_cast<const bf16x8*>(kb+d0*2048+512);
    if(d0==0){p0=__builtin_amdgcn_mfma_f32_32x32x16_bf16(b0,qr[0],negm,0,0,0);p1=__builtin_amdgcn_mfma_f32_32x32x16_bf16(b1,qr[0],negm,0,0,0);}
    else{p0=__builtin_amdgcn_mfma_f32_32x32x16_bf16(b0,qr[d0],p0,0,0,0);p1=__builtin_amdgcn_mfma_f32_32x32x16_bf16(b1,qr[d0],p1,0,0,0);}}
}
typedef __attribute__((address_space(3))) const char* lds_cptr;
typedef short v4i16_t __attribute__((ext_vector_type(4)));
__device__ __forceinline__ void kload8(bf16x8*kf,lds_cptr kp){
  kf[0]=*(const __attribute__((address_space(3))) bf16x8*)(kp);      kf[1]=*(const __attribute__((address_space(3))) bf16x8*)(kp+512);
  kf[2]=*(const __attribute__((address_space(3))) bf16x8*)(kp+2048); kf[3]=*(const __attribute__((address_space(3))) bf16x8*)(kp+2560);
  kf[4]=*(const __attribute__((address_space(3))) bf16x8*)(kp+4096); kf[5]=*(const __attribute__((address_space(3))) bf16x8*)(kp+4608);
  kf[6]=*(const __attribute__((address_space(3))) bf16x8*)(kp+6144); kf[7]=*(const __attribute__((address_space(3))) bf16x8*)(kp+6656);
}
__device__ __forceinline__ void kload2(bf16x8*kf,lds_cptr kp,int j){ kf[2*j]=*(const __attribute__((address_space(3))) bf16x8*)(kp+j*2048); kf[2*j+1]=*(const __attribute__((address_space(3))) bf16x8*)(kp+j*2048+512); }
__device__ __forceinline__ s16x4 vtr(lds_cptr p){ return __builtin_bit_cast(s16x4,__builtin_amdgcn_ds_read_tr16_b64_v4i16((__attribute__((address_space(3))) v4i16_t*)p)); }
__device__ __forceinline__ float rowmax(const f32x16&p0,const f32x16&p1){
  float a=max3f(p0[0],p0[1],p1[0]),b=max3f(p0[2],p0[3],p1[1]);a=max3f(a,p1[2],p1[3]);
  #pragma unroll
  for(int r=4;r<16;r+=4){a=max3f(a,p0[r],p0[r+1]);b=max3f(b,p0[r+2],p0[r+3]);a=max3f(a,p1[r],p1[r+1]);b=max3f(b,p1[r+2],p1[r+3]);}
  const float m=max2f(a,b);
  auto rr=__builtin_amdgcn_permlane32_swap(__float_as_uint(m),__float_as_uint(m),false,false);
  return max2f(__uint_as_float(rr[0]),__uint_as_float(rr[1]));
}
__device__ __forceinline__ void pv(f32x16*o,int vb,bf16x8 pa0,bf16x8 pa1,bf16x8 pa2,bf16x8 pa3){
  #pragma unroll
  for(int d0=0;d0<2;++d0){s16x4 lo[4],hi[4];
    #pragma unroll
    for(int ks=0;ks<4;++ks){
      asm volatile("ds_read_b64_tr_b16 %0,%1 offset:%c2":"=&v"(lo[ks]):"v"(vb),"i"(d0*4096+ks*1024):"memory");
      asm volatile("ds_read_b64_tr_b16 %0,%1 offset:%c2":"=&v"(hi[ks]):"v"(vb),"i"(d0*4096+ks*1024+512):"memory");}
    asm volatile("s_waitcnt lgkmcnt(0)":::"memory");SBAR();
    #define PK(k) (bf16x8){lo[k][0],lo[k][1],lo[k][2],lo[k][3],hi[k][0],hi[k][1],hi[k][2],hi[k][3]}
    o[d0]=__builtin_amdgcn_mfma_f32_32x32x16_bf16(pa0,PK(0),o[d0],0,0,0);
    o[d0]=__builtin_amdgcn_mfma_f32_32x32x16_bf16(pa1,PK(1),o[d0],0,0,0);
    o[d0]=__builtin_amdgcn_mfma_f32_32x32x16_bf16(pa2,PK(2),o[d0],0,0,0);
    o[d0]=__builtin_amdgcn_mfma_f32_32x32x16_bf16(pa3,PK(3),o[d0],0,0,0);
    #undef PK
  }
}

#ifndef ATTN_STORE16
#define ATTN_STORE16(p,v) (*(u32x4*)(p)=(v))
#endif
template<int THRL> __device__ __forceinline__ void attn_unit(int b,int h,int qb,const bf16*Q,const bf16*__restrict__ K,const bf16*__restrict__ V,bf16*O,char*shm,const int tid_in){
  const int tid=tid_in,lane=tid&63,r32=lane&31,hi=lane>>5; const int wid=__builtin_amdgcn_readfirstlane(tid>>6);
  const long rowbase=(long)b*SEQ; const int q0=qb*QB;
  const bf16*Qw=Q+(rowbase+q0+wid*QBLK)*DM+h*D;
  const bf16*Kh=K+rowbase*DM+h*D,*Vh=V+rowbase*DM+h*D;
  const unsigned lds0=(unsigned)(uintptr_t)shm;
  float*wsf=(float*)(shm+LDS_WS)+wid*64;
  const bf16*ksrc=Kh+(long)lane*DM+wid*8;
  const bf16*vsrc=Vh+(long)(16*(wid&3)+(lane>>2))*DM+(wid>>2)*32+(lane&3)*8;
  const unsigned kdst=lds0+LDS_K+wid*1024, vdst=lds0+LDS_V+wid*1024;
  #define DMA_K(t,slot) glds16(ksrc+(long)(t)*KVBLK*DM,(unsigned)__builtin_amdgcn_readfirstlane(kdst+(slot)))
  #define DMA_V(t,slot) glds16(vsrc+(long)(t)*KVBLK*DM,(unsigned)__builtin_amdgcn_readfirstlane(vdst+(slot)))
  const int vb0=(int)(lds0+LDS_V)+((lane>>4)&1)*32+(lane&3)*8+(4*hi+((lane&15)>>2))*64;
  const char*Kbase=shm+LDS_K; bf16x8 kf[8];
  const lds_cptr shm3=(lds_cptr)shm; const lds_cptr kp0=shm3+LDS_K+hi*1024+r32*16; const lds_cptr vp0=shm3+LDS_V+((lane>>4)&1)*32+(lane&3)*8+(4*hi+((lane&15)>>2))*64;
  const int NT=(q0+QB)/KVBLK;
  DMA_K(0,0);DMA_V(0,0);DMA_K(1,SLOTB);
  bf16x8 qr[4];
  #pragma unroll
  for(int d0=0;d0<4;++d0)qr[d0]=*reinterpret_cast<const bf16x8*>(&Qw[(long)r32*DM+d0*16+hi*8]);
  float mhat=0.f,l_reg=0.f;f32x16 o[2];o[0]=f32x16{};o[1]=f32x16{};f32x16 negm=f32x16{};asm volatile("":"+v"(negm));
  const int qrel=wid*QBLK+r32;
  #define CMASK(P0,P1,t) do{int jb_=(t)-(NT-4); if(jb_>=0)cmask(P0,P1,jb_,qrel,hi);}while(0)
  bool resc=false;
  #define START(P0,P1) do{ const float rm=rowmax(P0,P1); resc=false; \
    { const float dl=rm; mhat=fadd_s(mhat,dl); \
      _Pragma("unroll") for(int r=0;r<16;++r){P0[r]=fsub_s(P0[r],dl);P1[r]=fsub_s(P1[r],dl);} \
      _Pragma("unroll") for(int r=0;r<16;++r)negm[r]=-mhat; asm volatile("":"+v"(negm)); } \
    _Pragma("unroll") for(int r=0;r<16;++r)P0[r]=__builtin_amdgcn_exp2f(P0[r]); }while(0)
  #define RESC() do{ if(resc){ asm volatile("s_waitcnt lgkmcnt(0)":::"memory"); \
      _Pragma("unroll") for(int d_=0;d_<2;++d_) _Pragma("unroll") for(int r=0;r<16;++r)o[d_][r]*=wsf[crow(r,hi)]; } }while(0)
  f32x16 pA0,pA1,pB0,pB1;
  int sl_prev=0,sl_cur=0,sl_next=SLOTB;
  #define ROT() do{sl_prev=sl_cur;sl_cur=sl_next;sl_next=(sl_next==(NSLOT-1)*SLOTB)?0:sl_next+SLOTB;}while(0)
  DMA_K(2,2*SLOTB);
  WAIT_BAR(3);
  qkt(pA0,pA1,Kbase,qr,negm,r32,hi);asm volatile("s_nop 15\n\ts_nop 7":"+v"(pA0),"+v"(pA1));CMASK(pA0,pA1,0);
  START(pA0,pA1);
  _Pragma("unroll") for(int r=0;r<16;++r)pA1[r]=__builtin_amdgcn_exp2f(pA1[r]);
  WAIT_BAR(0);
  DMA_K(3,0);DMA_V(1,SLOTB);
  ROT();
  kload8(kf,kp0+sl_cur);
  WAIT_BAR(2);
  s16x4 vlo[8],vhi[8]; u32x4 pw0,pw1,pw2,pw3;
  #define PKW(P,B) cvtpk_s(P[B],P[B+1])
  #define PAF(k) __builtin_bit_cast(bf16x8,pw##k)
  #define VFR(i) (bf16x8){vlo[i][0],vlo[i][1],vlo[i][2],vlo[i][3],vhi[i][0],vhi[i][1],vhi[i][2],vhi[i][3]}
  #define PIN(x) asm volatile("":"+v"(x))
  #define MX3(a,b,c) __builtin_fmaxf(__builtin_fmaxf((a),(b)),(c))
  #define GAPA(MF,A0,A1,A2,A3,W0,W1,PW) do{ MF; sacc+=A0; sacc+=A1; sacc+=A2; sacc+=A3; PIN(sacc); W0; W1; PIN(PW); SBAR(); }while(0)
  #define EX(v) __builtin_amdgcn_exp2f(v)
  #define GAPB(MF,X,B) do{ MF; X[B]=EX(X[B]); X[B+1]=EX(X[B+1]); X[B+2]=EX(X[B+2]); X[B+3]=EX(X[B+3]); PIN(X); SBAR(); }while(0)
  #define VRD(i) do{ vlo[i]=vtr(vp_+(((i)>>2)*4096+((i)&3)*1024)); vhi[i]=vtr(vp_+(((i)>>2)*4096+((i)&3)*1024+512)); }while(0)
  #define KRD(G,j) do{ if(G){ kload2(kf,kp0+sl_next,j); SBAR(); } }while(0)
  #define STEP(C0,C1,P0,P1,t,GK,GV,GL) do{ SBAR(); \
    const lds_cptr vp_=vp0+sl_prev; \
    VRD(0); SBAR(); float sacc=(P0[0]+P0[1]); \
    GAPA(C0=__builtin_amdgcn_mfma_f32_32x32x16_bf16(kf[0],qr[0],negm,0,0,0), P0[2],P0[3],P0[4],P0[5],     pw0[0]=PKW(P0,0), pw0[1]=PKW(P0,2), pw0); \
    VRD(4); SBAR(); GAPA(C1=__builtin_amdgcn_mfma_f32_32x32x16_bf16(kf[1],qr[0],negm,0,0,0), P0[6],P0[7],P0[8],P0[9],     pw0[2]=PKW(P0,4), pw0[3]=PKW(P0,6), pw0); \
    VRD(1); SBAR(); GAPA(C0=__builtin_amdgcn_mfma_f32_32x32x16_bf16(kf[2],qr[1],C0,0,0,0),   P0[10],P0[11],P0[12],P0[13], pw1[0]=PKW(P0,8), pw1[1]=PKW(P0,10), pw1); \
    VRD(5); SBAR(); GAPA(C1=__builtin_amdgcn_mfma_f32_32x32x16_bf16(kf[3],qr[1],C1,0,0,0),   P0[14],P0[15],P1[0],P1[1],   pw1[2]=PKW(P0,12),pw1[3]=PKW(P0,14), pw1); \
    VRD(2); SBAR(); GAPA(C0=__builtin_amdgcn_mfma_f32_32x32x16_bf16(kf[4],qr[2],C0,0,0,0),   P1[2],P1[3],P1[4],P1[5],     pw2[0]=PKW(P1,0), pw2[1]=PKW(P1,2), pw2); \
    VRD(6); SBAR(); GAPA(C1=__builtin_amdgcn_mfma_f32_32x32x16_bf16(kf[5],qr[2],C1,0,0,0),   P1[6],P1[7],P1[8],P1[9],     pw2[2]=PKW(P1,4), pw2[3]=PKW(P1,6), pw2); \
    VRD(3); SBAR(); GAPA(C0=__builtin_amdgcn_mfma_f32_32x32x16_bf16(kf[6],qr[3],C0,0,0,0),   P1[10],P1[11],P1[12],P1[13], pw3[0]=PKW(P1,8), pw3[1]=PKW(P1,10), pw3); \
    VRD(7); SBAR(); GAPA(C1=__builtin_amdgcn_mfma_f32_32x32x16_bf16(kf[7],qr[3],C1,0,0,0),   P1[14],P1[15],0.f,0.f,       pw3[2]=PKW(P1,12),pw3[3]=PKW(P1,14), pw3); \
    l_reg+=sacc; \
    if(GK){DMA_K((t)+3,sl_cur);} if(GV){DMA_V((t)+1,sl_next);} \
    CMASK(C0,C1,t); \
    { float a=MX3(C0[0],C0[1],C1[0]),b=MX3(C0[2],C0[3],C1[1]); a=MX3(a,C1[2],C1[3]); \
      _Pragma("unroll") for(int r=4;r<16;r+=4){a=MX3(a,C0[r],C0[r+1]);b=MX3(b,C0[r+2],C0[r+3]);a=MX3(a,C1[r],C1[r+1]);b=MX3(b,C1[r+2],C1[r+3]);} \
      float rm=__builtin_fmaxf(a,b); { auto rr=__builtin_amdgcn_permlane32_swap(__float_as_uint(rm),__float_as_uint(rm),false,false); rm=__builtin_fmaxf(__uint_as_float(rr[0]),__uint_as_float(rr[1])); } \
      resc=false; \
      if(__builtin_expect(__any(rm>(float)THRL),0)){ const float dl=__builtin_fmaxf(rm,0.f); mhat+=dl; \
        _Pragma("unroll") for(int r=0;r<16;++r){C0[r]-=dl;C1[r]-=dl;} \
        _Pragma("unroll") for(int r=0;r<16;++r)negm[r]=-mhat; asm volatile("":"+v"(negm)); \
        const float f=__builtin_amdgcn_exp2f(-dl); l_reg*=f; if(hi==0)wsf[r32]=f; resc=true; } } \
    SBAR(); \
    GAPB(o[0]=__builtin_amdgcn_mfma_f32_32x32x16_bf16(PAF(0),VFR(0),o[0],0,0,0), C0,0); \
    GAPB(o[1]=__builtin_amdgcn_mfma_f32_32x32x16_bf16(PAF(0),VFR(4),o[1],0,0,0), C0,4); \
    KRD(GL,0); GAPB(o[0]=__builtin_amdgcn_mfma_f32_32x32x16_bf16(PAF(1),VFR(1),o[0],0,0,0), C0,8); \
    KRD(GL,1); GAPB(o[1]=__builtin_amdgcn_mfma_f32_32x32x16_bf16(PAF(1),VFR(5),o[1],0,0,0), C0,12); \
    KRD(GL,2); GAPB(o[0]=__builtin_amdgcn_mfma_f32_32x32x16_bf16(PAF(2),VFR(2),o[0],0,0,0), C1,0); \
    KRD(GL,3); GAPB(o[1]=__builtin_amdgcn_mfma_f32_32x32x16_bf16(PAF(2),VFR(6),o[1],0,0,0), C1,4); \
    GAPB(o[0]=__builtin_amdgcn_mfma_f32_32x32x16_bf16(PAF(3),VFR(3),o[0],0,0,0), C1,8); \
    GAPB(o[1]=__builtin_amdgcn_mfma_f32_32x32x16_bf16(PAF(3),VFR(7),o[1],0,0,0), C1,12); \
    }while(0)
  int t=1;
  #undef CMASK
  #define CMASK(P0,P1,t) do{}while(0)
  for(;t+5<NT;t+=2){
    STEP(pB0,pB1,pA0,pA1,t,true,true,true);     WAIT_BAR(2); RESC(); ROT();
    STEP(pA0,pA1,pB0,pB1,t+1,true,true,true);   WAIT_BAR(2); RESC(); ROT();
  }
  #undef CMASK
  #define CMASK(P0,P1,t) do{int jb_=(t)-(NT-4); if(jb_>=0)cmask(P0,P1,jb_,qrel,hi);}while(0)
  #define ENDW(tt) do{ if((tt)+3<NT){WAIT_BAR(2);} else if((tt)+2<NT){WAIT_BAR(1);} else {WAIT_BAR(0);} }while(0)
  for(;t+1<NT;t+=2){
    STEP(pB0,pB1,pA0,pA1,t,(t+3<NT),(t+1<NT),(t+1<NT));       ENDW(t);   RESC(); ROT();
    STEP(pA0,pA1,pB0,pB1,t+1,(t+4<NT),(t+2<NT),(t+2<NT));     ENDW(t+1); RESC(); ROT();
  }
  STEP(pB0,pB1,pA0,pA1,NT-1,false,false,false); RESC();
  { float sacc=pB0[0]+pB0[1]; _Pragma("unroll") for(int r=2;r<16;++r)sacc+=pB0[r]; _Pragma("unroll") for(int r=0;r<16;++r)sacc+=pB1[r]; l_reg+=sacc;
    pw0=(u32x4){PKW(pB0,0),PKW(pB0,2),PKW(pB0,4),PKW(pB0,6)};pw1=(u32x4){PKW(pB0,8),PKW(pB0,10),PKW(pB0,12),PKW(pB0,14)};pw2=(u32x4){PKW(pB1,0),PKW(pB1,2),PKW(pB1,4),PKW(pB1,6)};pw3=(u32x4){PKW(pB1,8),PKW(pB1,10),PKW(pB1,12),PKW(pB1,14)};
    SBAR(); pv(o,vb0+sl_cur,PAF(0),PAF(1),PAF(2),PAF(3)); }
  #undef PKW
  #undef PAF
  #undef VFR
  #undef PIN
  #undef MX3
  #undef GAPA
  #undef GAPB
  #undef EX
  #undef VRD
  #undef KRD
  #undef STEP
  #undef ENDW
  {auto rr=__builtin_amdgcn_permlane32_swap(__float_as_uint(l_reg),__float_as_uint(l_reg),false,false);l_reg=__uint_as_float(rr[0])+__uint_as_float(rr[1]);}
  if(hi==0)wsf[32+r32]=l_reg;asm volatile("s_waitcnt lgkmcnt(0)":::"memory");
  float rli[16];
  #pragma unroll
  for(int r=0;r<16;++r)rli[r]=__builtin_amdgcn_rcpf(wsf[32+crow(r,hi)]);
  bf16*Ow=O+(rowbase+q0+wid*QBLK)*DM+h*D;
  { bf16*stg=(bf16*)(shm+LDS_OST)+wid*2048;
    #pragma unroll
    for(int r=0;r<16;++r){const int orow=crow(r,hi);
      #pragma unroll
      for(int d0=0;d0<2;++d0)stg[orow*64+d0*32+r32]=__float2bfloat16(o[d0][r]*rli[r]);}
    asm volatile("s_waitcnt lgkmcnt(0)":::"memory");
    #pragma unroll
    for(int i=0;i<4;++i){const int row=i*8+(lane>>3),ch=lane&7; const u32x4 v=*(const u32x4*)(stg+row*64+ch*8); ATTN_STORE16(Ow+(long)row*DM+ch*8,v);} }
  asm volatile("s_waitcnt lgkmcnt(0)\n\ts_barrier":::"memory");
  #undef DMA_K
  #undef DMA_V
  #undef CMASK
  #undef START
  #undef RESC
  #undef ROT
}
constexpr int ATTN_LDS_BYTES=LDS_BYTES;
struct AttnTensors { const bf16* Q; const bf16* K; const bf16* V; bf16* O; };
struct AttnUnit { int bh; int qb; };
template<class Sched,int THRL=8> __device__ __forceinline__ void attn_phase(char*lds,const AttnTensors&T,const Sched&S,const int tid_in){
  AttnUnit u;
  for(int i=0;S.next(i,u);++i){ S.a_ready(u); attn_unit<THRL>(u.bh/NHEAD,u.bh%NHEAD,u.qb,T.Q,T.K,T.V,T.O,lds,tid_in); S.done(u); }
}
#undef SBAR
#undef WAIT_BAR
}
constexpr int NWAVES = 8;
constexpr int BATCH = 8, SEQ = 4096, DM = 1024, M = BATCH * SEQ;
constexpr int IN_COLS = 2560, PLE_DIM = 256, NEXP = 16384, QCOLS = 2048;
constexpr float EPS = 1e-6f;
#ifndef MK_N_LAUNCHES
#define MK_N_LAUNCHES 8
#endif
constexpr int N_PHASES = 8;
constexpr size_t MiB = 1u << 20;
constexpr size_t WS_CTL = 0, CTL_ZERO_BYTES = 1 * MiB;
constexpr size_t WS_ROPEC = 1 * MiB, WS_ROPES = 1 * MiB + 512 * 1024;
constexpr size_t WS_KEYS = 2 * MiB;
constexpr size_t WS_WPROJ = 3 * MiB;
constexpr size_t WS_WIN = 4 * MiB;
constexpr size_t WS_WOUT = 10 * MiB, WS_WQ = 12 * MiB, WS_WGATE = 16 * MiB;
constexpr size_t WS_SSQ1 = 18 * MiB;
constexpr size_t WS_PB = 24 * MiB;
constexpr size_t WS_E = 40 * MiB;
constexpr size_t WS_UT = 104 * MiB, WS_VT = 136 * MiB;
constexpr size_t WS_XN = 168 * MiB;
constexpr size_t WS_QO = 232 * MiB, WS_K = 296 * MiB, WS_V = 360 * MiB;
constexpr size_t WS_U = 424 * MiB;
constexpr size_t WS_H1B = 232 * MiB;
constexpr size_t WS_QP = 296 * MiB;
constexpr size_t WS_XN2 = 424 * MiB;
constexpr size_t WS_END = 488 * MiB;
constexpr int RING_BYTES = 131072, LDS_BYTES = 147456;
constexpr int MISC_OFF = LDS_BYTES - 256;
constexpr int CW_BAR = 4096;

#define GAS __attribute__((address_space(1)))
#define LAS __attribute__((address_space(3)))
typedef unsigned short bf16;
typedef unsigned v4u __attribute__((ext_vector_type(4)));
typedef float f32x4 __attribute__((ext_vector_type(4)));
typedef float f32x16 __attribute__((ext_vector_type(16)));
typedef short bf16x8 __attribute__((ext_vector_type(8)));
typedef __bf16 bf16x2_t __attribute__((ext_vector_type(2)));
#define LDS_WAIT() asm volatile("s_waitcnt lgkmcnt(0)" ::: "memory")
#define VM_WAIT() asm volatile("s_waitcnt vmcnt(0)" ::: "memory")
__device__ __forceinline__ unsigned f2bf(float f) { unsigned u = __builtin_bit_cast(unsigned, f); return (u + 0x7fffu + ((u >> 16) & 1u)) >> 16; }
__device__ __forceinline__ unsigned pk2(float lo, float hi) { return f2bf(lo) | (f2bf(hi) << 16); }
__device__ __forceinline__ v4u pk8(const f32x4 a, const f32x4 b) { v4u w; w.x = pk2(a[0], a[1]); w.y = pk2(a[2], a[3]); w.z = pk2(b[0], b[1]); w.w = pk2(b[2], b[3]); return w; }
__device__ __forceinline__ float bflo(unsigned w) { return __uint_as_float(w << 16); }
__device__ __forceinline__ float bfhi(unsigned w) { return __uint_as_float(w & 0xffff0000u); }
__device__ __forceinline__ float dot4s_(const f32x4 a) { return (a[0] * a[0] + a[1] * a[1]) + (a[2] * a[2] + a[3] * a[3]); }
__device__ __forceinline__ float wave_sum(float v) {
#pragma unroll
    for (int o = 1; o < 64; o <<= 1) v += __shfl_xor(v, o);
    return v;
}
__device__ __forceinline__ float dot2bf(unsigned w, unsigned x, float acc) { return __builtin_amdgcn_fdot2_f32_bf16(__builtin_bit_cast(bf16x2_t, w), __builtin_bit_cast(bf16x2_t, x), acc, false); }

typedef GAS unsigned gu32;
#define RLX_AGENT __ATOMIC_RELAXED, __HIP_MEMORY_SCOPE_AGENT
#define XB_TMO      128
#define XB_XCNT(j)  (256  + 64 * (j))
#define XB_XSUB(j)  (1280 + 64 * (j))
#define XB_XGEN(j)  (2304 + 64 * (j))
#define XB_TOP      3328
#define XB_TOPGEN   3392
#define XCD_BAR_WORDS 3456
#define XB_SPIN_CAP (1u << 18)

__device__ __forceinline__ unsigned xb_ld(unsigned* p)              { return __hip_atomic_load(p, __ATOMIC_RELAXED, __HIP_MEMORY_SCOPE_AGENT); }
__device__ __forceinline__ unsigned xb_add(unsigned* p, unsigned v) { return __hip_atomic_fetch_add(p, v, __ATOMIC_RELAXED, __HIP_MEMORY_SCOPE_AGENT); }
__device__ __forceinline__ unsigned xb_xcc_id() { return (unsigned)__builtin_amdgcn_s_getreg((3 << 11) | 20) & 0xFu; }
#define XB_SPIN(cond, bar) do { unsigned _sp = 0; while (cond) { __builtin_amdgcn_s_sleep(1); \
    if ((++_sp & 255u) == 0u) { if (xb_ld(&(bar)[XB_TMO])) break; if (_sp > XB_SPIN_CAP) { atomicAdd(&(bar)[XB_TMO], 1u); break; } } } } while (0)

struct XcdBarrier {
    unsigned* bar; unsigned x;
    volatile LAS unsigned* st;
};

__device__ __forceinline__ XcdBarrier xcd_barrier_post(unsigned* bar, volatile LAS unsigned* st, const bool leader) {
    XcdBarrier b; b.bar = bar; b.x = xb_xcc_id(); b.st = st;
    if (leader) (void)xb_add(&bar[XB_XCNT(b.x)], 1u);
    return b;
}
__device__ __forceinline__ void xcd_barrier_complete(unsigned* bar, unsigned x, unsigned& nloc, unsigned& nx) {
    const unsigned G = gridDim.x * gridDim.y * gridDim.z;
    unsigned sum, cnt, mine, sp = 0u;
    for (;;) {
        sum = 0u; cnt = 0u; mine = 0u;
#pragma unroll
        for (unsigned j = 0; j < 16; ++j) { const unsigned c = xb_ld(&bar[XB_XCNT(j)]); sum += c; cnt += (c > 0u) ? 1u : 0u; mine = (j == x) ? c : mine; }
        if (sum == G) break;
        __builtin_amdgcn_s_sleep(1);
        if ((++sp & 255u) == 0u) { if (xb_ld(&bar[XB_TMO])) break; if (sp > XB_SPIN_CAP) { atomicAdd(&bar[XB_TMO], 1u); break; } }
    }
    nloc = mine > 0u ? mine : 1u; nx = cnt > 0u ? cnt : 1u;
}

__device__ __forceinline__ void xcd_barrier(const XcdBarrier& b, const bool leader  ) {
    asm volatile("s_waitcnt vmcnt(0)" ::: "memory");
    __syncthreads();
    if (leader) {
        unsigned* bar = b.bar;
        __builtin_amdgcn_s_waitcnt(0);
        unsigned nloc = b.st[0], nx = b.st[1];
        if (nloc == 0u) { xcd_barrier_complete(bar, b.x, nloc, nx); b.st[0] = nloc; b.st[1] = nx; }
        const unsigned old = xb_add(&bar[XB_XSUB(b.x)], 1u);
        const unsigned gen = old / nloc;
        if (old + 1u == (gen + 1u) * nloc) {
            __builtin_amdgcn_fence(__ATOMIC_RELEASE, "agent");
            asm volatile("s_waitcnt vmcnt(0)" ::: "memory");
            const unsigned og = xb_add(&bar[XB_TOP], 1u);
            const unsigned tg = og / nx;
            if (og + 1u == (tg + 1u) * nx) xb_add(&bar[XB_TOPGEN], 1u);
            else XB_SPIN(xb_ld(&bar[XB_TOPGEN]) == tg, bar);
            __builtin_amdgcn_fence(__ATOMIC_ACQUIRE, "agent");
            xb_add(&bar[XB_XGEN(b.x)], 1u);
            asm volatile("s_waitcnt vmcnt(0)" ::: "memory");
        } else {
            XB_SPIN(xb_ld(&bar[XB_XGEN(b.x)]) == gen, bar);
            __builtin_amdgcn_fence(__ATOMIC_ACQUIRE, "agent");
            asm volatile("s_waitcnt vmcnt(0)" ::: "memory");
        }
    }
    __syncthreads();
}

__device__ __forceinline__ int lane_id() { int l; asm volatile("v_mbcnt_lo_u32_b32 %0, -1, 0\n\tv_mbcnt_hi_u32_b32 %0, -1, %0" : "=v"(l)); return l; }
struct Frame {
    LAS unsigned char* lds; unsigned char* ldsg;
    int wave, vcu, G;
    float* out; unsigned char* ws;
};
template <int I> __device__ __forceinline__ const float* inptr() {
    const float* p = nullptr;
#if defined(__HIP_DEVICE_COMPILE__)
    const void* ka = (const void*)__builtin_amdgcn_kernarg_segment_ptr();
    asm volatile("s_load_dwordx2 %0, %1, %2\n\ts_waitcnt lgkmcnt(0)" : "=s"(p) : "s"(ka), "i"(I * 8) : "memory");
#endif
    return p;
}
#define INP(i) inptr<i>()

__device__ const double INVREV[32] = {0.15915494309189535, 0.11934937021124886, 0.089499401608891013, 0.067115083005227255, 0.050329212104487035, 0.037741584717419771, 0.028302195830623399, 0.02122365276477766,
    0.015915494309189534, 0.011934937021124886, 0.0089499401608891024, 0.0067115083005227253, 0.0050329212104487037, 0.0037741584717419772, 0.0028302195830623399, 0.0021223652764777662,
    0.0015915494309189536, 0.0011934937021124885, 0.00089499401608891024, 0.0006711508300522726, 0.00050329212104487033, 0.00037741584717419774, 0.00028302195830623395, 0.00021223652764777661,
    0.00015915494309189535, 0.00011934937021124886, 8.9499401608891018e-05, 6.7115083005227254e-05, 5.0329212104487035e-05, 3.7741584717419777e-05, 2.8302195830623396e-05, 2.1223652764777659e-05};
__device__ __forceinline__ int win_rowmap(int n) {
    if (n < 1024) { const int region = n >> 9, r = n & 511, tile = r >> 8, w = r & 255, blk = w >> 6, d = w & 63, bj = d >> 5, dlo = d & 31; return region * 512 + tile * 256 + bj * 128 + blk * 32 + dlo; }
    if (n < 1536) return n;
    const int cc = n - 1536, isg = cc >> 9, ch = cc & 511, j = ch >> 7, c2 = ch & 127; return 1536 + j * 256 + isg * 128 + c2;
}
template <bool MAP>
__device__ __forceinline__ void p0_transpose_item(const float* W, int K, int N, bf16* WT, const float* gk, LAS float* scr, int item, int lane) {
    const int nblk = N / 32, kb = item / nblk, nb = item % nblk, k0 = 64 * kb, n0 = 32 * nb;
#pragma unroll 8
    for (int i = 0; i < 32; ++i) { const int kk = 2 * i + (lane >> 5); float v = W[(size_t)(k0 + kk) * N + n0 + (lane & 31)]; if (gk) v *= gk[k0 + kk]; scr[kk * 33 + (lane & 31)] = v; }
    LDS_WAIT(); asm volatile("" ::: "memory");
    const int c = lane & 7; const int r0 = MAP ? win_rowmap(n0) : n0;
#pragma unroll
    for (int j = 0; j < 4; ++j) { const int n = (lane >> 3) + 8 * j; const LAS float* s = scr + (8 * c) * 33 + n;
        v4u o; o.x = pk2(s[0 * 33], s[1 * 33]); o.y = pk2(s[2 * 33], s[3 * 33]); o.z = pk2(s[4 * 33], s[5 * 33]); o.w = pk2(s[6 * 33], s[7 * 33]);
        *(GAS v4u*)(WT + (size_t)(r0 + n) * K + k0 + 8 * c) = o; }
    LDS_WAIT(); asm volatile("" ::: "memory");
}
__device__ __forceinline__ void cvt_stream(const float* src, bf16* dst, size_t n8, int gw, int NGW, int lane) {
    for (size_t c = (size_t)gw * 64 + lane; c < n8; c += (size_t)NGW * 64) { const f32x4 a = *(const GAS f32x4*)(src + c * 8), b = *(const GAS f32x4*)(src + c * 8 + 4); *(GAS v4u*)(dst + c * 8) = pk8(a, b); }
}
__device__ __forceinline__ void p0_prologue(Frame& F) {
    const int lane = lane_id();
    LAS float* scr = (LAS float*)(F.lds + F.wave * 16384);
    const int gw = F.vcu * NWAVES + F.wave, NGW = F.G * NWAVES;
    bf16* WIN = (bf16*)(F.ws + WS_WIN); bf16* WOUT = (bf16*)(F.ws + WS_WOUT); bf16* WQ = (bf16*)(F.ws + WS_WQ); bf16* WGATE = (bf16*)(F.ws + WS_WGATE); bf16* WPROJ = (bf16*)(F.ws + WS_WPROJ);
    constexpr int I_IN = (DM / 64) * (IN_COLS / 32), I_OUT = (DM / 64) * (DM / 32), I_Q = (DM / 64) * (QCOLS / 32), I_G = I_OUT, I_P = (PLE_DIM / 64) * (DM / 32);
    constexpr int NITEMS = I_IN + I_OUT + I_Q + I_G + I_P;
    for (int it = gw; it < NITEMS; it += NGW) {
        int r = it;
        if (r < I_IN) { p0_transpose_item<true>(INP(3), DM, IN_COLS, WIN, nullptr, scr, r, lane); continue; } r -= I_IN;
        if (r < I_OUT) { p0_transpose_item<false>(INP(13), DM, DM, WOUT, nullptr, scr, r, lane); continue; } r -= I_OUT;
        if (r < I_Q) { p0_transpose_item<false>(INP(15), DM, QCOLS, WQ, INP(14), scr, r, lane); continue; } r -= I_Q;
        if (r < I_G) { p0_transpose_item<false>(INP(20), DM, DM, WGATE, nullptr, scr, r, lane); continue; } r -= I_G;
        p0_transpose_item<false>(INP(21), PLE_DIM, DM, WPROJ, nullptr, scr, r, lane);
    }
    cvt_stream(INP(16), (bf16*)(F.ws + WS_KEYS), (size_t)2 * 128 * 128 / 8, gw, NGW, lane);
    cvt_stream(INP(17), (bf16*)(F.ws + WS_UT), (size_t)NEXP * DM / 8, gw, NGW, lane);
    cvt_stream(INP(18), (bf16*)(F.ws + WS_VT), (size_t)NEXP * DM / 8, gw, NGW, lane);
    cvt_stream(INP(1), (bf16*)(F.ws + WS_PB), (size_t)M * PLE_DIM / 8, gw, NGW, lane);
    { float* rc = (float*)(F.ws + WS_ROPEC); float* rs = (float*)(F.ws + WS_ROPES);
      for (int idx = gw * 64 + lane; idx < SEQ * 32; idx += NGW * 64) { const int pos = idx >> 5, i = idx & 31; const double rev = (double)pos * INVREV[i]; const float fr = (float)(rev - __builtin_floor(rev));
          rc[idx] = __builtin_amdgcn_cosf(fr); rs[idx] = __builtin_amdgcn_sinf(fr); } }
    { const float* x = INP(0); const float* g = INP(2); bf16* XN = (bf16*)(F.ws + WS_XN);
      f32x4 gv[4];
#pragma unroll
      for (int j = 0; j < 4; ++j) gv[j] = ((const GAS f32x4*)g)[64 * j + lane];
      for (int m = gw; m < M; m += NGW) { const GAS f32x4* xr = (const GAS f32x4*)(x + (size_t)m * DM) + lane; f32x4 v[4]; float s2 = 0.f;
#pragma unroll
          for (int j = 0; j < 4; ++j) { v[j] = xr[64 * j]; s2 += (v[j].x * v[j].x + v[j].y * v[j].y) + (v[j].z * v[j].z + v[j].w * v[j].w); }
          const float rstd = rsqrtf(wave_sum(s2) * (1.f / DM) + EPS);
          GAS unsigned long long* o8 = (GAS unsigned long long*)(XN + (size_t)m * DM) + lane;
#pragma unroll
          for (int j = 0; j < 4; ++j) { const f32x4 w = v[j] * rstd * gv[j]; o8[64 * j] = (unsigned long long)pk2(w.x, w.y) | ((unsigned long long)pk2(w.z, w.w) << 32); } } }
}

struct AttnOrder {
    int vcu;
    __device__ __forceinline__ bool next(int i, attn_body::AttnUnit& u) const { if (i >= 8) return false; const int s = vcu & 7; u.bh = (vcu >> 5) * 16 + ((vcu >> 3) & 3) * 4 + (i & 3); u.qb = (i < 4) ? 15 - s : s; return true; }
    __device__ __forceinline__ void a_ready(const attn_body::AttnUnit&) const {}
    __device__ __forceinline__ void done(const attn_body::AttnUnit&) const {}
};
__device__ __forceinline__ void p2_attention(Frame& F) {
    { const attn_body::AttnTensors AT{(const attn_body::bf16*)(F.ws + WS_QO), (const attn_body::bf16*)(F.ws + WS_K), (const attn_body::bf16*)(F.ws + WS_V), (attn_body::bf16*)(F.ws + WS_QO)};
      const AttnOrder S{F.vcu};
      attn_body::attn_phase<AttnOrder>((char*)F.ldsg, AT, S, F.wave * 64 + lane_id()); }
    VM_WAIT(); __syncthreads();
    const int lane = lane_id();
    const float s1 = wave_sum(INP(4)[lane] * INP(5)[lane]), s2 = wave_sum(INP(6)[lane] * INP(7)[lane]);
    const float lam = __expf(s1) - __expf(s2) + 0.2f;
    const float* sg = INP(8); const float g0 = sg[2 * lane] * 0.8f, g1 = sg[2 * lane + 1] * 0.8f;
    const unsigned* O32 = (const unsigned*)(F.ws + WS_QO); unsigned* A2 = (unsigned*)(F.ws + WS_XN);
    const int b = F.vcu >> 5, h = (F.vcu >> 3) & 3, s = F.vcu & 7;
    for (int i = 0; i < 2; ++i) { const int qb = (i == 0) ? 15 - s : s;
        const size_t rbase = (size_t)b * SEQ + (size_t)qb * 256 + F.wave * 32;
        for (int r = 0; r < 32; ++r) { const size_t row = rbase + r;
            const unsigned w0 = __builtin_nontemporal_load(O32 + row * 512 + (h * 4 + 0 + (lane >> 5)) * 32 + (lane & 31)), w1 = __builtin_nontemporal_load(O32 + row * 512 + (h * 4 + 2 + (lane >> 5)) * 32 + (lane & 31));
            const float d0 = bflo(w0) - lam * bflo(w1), d1 = bfhi(w0) - lam * bfhi(w1);
            const float rstd = rsqrtf(wave_sum(d0 * d0 + d1 * d1) * (1.f / 128.f) + EPS);
            A2[row * 512 + h * 64 + lane] = pk2(d0 * rstd * g0, d1 * rstd * g1); } }
}
__device__ __forceinline__ void p2_conv(Frame& F) {
    const bf16* Ub = (const bf16*)(F.ws + WS_U); bf16* A2 = (bf16*)(F.ws + WS_XN);
    LAS float* yl = (LAS float*)F.lds;
    const int lane = lane_id(); const int c = F.wave * 64 + lane;
    float w[31];
    { const float* cw = INP(9);
#pragma unroll
      for (int j = 0; j < 31; ++j) w[j] = cw[j * 512 + c]; }
    const float bias = INP(10)[c];
    const float* lng = INP(11); const float* lnb = INP(12);
    const f32x4 lg0 = *(const f32x4*)(lng + 8 * lane), lg1 = *(const f32x4*)(lng + 8 * lane + 4), lb0 = *(const f32x4*)(lnb + 8 * lane), lb1 = *(const f32x4*)(lnb + 8 * lane + 4);
    for (int tile = F.vcu; tile < M / 32; tile += F.G) {
        const int t0 = tile * 32, pos0 = t0 & (SEQ - 1);
        float xin[62];
#pragma unroll
        for (int r = 0; r < 62; ++r) { const int p = pos0 - 30 + r; xin[r] = (p >= 0) ? __uint_as_float((unsigned)Ub[(size_t)(t0 - 30 + r) * 512 + c] << 16) : 0.f; }
#pragma unroll
        for (int t = 0; t < 32; ++t) { float y = bias;
#pragma unroll
            for (int j = 0; j < 31; ++j) y += w[j] * xin[t + j];
            yl[t * 512 + c] = y; }
        __syncthreads();
#pragma unroll
        for (int q = 0; q < 4; ++q) { const int t = F.wave * 4 + q;
            const f32x4 a = *(const LAS f32x4*)(yl + t * 512 + 8 * lane), b2 = *(const LAS f32x4*)(yl + t * 512 + 8 * lane + 4);
            const float mean = wave_sum((a[0] + a[1]) + (a[2] + a[3]) + (b2[0] + b2[1]) + (b2[2] + b2[3])) * (1.f / 512.f);
            const f32x4 da = a - mean, db = b2 - mean;
            const float var = wave_sum((da[0] * da[0] + da[1] * da[1]) + (da[2] * da[2] + da[3] * da[3]) + (db[0] * db[0] + db[1] * db[1]) + (db[2] * db[2] + db[3] * db[3])) * (1.f / 512.f);
            const float rstd = rsqrtf(var + EPS);
            f32x4 oa = da * rstd * lg0 + lb0, ob = db * rstd * lg1 + lb1;
#pragma unroll
            for (int e = 0; e < 4; ++e) { oa[e] = oa[e] * __builtin_amdgcn_rcpf(1.0f + __expf(-oa[e])); ob[e] = ob[e] * __builtin_amdgcn_rcpf(1.0f + __expf(-ob[e])); }
            *(GAS v4u*)(A2 + (size_t)(t0 + t) * 1024 + 512 + 8 * lane) = pk8(oa, ob); }
        __syncthreads();
    }
}
__device__ __forceinline__ int crow16(int r, int hi) { return (r & 3) + 8 * (r >> 2) + 4 * hi; }
__device__ __forceinline__ unsigned enc_key(float f, unsigned tag, unsigned mask) { unsigned u = __float_as_uint(f); u = (u & 0x80000000u) ? ~u : (u | 0x80000000u); return (u & ~mask) | tag; }
__device__ __forceinline__ float dec_key(unsigned k, unsigned mask) { unsigned u = k & ~mask; u = (u & 0x80000000u) ? (u & 0x7fffffffu) : ~u; return __uint_as_float(u); }
__device__ __forceinline__ void ce_desc(unsigned& a, unsigned& b) { const unsigned mx = a > b ? a : b, mn = a > b ? b : a; a = mx; b = mn; }
template <int K, int J> __device__ __forceinline__ void bitonic_stage16(unsigned (&a)[16]) {
#pragma unroll
    for (int i = 0; i < 16; ++i) { const int l = i ^ J; if (l > i) { if ((i & K) == 0) ce_desc(a[i], a[l]); else ce_desc(a[l], a[i]); } }
}
__device__ __forceinline__ void sort16_desc(unsigned (&a)[16]) {
    bitonic_stage16<2, 1>(a); bitonic_stage16<4, 2>(a); bitonic_stage16<4, 1>(a); bitonic_stage16<8, 4>(a); bitonic_stage16<8, 2>(a); bitonic_stage16<8, 1>(a);
    bitonic_stage16<16, 8>(a); bitonic_stage16<16, 4>(a); bitonic_stage16<16, 2>(a); bitonic_stage16<16, 1>(a);
}
__device__ __forceinline__ void merge16_desc(unsigned (&a)[16], const unsigned (&b)[16]) {
#pragma unroll
    for (int i = 0; i < 16; ++i) a[i] = a[i] > b[15 - i] ? a[i] : b[15 - i];
    bitonic_stage16<16, 8>(a); bitonic_stage16<16, 4>(a); bitonic_stage16<16, 2>(a); bitonic_stage16<16, 1>(a);
}
__device__ __forceinline__ void top16_of_64(unsigned (&k)[4][16]) {
    sort16_desc(k[0]); sort16_desc(k[1]); sort16_desc(k[2]); sort16_desc(k[3]);
    merge16_desc(k[0], k[1]); merge16_desc(k[2], k[3]); merge16_desc(k[0], k[2]);
}
__host__ __device__ constexpr int cand_i(int s) { int c = 0; for (int i = 0; i < 16; ++i) { const int nj = 16 / (i + 1); if (s < c + nj) return i; c += nj; } return -1; }
__host__ __device__ constexpr int cand_j(int s) { int c = 0; for (int i = 0; i < 16; ++i) { const int nj = 16 / (i + 1); if (s < c + nj) return s - c; c += nj; } return -1; }
template <int S> __device__ __forceinline__ void cand_fill(unsigned (&c)[4][16], const float (&v0)[16], const float (&v1)[16]) {
    if constexpr (S < 64) { constexpr int i = cand_i(S), j = cand_j(S);
        if constexpr (i >= 0) c[S >> 4][S & 15] = enc_key(v0[i] + v1[j], 255u - (unsigned)(i * 16 + j), 255u); else c[S >> 4][S & 15] = 0u;
        cand_fill<S + 1>(c, v0, v1); }
}
__device__ __forceinline__ float gelu_exact(float v) {
    const float av = __builtin_fabsf(v), d = av * 0.2316418882f + 1.0f, t = __builtin_amdgcn_rcpf(d);
    float q = t * 0.5307027145f + (-0.7265760135f); q = q * t + 0.7107068705f; q = q * t + (-0.142248368f); q = q * t + 0.127414796f; q = q * t;
    const float e = __builtin_amdgcn_exp2f((v * v) * (-0.72134752044f)); const float m = v * (q * e); return v < 0.f ? m : v - m;
}
constexpr int P5_TOK = 32;
constexpr int P5_KEYS = 0, P5_LS = 65536, P5_EID = 65536 + 33792, P5_GATE = 65536 + 33792 + 16384;
__device__ __forceinline__ void p5_peer(Frame& F) {
    const bf16* QP = (const bf16*)(F.ws + WS_QP); const bf16* KEYS = (const bf16*)(F.ws + WS_KEYS);
    const unsigned char* UT = F.ws + WS_UT; const unsigned char* VT = F.ws + WS_VT; bf16* XN2 = (bf16*)(F.ws + WS_XN2);
    LAS unsigned* lsc = (LAS unsigned*)(F.lds + P5_LS) + (F.wave * 32 + (lane_id() & 31)) * 33; LAS unsigned* eidL = (LAS unsigned*)(F.lds + P5_EID); LAS float* gateL = (LAS float*)(F.lds + P5_GATE);
    const int lane = lane_id(), tid = F.wave * 64 + lane, r32 = lane & 31, hi = lane >> 5, h = F.wave;
    const float* gffn = INP(14); const float* gple = INP(19);
#pragma unroll
    for (int i = 0; i < 8; ++i) { const int q = tid + 512 * i, row = q >> 4, ch = q & 15; *(LAS v4u*)(F.lds + P5_KEYS + row * 256 + ((ch ^ (row & 15)) << 4)) = *(const GAS v4u*)(KEYS + row * 128 + ch * 8); }
    __syncthreads();
    const LAS unsigned char* kl = F.lds + P5_KEYS + r32 * 256;
    for (int tile = F.vcu; tile < M / P5_TOK; tile += F.G) {
        const size_t t0 = (size_t)tile * P5_TOK;
        float sv[2][16];
#pragma unroll
        for (int c = 0; c < 2; ++c) {
            bf16x8 qf[8];
#pragma unroll
            for (int ks = 0; ks < 8; ++ks) qf[ks] = *(const bf16x8*)(QP + (t0 + r32) * QCOLS + h * 256 + c * 128 + ks * 16 + hi * 8);
            unsigned key[4][16];
#pragma unroll
            for (int nb = 0; nb < 4; ++nb) { f32x16 acc = {}; asm volatile("" ::: "memory");
#pragma unroll
                for (int ks = 0; ks < 8; ++ks) { const bf16x8 kf = *(const LAS bf16x8*)(kl + (c * 128 + nb * 32) * 256 + (((ks * 2 + hi) ^ (r32 & 15)) << 4)); acc = __builtin_amdgcn_mfma_f32_32x32x16_bf16(kf, qf[ks], acc, 0, 0, 0); }
#pragma unroll
                for (int r = 0; r < 16; ++r) key[nb][r] = enc_key(acc[r], 127u - (unsigned)(nb * 32 + crow16(r, hi)), 127u); }
            top16_of_64(key);
            unsigned other[16];
#pragma unroll
            for (int i = 0; i < 16; ++i) other[i] = __shfl_xor(key[0][i], 32);
            merge16_desc(key[0], other);
#pragma unroll
            for (int i = 0; i < 16; ++i) { sv[c][i] = dec_key(key[0][i], 127u); if (hi == 0) lsc[c * 16 + i] = key[0][i]; }
        }
        asm volatile("" ::: "memory");
        unsigned cand[4][16];
        cand_fill<0>(cand, sv[0], sv[1]);
        top16_of_64(cand);
        LDS_WAIT();
        { float wv[16]; float wsum = 0.f; const float mx = dec_key(cand[0][0], 255u);
#pragma unroll
          for (int k = 0; k < 16; ++k) { wv[k] = __expf(dec_key(cand[0][k], 255u) - mx); wsum += wv[k]; }
          const float rs = 1.0f / wsum;
#pragma unroll
          for (int k = 0; k < 16; ++k) { const unsigned id = 255u - (cand[0][k] & 255u); const unsigned k0 = lsc[id >> 4], k1 = lsc[16 + (id & 15u)];
              const unsigned e = (127u - (k0 & 127u)) * 128u + (127u - (k1 & 127u));
              if (hi == 0) { eidL[r32 * 128 + h * 16 + k] = e; gateL[r32 * 128 + h * 16 + k] = wv[k] * rs; } } }
        __syncthreads();
#pragma unroll 1
        for (int j = 0; j < 4; ++j) {
            const int tl = F.wave * 4 + j; const size_t tok = t0 + tl; float* hrow = F.out + tok * DM;
            const f32x4 ha0 = *(const f32x4*)(hrow + 8 * lane), ha1 = *(const f32x4*)(hrow + 8 * lane + 4), hb0 = *(const f32x4*)(hrow + 512 + 8 * lane), hb1 = *(const f32x4*)(hrow + 512 + 8 * lane + 4);
            const float rstd1 = rsqrtf(wave_sum(dot4s_(ha0) + dot4s_(ha1) + dot4s_(hb0) + dot4s_(hb1)) * (1.f / DM) + EPS);
            unsigned mp[8];
            { const f32x4 g0 = *(const f32x4*)(gffn + 8 * lane), g1 = *(const f32x4*)(gffn + 8 * lane + 4), g2 = *(const f32x4*)(gffn + 512 + 8 * lane), g3 = *(const f32x4*)(gffn + 512 + 8 * lane + 4);
              const v4u a = pk8(ha0 * rstd1 * g0, ha1 * rstd1 * g1), b = pk8(hb0 * rstd1 * g2, hb1 * rstd1 * g3);
              mp[0] = a.x; mp[1] = a.y; mp[2] = a.z; mp[3] = a.w; mp[4] = b.x; mp[5] = b.y; mp[6] = b.z; mp[7] = b.w; }
            const unsigned ev0 = eidL[tl * 128 + lane], ev1 = eidL[tl * 128 + 64 + lane];
            float alo = 0.f, ahi = 0.f;
#pragma unroll 1
            for (int kg = 0; kg < 16; ++kg) {
                const unsigned evs = kg < 8 ? ev0 : ev1;
                v4u ra[8], rb[8];
#pragma unroll
                for (int q = 0; q < 8; ++q) { const unsigned e = __builtin_amdgcn_readlane(evs, (kg * 8 + q) & 63); const unsigned char* rp = UT + (size_t)e * 2048 + lane * 16;
                    ra[q] = *(const GAS v4u*)rp; rb[q] = *(const GAS v4u*)(rp + 1024); }
#pragma unroll
                for (int q = 0; q < 8; ++q) { float p = dot2bf(ra[q].x, mp[0], 0.f); p = dot2bf(ra[q].y, mp[1], p); p = dot2bf(ra[q].z, mp[2], p); p = dot2bf(ra[q].w, mp[3], p);
                    p = dot2bf(rb[q].x, mp[4], p); p = dot2bf(rb[q].y, mp[5], p); p = dot2bf(rb[q].z, mp[6], p); p = dot2bf(rb[q].w, mp[7], p);
                    p = wave_sum(p); const int k = kg * 8 + q; alo = (lane == k) ? p : alo; ahi = (lane == k - 64) ? p : ahi; }
            }
            const float hlo = gelu_exact(alo) * gateL[tl * 128 + lane], hhi = gelu_exact(ahi) * gateL[tl * 128 + 64 + lane];
            float y[16];
#pragma unroll
            for (int i = 0; i < 16; ++i) y[i] = 0.f;
#pragma unroll 1
            for (int kg = 0; kg < 16; ++kg) {
                const unsigned evs = kg < 8 ? ev0 : ev1; const float hvs = kg < 8 ? hlo : hhi;
                v4u ra[8], rb[8];
#pragma unroll
                for (int q = 0; q < 8; ++q) { const unsigned e = __builtin_amdgcn_readlane(evs, (kg * 8 + q) & 63); const unsigned char* rp = VT + (size_t)e * 2048 + lane * 16;
                    ra[q] = *(const GAS v4u*)rp; rb[q] = *(const GAS v4u*)(rp + 1024); }
#pragma unroll
                for (int q = 0; q < 8; ++q) { const float hk = __uint_as_float(__builtin_amdgcn_readlane(__float_as_uint(hvs), (kg * 8 + q) & 63));
                    y[0] += hk * bflo(ra[q].x); y[1] += hk * bfhi(ra[q].x); y[2] += hk * bflo(ra[q].y); y[3] += hk * bfhi(ra[q].y); y[4] += hk * bflo(ra[q].z); y[5] += hk * bfhi(ra[q].z); y[6] += hk * bflo(ra[q].w); y[7] += hk * bfhi(ra[q].w);
                    y[8] += hk * bflo(rb[q].x); y[9] += hk * bfhi(rb[q].x); y[10] += hk * bflo(rb[q].y); y[11] += hk * bfhi(rb[q].y); y[12] += hk * bflo(rb[q].z); y[13] += hk * bfhi(rb[q].z); y[14] += hk * bflo(rb[q].w); y[15] += hk * bfhi(rb[q].w); }
            }
            const f32x4 n0 = ha0 + (f32x4){y[0], y[1], y[2], y[3]}, n1 = ha1 + (f32x4){y[4], y[5], y[6], y[7]}, n2 = hb0 + (f32x4){y[8], y[9], y[10], y[11]}, n3 = hb1 + (f32x4){y[12], y[13], y[14], y[15]};
            const float rstd2 = rsqrtf(wave_sum(dot4s_(n0) + dot4s_(n1) + dot4s_(n2) + dot4s_(n3)) * (1.f / DM) + EPS);
            *(f32x4*)(hrow + 8 * lane) = n0; *(f32x4*)(hrow + 8 * lane + 4) = n1; *(f32x4*)(hrow + 512 + 8 * lane) = n2; *(f32x4*)(hrow + 512 + 8 * lane + 4) = n3;
            const f32x4 p0 = *(const f32x4*)(gple + 8 * lane), p1 = *(const f32x4*)(gple + 8 * lane + 4), p2 = *(const f32x4*)(gple + 512 + 8 * lane), p3 = *(const f32x4*)(gple + 512 + 8 * lane + 4);
            *(GAS v4u*)(XN2 + tok * DM + 8 * lane) = pk8(n0 * rstd2 * p0, n1 * rstd2 * p1); *(GAS v4u*)(XN2 + tok * DM + 512 + 8 * lane) = pk8(n2 * rstd2 * p2, n3 * rstd2 * p3);
        }
        __syncthreads();
    }
}
__device__ __forceinline__ void p7_final(Frame& F) {
    const int lane = lane_id(); const int gw = F.vcu * NWAVES + F.wave, NGW = F.G * NWAVES; const float* g = INP(22);
    f32x4 gv[4];
#pragma unroll
    for (int j = 0; j < 4; ++j) gv[j] = ((const GAS f32x4*)g)[64 * j + lane];
    for (int m = gw; m < M; m += NGW) { GAS f32x4* xr = (GAS f32x4*)(F.out + (size_t)m * DM) + lane; f32x4 v[4]; float s2 = 0.f;
#pragma unroll
        for (int j = 0; j < 4; ++j) { v[j] = xr[64 * j]; s2 += (v[j].x * v[j].x + v[j].y * v[j].y) + (v[j].z * v[j].z + v[j].w * v[j].w); }
        const float rstd = rsqrtf(wave_sum(s2) * (1.f / DM) + EPS);
#pragma unroll
        for (int j = 0; j < 4; ++j) xr[64 * j] = v[j] * rstd * gv[j]; }
}
struct Args { const float* in[23]; float* out; unsigned char* ws; int ph_lo, ph_hi; };
__global__ void __launch_bounds__(NWAVES * 64, 2) hymba_fwd(Args args) {
    extern __shared__ __attribute__((aligned(16))) unsigned char lds[];
    cg::grid_group grid = cg::this_grid();
    Frame F;
    F.lds = (LAS unsigned char*)lds; F.ldsg = lds;
    F.wave = __builtin_amdgcn_readfirstlane(threadIdx.x >> 6);
    F.G = gridDim.x; { const int bx = blockIdx.x; F.vcu = (F.G % 8 == 0) ? (bx % 8) * (F.G / 8) + bx / 8 : bx; }
    F.out = args.out; F.ws = args.ws;
    const int lo = args.ph_lo, hi = args.ph_hi;
#ifdef ONLY_PH
#define IN(k) ((k) == ONLY_PH)
#else
#define IN(k) (lo <= (k) && (k) < hi)
#endif
#define BOTH(k) (IN(k) && IN((k) + 1))
    { const int l0 = lane_id(); if (F.wave == 0) ((volatile LAS unsigned*)(F.lds + MISC_OFF))[l0] = 0u; }
    __syncthreads();
    const XcdBarrier bar = xcd_barrier_post((unsigned*)(F.ws + WS_CTL) + CW_BAR, (volatile LAS unsigned*)(F.lds + MISC_OFF) + 8, F.wave == 0 && lane_id() == 0);
#define GRID_BAR(k) do { if ((k) == 0) grid.sync(); else xcd_barrier(bar, F.wave == 0 && lane_id() == 0); } while (0)
    if (IN(0)) { p0_prologue(F); if (BOTH(0)) GRID_BAR(0); }
    if (IN(1)) {
        { pg8::Gemm g{(const pg8::bf16_t*)(F.ws + WS_XN), (const pg8::bf16_t*)(F.ws + WS_WIN), M, IN_COLS, DM}; pg8::StaticOrder S; S.init(M, IN_COLS, F.G, (int)blockIdx.x);
          pg8::EpiIn E{(pg8::bf16_t*)(F.ws + WS_QO), (pg8::bf16_t*)(F.ws + WS_K), (pg8::bf16_t*)(F.ws + WS_V), (pg8::bf16_t*)(F.ws + WS_U), (const float*)(F.ws + WS_ROPEC), (const float*)(F.ws + WS_ROPES), attn_body::C2};
          pg8::gemm_phase<pg8::EpiIn, pg8::StaticOrder, true, true>(F.lds, g, S, E, F.wave); }
        { pg8::Gemm g{(const pg8::bf16_t*)(F.ws + WS_PB), (const pg8::bf16_t*)(F.ws + WS_WPROJ), M, DM, PLE_DIM}; pg8::StaticOrder S; S.init(M, DM, F.G, (int)blockIdx.x);
          pg8::EpiBf16<0> E{(pg8::bf16_t*)(F.ws + WS_E), DM, nullptr, 0, 0, 1.f};
          pg8::gemm_phase<pg8::EpiBf16<0>, pg8::StaticOrder, true, true>(F.lds, g, S, E, F.wave); }
        if (BOTH(1)) GRID_BAR(1);
    }
    if (IN(2)) { p2_attention(F); p2_conv(F); if (BOTH(2)) GRID_BAR(2); }
    if (IN(3)) {
        pg8::Gemm g{(const pg8::bf16_t*)(F.ws + WS_XN), (const pg8::bf16_t*)(F.ws + WS_WOUT), M, DM, DM}; pg8::StaticOrder S; S.init(M, DM, F.G, (int)blockIdx.x);
        pg8::EpiOut E{INP(0), F.out, (pg8::bf16_t*)(F.ws + WS_H1B), (float*)(F.ws + WS_SSQ1)};
        pg8::gemm_phase<pg8::EpiOut, pg8::StaticOrder, true, true>(F.lds, g, S, E, F.wave);
        if (BOTH(3)) GRID_BAR(3);
    }
    if (IN(4)) {
        pg8::Gemm g{(const pg8::bf16_t*)(F.ws + WS_H1B), (const pg8::bf16_t*)(F.ws + WS_WQ), M, QCOLS, DM}; pg8::StaticOrder S; S.init(M, QCOLS, F.G, (int)blockIdx.x);
        pg8::EpiQ E{(const float*)(F.ws + WS_SSQ1), (pg8::bf16_t*)(F.ws + WS_QP), EPS};
        pg8::gemm_phase<pg8::EpiQ, pg8::StaticOrder, true, true>(F.lds, g, S, E, F.wave);
        if (BOTH(4)) GRID_BAR(4);
    }
    if (IN(5)) { p5_peer(F); if (BOTH(5)) GRID_BAR(5); }
    if (IN(6)) {
        pg8::Gemm g{(const pg8::bf16_t*)(F.ws + WS_XN2), (const pg8::bf16_t*)(F.ws + WS_WGATE), M, DM, DM}; pg8::StaticOrder S; S.init(M, DM, F.G, (int)blockIdx.x);
        pg8::EpiGate E{F.out, (const pg8::bf16_t*)(F.ws + WS_E)};
        pg8::gemm_phase<pg8::EpiGate, pg8::StaticOrder, true, true>(F.lds, g, S, E, F.wave);
        if (BOTH(6)) GRID_BAR(6);
    }
    if (IN(7)) p7_final(F);
#undef IN
#undef BOTH
}

extern "C" void kernel_launch(void* const* d_in, const int* in_sizes, int n_in, void* d_out, int out_size, void* d_ws, size_t ws_size, hipStream_t stream) {
    static int grid = 0;
    if (grid == 0) {
        if (n_in != 23 || in_sizes[0] != M * DM || out_size != M * DM || ws_size < WS_END) { fprintf(stderr, "kernel_launch: unexpected shapes (n_in %d, in0 %d, out %d, ws %zu); nothing launched\n", n_in, n_in > 0 ? in_sizes[0] : -1, out_size, ws_size); grid = -1; return; }
        int dev = 0, cus = 0, per_cu = 0;
        if (hipGetDevice(&dev) != hipSuccess || hipDeviceGetAttribute(&cus, hipDeviceAttributeMultiprocessorCount, dev) != hipSuccess) { fprintf(stderr, "kernel_launch: device query failed\n"); grid = -1; return; }
        if (hipFuncSetAttribute((const void*)hymba_fwd, hipFuncAttributeMaxDynamicSharedMemorySize, LDS_BYTES) != hipSuccess) { fprintf(stderr, "kernel_launch: hipFuncSetAttribute failed\n"); grid = -1; return; }
        if (hipOccupancyMaxActiveBlocksPerMultiprocessor(&per_cu, (const void*)hymba_fwd, NWAVES * 64, LDS_BYTES) != hipSuccess || per_cu < 1) { fprintf(stderr, "kernel_launch: occupancy query says %d blocks per CU\n", per_cu); (void)hipGetLastError(); grid = -1; return; }
        grid = cus * per_cu;
        if (grid != 256) { fprintf(stderr, "kernel_launch: this kernel's attention order needs exactly 256 resident workgroups (got %d x %d); nothing launched\n", cus, per_cu); grid = -1; return; }
    }
    if (grid < 0) return;
    if (hipMemsetAsync((char*)d_ws + WS_CTL, 0, CTL_ZERO_BYTES, stream) != hipSuccess) { fprintf(stderr, "kernel_launch: hipMemsetAsync failed\n"); return; }
    Args a{};
    for (int i = 0; i < 23; ++i) a.in[i] = (const float*)d_in[i];
    a.out = (float*)d_out; a.ws = (unsigned char*)d_ws;
#if MK_N_LAUNCHES == 1
    a.ph_lo = 0; a.ph_hi = N_PHASES;
    void* kargs[] = {&a};
    hipError_t e = hipLaunchCooperativeKernel((const void*)hymba_fwd, dim3(grid), dim3(NWAVES * 64), kargs, LDS_BYTES, stream);
    if (e != hipSuccess) fprintf(stderr, "kernel_launch: cooperative launch failed: %s (grid %d)\n", hipGetErrorString(e), grid);
#else
    for (int li = 0; li < N_PHASES; ++li) { a.ph_lo = li; a.ph_hi = li + 1;
        hipLaunchKernelGGL(hymba_fwd, dim3(grid), dim3(NWAVES * 64), LDS_BYTES, stream, a);
        const hipError_t le = hipPeekAtLastError(); if (le != hipSuccess) { fprintf(stderr, "kernel_launch: launch %d failed: %s\n", li, hipGetErrorName(le)); break; } }
#endif
}
```

```cpp
#include <hip/hip_runtime.h>
#include <hip/hip_cooperative_groups.h>
#include <cstdio>
#include <cstdint>
namespace cg = cooperative_groups;
namespace pg8 {
#define PG8_LAS __attribute__((address_space(3)))
typedef unsigned short bf16_t;
typedef short bf16x8 __attribute__((ext_vector_type(8)));
typedef float f32x4 __attribute__((ext_vector_type(4)));
typedef unsigned u32x4 __attribute__((ext_vector_type(4)));
constexpr int BM = 256, BK = 64, HALF = 128, HTB = HALF * BK * 2  , STAGE_BYTES = 8 * HTB, NXCD = 8, WGM = 8;

__host__ __device__ __forceinline__ int lds_byte(int r, int c) { const int st = (r >> 4) * 2 + (c >> 5), rr = r & 15, cc = c & 31, ob = rr * 64 + cc * 2; return st * 1024 + (ob ^ (((ob >> 9) & 1) << 5)); }
__host__ __device__ __forceinline__ void stage_rc(int b, int& R, int& C) { const int st = b / 1024, sb = b % 1024, swz = sb ^ (((sb >> 9) & 1) << 5); R = (st >> 1) * 16 + swz / 64; C = (st & 1) * 32 + (swz % 64) / 2; }
__host__ __device__ __forceinline__ int perm32(int rho) { const int n = rho >> 4, i = rho & 15; return 8 * (i >> 2) + 4 * n + (i & 3); }

struct Unit { int pm, pn; };
struct Gemm { const bf16_t* A; const bf16_t* Bt; int M, N, K; };

struct StaticOrder {
    int nM, nN, nwg, G, c;
    __host__ __device__ void init(int M, int N, int G_, int c_) { nM = M / BM; nN = N / BM; nwg = nM * nN; G = G_; c = c_; }
    __host__ __device__ bool next(int i, Unit& u) const {
        const long L = (long)i * G + c; if (L >= nwg) return false;
        int wgid = (int)L; { const int q = nwg / NXCD, r = nwg % NXCD, xcd = wgid % NXCD, off = wgid / NXCD; wgid = (xcd < r ? xcd * (q + 1) : r * (q + 1) + (xcd - r) * q) + off; }
        const int nig = WGM * nN, gid = wgid / nig, fm = gid * WGM, gsz = (nM - fm) < WGM ? (nM - fm) : WGM;
        u.pm = fm + ((wgid % nig) % gsz); u.pn = (wgid % nig) / gsz; return true;
    }
    __device__ __forceinline__ void a_ready(const Unit&) const {}
    __device__ __forceinline__ void done(const Unit&) const {}
};

__device__ __forceinline__ unsigned cvt_pk_bf16(float lo, float hi) { unsigned r; asm volatile("v_cvt_pk_bf16_f32 %0, %1, %2" : "=v"(r) : "v"(lo), "v"(hi)); return r; }
typedef float f32x2 __attribute__((ext_vector_type(2)));
__device__ __forceinline__ f32x2 gelu_pk(f32x2 v) {
    const f32x2 av = __builtin_elementwise_abs(v), d = av * 0.2316418882f + 1.0f;
    f32x2 t; t.x = __builtin_amdgcn_rcpf(d.x); t.y = __builtin_amdgcn_rcpf(d.y);
    f32x2 q = t * 0.5307027145f + (-0.7265760135f); q = q * t + 0.7107068705f; q = q * t + (-0.142248368f); q = q * t + 0.127414796f; q = q * t;
    const f32x2 s = (v * v) * (-0.72134752044f);
    f32x2 e; e.x = __builtin_amdgcn_exp2f(s.x); e.y = __builtin_amdgcn_exp2f(s.y);
    const f32x2 m = v * (q * e), r = v - m;
    f32x2 o; o.x = v.x < 0.f ? m.x : r.x; o.y = v.y < 0.f ? m.y : r.y; return o;
}

template <int ACT  > struct EpiBf16 {
    static constexpr bool PERM = true, AFTER_DRAIN = false; static_assert(ACT == 0 || ACT == 1, "EpiBf16: ACT is 0 (none) or 1 (gelu_pk)");
    bf16_t* O; int ldc; const float* bias; int split_cols; size_t split_stride; float scale0;
    __device__ __forceinline__ void operator()(const f32x4 (&acc)[2][2][4][2], const Unit& u, int wr, int wc, int fr, int fq) const {
        const int row0 = u.pm * BM + wr * 64 + fr; int colt = u.pn * BM; bf16_t* base = O;
        float sc = 1.f; if (split_cols) { const int t = colt / split_cols; base += (size_t)t * split_stride; colt -= t * split_cols; if (t == 0) sc = scale0; }
        const int col0 = colt + wc * 32 + 8 * fq, bcol0 = u.pn * BM + wc * 32 + 8 * fq;
        f32x4 bv[2][2];
#pragma unroll
        for (int bj = 0; bj < 2; ++bj)
#pragma unroll
            for (int n = 0; n < 2; ++n) bv[bj][n] = bias ? *(const f32x4*)(bias + bcol0 + bj * HALF + 4 * n) : (f32x4){0.f, 0.f, 0.f, 0.f};
#pragma unroll
        for (int ai = 0; ai < 2; ++ai)
#pragma unroll
            for (int m = 0; m < 4; ++m) { bf16_t* rowp = base + (size_t)(row0 + ai * HALF + m * 16) * ldc + col0;
#pragma unroll
                for (int bj = 0; bj < 2; ++bj) { f32x4 v0 = acc[ai][bj][m][0] + bv[bj][0], v1 = acc[ai][bj][m][1] + bv[bj][1];
                    if (ACT == 1) { f32x2 a = gelu_pk((f32x2){v0[0], v0[1]}), b = gelu_pk((f32x2){v0[2], v0[3]}), c = gelu_pk((f32x2){v1[0], v1[1]}), d = gelu_pk((f32x2){v1[2], v1[3]});
                        v0 = (f32x4){a.x, a.y, b.x, b.y}; v1 = (f32x4){c.x, c.y, d.x, d.y}; }
                    v0 = v0 * sc; v1 = v1 * sc; u32x4 w; w.x = cvt_pk_bf16(v0[0], v0[1]); w.y = cvt_pk_bf16(v0[2], v0[3]); w.z = cvt_pk_bf16(v1[0], v1[1]); w.w = cvt_pk_bf16(v1[2], v1[3]);
                    *(u32x4*)(rowp + bj * HALF) = w; } }
    }
};
__device__ __forceinline__ float sigmoid_fast(float x) { return __builtin_amdgcn_rcpf(1.0f + __expf(-x)); }
__device__ __forceinline__ f32x4 sigmoid4(f32x4 x) { f32x4 r; r[0] = sigmoid_fast(x[0]); r[1] = sigmoid_fast(x[1]); r[2] = sigmoid_fast(x[2]); r[3] = sigmoid_fast(x[3]); return r; }
__device__ __forceinline__ u32x4 pack8(const f32x4 a, const f32x4 b) { u32x4 w; w.x = cvt_pk_bf16(a[0], a[1]); w.y = cvt_pk_bf16(a[2], a[3]); w.z = cvt_pk_bf16(b[0], b[1]); w.w = cvt_pk_bf16(b[2], b[3]); return w; }
__device__ __forceinline__ float dot4s(const f32x4 a) { return (a[0] * a[0] + a[1] * a[1]) + (a[2] * a[2] + a[3] * a[3]); }

struct EpiIn {
    static constexpr bool PERM = true, AFTER_DRAIN = false;
    bf16_t *Q, *Kk, *V, *U; const float* ropec; const float* ropes; float qscale;
    __device__ __forceinline__ void operator()(const f32x4 (&acc)[2][2][4][2], const Unit& u, int wr, int wc, int fr, int fq) const {
        const int row0 = u.pm * BM + wr * 64 + fr; const int pn = u.pn;
        if (pn < 4) {
            bf16_t* dst = (pn < 2) ? Q : Kk; const float sc = (pn < 2) ? qscale : 1.0f; const int colb = ((pn & 1) * 4 + wc) * 128 + 8 * fq;
#pragma unroll
            for (int ai = 0; ai < 2; ++ai)
#pragma unroll
                for (int m = 0; m < 4; ++m) { const int row = row0 + ai * HALF + m * 16; const int pos = row & 4095;
                    const f32x4 c0 = *(const f32x4*)(ropec + pos * 32 + 8 * fq), c1 = *(const f32x4*)(ropec + pos * 32 + 8 * fq + 4);
                    const f32x4 s0 = *(const f32x4*)(ropes + pos * 32 + 8 * fq), s1 = *(const f32x4*)(ropes + pos * 32 + 8 * fq + 4);
                    const f32x4 x10 = acc[ai][0][m][0], x11 = acc[ai][0][m][1], x20 = acc[ai][1][m][0], x21 = acc[ai][1][m][1];
                    const f32x4 o10 = (x10 * c0 - x20 * s0) * sc, o11 = (x11 * c1 - x21 * s1) * sc, o20 = (x20 * c0 + x10 * s0) * sc, o21 = (x21 * c1 + x11 * s1) * sc;
                    bf16_t* rp = dst + (size_t)row * 1024 + colb; const u32x4 w1 = pack8(o10, o11), w2 = pack8(o20, o21);
                    *(u32x4*)rp = w1; *(u32x4*)(rp + 32) = w2; *(u32x4*)(rp + 64) = w1; *(u32x4*)(rp + 96) = w2; }
        } else if (pn < 6) {
#pragma unroll
            for (int ai = 0; ai < 2; ++ai)
#pragma unroll
                for (int m = 0; m < 4; ++m) { const int row = row0 + ai * HALF + m * 16;
#pragma unroll
                    for (int bj = 0; bj < 2; ++bj) { const int hh = (pn - 4) * 2 + bj, vh = wc >> 1, d = (wc & 1) * 32 + 8 * fq;
                        const u32x4 w = pack8(acc[ai][bj][m][0], acc[ai][bj][m][1]); bf16_t* rp = V + (size_t)row * 1024 + (hh * 4 + vh) * 64 + d; *(u32x4*)rp = w; *(u32x4*)(rp + 128) = w; } }
        } else {
#pragma unroll
            for (int ai = 0; ai < 2; ++ai)
#pragma unroll
                for (int m = 0; m < 4; ++m) { const int row = row0 + ai * HALF + m * 16;
                    const f32x4 u0 = acc[ai][0][m][0] * sigmoid4(acc[ai][1][m][0]), u1 = acc[ai][0][m][1] * sigmoid4(acc[ai][1][m][1]);
                    *(u32x4*)(U + (size_t)row * 512 + (pn - 6) * 128 + wc * 32 + 8 * fq) = pack8(u0, u1); }
        }
    }
};
struct EpiOut {
    static constexpr bool PERM = true, AFTER_DRAIN = false;
    const float* x; float* out; bf16_t* hb; float* ssq;
    __device__ __forceinline__ void operator()(const f32x4 (&acc)[2][2][4][2], const Unit& u, int wr, int wc, int fr, int fq) const {
        const int row0 = u.pm * BM + wr * 64 + fr;
#pragma unroll
        for (int ai = 0; ai < 2; ++ai)
#pragma unroll
            for (int m = 0; m < 4; ++m) { const int row = row0 + ai * HALF + m * 16; float ss = 0.f;
#pragma unroll
                for (int bj = 0; bj < 2; ++bj) { const size_t off = (size_t)row * 1024 + u.pn * BM + bj * HALF + wc * 32 + 8 * fq;
                    const f32x4 h0 = acc[ai][bj][m][0] + *(const f32x4*)(x + off), h1 = acc[ai][bj][m][1] + *(const f32x4*)(x + off + 4);
                    *(f32x4*)(out + off) = h0; *(f32x4*)(out + off + 4) = h1; *(u32x4*)(hb + off) = pack8(h0, h1); ss += dot4s(h0) + dot4s(h1); }
                ss += __shfl_xor(ss, 16); ss += __shfl_xor(ss, 32);
                if (fq == 0) ssq[(size_t)row * 16 + u.pn * 4 + wc] = ss; }
    }
};
struct EpiQ {
    static constexpr bool PERM = true, AFTER_DRAIN = false;
    const float* ssq; bf16_t* qp; float eps;
    __device__ __forceinline__ void operator()(const f32x4 (&acc)[2][2][4][2], const Unit& u, int wr, int wc, int fr, int fq) const {
        const int row0 = u.pm * BM + wr * 64 + fr;
#pragma unroll
        for (int ai = 0; ai < 2; ++ai)
#pragma unroll
            for (int m = 0; m < 4; ++m) { const int row = row0 + ai * HALF + m * 16; const f32x4* sp = (const f32x4*)(ssq + (size_t)row * 16);
                const f32x4 a = sp[0], b = sp[1], c = sp[2], d = sp[3]; const f32x4 t = (a + b) + (c + d);
                const float rstd = rsqrtf(((t[0] + t[1]) + (t[2] + t[3])) * (1.0f / 1024.0f) + eps);
#pragma unroll
                for (int bj = 0; bj < 2; ++bj) *(u32x4*)(qp + (size_t)row * 2048 + u.pn * BM + bj * HALF + wc * 32 + 8 * fq) = pack8(acc[ai][bj][m][0] * rstd, acc[ai][bj][m][1] * rstd); }
    }
};
__device__ __forceinline__ f32x4 bf_lo4(unsigned a, unsigned b) { f32x4 r; r[0] = __uint_as_float(a << 16); r[1] = __uint_as_float(a & 0xffff0000u); r[2] = __uint_as_float(b << 16); r[3] = __uint_as_float(b & 0xffff0000u); return r; }
struct EpiGate {
    static constexpr bool PERM = true, AFTER_DRAIN = false;
    float* out; const bf16_t* e;
    __device__ __forceinline__ void operator()(const f32x4 (&acc)[2][2][4][2], const Unit& u, int wr, int wc, int fr, int fq) const {
        const int row0 = u.pm * BM + wr * 64 + fr;
#pragma unroll
        for (int ai = 0; ai < 2; ++ai)
#pragma unroll
            for (int m = 0; m < 4; ++m) { const int row = row0 + ai * HALF + m * 16;
#pragma unroll
                for (int bj = 0; bj < 2; ++bj) { const size_t off = (size_t)row * 1024 + u.pn * BM + bj * HALF + wc * 32 + 8 * fq;
                    const u32x4 ev = *(const u32x4*)(e + off); const f32x4 e0 = bf_lo4(ev.x, ev.y), e1 = bf_lo4(ev.z, ev.w);
                    const f32x4 h0 = *(const f32x4*)(out + off) + e0 * sigmoid4(acc[ai][bj][m][0]), h1 = *(const f32x4*)(out + off + 4) + e1 * sigmoid4(acc[ai][bj][m][1]);
                    *(f32x4*)(out + off) = h0; *(f32x4*)(out + off + 4) = h1; } }
    }
};
template <class Epi, class Sched, bool ALIGN_EPI = false, bool SP2 = false>
__device__ __forceinline__ void gemm_phase(PG8_LAS unsigned char* lds, const Gemm g, const Sched& S, const Epi& E, const int wid  ) {
    int lane; asm volatile("v_mbcnt_lo_u32_b32 %0, -1, 0\n\tv_mbcnt_hi_u32_b32 %0, -1, %0" : "=v"(lane));
    const int tid = wid * 64 + lane, wr = wid >> 2, wc = wid & 3, fr = lane & 15, fq = lane >> 4;
    const int K = g.K, nt = K / BK;
    unsigned voffA[2], voffB[2];
#pragma unroll
    for (int i = 0; i < 2; ++i) { int R, C; stage_rc(tid * 16 + i * 8192, R, C); const int Rb = Epi::PERM ? ((R & ~31) + perm32(R & 31)) : R;
        voffA[i] = (unsigned)(R * K + C) * 2u; voffB[i] = (unsigned)(Rb * K + C) * 2u; }
    const size_t kstep = (size_t)(BK * 2);
    const size_t hstep = (size_t)HALF * K * 2;
    const size_t tstep = 2 * hstep;
    const unsigned ldsw = (unsigned)wid * 1024u;
    const int aoff = lds_byte(wr * 64 + fr, fq * 8), boff = lds_byte(wc * 32 + fr, fq * 8);
#define PG8_SA(b, h) (((b) * 2 + (h)) * HTB)
#define PG8_SB(b, h) ((4 + (b) * 2 + (h)) * HTB)
#define PG8_STAGE(bufoff, gbase, voff) do { _Pragma("unroll") for (int _i = 0; _i < 2; ++_i) \
        __builtin_amdgcn_global_load_lds((const unsigned*)((const char*)(gbase) + (voff)[_i]), (PG8_LAS unsigned*)(lds + (bufoff) + ldsw + _i * 8192), 16, 0, 0); } while (0)
#define PG8_LDA(dst, b, h) do { _Pragma("unroll") for (int m = 0; m < 4; ++m) _Pragma("unroll") for (int k = 0; k < 2; ++k) dst[m][k] = *(const PG8_LAS bf16x8*)(lds + PG8_SA(b, h) + aoff + m * 2048 + k * 1024); } while (0)
#define PG8_LDB(dst, b, h) do { _Pragma("unroll") for (int n = 0; n < 2; ++n) _Pragma("unroll") for (int k = 0; k < 2; ++k) dst[n][k] = *(const PG8_LAS bf16x8*)(lds + PG8_SB(b, h) + boff + n * 2048 + k * 1024); } while (0)
#define PG8_MMA(ai, bj, At, Bt) do { __builtin_amdgcn_s_setprio(1); _Pragma("unroll") for (int m = 0; m < 4; ++m) _Pragma("unroll") for (int n = 0; n < 2; ++n) _Pragma("unroll") for (int k = 0; k < 2; ++k) \
        acc[ai][bj][m][n] = __builtin_amdgcn_mfma_f32_16x16x32_bf16(Bt[n][k], At[m][k], acc[ai][bj][m][n], 0, 0, 0); __builtin_amdgcn_s_setprio(0); } while (0)
#define PG8_WAIT_V(n) asm volatile("s_waitcnt vmcnt(" #n ")" ::: "memory")
#define PG8_WAIT_L(n) asm volatile("s_waitcnt lgkmcnt(" #n ")" ::: "memory")
#define PG8_BAR __builtin_amdgcn_s_barrier()
#define PG8_SCHED __builtin_amdgcn_sched_barrier(0)
    Unit cur, nxt; int ui = 0;
    if (!S.next(0, cur)) return;
    f32x4 acc[2][2][4][2];
#pragma unroll
    for (int a = 0; a < 2; ++a)
#pragma unroll
        for (int b = 0; b < 2; ++b)
#pragma unroll
            for (int m = 0; m < 4; ++m)
#pragma unroll
                for (int n = 0; n < 2; ++n) acc[a][b][m][n] = (f32x4){0.f, 0.f, 0.f, 0.f};
    bf16x8 At[4][2], B0[2][2], B1[2][2];
    const char* cA = (const char*)g.A + (size_t)cur.pm * tstep; const char* cB = (const char*)g.Bt + (size_t)cur.pn * tstep;
    S.a_ready(cur);
    if constexpr (SP2) {
        PG8_STAGE(PG8_SB(0, 0), cB, voffB); PG8_STAGE(PG8_SB(0, 1), cB + hstep, voffB); PG8_STAGE(PG8_SA(0, 0), cA, voffA); PG8_STAGE(PG8_SA(0, 1), cA + hstep, voffA);
        if (wr == 1) PG8_BAR;
        PG8_WAIT_V(2); PG8_BAR;
        PG8_STAGE(PG8_SB(1, 0), cB + kstep, voffB); PG8_STAGE(PG8_SA(1, 0), cA + kstep, voffA); PG8_STAGE(PG8_SB(1, 1), cB + hstep + kstep, voffB);
        PG8_WAIT_V(6); PG8_BAR;
    } else {
        PG8_STAGE(PG8_SB(0, 0), cB, voffB); PG8_STAGE(PG8_SA(0, 0), cA, voffA); PG8_STAGE(PG8_SB(0, 1), cB + hstep, voffB); PG8_STAGE(PG8_SA(0, 1), cA + hstep, voffA);
        if (wr == 1) PG8_BAR;
        PG8_WAIT_V(4); PG8_BAR;
        PG8_STAGE(PG8_SB(1, 0), cB + kstep, voffB); PG8_STAGE(PG8_SA(1, 0), cA + kstep, voffA); PG8_STAGE(PG8_SB(1, 1), cB + hstep + kstep, voffB);
        PG8_WAIT_V(6); PG8_BAR;
    }
    for (;;) {
        const bool has_next = S.next(ui + 1, nxt);
        const char* nA = has_next ? (const char*)g.A + (size_t)nxt.pm * tstep : cA; const char* nB = has_next ? (const char*)g.Bt + (size_t)nxt.pn * tstep : cB;
        for (int t = 0; t < nt; t += 2) {
            const bool last = (t == nt - 2);
            const char* a1 = cA + (size_t)(t + 1) * kstep;
            const char* a2 = last ? nA : cA + (size_t)(t + 2) * kstep; const char* b2 = last ? nB : cB + (size_t)(t + 2) * kstep;
            const char* a3 = a2 + kstep; const char* b3 = b2 + kstep;
            if (last && has_next) S.a_ready(nxt);
            if constexpr (SP2) {
            PG8_LDB(B0, 0, 0); PG8_LDB(B1, 0, 1); PG8_SCHED; PG8_LDA(At, 0, 0); PG8_STAGE(PG8_SA(1, 1), a1 + hstep, voffA);
            PG8_WAIT_V(8); PG8_WAIT_L(0); PG8_BAR; PG8_MMA(0, 0, At, B0); PG8_MMA(0, 1, At, B1); PG8_BAR; PG8_SCHED;
            PG8_LDA(At, 0, 1); PG8_STAGE(PG8_SB(0, 0), b2, voffB); PG8_STAGE(PG8_SB(0, 1), b2 + hstep, voffB); PG8_STAGE(PG8_SA(0, 0), a2, voffA);
            PG8_WAIT_V(8); PG8_WAIT_L(0); PG8_BAR; PG8_MMA(1, 0, At, B0); PG8_MMA(1, 1, At, B1); PG8_BAR; PG8_SCHED;
            PG8_LDB(B0, 1, 0); PG8_LDB(B1, 1, 1); PG8_SCHED; PG8_LDA(At, 1, 0); PG8_STAGE(PG8_SA(0, 1), a2 + hstep, voffA);
            PG8_WAIT_V(8); PG8_WAIT_L(0); PG8_BAR; PG8_MMA(0, 0, At, B0); PG8_MMA(0, 1, At, B1); PG8_BAR; PG8_SCHED;
            PG8_LDA(At, 1, 1); PG8_STAGE(PG8_SB(1, 0), b3, voffB); PG8_STAGE(PG8_SB(1, 1), b3 + hstep, voffB); PG8_STAGE(PG8_SA(1, 0), a3, voffA);
            PG8_WAIT_V(8); PG8_WAIT_L(0); PG8_BAR; PG8_MMA(1, 0, At, B0); PG8_MMA(1, 1, At, B1); PG8_BAR; PG8_SCHED;
            } else {
            PG8_LDB(B0, 0, 0); PG8_SCHED; PG8_LDA(At, 0, 0); PG8_STAGE(PG8_SA(1, 1), a1 + hstep, voffA);
            PG8_WAIT_L(8); PG8_BAR; PG8_WAIT_L(0); PG8_MMA(0, 0, At, B0); PG8_BAR; PG8_SCHED;
            PG8_LDB(B1, 0, 1); PG8_STAGE(PG8_SB(0, 0), b2, voffB);
            PG8_BAR; PG8_WAIT_L(0); PG8_MMA(0, 1, At, B1); PG8_BAR;
            PG8_LDA(At, 0, 1); PG8_STAGE(PG8_SA(0, 0), a2, voffA);
            PG8_BAR; PG8_WAIT_L(0); PG8_MMA(1, 0, At, B0); PG8_BAR; PG8_SCHED;
            PG8_STAGE(PG8_SB(0, 1), b2 + hstep, voffB);
            PG8_WAIT_V(6); PG8_BAR; PG8_MMA(1, 1, At, B1); PG8_BAR;
            PG8_LDB(B0, 1, 0); PG8_SCHED; PG8_LDA(At, 1, 0); PG8_STAGE(PG8_SA(0, 1), a2 + hstep, voffA);
            PG8_WAIT_L(8); PG8_BAR; PG8_WAIT_L(0); PG8_MMA(0, 0, At, B0); PG8_BAR; PG8_SCHED;
            PG8_LDB(B1, 1, 1); PG8_STAGE(PG8_SB(1, 0), b3, voffB);
            PG8_BAR; PG8_WAIT_L(0); PG8_MMA(0, 1, At, B1); PG8_BAR;
            PG8_LDA(At, 1, 1); PG8_STAGE(PG8_SA(1, 0), a3, voffA);
            PG8_BAR; PG8_WAIT_L(0); PG8_MMA(1, 0, At, B0); PG8_BAR; PG8_SCHED;
            PG8_STAGE(PG8_SB(1, 1), b3 + hstep, voffB);
            PG8_WAIT_V(6); PG8_BAR; PG8_MMA(1, 1, At, B1); PG8_BAR;
            }
        }
        if constexpr (ALIGN_EPI) { if (wr == 0) PG8_BAR; }
        if constexpr (!Epi::AFTER_DRAIN) { E(acc, cur, wr, wc, fr, fq); S.done(cur); }
        if (!has_next) break;
#pragma unroll
        for (int a = 0; a < 2; ++a)
#pragma unroll
            for (int b = 0; b < 2; ++b)
#pragma unroll
                for (int m = 0; m < 4; ++m)
#pragma unroll
                    for (int n = 0; n < 2; ++n) acc[a][b][m][n] = (f32x4){0.f, 0.f, 0.f, 0.f};
        cur = nxt; cA = nA; cB = nB; ++ui;
        if constexpr (ALIGN_EPI) { if (wr == 1) PG8_BAR; }
    }
    PG8_WAIT_V(0);
    if constexpr (!ALIGN_EPI) { if (wr == 0) PG8_BAR; }
    PG8_BAR;
    if constexpr (Epi::AFTER_DRAIN) { E.fused(acc, cur, wr, wc, fr, fq, lds, wid, lane); S.done(cur); }
#undef PG8_SA
#undef PG8_SB
#undef PG8_STAGE
#undef PG8_LDA
#undef PG8_LDB
#undef PG8_MMA
#undef PG8_WAIT_V
#undef PG8_WAIT_L
#undef PG8_BAR
#undef PG8_SCHED
}
}
#include <hip/hip_bf16.h>
#include <cmath>
namespace attn_body {
using bf16=__hip_bfloat16;
using bf16x8=__attribute__((ext_vector_type(8)))short;
using s16x4=__attribute__((ext_vector_type(4)))short;
using f32x16=__attribute__((ext_vector_type(16)))float;
using u32x4=__attribute__((ext_vector_type(4)))unsigned;
constexpr int BATCH=8,NHEAD=16,SEQ=4096,D=64,DM=NHEAD*D;
constexpr int NW=8,QBLK=32,QB=QBLK*NW,KVBLK=64,NQB=SEQ/QB;
constexpr int ATTN_PITCH=DM, ATTN_UNIT_ROWS=QB;
__device__ __forceinline__ int crow(int r,int hi){return (r&3)+8*(r>>2)+4*hi;}
#define SBAR() __builtin_amdgcn_sched_barrier(0)
__device__ __forceinline__ void cmask(f32x16&p0,f32x16&p1,int jb,int qrel,int hi){
  const float NEG=-INFINITY; int kb=64*jb+4*hi;
  #pragma unroll
  for(int r=0;r<16;++r){int kv=kb+(r&3)+8*(r>>2); if(kv>qrel)p0[r]=NEG; if(kv+32>qrel)p1[r]=NEG;}
}

constexpr int NSLOT=3, SLOTB=8192;
constexpr int LDS_K=0, LDS_V=NSLOT*SLOTB, LDS_WS=2*NSLOT*SLOTB, LDS_OST=LDS_WS+NW*64*4, LDS_BYTES=LDS_OST+NW*4096;
constexpr float C2=0.125f*1.4426950408889634f;
__device__ __forceinline__ void glds16(const void*gsrc,unsigned lds_dst){unsigned keep;
  asm volatile("s_mov_b32 %0, m0\n\ts_mov_b32 m0, %2\n\ts_nop 0\n\tglobal_load_lds_dwordx4 %1, off\n\ts_mov_b32 m0, %0":"=&s"(keep):"v"(gsrc),"s"(lds_dst):"memory");}
__device__ __forceinline__ float max3f(float a,float b,float c){float r;asm("v_max3_f32 %0, %1, %2, %3":"=v"(r):"v"(a),"v"(b),"v"(c));return r;}
__device__ __forceinline__ float max2f(float a,float b){float r;asm("v_max_f32_e32 %0, %1, %2":"=v"(r):"v"(a),"v"(b));return r;}
__device__ __forceinline__ float fadd_s(float a,float b){float r;asm("v_add_f32_e32 %0, %1, %2":"=v"(r):"v"(a),"v"(b));return r;}
__device__ __forceinline__ float fsub_s(float a,float b){float r;asm("v_sub_f32_e32 %0, %1, %2":"=v"(r):"v"(a),"v"(b));return r;}
typedef float f32x2_t __attribute__((ext_vector_type(2))); typedef __bf16 bf16x2_t __attribute__((ext_vector_type(2)));
__device__ __forceinline__ unsigned cvtpk_s(float lo,float hi){f32x2_t v={lo,hi};bf16x2_t b=__builtin_convertvector(v,bf16x2_t);return __builtin_bit_cast(unsigned,b);}
#define WAIT_BAR(N) asm volatile("s_waitcnt vmcnt(" #N ") lgkmcnt(0)\n\ts_barrier":::"memory")

__device__ __forceinline__ void qkt(f32x16&p0,f32x16&p1,const char*Kslot,const bf16x8*qr,const f32x16&negm,int r32,int hi){
  const char*kb=Kslot+hi*1024+r32*16;
  #pragma unroll
  for(int d0=0;d0<4;++d0){
    const bf16x8 b0=*reinterpret_cast<const bf16x8*>(kb+d0*2048);
    const bf16x8 b1=*reinterpret_cast<const bf16x8*>(kb+d0*2048+512);
    if(d0==0){p0=__builtin_amdgcn_mfma_f32_32x32x16_bf16(b0,qr[0],negm,0,0,0);p1=__builtin_amdgcn_mfma_f32_32x32x16_bf16(b1,qr[0],negm,0,0,0);}
    else{p0=__builtin_amdgcn_mfma_f32_32x32x16_bf16(b0,qr[d0],p0,0,0,0);p1=__builtin_amdgcn_mfma_f32_32x32x16_bf16(b1,qr[d0],p1,0,0,0);}}
}
typedef __attribute__((address_space(3))) const char* lds_cptr;
typedef short v4i16_t __attribute__((ext_vector_type(4)));
__device__ __forceinline__ void kload8(bf16x8*kf,lds_cptr kp){
  kf[0]=*(const __attribute__((address_space(3))) bf16x8*)(kp);      kf[1]=*(const __attribute__((address_space(3))) bf16x8*)(kp+512);
  kf[2]=*(const __attribute__((address_space(3))) bf16x8*)(kp+2048); kf[3]=*(const __attribute__((address_space(3))) bf16x8*)(kp+2560);
  kf[4]=*(const __attribute__((address_space(3))) bf16x8*)(kp+4096); kf[5]=*(const __attribute__((address_space(3))) bf16x8*)(kp+4608);
  kf[6]=*(const __attribute__((address_space(3))) bf16x8*)(kp+6144); kf[7]=*(const __attribute__((address_space(3))) bf16x8*)(kp+6656);
}
__device__ __forceinline__ void kload2(bf16x8*kf,lds_cptr kp,int j){ kf[2*j]=*(const __attribute__((address_space(3))) bf16x8*)(kp+j*2048); kf[2*j+1]=*(const __attribute__((address_space(3))) bf16x8*)(kp+j*2048+512); }
__device__ __forceinline__ s16x4 vtr(lds_cptr p){ return __builtin_bit_cast(s16x4,__builtin_amdgcn_ds_read_tr16_b64_v4i16((__attribute__((address_space(3))) v4i16_t*)p)); }
__device__ __forceinline__ float rowmax(const f32x16&p0,const f32x16&p1){
  float a=max3f(p0[0],p0[1],p1[0]),b=max3f(p0[2],p0[3],p1[1]);a=max3f(a,p1[2],p1[3]);
  #pragma unroll
  for(int r=4;r<16;r+=4){a=max3f(a,p0[r],p0[r+1]);b=max3f(b,p0[r+2],p0[r+3]);a=max3f(a,p1[r],p1[r+1]);b=max3f(b,p1[r+2],p1[r+3]);}
  const float m=max2f(a,b);
  auto rr=__builtin_amdgcn_permlane32_swap(__float_as_uint(m),__float_as_uint(m),false,false);
  return max2f(__uint_as_float(rr[0]),__uint_as_float(rr[1]));
}
__device__ __forceinline__ void pv(f32x16*o,int vb,bf16x8 pa0,bf16x8 pa1,bf16x8 pa2,bf16x8 pa3){
  #pragma unroll
  for(int d0=0;d0<2;++d0){s16x4 lo[4],hi[4];
    #pragma unroll
    for(int ks=0;ks<4;++ks){
      asm volatile("ds_read_b64_tr_b16 %0,%1 offset:%c2":"=&v"(lo[ks]):"v"(vb),"i"(d0*4096+ks*1024):"memory");
      asm volatile("ds_read_b64_tr_b16 %0,%1 offset:%c2":"=&v"(hi[ks]):"v"(vb),"i"(d0*4096+ks*1024+512):"memory");}
    asm volatile("s_waitcnt lgkmcnt(0)":::"memory");SBAR();
    #define PK(k) (bf16x8){lo[k][0],lo[k][1],lo[k][2],lo[k][3],hi[k][0],hi[k][1],hi[k][2],hi[k][3]}
    o[d0]=__builtin_amdgcn_mfma_f32_32x32x16_bf16(pa0,PK(0),o[d0],0,0,0);
    o[d0]=__builtin_amdgcn_mfma_f32_32x32x16_bf16(pa1,PK(1),o[d0],0,0,0);
    o[d0]=__builtin_amdgcn_mfma_f32_32x32x16_bf16(pa2,PK(2),o[d0],0,0,0);
    o[d0]=__builtin_amdgcn_mfma_f32_32x32x16_bf16(pa3,PK(3),o[d0],0,0,0);
    #undef PK
  }
}

#ifndef ATTN_STORE16
#define ATTN_STORE16(p,v) (*(u32x4*)(p)=(v))
#endif
template<int THRL> __device__ __forceinline__ void attn_unit(int b,int h,int qb,const bf16*Q,const bf16*__restrict__ K,const bf16*__restrict__ V,bf16*O,char*shm,const int tid_in){
  const int tid=tid_in,lane=tid&63,r32=lane&31,hi=lane>>5; const int wid=__builtin_amdgcn_readfirstlane(tid>>6);
  const long rowbase=(long)b*SEQ; const int q0=qb*QB;
  const bf16*Qw=Q+(rowbase+q0+wid*QBLK)*DM+h*D;
  const bf16*Kh=K+rowbase*DM+h*D,*Vh=V+rowbase*DM+h*D;
  const unsigned lds0=(unsigned)(uintptr_t)shm;
  float*wsf=(float*)(shm+LDS_WS)+wid*64;
  const bf16*ksrc=Kh+(long)lane*DM+wid*8;
  const bf16*vsrc=Vh+(long)(16*(wid&3)+(lane>>2))*DM+(wid>>2)*32+(lane&3)*8;
  const unsigned kdst=lds0+LDS_K+wid*1024, vdst=lds0+LDS_V+wid*1024;
  #define DMA_K(t,slot) glds16(ksrc+(long)(t)*KVBLK*DM,(unsigned)__builtin_amdgcn_readfirstlane(kdst+(slot)))
  #define DMA_V(t,slot) glds16(vsrc+(long)(t)*KVBLK*DM,(unsigned)__builtin_amdgcn_readfirstlane(vdst+(slot)))
  const int vb0=(int)(lds0+LDS_V)+((lane>>4)&1)*32+(lane&3)*8+(4*hi+((lane&15)>>2))*64;
  const char*Kbase=shm+LDS_K; bf16x8 kf[8];
  const lds_cptr shm3=(lds_cptr)shm; const lds_cptr kp0=shm3+LDS_K+hi*1024+r32*16; const lds_cptr vp0=shm3+LDS_V+((lane>>4)&1)*32+(lane&3)*8+(4*hi+((lane&15)>>2))*64;
  const int NT=(q0+QB)/KVBLK;
  DMA_K(0,0);DMA_V(0,0);DMA_K(1,SLOTB);
  bf16x8 qr[4];
  #pragma unroll
  for(int d0=0;d0<4;++d0)qr[d0]=*reinterpret_cast<const bf16x8*>(&Qw[(long)r32*DM+d0*16+hi*8]);
  float mhat=0.f,l_reg=0.f;f32x16 o[2];o[0]=f32x16{};o[1]=f32x16{};f32x16 negm=f32x16{};asm volatile("":"+v"(negm));
  const int qrel=wid*QBLK+r32;
  #define CMASK(P0,P1,t) do{int jb_=(t)-(NT-4); if(jb_>=0)cmask(P0,P1,jb_,qrel,hi);}while(0)
  bool resc=false;
  #define START(P0,P1) do{ const float rm=rowmax(P0,P1); resc=false; \
    { const float dl=rm; mhat=fadd_s(mhat,dl); \
      _Pragma("unroll") for(int r=0;r<16;++r){P0[r]=fsub_s(P0[r],dl);P1[r]=fsub_s(P1[r],dl);} \
      _Pragma("unroll") for(int r=0;r<16;++r)negm[r]=-mhat; asm volatile("":"+v"(negm)); } \
    _Pragma("unroll") for(int r=0;r<16;++r)P0[r]=__builtin_amdgcn_exp2f(P0[r]); }while(0)
  #define RESC() do{ if(resc){ asm volatile("s_waitcnt lgkmcnt(0)":::"memory"); \
      _Pragma("unroll") for(int d_=0;d_<2;++d_) _Pragma("unroll") for(int r=0;r<16;++r)o[d_][r]*=wsf[crow(r,hi)]; } }while(0)
  f32x16 pA0,pA1,pB0,pB1;
  int sl_prev=0,sl_cur=0,sl_next=SLOTB;
  #define ROT() do{sl_prev=sl_cur;sl_cur=sl_next;sl_next=(sl_next==(NSLOT-1)*SLOTB)?0:sl_next+SLOTB;}while(0)
  DMA_K(2,2*SLOTB);
  WAIT_BAR(3);
  qkt(pA0,pA1,Kbase,qr,negm,r32,hi);asm volatile("s_nop 15\n\ts_nop 7":"+v"(pA0),"+v"(pA1));CMASK(pA0,pA1,0);
  START(pA0,pA1);
  _Pragma("unroll") for(int r=0;r<16;++r)pA1[r]=__builtin_amdgcn_exp2f(pA1[r]);
  WAIT_BAR(0);
  DMA_K(3,0);DMA_V(1,SLOTB);
  ROT();
  kload8(kf,kp0+sl_cur);
  WAIT_BAR(2);
  s16x4 vlo[8],vhi[8]; u32x4 pw0,pw1,pw2,pw3;
  #define PKW(P,B) cvtpk_s(P[B],P[B+1])
  #define PAF(k) __builtin_bit_cast(bf16x8,pw##k)
  #define VFR(i) (bf16x8){vlo[i][0],vlo[i][1],vlo[i][2],vlo[i][3],vhi[i][0],vhi[i][1],vhi[i][2],vhi[i][3]}
  #define PIN(x) asm volatile("":"+v"(x))
  #define MX3(a,b,c) __builtin_fmaxf(__builtin_fmaxf((a),(b)),(c))
  #define GAPA(MF,A0,A1,A2,A3,W0,W1,PW) do{ MF; sacc+=A0; sacc+=A1; sacc+=A2; sacc+=A3; PIN(sacc); W0; W1; PIN(PW); SBAR(); }while(0)
  #define EX(v) __builtin_amdgcn_exp2f(v)
  #define GAPB(MF,X,B) do{ MF; X[B]=EX(X[B]); X[B+1]=EX(X[B+1]); X[B+2]=EX(X[B+2]); X[B+3]=EX(X[B+3]); PIN(X); SBAR(); }while(0)
  #define VRD(i) do{ vlo[i]=vtr(vp_+(((i)>>2)*4096+((i)&3)*1024)); vhi[i]=vtr(vp_+(((i)>>2)*4096+((i)&3)*1024+512)); }while(0)
  #define KRD(G,j) do{ if(G){ kload2(kf,kp0+sl_next,j); SBAR(); } }while(0)
  #define STEP(C0,C1,P0,P1,t,GK,GV,GL) do{ SBAR(); \
    const lds_cptr vp_=vp0+sl_prev; \
    VRD(0); SBAR(); float sacc=(P0[0]+P0[1]); \
    GAPA(C0=__builtin_amdgcn_mfma_f32_32x32x16_bf16(kf[0],qr[0],negm,0,0,0), P0[2],P0[3],P0[4],P0[5],     pw0[0]=PKW(P0,0), pw0[1]=PKW(P0,2), pw0); \
    VRD(4); SBAR(); GAPA(C1=__builtin_amdgcn_mfma_f32_32x32x16_bf16(kf[1],qr[0],negm,0,0,0), P0[6],P0[7],P0[8],P0[9],     pw0[2]=PKW(P0,4), pw0[3]=PKW(P0,6), pw0); \
    VRD(1); SBAR(); GAPA(C0=__builtin_amdgcn_mfma_f32_32x32x16_bf16(kf[2],qr[1],C0,0,0,0),   P0[10],P0[11],P0[12],P0[13], pw1[0]=PKW(P0,8), pw1[1]=PKW(P0,10), pw1); \
    VRD(5); SBAR(); GAPA(C1=__builtin_amdgcn_mfma_f32_32x32x16_bf16(kf[3],qr[1],C1,0,0,0),   P0[14],P0[15],P1[0],P1[1],   pw1[2]=PKW(P0,12),pw1[3]=PKW(P0,14), pw1); \
    VRD(2); SBAR(); GAPA(C0=__builtin_amdgcn_mfma_f32_32x32x16_bf16(kf[4],qr[2],C0,0,0,0),   P1[2],P1[3],P1[4],P1[5],     pw2[0]=PKW(P1,0), pw2[1]=PKW(P1,2), pw2); \
    VRD(6); SBAR(); GAPA(C1=__builtin_amdgcn_mfma_f32_32x32x16_bf16(kf[5],qr[2],C1,0,0,0),   P1[6],P1[7],P1[8],P1[9],     pw2[2]=PKW(P1,4), pw2[3]=PKW(P1,6), pw2); \
    VRD(3); SBAR(); GAPA(C0=__builtin_amdgcn_mfma_f32_32x32x16_bf16(kf[6],qr[3],C0,0,0,0),   P1[10],P1[11],P1[12],P1[13], pw3[0]=PKW(P1,8), pw3[1]=PKW(P1,10), pw3); \
    VRD(7); SBAR(); GAPA(C1=__builtin_amdgcn_mfma_f32_32x32x16_bf16(kf[7],qr[3],C1,0,0,0),   P1[14],P1[15],0.f,0.f,       pw3[2]=PKW(P1,12),pw3[3]=PKW(P1,14), pw3); \
    l_reg+=sacc; \
    if(GK){DMA_K((t)+3,sl_cur);} if(GV){DMA_V((t)+1,sl_next);} \
    CMASK(C0,C1,t); \
    { float a=MX3(C0[0],C0[1],C1[0]),b=MX3(C0[2],C0[3],C1[1]); a=MX3(a,C1[2],C1[3]); \
      _Pragma("unroll") for(int r=4;r<16;r+=4){a=MX3(a,C0[r],C0[r+1]);b=MX3(b,C0[r+2],C0[r+3]);a=MX3(a,C1[r],C1[r+1]);b=MX3(b,C1[r+2],C1[r+3]);} \
      float rm=__builtin_fmaxf(a,b); { auto rr=__builtin_amdgcn_permlane32_swap(__float_as_uint(rm),__float_as_uint(rm),false,false); rm=__builtin_fmaxf(__uint_as_float(rr[0]),__uint_as_float(rr[1])); } \
      resc=false; \
      if(__builtin_expect(__any(rm>(float)THRL),0)){ const float dl=__builtin_fmaxf(rm,0.f); mhat+=dl; \
        _Pragma("unroll") for(int r=0;r<16;++r){C0[r]-=dl;C1[r]-=dl;} \
        _Pragma("unroll") for(int r=0;r<16;++r)negm[r]=-mhat; asm volatile("":"+v"(negm)); \
        const float f=__builtin_amdgcn_exp2f(-dl); l_reg*=f; if(hi==0)wsf[r32]=f; resc=true; } } \
    SBAR(); \
    GAPB(o[0]=__builtin_amdgcn_mfma_f32_32x32x16_bf16(PAF(0),VFR(0),o[0],0,0,0), C0,0); \
    GAPB(o[1]=__builtin_amdgcn_mfma_f32_32x32x16_bf16(PAF(0),VFR(4),o[1],0,0,0), C0,4); \
    KRD(GL,0); GAPB(o[0]=__builtin_amdgcn_mfma_f32_32x32x16_bf16(PAF(1),VFR(1),o[0],0,0,0), C0,8); \
    KRD(GL,1); GAPB(o[1]=__builtin_amdgcn_mfma_f32_32x32x16_bf16(PAF(1),VFR(5),o[1],0,0,0), C0,12); \
    KRD(GL,2); GAPB(o[0]=__builtin_amdgcn_mfma_f32_32x32x16_bf16(PAF(2),VFR(2),o[0],0,0,0), C1,0); \
    KRD(GL,3); GAPB(o[1]=__builtin_amdgcn_mfma_f32_32x32x16_bf16(PAF(2),VFR(6),o[1],0,0,0), C1,4); \
    GAPB(o[0]=__builtin_amdgcn_mfma_f32_32x32x16_bf16(PAF(3),VFR(3),o[0],0,0,0), C1,8); \
    GAPB(o[1]=__builtin_amdgcn_mfma_f32_32x32x16_bf16(PAF(3),VFR(7),o[1],0,0,0), C1,12); \
    }while(0)
  int t=1;
  #undef CMASK
  #define CMASK(P0,P1,t) do{}while(0)
  for(;t+5<NT;t+=2){
    STEP(pB0,pB1,pA0,pA1,t,true,true,true);     WAIT_BAR(2); RESC(); ROT();
    STEP(pA0,pA1,pB0,pB1,t+1,true,true,true);   WAIT_BAR(2); RESC(); ROT();
  }
  #undef CMASK
  #define CMASK(P0,P1,t) do{int jb_=(t)-(NT-4); if(jb_>=0)cmask(P0,P1,jb_,qrel,hi);}while(0)
  #define ENDW(tt) do{ if((tt)+3<NT){WAIT_BAR(2);} else if((tt)+2<NT){WAIT_BAR(1);} else {WAIT_BAR(0);} }while(0)
  for(;t+1<NT;t+=2){
    STEP(pB0,pB1,pA0,pA1,t,(t+3<NT),(t+1<NT),(t+1<NT));       ENDW(t);   RESC(); ROT();
    STEP(pA0,pA1,pB0,pB1,t+1,(t+4<NT),(t+2<NT),(t+2<NT));     ENDW(t+1); RESC(); ROT();
  }
  STEP(pB0,pB1,pA0,pA1,NT-1,false,false,false); RESC();
  { float sacc=pB0[0]+pB0[1]; _Pragma("unroll") for(int r=2;r<16;++r)sacc+=pB0[r]; _Pragma("unroll") for(int r=0;r<16;++r)sacc+=pB1[r]; l_reg+=sacc;
    pw0=(u32x4){PKW(pB0,0),PKW(pB0,2),PKW(pB0,4),PKW(pB0,6)};pw1=(u32x4){PKW(pB0,8),PKW(pB0,10),PKW(pB0,12),PKW(pB0,14)};pw2=(u32x4){PKW(pB1,0),PKW(pB1,2),PKW(pB1,4),PKW(pB1,6)};pw3=(u32x4){PKW(pB1,8),PKW(pB1,10),PKW(pB1,12),PKW(pB1,14)};
    SBAR(); pv(o,vb0+sl_cur,PAF(0),PAF(1),PAF(2),PAF(3)); }
  #undef PKW
  #undef PAF
  #undef VFR
  #undef PIN
  #undef MX3
  #undef GAPA
  #undef GAPB
  #undef EX
  #undef VRD
  #undef KRD
  #undef STEP
  #undef ENDW
  {auto rr=__builtin_amdgcn_permlane32_swap(__float_as_uint(l_reg),__float_as_uint(l_reg),false,false);l_reg=__uint_as_float(rr[0])+__uint_as_float(rr[1]);}
  if(hi==0)wsf[32+r32]=l_reg;asm volatile("s_waitcnt lgkmcnt(0)":::"memory");
  float rli[16];
  #pragma unroll
  for(int r=0;r<16;++r)rli[r]=__builtin_amdgcn_rcpf(wsf[32+crow(r,hi)]);
  bf16*Ow=O+(rowbase+q0+wid*QBLK)*DM+h*D;
  { bf16*stg=(bf16*)(shm+LDS_OST)+wid*2048;
    #pragma unroll
    for(int r=0;r<16;++r){const int orow=crow(r,hi);
      #pragma unroll
      for(int d0=0;d0<2;++d0)stg[orow*64+d0*32+r32]=__float2bfloat16(o[d0][r]*rli[r]);}
    asm volatile("s_waitcnt lgkmcnt(0)":::"memory");
    #pragma unroll
    for(int i=0;i<4;++i){const int row=i*8+(lane>>3),ch=lane&7; const u32x4 v=*(const u32x4*)(stg+row*64+ch*8); ATTN_STORE16(Ow+(long)row*DM+ch*8,v);} }
  asm volatile("s_waitcnt lgkmcnt(0)\n\ts_barrier":::"memory");
  #undef DMA_K
  #undef DMA_V
  #undef CMASK
  #undef START
  #undef RESC
  #undef ROT
}
constexpr int ATTN_LDS_BYTES=LDS_BYTES;
struct AttnTensors { const bf16* Q; const bf16* K; const bf16* V; bf16* O; };
struct AttnUnit { int bh; int qb; };
template<class Sched,int THRL=8> __device__ __forceinline__ void attn_phase(char*lds,const AttnTensors&T,const Sched&S,const int tid_in){
  AttnUnit u;
  for(int i=0;S.next(i,u);++i){ S.a_ready(u); attn_unit<THRL>(u.bh/NHEAD,u.bh%NHEAD,u.qb,T.Q,T.K,T.V,T.O,lds,tid_in); S.done(u); }
}
#undef SBAR
#undef WAIT_BAR
}
constexpr int NWAVES = 8;
constexpr int BATCH = 8, SEQ = 4096, DM = 1024, M = BATCH * SEQ;
constexpr int IN_COLS = 2560, PLE_DIM = 256, NEXP = 16384, QCOLS = 2048;
constexpr float EPS = 1e-6f;
#ifndef MK_N_LAUNCHES
#define MK_N_LAUNCHES 1
#endif
constexpr int N_PHASES = 8;
constexpr size_t MiB = 1u << 20;
constexpr size_t WS_CTL = 0, CTL_ZERO_BYTES = 1 * MiB;
constexpr size_t WS_ROPEC = 1 * MiB, WS_ROPES = 1 * MiB + 512 * 1024;
constexpr size_t WS_KEYS = 2 * MiB;
constexpr size_t WS_WPROJ = 3 * MiB;
constexpr size_t WS_WIN = 4 * MiB;
constexpr size_t WS_WOUT = 10 * MiB, WS_WQ = 12 * MiB, WS_WGATE = 16 * MiB;
constexpr size_t WS_SSQ1 = 18 * MiB;
constexpr size_t WS_PB = 24 * MiB;
constexpr size_t WS_E = 40 * MiB;
constexpr size_t WS_UT = 104 * MiB, WS_VT = 136 * MiB;
constexpr size_t WS_XN = 168 * MiB;
constexpr size_t WS_QO = 232 * MiB, WS_K = 296 * MiB, WS_V = 360 * MiB;
constexpr size_t WS_U = 424 * MiB;
constexpr size_t WS_H1B = 232 * MiB;
constexpr size_t WS_QP = 296 * MiB;
constexpr size_t WS_XN2 = 424 * MiB;
constexpr size_t WS_END = 488 * MiB;
constexpr int RING_BYTES = 131072, LDS_BYTES = 147456;
constexpr int MISC_OFF = LDS_BYTES - 256;
constexpr int CW_BAR = 4096;

#define GAS __attribute__((address_space(1)))
#define LAS __attribute__((address_space(3)))
typedef unsigned short bf16;
typedef unsigned v4u __attribute__((ext_vector_type(4)));
typedef float f32x4 __attribute__((ext_vector_type(4)));
typedef float f32x16 __attribute__((ext_vector_type(16)));
typedef short bf16x8 __attribute__((ext_vector_type(8)));
typedef __bf16 bf16x2_t __attribute__((ext_vector_type(2)));
#define LDS_WAIT() asm volatile("s_waitcnt lgkmcnt(0)" ::: "memory")
#define VM_WAIT() asm volatile("s_waitcnt vmcnt(0)" ::: "memory")
__device__ __forceinline__ unsigned f2bf(float f) { unsigned u = __builtin_bit_cast(unsigned, f); return (u + 0x7fffu + ((u >> 16) & 1u)) >> 16; }
__device__ __forceinline__ unsigned pk2(float lo, float hi) { return f2bf(lo) | (f2bf(hi) << 16); }
__device__ __forceinline__ v4u pk8(const f32x4 a, const f32x4 b) { v4u w; w.x = pk2(a[0], a[1]); w.y = pk2(a[2], a[3]); w.z = pk2(b[0], b[1]); w.w = pk2(b[2], b[3]); return w; }
__device__ __forceinline__ float bflo(unsigned w) { return __uint_as_float(w << 16); }
__device__ __forceinline__ float bfhi(unsigned w) { return __uint_as_float(w & 0xffff0000u); }
__device__ __forceinline__ float dot4s_(const f32x4 a) { return (a[0] * a[0] + a[1] * a[1]) + (a[2] * a[2] + a[3] * a[3]); }
__device__ __forceinline__ float wave_sum(float v) {
#pragma unroll
    for (int o = 1; o < 64; o <<= 1) v += __shfl_xor(v, o);
    return v;
}
__device__ __forceinline__ float dot2bf(unsigned w, unsigned x, float acc) { return __builtin_amdgcn_fdot2_f32_bf16(__builtin_bit_cast(bf16x2_t, w), __builtin_bit_cast(bf16x2_t, x), acc, false); }

typedef GAS unsigned gu32;
#define RLX_AGENT __ATOMIC_RELAXED, __HIP_MEMORY_SCOPE_AGENT
#define XB_TMO      128
#define XB_XCNT(j)  (256  + 64 * (j))
#define XB_XSUB(j)  (1280 + 64 * (j))
#define XB_XGEN(j)  (2304 + 64 * (j))
#define XB_TOP      3328
#define XB_TOPGEN   3392
#define XCD_BAR_WORDS 3456
#define XB_SPIN_CAP (1u << 18)

__device__ __forceinline__ unsigned xb_ld(unsigned* p)              { return __hip_atomic_load(p, __ATOMIC_RELAXED, __HIP_MEMORY_SCOPE_AGENT); }
__device__ __forceinline__ unsigned xb_add(unsigned* p, unsigned v) { return __hip_atomic_fetch_add(p, v, __ATOMIC_RELAXED, __HIP_MEMORY_SCOPE_AGENT); }
__device__ __forceinline__ unsigned xb_xcc_id() { return (unsigned)__builtin_amdgcn_s_getreg((3 << 11) | 20) & 0xFu; }
#define XB_SPIN(cond, bar) do { unsigned _sp = 0; while (cond) { __builtin_amdgcn_s_sleep(1); \
    if ((++_sp & 255u) == 0u) { if (xb_ld(&(bar)[XB_TMO])) break; if (_sp > XB_SPIN_CAP) { atomicAdd(&(bar)[XB_TMO], 1u); break; } } } } while (0)

struct XcdBarrier {
    unsigned* bar; unsigned x;
    volatile LAS unsigned* st;
};

__device__ __forceinline__ XcdBarrier xcd_barrier_post(unsigned* bar, volatile LAS unsigned* st, const bool leader) {
    XcdBarrier b; b.bar = bar; b.x = xb_xcc_id(); b.st = st;
    if (leader) (void)xb_add(&bar[XB_XCNT(b.x)], 1u);
    return b;
}
__device__ __forceinline__ void xcd_barrier_complete(unsigned* bar, unsigned x, unsigned& nloc, unsigned& nx) {
    const unsigned G = gridDim.x * gridDim.y * gridDim.z;
    unsigned sum, cnt, mine, sp = 0u;
    for (;;) {
        sum = 0u; cnt = 0u; mine = 0u;
#pragma unroll
        for (unsigned j = 0; j < 16; ++j) { const unsigned c = xb_ld(&bar[XB_XCNT(j)]); sum += c; cnt += (c > 0u) ? 1u : 0u; mine = (j == x) ? c : mine; }
        if (sum == G) break;
        __builtin_amdgcn_s_sleep(1);
        if ((++sp & 255u) == 0u) { if (xb_ld(&bar[XB_TMO])) break; if (sp > XB_SPIN_CAP) { atomicAdd(&bar[XB_TMO], 1u); break; } }
    }
    nloc = mine > 0u ? mine : 1u; nx = cnt > 0u ? cnt : 1u;
}

__device__ __forceinline__ void xcd_barrier(const XcdBarrier& b, const bool leader  ) {
    asm volatile("s_waitcnt vmcnt(0)" ::: "memory");
    __syncthreads();
    if (leader) {
        unsigned* bar = b.bar;
        __builtin_amdgcn_s_waitcnt(0);
        unsigned nloc = b.st[0], nx = b.st[1];
        if (nloc == 0u) { xcd_barrier_complete(bar, b.x, nloc, nx); b.st[0] = nloc; b.st[1] = nx; }
        const unsigned old = xb_add(&bar[XB_XSUB(b.x)], 1u);
        const unsigned gen = old / nloc;
        if (old + 1u == (gen + 1u) * nloc) {
            __builtin_amdgcn_fence(__ATOMIC_RELEASE, "agent");
            asm volatile("s_waitcnt vmcnt(0)" ::: "memory");
            const unsigned og = xb_add(&bar[XB_TOP], 1u);
            const unsigned tg = og / nx;
            if (og + 1u == (tg + 1u) * nx) xb_add(&bar[XB_TOPGEN], 1u);
            else XB_SPIN(xb_ld(&bar[XB_TOPGEN]) == tg, bar);
            __builtin_amdgcn_fence(__ATOMIC_ACQUIRE, "agent");
            xb_add(&bar[XB_XGEN(b.x)], 1u);
            asm volatile("s_waitcnt vmcnt(0)" ::: "memory");
        } else {
            XB_SPIN(xb_ld(&bar[XB_XGEN(b.x)]) == gen, bar);
            __builtin_amdgcn_fence(__ATOMIC_ACQUIRE, "agent");
            asm volatile("s_waitcnt vmcnt(0)" ::: "memory");
        }
    }
    __syncthreads();
}

__device__ __forceinline__ int lane_id() { int l; asm volatile("v_mbcnt_lo_u32_b32 %0, -1, 0\n\tv_mbcnt_hi_u32_b32 %0, -1, %0" : "=v"(l)); return l; }
struct Frame {
    LAS unsigned char* lds; unsigned char* ldsg;
    int wave, vcu, G;
    float* out; unsigned char* ws;
};
template <int I> __device__ __forceinline__ const float* inptr() {
    const float* p = nullptr;
#if defined(__HIP_DEVICE_COMPILE__)
    const void* ka = (const void*)__builtin_amdgcn_kernarg_segment_ptr();
    asm volatile("s_load_dwordx2 %0, %1, %2\n\ts_waitcnt lgkmcnt(0)" : "=s"(p) : "s"(ka), "i"(I * 8) : "memory");
#endif
    return p;
}
#define INP(i) inptr<i>()

__device__ const double INVREV[32] = {0.15915494309189535, 0.11934937021124886, 0.089499401608891013, 0.067115083005227255, 0.050329212104487035, 0.037741584717419771, 0.028302195830623399, 0.02122365276477766,
    0.015915494309189534, 0.011934937021124886, 0.0089499401608891024, 0.0067115083005227253, 0.0050329212104487037, 0.0037741584717419772, 0.0028302195830623399, 0.0021223652764777662,
    0.0015915494309189536, 0.0011934937021124885, 0.00089499401608891024, 0.0006711508300522726, 0.00050329212104487033, 0.00037741584717419774, 0.00028302195830623395, 0.00021223652764777661,
    0.00015915494309189535, 0.00011934937021124886, 8.9499401608891018e-05, 6.7115083005227254e-05, 5.0329212104487035e-05, 3.7741584717419777e-05, 2.8302195830623396e-05, 2.1223652764777659e-05};
__device__ __forceinline__ int win_rowmap(int n) {
    if (n < 1024) { const int region = n >> 9, r = n & 511, tile = r >> 8, w = r & 255, blk = w >> 6, d = w & 63, bj = d >> 5, dlo = d & 31; return region * 512 + tile * 256 + bj * 128 + blk * 32 + dlo; }
    if (n < 1536) return n;
    const int cc = n - 1536, isg = cc >> 9, ch = cc & 511, j = ch >> 7, c2 = ch & 127; return 1536 + j * 256 + isg * 128 + c2;
}
template <bool MAP>
__device__ __forceinline__ void p0_transpose_item(const float* W, int K, int N, bf16* WT, const float* gk, LAS float* scr, int item, int lane) {
    const int nblk = N / 32, kb = item / nblk, nb = item % nblk, k0 = 64 * kb, n0 = 32 * nb;
#pragma unroll 8
    for (int i = 0; i < 32; ++i) { const int kk = 2 * i + (lane >> 5); float v = W[(size_t)(k0 + kk) * N + n0 + (lane & 31)]; if (gk) v *= gk[k0 + kk]; scr[kk * 33 + (lane & 31)] = v; }
    LDS_WAIT(); asm volatile("" ::: "memory");
    const int c = lane & 7; const int r0 = MAP ? win_rowmap(n0) : n0;
#pragma unroll
    for (int j = 0; j < 4; ++j) { const int n = (lane >> 3) + 8 * j; const LAS float* s = scr + (8 * c) * 33 + n;
        v4u o; o.x = pk2(s[0 * 33], s[1 * 33]); o.y = pk2(s[2 * 33], s[3 * 33]); o.z = pk2(s[4 * 33], s[5 * 33]); o.w = pk2(s[6 * 33], s[7 * 33]);
        *(GAS v4u*)(WT + (size_t)(r0 + n) * K + k0 + 8 * c) = o; }
    LDS_WAIT(); asm volatile("" ::: "memory");
}
__device__ __forceinline__ void cvt_stream(const float* src, bf16* dst, size_t n8, int gw, int NGW, int lane) {
    for (size_t c = (size_t)gw * 64 + lane; c < n8; c += (size_t)NGW * 64) { const f32x4 a = *(const GAS f32x4*)(src + c * 8), b = *(const GAS f32x4*)(src + c * 8 + 4); *(GAS v4u*)(dst + c * 8) = pk8(a, b); }
}
__device__ __forceinline__ void p0_prologue(Frame& F) {
    const int lane = lane_id();
    LAS float* scr = (LAS float*)(F.lds + F.wave * 16384);
    const int gw = F.vcu * NWAVES + F.wave, NGW = F.G * NWAVES;
    bf16* WIN = (bf16*)(F.ws + WS_WIN); bf16* WOUT = (bf16*)(F.ws + WS_WOUT); bf16* WQ = (bf16*)(F.ws + WS_WQ); bf16* WGATE = (bf16*)(F.ws + WS_WGATE); bf16* WPROJ = (bf16*)(F.ws + WS_WPROJ);
    constexpr int I_IN = (DM / 64) * (IN_COLS / 32), I_OUT = (DM / 64) * (DM / 32), I_Q = (DM / 64) * (QCOLS / 32), I_G = I_OUT, I_P = (PLE_DIM / 64) * (DM / 32);
    constexpr int NITEMS = I_IN + I_OUT + I_Q + I_G + I_P;
    for (int it = gw; it < NITEMS; it += NGW) {
        int r = it;
        if (r < I_IN) { p0_transpose_item<true>(INP(3), DM, IN_COLS, WIN, nullptr, scr, r, lane); continue; } r -= I_IN;
        if (r < I_OUT) { p0_transpose_item<false>(INP(13), DM, DM, WOUT, nullptr, scr, r, lane); continue; } r -= I_OUT;
        if (r < I_Q) { p0_transpose_item<false>(INP(15), DM, QCOLS, WQ, INP(14), scr, r, lane); continue; } r -= I_Q;
        if (r < I_G) { p0_transpose_item<false>(INP(20), DM, DM, WGATE, nullptr, scr, r, lane); continue; } r -= I_G;
        p0_transpose_item<false>(INP(21), PLE_DIM, DM, WPROJ, nullptr, scr, r, lane);
    }
    cvt_stream(INP(16), (bf16*)(F.ws + WS_KEYS), (size_t)2 * 128 * 128 / 8, gw, NGW, lane);
    cvt_stream(INP(17), (bf16*)(F.ws + WS_UT), (size_t)NEXP * DM / 8, gw, NGW, lane);
    cvt_stream(INP(18), (bf16*)(F.ws + WS_VT), (size_t)NEXP * DM / 8, gw, NGW, lane);
    cvt_stream(INP(1), (bf16*)(F.ws + WS_PB), (size_t)M * PLE_DIM / 8, gw, NGW, lane);
    { float* rc = (float*)(F.ws + WS_ROPEC); float* rs = (float*)(F.ws + WS_ROPES);
      for (int idx = gw * 64 + lane; idx < SEQ * 32; idx += NGW * 64) { const int pos = idx >> 5, i = idx & 31; const double rev = (double)pos * INVREV[i]; const float fr = (float)(rev - __builtin_floor(rev));
          rc[idx] = __builtin_amdgcn_cosf(fr); rs[idx] = __builtin_amdgcn_sinf(fr); } }
    { const float* x = INP(0); const float* g = INP(2); bf16* XN = (bf16*)(F.ws + WS_XN);
      f32x4 gv[4];
#pragma unroll
      for (int j = 0; j < 4; ++j) gv[j] = ((const GAS f32x4*)g)[64 * j + lane];
      for (int m = gw; m < M; m += NGW) { const GAS f32x4* xr = (const GAS f32x4*)(x + (size_t)m * DM) + lane; f32x4 v[4]; float s2 = 0.f;
#pragma unroll
          for (int j = 0; j < 4; ++j) { v[j] = xr[64 * j]; s2 += (v[j].x * v[j].x + v[j].y * v[j].y) + (v[j].z * v[j].z + v[j].w * v[j].w); }
          const float rstd = rsqrtf(wave_sum(s2) * (1.f / DM) + EPS);
          GAS unsigned long long* o8 = (GAS unsigned long long*)(XN + (size_t)m * DM) + lane;
#pragma unroll
          for (int j = 0; j < 4; ++j) { const f32x4 w = v[j] * rstd * gv[j]; o8[64 * j] = (unsigned long long)pk2(w.x, w.y) | ((unsigned long long)pk2(w.z, w.w) << 32); } } }
}

struct AttnOrder {
    int vcu;
    __device__ __forceinline__ bool next(int i, attn_body::AttnUnit& u) const { if (i >= 8) return false; const int s = vcu & 7; u.bh = (vcu >> 5) * 16 + ((vcu >> 3) & 3) * 4 + (i & 3); u.qb = (i < 4) ? 15 - s : s; return true; }
    __device__ __forceinline__ void a_ready(const attn_body::AttnUnit&) const {}
    __device__ __forceinline__ void done(const attn_body::AttnUnit&) const {}
};
__device__ __forceinline__ void p2_attention(Frame& F) {
    { const attn_body::AttnTensors AT{(const attn_body::bf16*)(F.ws + WS_QO), (const attn_body::bf16*)(F.ws + WS_K), (const attn_body::bf16*)(F.ws + WS_V), (attn_body::bf16*)(F.ws + WS_QO)};
      const AttnOrder S{F.vcu};
      attn_body::attn_phase<AttnOrder>((char*)F.ldsg, AT, S, F.wave * 64 + lane_id()); }
    VM_WAIT(); __syncthreads();
    const int lane = lane_id();
    const float s1 = wave_sum(INP(4)[lane] * INP(5)[lane]), s2 = wave_sum(INP(6)[lane] * INP(7)[lane]);
    const float lam = __expf(s1) - __expf(s2) + 0.2f;
    const float* sg = INP(8); const float g0 = sg[2 * lane] * 0.8f, g1 = sg[2 * lane + 1] * 0.8f;
    const unsigned* O32 = (const unsigned*)(F.ws + WS_QO); unsigned* A2 = (unsigned*)(F.ws + WS_XN);
    const int b = F.vcu >> 5, h = (F.vcu >> 3) & 3, s = F.vcu & 7;
    for (int i = 0; i < 2; ++i) { const int qb = (i == 0) ? 15 - s : s;
        const size_t rbase = (size_t)b * SEQ + (size_t)qb * 256 + F.wave * 32;
        for (int r = 0; r < 32; ++r) { const size_t row = rbase + r;
            const unsigned w0 = __builtin_nontemporal_load(O32 + row * 512 + (h * 4 + 0 + (lane >> 5)) * 32 + (lane & 31)), w1 = __builtin_nontemporal_load(O32 + row * 512 + (h * 4 + 2 + (lane >> 5)) * 32 + (lane & 31));
            const float d0 = bflo(w0) - lam * bflo(w1), d1 = bfhi(w0) - lam * bfhi(w1);
            const float rstd = rsqrtf(wave_sum(d0 * d0 + d1 * d1) * (1.f / 128.f) + EPS);
            A2[row * 512 + h * 64 + lane] = pk2(d0 * rstd * g0, d1 * rstd * g1); } }
}
__device__ __forceinline__ void p2_conv(Frame& F) {
    const bf16* Ub = (const bf16*)(F.ws + WS_U); bf16* A2 = (bf16*)(F.ws + WS_XN);
    LAS float* yl = (LAS float*)F.lds;
    const int lane = lane_id(); const int c = F.wave * 64 + lane;
    float w[31];
    { const float* cw = INP(9);
#pragma unroll
      for (int j = 0; j < 31; ++j) w[j] = cw[j * 512 + c]; }
    const float bias = INP(10)[c];
    const float* lng = INP(11); const float* lnb = INP(12);
    const f32x4 lg0 = *(const f32x4*)(lng + 8 * lane), lg1 = *(const f32x4*)(lng + 8 * lane + 4), lb0 = *(const f32x4*)(lnb + 8 * lane), lb1 = *(const f32x4*)(lnb + 8 * lane + 4);
    for (int tile = F.vcu; tile < M / 32; tile += F.G) {
        const int t0 = tile * 32, pos0 = t0 & (SEQ - 1);
        float xin[62];
#pragma unroll
        for (int r = 0; r < 62; ++r) { const int p = pos0 - 30 + r; xin[r] = (p >= 0) ? __uint_as_float((unsigned)Ub[(size_t)(t0 - 30 + r) * 512 + c] << 16) : 0.f; }
#pragma unroll
        for (int t = 0; t < 32; ++t) { float y = bias;
#pragma unroll
            for (int j = 0; j < 31; ++j) y += w[j] * xin[t + j];
            yl[t * 512 + c] = y; }
        __syncthreads();
#pragma unroll
        for (int q = 0; q < 4; ++q) { const int t = F.wave * 4 + q;
            const f32x4 a = *(const LAS f32x4*)(yl + t * 512 + 8 * lane), b2 = *(const LAS f32x4*)(yl + t * 512 + 8 * lane + 4);
            const float mean = wave_sum((a[0] + a[1]) + (a[2] + a[3]) + (b2[0] + b2[1]) + (b2[2] + b2[3])) * (1.f / 512.f);
            const f32x4 da = a - mean, db = b2 - mean;
            const float var = wave_sum((da[0] * da[0] + da[1] * da[1]) + (da[2] * da[2] + da[3] * da[3]) + (db[0] * db[0] + db[1] * db[1]) + (db[2] * db[2] + db[3] * db[3])) * (1.f / 512.f);
            const float rstd = rsqrtf(var + EPS);
            f32x4 oa = da * rstd * lg0 + lb0, ob = db * rstd * lg1 + lb1;
#pragma unroll
            for (int e = 0; e < 4; ++e) { oa[e] = oa[e] * __builtin_amdgcn_rcpf(1.0f + __expf(-oa[e])); ob[e] = ob[e] * __builtin_amdgcn_rcpf(1.0f + __expf(-ob[e])); }
            *(GAS v4u*)(A2 + (size_t)(t0 + t) * 1024 + 512 + 8 * lane) = pk8(oa, ob); }
        __syncthreads();
    }
}
__device__ __forceinline__ int crow16(int r, int hi) { return (r & 3) + 8 * (r >> 2) + 4 * hi; }
__device__ __forceinline__ unsigned enc_key(float f, unsigned tag, unsigned mask) { unsigned u = __float_as_uint(f); u = (u & 0x80000000u) ? ~u : (u | 0x80000000u); return (u & ~mask) | tag; }
__device__ __forceinline__ float dec_key(unsigned k, unsigned mask) { unsigned u = k & ~mask; u = (u & 0x80000000u) ? (u & 0x7fffffffu) : ~u; return __uint_as_float(u); }
__device__ __forceinline__ void ce_desc(unsigned& a, unsigned& b) { const unsigned mx = a > b ? a : b, mn = a > b ? b : a; a = mx; b = mn; }
template <int K, int J> __device__ __forceinline__ void bitonic_stage16(unsigned (&a)[16]) {
#pragma unroll
    for (int i = 0; i < 16; ++i) { const int l = i ^ J; if (l > i) { if ((i & K) == 0) ce_desc(a[i], a[l]); else ce_desc(a[l], a[i]); } }
}
__device__ __forceinline__ void sort16_desc(unsigned (&a)[16]) {
    bitonic_stage16<2, 1>(a); bitonic_stage16<4, 2>(a); bitonic_stage16<4, 1>(a); bitonic_stage16<8, 4>(a); bitonic_stage16<8, 2>(a); bitonic_stage16<8, 1>(a);
    bitonic_stage16<16, 8>(a); bitonic_stage16<16, 4>(a); bitonic_stage16<16, 2>(a); bitonic_stage16<16, 1>(a);
}
__device__ __forceinline__ void merge16_desc(unsigned (&a)[16], const unsigned (&b)[16]) {
#pragma unroll
    for (int i = 0; i < 16; ++i) a[i] = a[i] > b[15 - i] ? a[i] : b[15 - i];
    bitonic_stage16<16, 8>(a); bitonic_stage16<16, 4>(a); bitonic_stage16<16, 2>(a); bitonic_stage16<16, 1>(a);
}
__device__ __forceinline__ void top16_of_64(unsigned (&k)[4][16]) {
    sort16_desc(k[0]); sort16_desc(k[1]); sort16_desc(k[2]); sort16_desc(k[3]);
    merge16_desc(k[0], k[1]); merge16_desc(k[2], k[3]); merge16_desc(k[0], k[2]);
}
__host__ __device__ constexpr int cand_i(int s) { int c = 0; for (int i = 0; i < 16; ++i) { const int nj = 16 / (i + 1); if (s < c + nj) return i; c += nj; } return -1; }
__host__ __device__ constexpr int cand_j(int s) { int c = 0; for (int i = 0; i < 16; ++i) { const int nj = 16 / (i + 1); if (s < c + nj) return s - c; c += nj; } return -1; }
template <int S> __device__ __forceinline__ void cand_fill(unsigned (&c)[4][16], const float (&v0)[16], const float (&v1)[16]) {
    if constexpr (S < 64) { constexpr int i = cand_i(S), j = cand_j(S);
        if constexpr (i >= 0) c[S >> 4][S & 15] = enc_key(v0[i] + v1[j], 255u - (unsigned)(i * 16 + j), 255u); else c[S >> 4][S & 15] = 0u;
        cand_fill<S + 1>(c, v0, v1); }
}
__device__ __forceinline__ float gelu_exact(float v) {
    const float av = __builtin_fabsf(v), d = av * 0.2316418882f + 1.0f, t = __builtin_amdgcn_rcpf(d);
    float q = t * 0.5307027145f + (-0.7265760135f); q = q * t + 0.7107068705f; q = q * t + (-0.142248368f); q = q * t + 0.127414796f; q = q * t;
    const float e = __builtin_amdgcn_exp2f((v * v) * (-0.72134752044f)); const float m = v * (q * e); return v < 0.f ? m : v - m;
}
constexpr int P5_TOK = 32;
constexpr int P5_KEYS = 0, P5_LS = 65536, P5_EID = 65536 + 33792, P5_GATE = 65536 + 33792 + 16384;
__device__ __forceinline__ void p5_peer(Frame& F) {
    const bf16* QP = (const bf16*)(F.ws + WS_QP); const bf16* KEYS = (const bf16*)(F.ws + WS_KEYS);
    const unsigned char* UT = F.ws + WS_UT; const unsigned char* VT = F.ws + WS_VT; bf16* XN2 = (bf16*)(F.ws + WS_XN2);
    LAS unsigned* lsc = (LAS unsigned*)(F.lds + P5_LS) + (F.wave * 32 + (lane_id() & 31)) * 33; LAS unsigned* eidL = (LAS unsigned*)(F.lds + P5_EID); LAS float* gateL = (LAS float*)(F.lds + P5_GATE);
    const int lane = lane_id(), tid = F.wave * 64 + lane, r32 = lane & 31, hi = lane >> 5, h = F.wave;
    const float* gffn = INP(14); const float* gple = INP(19);
#pragma unroll
    for (int i = 0; i < 8; ++i) { const int q = tid + 512 * i, row = q >> 4, ch = q & 15; *(LAS v4u*)(F.lds + P5_KEYS + row * 256 + ((ch ^ (row & 15)) << 4)) = *(const GAS v4u*)(KEYS + row * 128 + ch * 8); }
    __syncthreads();
    const LAS unsigned char* kl = F.lds + P5_KEYS + r32 * 256;
    for (int tile = F.vcu; tile < M / P5_TOK; tile += F.G) {
        const size_t t0 = (size_t)tile * P5_TOK;
        float sv[2][16];
#pragma unroll
        for (int c = 0; c < 2; ++c) {
            bf16x8 qf[8];
#pragma unroll
            for (int ks = 0; ks < 8; ++ks) qf[ks] = *(const bf16x8*)(QP + (t0 + r32) * QCOLS + h * 256 + c * 128 + ks * 16 + hi * 8);
            unsigned key[4][16];
#pragma unroll
            for (int nb = 0; nb < 4; ++nb) { f32x16 acc = {}; asm volatile("" ::: "memory");
#pragma unroll
                for (int ks = 0; ks < 8; ++ks) { const bf16x8 kf = *(const LAS bf16x8*)(kl + (c * 128 + nb * 32) * 256 + (((ks * 2 + hi) ^ (r32 & 15)) << 4)); acc = __builtin_amdgcn_mfma_f32_32x32x16_bf16(kf, qf[ks], acc, 0, 0, 0); }
#pragma unroll
                for (int r = 0; r < 16; ++r) key[nb][r] = enc_key(acc[r], 127u - (unsigned)(nb * 32 + crow16(r, hi)), 127u); }
            top16_of_64(key);
            unsigned other[16];
#pragma unroll
            for (int i = 0; i < 16; ++i) other[i] = __shfl_xor(key[0][i], 32);
            merge16_desc(key[0], other);
#pragma unroll
            for (int i = 0; i < 16; ++i) { sv[c][i] = dec_key(key[0][i], 127u); if (hi == 0) lsc[c * 16 + i] = key[0][i]; }
        }
        asm volatile("" ::: "memory");
        unsigned cand[4][16];
        cand_fill<0>(cand, sv[0], sv[1]);
        top16_of_64(cand);
        LDS_WAIT();
        { float wv[16]; float wsum = 0.f; const float mx = dec_key(cand[0][0], 255u);
#pragma unroll
          for (int k = 0; k < 16; ++k) { wv[k] = __expf(dec_key(cand[0][k], 255u) - mx); wsum += wv[k]; }
          const float rs = 1.0f / wsum;
#pragma unroll
          for (int k = 0; k < 16; ++k) { const unsigned id = 255u - (cand[0][k] & 255u); const unsigned k0 = lsc[id >> 4], k1 = lsc[16 + (id & 15u)];
              const unsigned e = (127u - (k0 & 127u)) * 128u + (127u - (k1 & 127u));
              if (hi == 0) { eidL[r32 * 128 + h * 16 + k] = e; gateL[r32 * 128 + h * 16 + k] = wv[k] * rs; } } }
        __syncthreads();
#pragma unroll 1
        for (int j = 0; j < 4; ++j) {
            const int tl = F.wave * 4 + j; const size_t tok = t0 + tl; float* hrow = F.out + tok * DM;
            const f32x4 ha0 = *(const f32x4*)(hrow + 8 * lane), ha1 = *(const f32x4*)(hrow + 8 * lane + 4), hb0 = *(const f32x4*)(hrow + 512 + 8 * lane), hb1 = *(const f32x4*)(hrow + 512 + 8 * lane + 4);
            const float rstd1 = rsqrtf(wave_sum(dot4s_(ha0) + dot4s_(ha1) + dot4s_(hb0) + dot4s_(hb1)) * (1.f / DM) + EPS);
            unsigned mp[8];
            { const f32x4 g0 = *(const f32x4*)(gffn + 8 * lane), g1 = *(const f32x4*)(gffn + 8 * lane + 4), g2 = *(const f32x4*)(gffn + 512 + 8 * lane), g3 = *(const f32x4*)(gffn + 512 + 8 * lane + 4);
              const v4u a = pk8(ha0 * rstd1 * g0, ha1 * rstd1 * g1), b = pk8(hb0 * rstd1 * g2, hb1 * rstd1 * g3);
              mp[0] = a.x; mp[1] = a.y; mp[2] = a.z; mp[3] = a.w; mp[4] = b.x; mp[5] = b.y; mp[6] = b.z; mp[7] = b.w; }
            const unsigned ev0 = eidL[tl * 128 + lane], ev1 = eidL[tl * 128 + 64 + lane];
            float alo = 0.f, ahi = 0.f;
#pragma unroll 1
            for (int kg = 0; kg < 16; ++kg) {
                const unsigned evs = kg < 8 ? ev0 : ev1;
                v4u ra[8], rb[8];
#pragma unroll
                for (int q = 0; q < 8; ++q) { const unsigned e = __builtin_amdgcn_readlane(evs, (kg * 8 + q) & 63); const unsigned char* rp = UT + (size_t)e * 2048 + lane * 16;
                    ra[q] = *(const GAS v4u*)rp; rb[q] = *(const GAS v4u*)(rp + 1024); }
#pragma unroll
                for (int q = 0; q < 8; ++q) { float p = dot2bf(ra[q].x, mp[0], 0.f); p = dot2bf(ra[q].y, mp[1], p); p = dot2bf(ra[q].z, mp[2], p); p = dot2bf(ra[q].w, mp[3], p);
                    p = dot2bf(rb[q].x, mp[4], p); p = dot2bf(rb[q].y, mp[5], p); p = dot2bf(rb[q].z, mp[6], p); p = dot2bf(rb[q].w, mp[7], p);
                    p = wave_sum(p); const int k = kg * 8 + q; alo = (lane == k) ? p : alo; ahi = (lane == k - 64) ? p : ahi; }
            }
            const float hlo = gelu_exact(alo) * gateL[tl * 128 + lane], hhi = gelu_exact(ahi) * gateL[tl * 128 + 64 + lane];
            float y[16];
#pragma unroll
            for (int i = 0; i < 16; ++i) y[i] = 0.f;
#pragma unroll 1
            for (int kg = 0; kg < 16; ++kg) {
                const unsigned evs = kg < 8 ? ev0 : ev1; const float hvs = kg < 8 ? hlo : hhi;
                v4u ra[8], rb[8];
#pragma unroll
                for (int q = 0; q < 8; ++q) { const unsigned e = __builtin_amdgcn_readlane(evs, (kg * 8 + q) & 63); const unsigned char* rp = VT + (size_t)e * 2048 + lane * 16;
                    ra[q] = *(const GAS v4u*)rp; rb[q] = *(const GAS v4u*)(rp + 1024); }
#pragma unroll
                for (int q = 0; q < 8; ++q) { const float hk = __uint_as_float(__builtin_amdgcn_readlane(__float_as_uint(hvs), (kg * 8 + q) & 63));
                    y[0] += hk * bflo(ra[q].x); y[1] += hk * bfhi(ra[q].x); y[2] += hk * bflo(ra[q].y); y[3] += hk * bfhi(ra[q].y); y[4] += hk * bflo(ra[q].z); y[5] += hk * bfhi(ra[q].z); y[6] += hk * bflo(ra[q].w); y[7] += hk * bfhi(ra[q].w);
                    y[8] += hk * bflo(rb[q].x); y[9] += hk * bfhi(rb[q].x); y[10] += hk * bflo(rb[q].y); y[11] += hk * bfhi(rb[q].y); y[12] += hk * bflo(rb[q].z); y[13] += hk * bfhi(rb[q].z); y[14] += hk * bflo(rb[q].w); y[15] += hk * bfhi(rb[q].w); }
            }
            const f32x4 n0 = ha0 + (f32x4){y[0], y[1], y[2], y[3]}, n1 = ha1 + (f32x4){y[4], y[5], y[6], y[7]}, n2 = hb0 + (f32x4){y[8], y[9], y[10], y[11]}, n3 = hb1 + (f32x4){y[12], y[13], y[14], y[15]};
            const float rstd2 = rsqrtf(wave_sum(dot4s_(n0) + dot4s_(n1) + dot4s_(n2) + dot4s_(n3)) * (1.f / DM) + EPS);
            *(f32x4*)(hrow + 8 * lane) = n0; *(f32x4*)(hrow + 8 * lane + 4) = n1; *(f32x4*)(hrow + 512 + 8 * lane) = n2; *(f32x4*)(hrow + 512 + 8 * lane + 4) = n3;
            const f32x4 p0 = *(const f32x4*)(gple + 8 * lane), p1 = *(const f32x4*)(gple + 8 * lane + 4), p2 = *(const f32x4*)(gple + 512 + 8 * lane), p3 = *(const f32x4*)(gple + 512 + 8 * lane + 4);
            *(GAS v4u*)(XN2 + tok * DM + 8 * lane) = pk8(n0 * rstd2 * p0, n1 * rstd2 * p1); *(GAS v4u*)(XN2 + tok * DM + 512 + 8 * lane) = pk8(n2 * rstd2 * p2, n3 * rstd2 * p3);
        }
        __syncthreads();
    }
}
__device__ __forceinline__ void p7_final(Frame& F) {
    const int lane = lane_id(); const int gw = F.vcu * NWAVES + F.wave, NGW = F.G * NWAVES; const float* g = INP(22);
    f32x4 gv[4];
#pragma unroll
    for (int j = 0; j < 4; ++j) gv[j] = ((const GAS f32x4*)g)[64 * j + lane];
    for (int m = gw; m < M; m += NGW) { GAS f32x4* xr = (GAS f32x4*)(F.out + (size_t)m * DM) + lane; f32x4 v[4]; float s2 = 0.f;
#pragma unroll
        for (int j = 0; j < 4; ++j) { v[j] = xr[64 * j]; s2 += (v[j].x * v[j].x + v[j].y * v[j].y) + (v[j].z * v[j].z + v[j].w * v[j].w); }
        const float rstd = rsqrtf(wave_sum(s2) * (1.f / DM) + EPS);
#pragma unroll
        for (int j = 0; j < 4; ++j) xr[64 * j] = v[j] * rstd * gv[j]; }
}
struct Args { const float* in[23]; float* out; unsigned char* ws; int ph_lo, ph_hi; };
__global__ void __launch_bounds__(NWAVES * 64, 2) hymba_fwd(Args args) {
    extern __shared__ __attribute__((aligned(16))) unsigned char lds[];
    cg::grid_group grid = cg::this_grid();
    Frame F;
    F.lds = (LAS unsigned char*)lds; F.ldsg = lds;
    F.wave = __builtin_amdgcn_readfirstlane(threadIdx.x >> 6);
    F.G = gridDim.x; { const int bx = blockIdx.x; F.vcu = (F.G % 8 == 0) ? (bx % 8) * (F.G / 8) + bx / 8 : bx; }
    F.out = args.out; F.ws = args.ws;
    const int lo = args.ph_lo, hi = args.ph_hi;
#ifdef ONLY_PH
#define IN(k) ((k) == ONLY_PH)
#else
#define IN(k) (lo <= (k) && (k) < hi)
#endif
#define BOTH(k) (IN(k) && IN((k) + 1))
    { const int l0 = lane_id(); if (F.wave == 0) ((volatile LAS unsigned*)(F.lds + MISC_OFF))[l0] = 0u; }
    __syncthreads();
    const XcdBarrier bar = xcd_barrier_post((unsigned*)(F.ws + WS_CTL) + CW_BAR, (volatile LAS unsigned*)(F.lds + MISC_OFF) + 8, F.wave == 0 && lane_id() == 0);
#define GRID_BAR(k) do { if ((k) == 0) grid.sync(); else xcd_barrier(bar, F.wave == 0 && lane_id() == 0); } while (0)
    if (IN(0)) { p0_prologue(F); if (BOTH(0)) GRID_BAR(0); }
    if (IN(1)) {
        { pg8::Gemm g{(const pg8::bf16_t*)(F.ws + WS_XN), (const pg8::bf16_t*)(F.ws + WS_WIN), M, IN_COLS, DM}; pg8::StaticOrder S; S.init(M, IN_COLS, F.G, (int)blockIdx.x);
          pg8::EpiIn E{(pg8::bf16_t*)(F.ws + WS_QO), (pg8::bf16_t*)(F.ws + WS_K), (pg8::bf16_t*)(F.ws + WS_V), (pg8::bf16_t*)(F.ws + WS_U), (const float*)(F.ws + WS_ROPEC), (const float*)(F.ws + WS_ROPES), attn_body::C2};
          pg8::gemm_phase<pg8::EpiIn, pg8::StaticOrder, true, true>(F.lds, g, S, E, F.wave); }
        { pg8::Gemm g{(const pg8::bf16_t*)(F.ws + WS_PB), (const pg8::bf16_t*)(F.ws + WS_WPROJ), M, DM, PLE_DIM}; pg8::StaticOrder S; S.init(M, DM, F.G, (int)blockIdx.x);
          pg8::EpiBf16<0> E{(pg8::bf16_t*)(F.ws + WS_E), DM, nullptr, 0, 0, 1.f};
          pg8::gemm_phase<pg8::EpiBf16<0>, pg8::StaticOrder, true, true>(F.lds, g, S, E, F.wave); }
        if (BOTH(1)) GRID_BAR(1);
    }
    if (IN(2)) { p2_attention(F); p2_conv(F); if (BOTH(2)) GRID_BAR(2); }
    if (IN(3)) {
        pg8::Gemm g{(const pg8::bf16_t*)(F.ws + WS_XN), (const pg8::bf16_t*)(F.ws + WS_WOUT), M, DM, DM}; pg8::StaticOrder S; S.init(M, DM, F.G, (int)blockIdx.x);
        pg8::EpiOut E{INP(0), F.out, (pg8::bf16_t*)(F.ws + WS_H1B), (float*)(F.ws + WS_SSQ1)};
        pg8::gemm_phase<pg8::EpiOut, pg8::StaticOrder, true, true>(F.lds, g, S, E, F.wave);
        if (BOTH(3)) GRID_BAR(3);
    }
    if (IN(4)) {
        pg8::Gemm g{(const pg8::bf16_t*)(F.ws + WS_H1B), (const pg8::bf16_t*)(F.ws + WS_WQ), M, QCOLS, DM}; pg8::StaticOrder S; S.init(M, QCOLS, F.G, (int)blockIdx.x);
        pg8::EpiQ E{(const float*)(F.ws + WS_SSQ1), (pg8::bf16_t*)(F.ws + WS_QP), EPS};
        pg8::gemm_phase<pg8::EpiQ, pg8::StaticOrder, true, true>(F.lds, g, S, E, F.wave);
        if (BOTH(4)) GRID_BAR(4);
    }
    if (IN(5)) { p5_peer(F); if (BOTH(5)) GRID_BAR(5); }
    if (IN(6)) {
        pg8::Gemm g{(const pg8::bf16_t*)(F.ws + WS_XN2), (const pg8::bf16_t*)(F.ws + WS_WGATE), M, DM, DM}; pg8::StaticOrder S; S.init(M, DM, F.G, (int)blockIdx.x);
        pg8::EpiGate E{F.out, (const pg8::bf16_t*)(F.ws + WS_E)};
        pg8::gemm_phase<pg8::EpiGate, pg8::StaticOrder, true, true>(F.lds, g, S, E, F.wave);
        if (BOTH(6)) GRID_BAR(6);
    }
    if (IN(7)) p7_final(F);
#undef IN
#undef BOTH
}

extern "C" void kernel_launch(void* const* d_in, const int* in_sizes, int n_in, void* d_out, int out_size, void* d_ws, size_t ws_size, hipStream_t stream) {
    static int grid = 0;
    if (grid == 0) {
        if (n_in != 23 || in_sizes[0] != M * DM || out_size != M * DM || ws_size < WS_END) { fprintf(stderr, "kernel_launch: unexpected shapes (n_in %d, in0 %d, out %d, ws %zu); nothing launched\n", n_in, n_in > 0 ? in_sizes[0] : -1, out_size, ws_size); grid = -1; return; }
        int dev = 0, cus = 0, per_cu = 0;
        if (hipGetDevice(&dev) != hipSuccess || hipDeviceGetAttribute(&cus, hipDeviceAttributeMultiprocessorCount, dev) != hipSuccess) { fprintf(stderr, "kernel_launch: device query failed\n"); grid = -1; return; }
        if (hipFuncSetAttribute((const void*)hymba_fwd, hipFuncAttributeMaxDynamicSharedMemorySize, LDS_BYTES) != hipSuccess) { fprintf(stderr, "kernel_launch: hipFuncSetAttribute failed\n"); grid = -1; return; }
        if (hipOccupancyMaxActiveBlocksPerMultiprocessor(&per_cu, (const void*)hymba_fwd, NWAVES * 64, LDS_BYTES) != hipSuccess || per_cu < 1) { fprintf(stderr, "kernel_launch: occupancy query says %d blocks per CU\n", per_cu); (void)hipGetLastError(); grid = -1; return; }
        grid = cus * per_cu;
        if (grid != 256) { fprintf(stderr, "kernel_launch: this kernel's attention order needs exactly 256 resident workgroups (got %d x %d); nothing launched\n", cus, per_cu); grid = -1; return; }
    }
    if (grid < 0) return;
    if (hipMemsetAsync((char*)d_ws + WS_CTL, 0, CTL_ZERO_BYTES, stream) != hipSuccess) { fprintf(stderr, "kernel_launch: hipMemsetAsync failed\n"); return; }
    Args a{};
    for (int i = 0; i < 23; ++i) a.in[i] = (const float*)d_in[i];
    a.out = (float*)d_out; a.ws = (unsigned char*)d_ws;
#if MK_N_LAUNCHES == 1
    a.ph_lo = 0; a.ph_hi = N_PHASES;
    void* kargs[] = {&a};
    hipError_t e = hipLaunchCooperativeKernel((const void*)hymba_fwd, dim3(grid), dim3(NWAVES * 64), kargs, LDS_BYTES, stream);
    if (e != hipSuccess) fprintf(stderr, "kernel_launch: cooperative launch failed: %s (grid %d)\n", hipGetErrorString(e), grid);
#else
    for (int li = 0; li < N_PHASES; ++li) { a.ph_lo = li; a.ph_hi = li + 1;
        hipLaunchKernelGGL(hymba_fwd, dim3(grid), dim3(NWAVES * 64), LDS_BYTES, stream, a);
        const hipError_t le = hipPeekAtLastError(); if (le != hipSuccess) { fprintf(stderr, "kernel_launch: launch %d failed: %s\n", li, hipGetErrorName(le)); break; } }
#endif
}
```

```cpp
#include <hip/hip_runtime.h>
#include <hip/hip_cooperative_groups.h>
#include <cstdio>
#include <cstdint>
namespace cg = cooperative_groups;
namespace pg8 {
#define PG8_LAS __attribute__((address_space(3)))
typedef unsigned short bf16_t;
typedef short bf16x8 __attribute__((ext_vector_type(8)));
typedef float f32x4 __attribute__((ext_vector_type(4)));
typedef unsigned u32x4 __attribute__((ext_vector_type(4)));
constexpr int BM = 256, BK = 64, HALF = 128, HTB = HALF * BK * 2  , STAGE_BYTES = 8 * HTB, NXCD = 8, WGM = 8;

__host__ __device__ __forceinline__ int lds_byte(int r, int c) { const int st = (r >> 4) * 2 + (c >> 5), rr = r & 15, cc = c & 31, ob = rr * 64 + cc * 2; return st * 1024 + (ob ^ (((ob >> 9) & 1) << 5)); }
__host__ __device__ __forceinline__ void stage_rc(int b, int& R, int& C) { const int st = b / 1024, sb = b % 1024, swz = sb ^ (((sb >> 9) & 1) << 5); R = (st >> 1) * 16 + swz / 64; C = (st & 1) * 32 + (swz % 64) / 2; }
__host__ __device__ __forceinline__ int perm32(int rho) { const int n = rho >> 4, i = rho & 15; return 8 * (i >> 2) + 4 * n + (i & 3); }

struct Unit { int pm, pn; };
struct Gemm { const bf16_t* A; const bf16_t* Bt; int M, N, K; };

struct StaticOrder {
    int nM, nN, nwg, G, c;
    __host__ __device__ void init(int M, int N, int G_, int c_) { nM = M / BM; nN = N / BM; nwg = nM * nN; G = G_; c = c_; }
    __host__ __device__ bool next(int i, Unit& u) const {
        const long L = (long)i * G + c; if (L >= nwg) return false;
        int wgid = (int)L; { const int q = nwg / NXCD, r = nwg % NXCD, xcd = wgid % NXCD, off = wgid / NXCD; wgid = (xcd < r ? xcd * (q + 1) : r * (q + 1) + (xcd - r) * q) + off; }
        const int nig = WGM * nN, gid = wgid / nig, fm = gid * WGM, gsz = (nM - fm) < WGM ? (nM - fm) : WGM;
        u.pm = fm + ((wgid % nig) % gsz); u.pn = (wgid % nig) / gsz; return true;
    }
    __device__ __forceinline__ void a_ready(const Unit&) const {}
    __device__ __forceinline__ void done(const Unit&) const {}
};

__device__ __forceinline__ unsigned cvt_pk_bf16(float lo, float hi) { unsigned r; asm volatile("v_cvt_pk_bf16_f32 %0, %1, %2" : "=v"(r) : "v"(lo), "v"(hi)); return r; }
typedef float f32x2 __attribute__((ext_vector_type(2)));
__device__ __forceinline__ f32x2 gelu_pk(f32x2 v) {
    const f32x2 av = __builtin_elementwise_abs(v), d = av * 0.2316418882f + 1.0f;
    f32x2 t; t.x = __builtin_amdgcn_rcpf(d.x); t.y = __builtin_amdgcn_rcpf(d.y);
    f32x2 q = t * 0.5307027145f + (-0.7265760135f); q = q * t + 0.7107068705f; q = q * t + (-0.142248368f); q = q * t + 0.127414796f; q = q * t;
    const f32x2 s = (v * v) * (-0.72134752044f);
    f32x2 e; e.x = __builtin_amdgcn_exp2f(s.x); e.y = __builtin_amdgcn_exp2f(s.y);
    const f32x2 m = v * (q * e), r = v - m;
    f32x2 o; o.x = v.x < 0.f ? m.x : r.x; o.y = v.y < 0.f ? m.y : r.y; return o;
}

template <int ACT  > struct EpiBf16 {
    static constexpr bool PERM = true, AFTER_DRAIN = false; static_assert(ACT == 0 || ACT == 1, "EpiBf16: ACT is 0 (none) or 1 (gelu_pk)");
    bf16_t* O; int ldc; const float* bias; int split_cols; size_t split_stride; float scale0;
    __device__ __forceinline__ void operator()(const f32x4 (&acc)[2][2][4][2], const Unit& u, int wr, int wc, int fr, int fq) const {
        const int row0 = u.pm * BM + wr * 64 + fr; int colt = u.pn * BM; bf16_t* base = O;
        float sc = 1.f; if (split_cols) { const int t = colt / split_cols; base += (size_t)t * split_stride; colt -= t * split_cols; if (t == 0) sc = scale0; }
        const int col0 = colt + wc * 32 + 8 * fq, bcol0 = u.pn * BM + wc * 32 + 8 * fq;
        f32x4 bv[2][2];
#pragma unroll
        for (int bj = 0; bj < 2; ++bj)
#pragma unroll
            for (int n = 0; n < 2; ++n) bv[bj][n] = bias ? *(const f32x4*)(bias + bcol0 + bj * HALF + 4 * n) : (f32x4){0.f, 0.f, 0.f, 0.f};
#pragma unroll
        for (int ai = 0; ai < 2; ++ai)
#pragma unroll
            for (int m = 0; m < 4; ++m) { bf16_t* rowp = base + (size_t)(row0 + ai * HALF + m * 16) * ldc + col0;
#pragma unroll
                for (int bj = 0; bj < 2; ++bj) { f32x4 v0 = acc[ai][bj][m][0] + bv[bj][0], v1 = acc[ai][bj][m][1] + bv[bj][1];
                    if (ACT == 1) { f32x2 a = gelu_pk((f32x2){v0[0], v0[1]}), b = gelu_pk((f32x2){v0[2], v0[3]}), c = gelu_pk((f32x2){v1[0], v1[1]}), d = gelu_pk((f32x2){v1[2], v1[3]});
                        v0 = (f32x4){a.x, a.y, b.x, b.y}; v1 = (f32x4){c.x, c.y, d.x, d.y}; }
                    v0 = v0 * sc; v1 = v1 * sc; u32x4 w; w.x = cvt_pk_bf16(v0[0], v0[1]); w.y = cvt_pk_bf16(v0[2], v0[3]); w.z = cvt_pk_bf16(v1[0], v1[1]); w.w = cvt_pk_bf16(v1[2], v1[3]);
                    *(u32x4*)(rowp + bj * HALF) = w; } }
    }
};
__device__ __forceinline__ float sigmoid_fast(float x) { return __builtin_amdgcn_rcpf(1.0f + __expf(-x)); }
__device__ __forceinline__ f32x4 sigmoid4(f32x4 x) { f32x4 r; r[0] = sigmoid_fast(x[0]); r[1] = sigmoid_fast(x[1]); r[2] = sigmoid_fast(x[2]); r[3] = sigmoid_fast(x[3]); return r; }
__device__ __forceinline__ u32x4 pack8(const f32x4 a, const f32x4 b) { u32x4 w; w.x = cvt_pk_bf16(a[0], a[1]); w.y = cvt_pk_bf16(a[2], a[3]); w.z = cvt_pk_bf16(b[0], b[1]); w.w = cvt_pk_bf16(b[2], b[3]); return w; }
__device__ __forceinline__ float dot4s(const f32x4 a) { return (a[0] * a[0] + a[1] * a[1]) + (a[2] * a[2] + a[3] * a[3]); }

struct EpiIn {
    static constexpr bool PERM = true, AFTER_DRAIN = false;
    bf16_t *Q, *Kk, *V, *U; const float* ropec; const float* ropes; float qscale;
    __device__ __forceinline__ void operator()(const f32x4 (&acc)[2][2][4][2], const Unit& u, int wr, int wc, int fr, int fq) const {
        const int row0 = u.pm * BM + wr * 64 + fr; const int pn = u.pn;
        if (pn < 4) {
            bf16_t* dst = (pn < 2) ? Q : Kk; const float sc = (pn < 2) ? qscale : 1.0f; const int colb = ((pn & 1) * 4 + wc) * 128 + 8 * fq;
#pragma unroll
            for (int ai = 0; ai < 2; ++ai)
#pragma unroll
                for (int m = 0; m < 4; ++m) { const int row = row0 + ai * HALF + m * 16; const int pos = row & 4095;
                    const f32x4 c0 = *(const f32x4*)(ropec + pos * 32 + 8 * fq), c1 = *(const f32x4*)(ropec + pos * 32 + 8 * fq + 4);
                    const f32x4 s0 = *(const f32x4*)(ropes + pos * 32 + 8 * fq), s1 = *(const f32x4*)(ropes + pos * 32 + 8 * fq + 4);
                    const f32x4 x10 = acc[ai][0][m][0], x11 = acc[ai][0][m][1], x20 = acc[ai][1][m][0], x21 = acc[ai][1][m][1];
                    const f32x4 o10 = (x10 * c0 - x20 * s0) * sc, o11 = (x11 * c1 - x21 * s1) * sc, o20 = (x20 * c0 + x10 * s0) * sc, o21 = (x21 * c1 + x11 * s1) * sc;
                    bf16_t* rp = dst + (size_t)row * 1024 + colb; const u32x4 w1 = pack8(o10, o11), w2 = pack8(o20, o21);
                    *(u32x4*)rp = w1; *(u32x4*)(rp + 32) = w2; *(u32x4*)(rp + 64) = w1; *(u32x4*)(rp + 96) = w2; }
        } else if (pn < 6) {
#pragma unroll
            for (int ai = 0; ai < 2; ++ai)
#pragma unroll
                for (int m = 0; m < 4; ++m) { const int row = row0 + ai * HALF + m * 16;
#pragma unroll
                    for (int bj = 0; bj < 2; ++bj) { const int hh = (pn - 4) * 2 + bj, vh = wc >> 1, d = (wc & 1) * 32 + 8 * fq;
                        const u32x4 w = pack8(acc[ai][bj][m][0], acc[ai][bj][m][1]); bf16_t* rp = V + (size_t)row * 1024 + (hh * 4 + vh) * 64 + d; *(u32x4*)rp = w; *(u32x4*)(rp + 128) = w; } }
        } else {
#pragma unroll
            for (int ai = 0; ai < 2; ++ai)
#pragma unroll
                for (int m = 0; m < 4; ++m) { const int row = row0 + ai * HALF + m * 16;
                    const f32x4 u0 = acc[ai][0][m][0] * sigmoid4(acc[ai][1][m][0]), u1 = acc[ai][0][m][1] * sigmoid4(acc[ai][1][m][1]);
                    *(u32x4*)(U + (size_t)row * 512 + (pn - 6) * 128 + wc * 32 + 8 * fq) = pack8(u0, u1); }
        }
    }
};
struct EpiOut {
    static constexpr bool PERM = true, AFTER_DRAIN = false;
    const float* x; float* out; bf16_t* hb; float* ssq;
    __device__ __forceinline__ void operator()(const f32x4 (&acc)[2][2][4][2], const Unit& u, int wr, int wc, int fr, int fq) const {
        const int row0 = u.pm * BM + wr * 64 + fr;
#pragma unroll
        for (int ai = 0; ai < 2; ++ai)
#pragma unroll
            for (int m = 0; m < 4; ++m) { const int row = row0 + ai * HALF + m * 16; float ss = 0.f;
#pragma unroll
                for (int bj = 0; bj < 2; ++bj) { const size_t off = (size_t)row * 1024 + u.pn * BM + bj * HALF + wc * 32 + 8 * fq;
                    const f32x4 h0 = acc[ai][bj][m][0] + *(const f32x4*)(x + off), h1 = acc[ai][bj][m][1] + *(const f32x4*)(x + off + 4);
                    *(f32x4*)(out + off) = h0; *(f32x4*)(out + off + 4) = h1; *(u32x4*)(hb + off) = pack8(h0, h1); ss += dot4s(h0) + dot4s(h1); }
                ss += __shfl_xor(ss, 16); ss += __shfl_xor(ss, 32);
                if (fq == 0) ssq[(size_t)row * 16 + u.pn * 4 + wc] = ss; }
    }
};
struct EpiQ {
    static constexpr bool PERM = true, AFTER_DRAIN = false;
    const float* ssq; bf16_t* qp; float eps;
    __device__ __forceinline__ void operator()(const f32x4 (&acc)[2][2][4][2], const Unit& u, int wr, int wc, int fr, int fq) const {
        const int row0 = u.pm * BM + wr * 64 + fr;
#pragma unroll
        for (int ai = 0; ai < 2; ++ai)
#pragma unroll
            for (int m = 0; m < 4; ++m) { const int row = row0 + ai * HALF + m * 16; const f32x4* sp = (const f32x4*)(ssq + (size_t)row * 16);
                const f32x4 a = sp[0], b = sp[1], c = sp[2], d = sp[3]; const f32x4 t = (a + b) + (c + d);
                const float rstd = rsqrtf(((t[0] + t[1]) + (t[2] + t[3])) * (1.0f / 1024.0f) + eps);
#pragma unroll
                for (int bj = 0; bj < 2; ++bj) *(u32x4*)(qp + (size_t)row * 2048 + u.pn * BM + bj * HALF + wc * 32 + 8 * fq) = pack8(acc[ai][bj][m][0] * rstd, acc[ai][bj][m][1] * rstd); }
    }
};
__device__ __forceinline__ f32x4 bf_lo4(unsigned a, unsigned b) { f32x4 r; r[0] = __uint_as_float(a << 16); r[1] = __uint_as_float(a & 0xffff0000u); r[2] = __uint_as_float(b << 16); r[3] = __uint_as_float(b & 0xffff0000u); return r; }
struct EpiGate {
    static constexpr bool PERM = true, AFTER_DRAIN = false;
    float* out; const bf16_t* e;
    __device__ __forceinline__ void operator()(const f32x4 (&acc)[2][2][4][2], const Unit& u, int wr, int wc, int fr, int fq) const {
        const int row0 = u.pm * BM + wr * 64 + fr;
#pragma unroll
        for (int ai = 0; ai < 2; ++ai)
#pragma unroll
            for (int m = 0; m < 4; ++m) { const int row = row0 + ai * HALF + m * 16;
#pragma unroll
                for (int bj = 0; bj < 2; ++bj) { const size_t off = (size_t)row * 1024 + u.pn * BM + bj * HALF + wc * 32 + 8 * fq;
                    const u32x4 ev = *(const u32x4*)(e + off); const f32x4 e0 = bf_lo4(ev.x, ev.y), e1 = bf_lo4(ev.z, ev.w);
                    const f32x4 h0 = *(const f32x4*)(out + off) + e0 * sigmoid4(acc[ai][bj][m][0]), h1 = *(const f32x4*)(out + off + 4) + e1 * sigmoid4(acc[ai][bj][m][1]);
                    *(f32x4*)(out + off) = h0; *(f32x4*)(out + off + 4) = h1; } }
    }
};
template <class Epi, class Sched, bool ALIGN_EPI = false, bool SP2 = false>
__device__ __forceinline__ void gemm_phase(PG8_LAS unsigned char* lds, const Gemm g, const Sched& S, const Epi& E, const int wid  ) {
    int lane; asm volatile("v_mbcnt_lo_u32_b32 %0, -1, 0\n\tv_mbcnt_hi_u32_b32 %0, -1, %0" : "=v"(lane));
    const int tid = wid * 64 + lane, wr = wid >> 2, wc = wid & 3, fr = lane & 15, fq = lane >> 4;
    const int K = g.K, nt = K / BK;
    unsigned voffA[2], voffB[2];
#pragma unroll
    for (int i = 0; i < 2; ++i) { int R, C; stage_rc(tid * 16 + i * 8192, R, C); const int Rb = Epi::PERM ? ((R & ~31) + perm32(R & 31)) : R;
        voffA[i] = (unsigned)(R * K + C) * 2u; voffB[i] = (unsigned)(Rb * K + C) * 2u; }
    const size_t kstep = (size_t)(BK * 2);
    const size_t hstep = (size_t)HALF * K * 2;
    const size_t tstep = 2 * hstep;
    const unsigned ldsw = (unsigned)wid * 1024u;
    const int aoff = lds_byte(wr * 64 + fr, fq * 8), boff = lds_byte(wc * 32 + fr, fq * 8);
#define PG8_SA(b, h) (((b) * 2 + (h)) * HTB)
#define PG8_SB(b, h) ((4 + (b) * 2 + (h)) * HTB)
#define PG8_STAGE(bufoff, gbase, voff) do { _Pragma("unroll") for (int _i = 0; _i < 2; ++_i) \
        __builtin_amdgcn_global_load_lds((const unsigned*)((const char*)(gbase) + (voff)[_i]), (PG8_LAS unsigned*)(lds + (bufoff) + ldsw + _i * 8192), 16, 0, 0); } while (0)
#define PG8_LDA(dst, b, h) do { _Pragma("unroll") for (int m = 0; m < 4; ++m) _Pragma("unroll") for (int k = 0; k < 2; ++k) dst[m][k] = *(const PG8_LAS bf16x8*)(lds + PG8_SA(b, h) + aoff + m * 2048 + k * 1024); } while (0)
#define PG8_LDB(dst, b, h) do { _Pragma("unroll") for (int n = 0; n < 2; ++n) _Pragma("unroll") for (int k = 0; k < 2; ++k) dst[n][k] = *(const PG8_LAS bf16x8*)(lds + PG8_SB(b, h) + boff + n * 2048 + k * 1024); } while (0)
#define PG8_MMA(ai, bj, At, Bt) do { __builtin_amdgcn_s_setprio(1); _Pragma("unroll") for (int m = 0; m < 4; ++m) _Pragma("unroll") for (int n = 0; n < 2; ++n) _Pragma("unroll") for (int k = 0; k < 2; ++k) \
        acc[ai][bj][m][n] = __builtin_amdgcn_mfma_f32_16x16x32_bf16(Bt[n][k], At[m][k], acc[ai][bj][m][n], 0, 0, 0); __builtin_amdgcn_s_setprio(0); } while (0)
#define PG8_WAIT_V(n) asm volatile("s_waitcnt vmcnt(" #n ")" ::: "memory")
#define PG8_WAIT_L(n) asm volatile("s_waitcnt lgkmcnt(" #n ")" ::: "memory")
#define PG8_BAR __builtin_amdgcn_s_barrier()
#define PG8_SCHED __builtin_amdgcn_sched_barrier(0)
    Unit cur, nxt; int ui = 0;
    if (!S.next(0, cur)) return;
    f32x4 acc[2][2][4][2];
#pragma unroll
    for (int a = 0; a < 2; ++a)
#pragma unroll
        for (int b = 0; b < 2; ++b)
#pragma unroll
            for (int m = 0; m < 4; ++m)
#pragma unroll
                for (int n = 0; n < 2; ++n) acc[a][b][m][n] = (f32x4){0.f, 0.f, 0.f, 0.f};
    bf16x8 At[4][2], B0[2][2], B1[2][2];
    const char* cA = (const char*)g.A + (size_t)cur.pm * tstep; const char* cB = (const char*)g.Bt + (size_t)cur.pn * tstep;
    S.a_ready(cur);
    if constexpr (SP2) {
        PG8_STAGE(PG8_SB(0, 0), cB, voffB); PG8_STAGE(PG8_SB(0, 1), cB + hstep, voffB); PG8_STAGE(PG8_SA(0, 0), cA, voffA); PG8_STAGE(PG8_SA(0, 1), cA + hstep, voffA);
        if (wr == 1) PG8_BAR;
        PG8_WAIT_V(2); PG8_BAR;
        PG8_STAGE(PG8_SB(1, 0), cB + kstep, voffB); PG8_STAGE(PG8_SA(1, 0), cA + kstep, voffA); PG8_STAGE(PG8_SB(1, 1), cB + hstep + kstep, voffB);
        PG8_WAIT_V(6); PG8_BAR;
    } else {
        PG8_STAGE(PG8_SB(0, 0), cB, voffB); PG8_STAGE(PG8_SA(0, 0), cA, voffA); PG8_STAGE(PG8_SB(0, 1), cB + hstep, voffB); PG8_STAGE(PG8_SA(0, 1), cA + hstep, voffA);
        if (wr == 1) PG8_BAR;
        PG8_WAIT_V(4); PG8_BAR;
        PG8_STAGE(PG8_SB(1, 0), cB + kstep, voffB); PG8_STAGE(PG8_SA(1, 0), cA + kstep, voffA); PG8_STAGE(PG8_SB(1, 1), cB + hstep + kstep, voffB);
        PG8_WAIT_V(6); PG8_BAR;
    }
    for (;;) {
        const bool has_next = S.next(ui + 1, nxt);
        const char* nA = has_next ? (const char*)g.A + (size_t)nxt.pm * tstep : cA; const char* nB = has_next ? (const char*)g.Bt + (size_t)nxt.pn * tstep : cB;
        for (int t = 0; t < nt; t += 2) {
            const bool last = (t == nt - 2);
            const char* a1 = cA + (size_t)(t + 1) * kstep;
            const char* a2 = last ? nA : cA + (size_t)(t + 2) * kstep; const char* b2 = last ? nB : cB + (size_t)(t + 2) * kstep;
            const char* a3 = a2 + kstep; const char* b3 = b2 + kstep;
            if (last && has_next) S.a_ready(nxt);
            if constexpr (SP2) {
            PG8_LDB(B0, 0, 0); PG8_LDB(B1, 0, 1); PG8_SCHED; PG8_LDA(At, 0, 0); PG8_STAGE(PG8_SA(1, 1), a1 + hstep, voffA);
            PG8_WAIT_V(8); PG8_WAIT_L(0); PG8_BAR; PG8_MMA(0, 0, At, B0); PG8_MMA(0, 1, At, B1); PG8_BAR; PG8_SCHED;
            PG8_LDA(At, 0, 1); PG8_STAGE(PG8_SB(0, 0), b2, voffB); PG8_STAGE(PG8_SB(0, 1), b2 + hstep, voffB); PG8_STAGE(PG8_SA(0, 0), a2, voffA);
            PG8_WAIT_V(8); PG8_WAIT_L(0); PG8_BAR; PG8_MMA(1, 0, At, B0); PG8_MMA(1, 1, At, B1); PG8_BAR; PG8_SCHED;
            PG8_LDB(B0, 1, 0); PG8_LDB(B1, 1, 1); PG8_SCHED; PG8_LDA(At, 1, 0); PG8_STAGE(PG8_SA(0, 1), a2 + hstep, voffA);
            PG8_WAIT_V(8); PG8_WAIT_L(0); PG8_BAR; PG8_MMA(0, 0, At, B0); PG8_MMA(0, 1, At, B1); PG8_BAR; PG8_SCHED;
            PG8_LDA(At, 1, 1); PG8_STAGE(PG8_SB(1, 0), b3, voffB); PG8_STAGE(PG8_SB(1, 1), b3 + hstep, voffB); PG8_STAGE(PG8_SA(1, 0), a3, voffA);
            PG8_WAIT_V(8); PG8_WAIT_L(0); PG8_BAR; PG8_MMA(1, 0, At, B0); PG8_MMA(1, 1, At, B1); PG8_BAR; PG8_SCHED;
            } else {
            PG8_LDB(B0, 0, 0); PG8_SCHED; PG8_LDA(At, 0, 0); PG8_STAGE(PG8_SA(1, 1), a1 + hstep, voffA);
            PG8_WAIT_L(8); PG8_BAR; PG8_WAIT_L(0); PG8_MMA(0, 0, At, B0); PG8_BAR; PG8_SCHED;
            PG8_LDB(B1, 0, 1); PG8_STAGE(PG8_SB(0, 0), b2, voffB);
            PG8_BAR; PG8_WAIT_L(0); PG8_MMA(0, 1, At, B1); PG8_BAR;
            PG8_LDA(At, 0, 1); PG8_STAGE(PG8_SA(0, 0), a2, voffA);
            PG8_BAR; PG8_WAIT_L(0); PG8_MMA(1, 0, At, B0); PG8_BAR; PG8_SCHED;
            PG8_STAGE(PG8_SB(0, 1), b2 + hstep, voffB);
            PG8_WAIT_V(6); PG8_BAR; PG8_MMA(1, 1, At, B1); PG8_BAR;
            PG8_LDB(B0, 1, 0); PG8_SCHED; PG8_LDA(At, 1, 0); PG8_STAGE(PG8_SA(0, 1), a2 + hstep, voffA);
            PG8_WAIT_L(8); PG8_BAR; PG8_WAIT_L(0); PG8_MMA(0, 0, At, B0); PG8_BAR; PG8_SCHED;
            PG8_LDB(B1, 1, 1); PG8_STAGE(PG8_SB(1, 0), b3, voffB);
            PG8_BAR; PG8_WAIT_L(0); PG8_MMA(0, 1, At, B1); PG8_BAR;
            PG8_LDA(At, 1, 1); PG8_STAGE(PG8_SA(1, 0), a3, voffA);
            PG8_BAR; PG8_WAIT_L(0); PG8_MMA(1, 0, At, B0); PG8_BAR; PG8_SCHED;
            PG8_STAGE(PG8_SB(1, 1), b3 + hstep, voffB);
            PG8_WAIT_V(6); PG8_BAR; PG8_MMA(1, 1, At, B1); PG8_BAR;
            }
        }
        if constexpr (ALIGN_EPI) { if (wr == 0) PG8_BAR; }
        if constexpr (!Epi::AFTER_DRAIN) { E(acc, cur, wr, wc, fr, fq); S.done(cur); }
        if (!has_next) break;
#pragma unroll
        for (int a = 0; a < 2; ++a)
#pragma unroll
            for (int b = 0; b < 2; ++b)
#pragma unroll
                for (int m = 0; m < 4; ++m)
#pragma unroll
                    for (int n = 0; n < 2; ++n) acc[a][b][m][n] = (f32x4){0.f, 0.f, 0.f, 0.f};
        cur = nxt; cA = nA; cB = nB; ++ui;
        if constexpr (ALIGN_EPI) { if (wr == 1) PG8_BAR; }
    }
    PG8_WAIT_V(0);
    if constexpr (!ALIGN_EPI) { if (wr == 0) PG8_BAR; }
    PG8_BAR;
    if constexpr (Epi::AFTER_DRAIN) { E.fused(acc, cur, wr, wc, fr, fq, lds, wid, lane); S.done(cur); }
#undef PG8_SA
#undef PG8_SB
#undef PG8_STAGE
#undef PG8_LDA
#undef PG8_LDB
#undef PG8_MMA
#undef PG8_WAIT_V
#undef PG8_WAIT_L
#undef PG8_BAR
#undef PG8_SCHED
}
}
#include <hip/hip_bf16.h>
#include <cmath>
namespace attn_body {
using bf16=__hip_bfloat16;
using bf16x8=__attribute__((ext_vector_type(8)))short;
using s16x4=__attribute__((ext_vector_type(4)))short;
using f32x16=__attribute__((ext_vector_type(16)))float;
using u32x4=__attribute__((ext_vector_type(4)))unsigned;
constexpr int BATCH=8,NHEAD=16,SEQ=4096,D=64,DM=NHEAD*D;
constexpr int NW=8,QBLK=32,QB=QBLK*NW,KVBLK=64,NQB=SEQ/QB;
constexpr int ATTN_PITCH=DM, ATTN_UNIT_ROWS=QB;
__device__ __forceinline__ int crow(int r,int hi){return (r&3)+8*(r>>2)+4*hi;}
#define SBAR() __builtin_amdgcn_sched_barrier(0)
__device__ __forceinline__ void cmask(f32x16&p0,f32x16&p1,int jb,int qrel,int hi){
  const float NEG=-INFINITY; int kb=64*jb+4*hi;
  #pragma unroll
  for(int r=0;r<16;++r){int kv=kb+(r&3)+8*(r>>2); if(kv>qrel)p0[r]=NEG; if(kv+32>qrel)p1[r]=NEG;}
}

constexpr int NSLOT=3, SLOTB=8192;
constexpr int LDS_K=0, LDS_V=NSLOT*SLOTB, LDS_WS=2*NSLOT*SLOTB, LDS_OST=LDS_WS+NW*64*4, LDS_BYTES=LDS_OST+NW*4096;
constexpr float C2=0.125f*1.4426950408889634f;
__device__ __forceinline__ void glds16(const void*gsrc,unsigned lds_dst){unsigned keep;
  asm volatile("s_mov_b32 %0, m0\n\ts_mov_b32 m0, %2\n\ts_nop 0\n\tglobal_load_lds_dwordx4 %1, off\n\ts_mov_b32 m0, %0":"=&s"(keep):"v"(gsrc),"s"(lds_dst):"memory");}
__device__ __forceinline__ float max3f(float a,float b,float c){float r;asm("v_max3_f32 %0, %1, %2, %3":"=v"(r):"v"(a),"v"(b),"v"(c));return r;}
__device__ __forceinline__ float max2f(float a,float b){float r;asm("v_max_f32_e32 %0, %1, %2":"=v"(r):"v"(a),"v"(b));return r;}
__device__ __forceinline__ float fadd_s(float a,float b){float r;asm("v_add_f32_e32 %0, %1, %2":"=v"(r):"v"(a),"v"(b));return r;}
__device__ __forceinline__ float fsub_s(float a,float b){float r;asm("v_sub_f32_e32 %0, %1, %2":"=v"(r):"v"(a),"v"(b));return r;}
typedef float f32x2_t __attribute__((ext_vector_type(2))); typedef __bf16 bf16x2_t __attribute__((ext_vector_type(2)));
__device__ __forceinline__ unsigned cvtpk_s(float lo,float hi){f32x2_t v={lo,hi};bf16x2_t b=__builtin_convertvector(v,bf16x2_t);return __builtin_bit_cast(unsigned,b);}
#define WAIT_BAR(N) asm volatile("s_waitcnt vmcnt(" #N ") lgkmcnt(0)\n\ts_barrier":::"memory")

__device__ __forceinline__ void qkt(f32x16&p0,f32x16&p1,const char*Kslot,const bf16x8*qr,const f32x16&negm,int r32,int hi){
  const char*kb=Kslot+hi*1024+r32*16;
  #pragma unroll
  for(int d0=0;d0<4;++d0){
    const bf16x8 b0=*reinterpret_cast<const bf16x8*>(kb+d0*2048);
    const bf16x8 b1=*reinterpret_cast<const bf16x8*>(kb+d0*2048+512);
    if(d0==0){p0=__builtin_amdgcn_mfma_f32_32x32x16_bf16(b0,qr[0],negm,0,0,0);p1=__builtin_amdgcn_mfma_f32_32x32x16_bf16(b1,qr[0],negm,0,0,0);}
    else{p0=__builtin_amdgcn_mfma_f32_32x32x16_bf16(b0,qr[d0],p0,0,0,0);p1=__builtin_amdgcn_mfma_f32_32x32x16_bf16(b1,qr[d0],p1,0,0,0);}}
}
typedef __attribute__((address_space(3))) const char* lds_cptr;
typedef short v4i16_t __attribute__((ext_vector_type(4)));
__device__ __forceinline__ void kload8(bf16x8*kf,lds_cptr kp){
  kf[0]=*(const __attribute__((address_space(3))) bf16x8*)(kp);      kf[1]=*(const __attribute__((address_space(3))) bf16x8*)(kp+512);
  kf[2]=*(const __attribute__((address_space(3))) bf16x8*)(kp+2048); kf[3]=*(const __attribute__((address_space(3))) bf16x8*)(kp+2560);
  kf[4]=*(const __attribute__((address_space(3))) bf16x8*)(kp+4096); kf[5]=*(const __attribute__((address_space(3))) bf16x8*)(kp+4608);
  kf[6]=*(const __attribute__((address_space(3))) bf16x8*)(kp+6144); kf[7]=*(const __attribute__((address_space(3))) bf16x8*)(kp+6656);
}
__device__ __forceinline__ void kload2(bf16x8*kf,lds_cptr kp,int j){ kf[2*j]=*(const __attribute__((address_space(3))) bf16x8*)(kp+j*2048); kf[2*j+1]=*(const __attribute__((address_space(3))) bf16x8*)(kp+j*2048+512); }
__device__ __forceinline__ s16x4 vtr(lds_cptr p){ return __builtin_bit_cast(s16x4,__builtin_amdgcn_ds_read_tr16_b64_v4i16((__attribute__((address_space(3))) v4i16_t*)p)); }
__device__ __forceinline__ float rowmax(const f32x16&p0,const f32x16&p1){
  float a=max3f(p0[0],p0[1],p1[0]),b=max3f(p0[2],p0[3],p1[1]);a=max3f(a,p1[2],p1[3]);
  #pragma unroll
  for(int r=4;r<16;r+=4){a=max3f(a,p0[r],p0[r+1]);b=max3f(b,p0[r+2],p0[r+3]);a=max3f(a,p1[r],p1[r+1]);b=max3f(b,p1[r+2],p1[r+3]);}
  const float m=max2f(a,b);
  auto rr=__builtin_amdgcn_permlane32_swap(__float_as_uint(m),__float_as_uint(m),false,false);
  return max2f(__uint_as_float(rr[0]),__uint_as_float(rr[1]));
}
__device__ __forceinline__ void pv(f32x16*o,int vb,bf16x8 pa0,bf16x8 pa1,bf16x8 pa2,bf16x8 pa3){
  #pragma unroll
  for(int d0=0;d0<2;++d0){s16x4 lo[4],hi[4];
    #pragma unroll
    for(int ks=0;ks<4;++ks){
      asm volatile("ds_read_b64_tr_b16 %0,%1 offset:%c2":"=&v"(lo[ks]):"v"(vb),"i"(d0*4096+ks*1024):"memory");
      asm volatile("ds_read_b64_tr_b16 %0,%1 offset:%c2":"=&v"(hi[ks]):"v"(vb),"i"(d0*4096+ks*1024+512):"memory");}
    asm volatile("s_waitcnt lgkmcnt(0)":::"memory");SBAR();
    #define PK(k) (bf16x8){lo[k][0],lo[k][1],lo[k][2],lo[k][3],hi[k][0],hi[k][1],hi[k][2],hi[k][3]}
    o[d0]=__builtin_amdgcn_mfma_f32_32x32x16_bf16(pa0,PK(0),o[d0],0,0,0);
    o[d0]=__builtin_amdgcn_mfma_f32_32x32x16_bf16(pa1,PK(1),o[d0],0,0,0);
    o[d0]=__builtin_amdgcn_mfma_f32_32x32x16_bf16(pa2,PK(2),o[d0],0,0,0);
    o[d0]=__builtin_amdgcn_mfma_f32_32x32x16_bf16(pa3,PK(3),o[d0],0,0,0);
    #undef PK
  }
}

#ifndef ATTN_STORE16
#define ATTN_STORE16(p,v) (*(u32x4*)(p)=(v))
#endif
template<int THRL> __device__ __forceinline__ void attn_unit(int b,int h,int qb,const bf16*Q,const bf16*__restrict__ K,const bf16*__restrict__ V,bf16*O,char*shm,const int tid_in){
  const int tid=tid_in,lane=tid&63,r32=lane&31,hi=lane>>5; const int wid=__builtin_amdgcn_readfirstlane(tid>>6);
  const long rowbase=(long)b*SEQ; const int q0=qb*QB;
  const bf16*Qw=Q+(rowbase+q0+wid*QBLK)*DM+h*D;
  const bf16*Kh=K+rowbase*DM+h*D,*Vh=V+rowbase*DM+h*D;
  const unsigned lds0=(unsigned)(uintptr_t)shm;
  float*wsf=(float*)(shm+LDS_WS)+wid*64;
  const bf16*ksrc=Kh+(long)lane*DM+wid*8;
  const bf16*vsrc=Vh+(long)(16*(wid&3)+(lane>>2))*DM+(wid>>2)*32+(lane&3)*8;
  const unsigned kdst=lds0+LDS_K+wid*1024, vdst=lds0+LDS_V+wid*1024;
  #define DMA_K(t,slot) glds16(ksrc+(long)(t)*KVBLK*DM,(unsigned)__builtin_amdgcn_readfirstlane(kdst+(slot)))
  #define DMA_V(t,slot) glds16(vsrc+(long)(t)*KVBLK*DM,(unsigned)__builtin_amdgcn_readfirstlane(vdst+(slot)))
  const int vb0=(int)(lds0+LDS_V)+((lane>>4)&1)*32+(lane&3)*8+(4*hi+((lane&15)>>2))*64;
  const char*Kbase=shm+LDS_K; bf16x8 kf[8];
  const lds_cptr shm3=(lds_cptr)shm; const lds_cptr kp0=shm3+LDS_K+hi*1024+r32*16; const lds_cptr vp0=shm3+LDS_V+((lane>>4)&1)*32+(lane&3)*8+(4*hi+((lane&15)>>2))*64;
  const int NT=(q0+QB)/KVBLK;
  DMA_K(0,0);DMA_V(0,0);DMA_K(1,SLOTB);
  bf16x8 qr[4];
  #pragma unroll
  for(int d0=0;d0<4;++d0)qr[d0]=*reinterpret_cast<const bf16x8*>(&Qw[(long)r32*DM+d0*16+hi*8]);
  float mhat=0.f,l_reg=0.f;f32x16 o[2];o[0]=f32x16{};o[1]=f32x16{};f32x16 negm=f32x16{};asm volatile("":"+v"(negm));
  const int qrel=wid*QBLK+r32;
  #define CMASK(P0,P1,t) do{int jb_=(t)-(NT-4); if(jb_>=0)cmask(P0,P1,jb_,qrel,hi);}while(0)
  bool resc=false;
  #define START(P0,P1) do{ const float rm=rowmax(P0,P1); resc=false; \
    { const float dl=rm; mhat=fadd_s(mhat,dl); \
      _Pragma("unroll") for(int r=0;r<16;++r){P0[r]=fsub_s(P0[r],dl);P1[r]=fsub_s(P1[r],dl);} \
      _Pragma("unroll") for(int r=0;r<16;++r)negm[r]=-mhat; asm volatile("":"+v"(negm)); } \
    _Pragma("unroll") for(int r=0;r<16;++r)P0[r]=__builtin_amdgcn_exp2f(P0[r]); }while(0)
  #define RESC() do{ if(resc){ asm volatile("s_waitcnt lgkmcnt(0)":::"memory"); \
      _Pragma("unroll") for(int d_=0;d_<2;++d_) _Pragma("unroll") for(int r=0;r<16;++r)o[d_][r]*=wsf[crow(r,hi)]; } }while(0)
  f32x16 pA0,pA1,pB0,pB1;
  int sl_prev=0,sl_cur=0,sl_next=SLOTB;
  #define ROT() do{sl_prev=sl_cur;sl_cur=sl_next;sl_next=(sl_next==(NSLOT-1)*SLOTB)?0:sl_next+SLOTB;}while(0)
  DMA_K(2,2*SLOTB);
  WAIT_BAR(3);
  qkt(pA0,pA1,Kbase,qr,negm,r32,hi);asm volatile("s_nop 15\n\ts_nop 7":"+v"(pA0),"+v"(pA1));CMASK(pA0,pA1,0);
  START(pA0,pA1);
  _Pragma("unroll") for(int r=0;r<16;++r)pA1[r]=__builtin_amdgcn_exp2f(pA1[r]);
  WAIT_BAR(0);
  DMA_K(3,0);DMA_V(1,SLOTB);
  ROT();
  kload8(kf,kp0+sl_cur);
  WAIT_BAR(2);
  s16x4 vlo[8],vhi[8]; u32x4 pw0,pw1,pw2,pw3;
  #define PKW(P,B) cvtpk_s(P[B],P[B+1])
  #define PAF(k) __builtin_bit_cast(bf16x8,pw##k)
  #define VFR(i) (bf16x8){vlo[i][0],vlo[i][1],vlo[i][2],vlo[i][3],vhi[i][0],vhi[i][1],vhi[i][2],vhi[i][3]}
  #define PIN(x) asm volatile("":"+v"(x))
  #define MX3(a,b,c) __builtin_fmaxf(__builtin_fmaxf((a),(b)),(c))
  #define GAPA(MF,A0,A1,A2,A3,W0,W1,PW) do{ MF; sacc+=A0; sacc+=A1; sacc+=A2; sacc+=A3; PIN(sacc); W0; W1; PIN(PW); SBAR(); }while(0)
  #define EX(v) __builtin_amdgcn_exp2f(v)
  #define GAPB(MF,X,B) do{ MF; X[B]=EX(X[B]); X[B+1]=EX(X[B+1]); X[B+2]=EX(X[B+2]); X[B+3]=EX(X[B+3]); PIN(X); SBAR(); }while(0)
  #define VRD(i) do{ vlo[i]=vtr(vp_+(((i)>>2)*4096+((i)&3)*1024)); vhi[i]=vtr(vp_+(((i)>>2)*4096+((i)&3)*1024+512)); }while(0)
  #define KRD(G,j) do{ if(G){ kload2(kf,kp0+sl_next,j); SBAR(); } }while(0)
  #define STEP(C0,C1,P0,P1,t,GK,GV,GL) do{ SBAR(); \
    const lds_cptr vp_=vp0+sl_prev; \
    VRD(0); SBAR(); float sacc=(P0[0]+P0[1]); \
    GAPA(C0=__builtin_amdgcn_mfma_f32_32x32x16_bf16(kf[0],qr[0],negm,0,0,0), P0[2],P0[3],P0[4],P0[5],     pw0[0]=PKW(P0,0), pw0[1]=PKW(P0,2), pw0); \
    VRD(4); SBAR(); GAPA(C1=__builtin_amdgcn_mfma_f32_32x32x16_bf16(kf[1],qr[0],negm,0,0,0), P0[6],P0[7],P0[8],P0[9],     pw0[2]=PKW(P0,4), pw0[3]=PKW(P0,6), pw0); \
    VRD(1); SBAR(); GAPA(C0=__builtin_amdgcn_mfma_f32_32x32x16_bf16(kf[2],qr[1],C0,0,0,0),   P0[10],P0[11],P0[12],P0[13], pw1[0]=PKW(P0,8), pw1[1]=PKW(P0,10), pw1); \
    VRD(5); SBAR(); GAPA(C1=__builtin_amdgcn_mfma_f32_32x32x16_bf16(kf[3],qr[1],C1,0,0,0),   P0[14],P0[15],P1[0],P1[1],   pw1[2]=PKW(P0,12),pw1[3]=PKW(P0,14), pw1); \
    VRD(2); SBAR(); GAPA(C0=__builtin_amdgcn_mfma_f32_32x32x16_bf16(kf[4],qr[2],C0,0,0,0),   P1[2],P1[3],P1[4],P1[5],     pw2[0]=PKW(P1,0), pw2[1]=PKW(P1,2), pw2); \
    VRD(6); SBAR(); GAPA(C1=__builtin_amdgcn_mfma_f32_32x32x16_bf16(kf[5],qr[2],C1,0,0,0),   P1[6],P1[7],P1[8],P1[9],     pw2[2]=PKW(P1,4), pw2[3]=PKW(P1,6), pw2); \
    VRD(3); SBAR(); GAPA(C0=__builtin_amdgcn_mfma_f32_32x32x16_bf16(kf[6],qr[3],C0,0,0,0),   P1[10],P1[11],P1[12],P1[13], pw3[0]=PKW(P1,8), pw3[1]=PKW(P1,10), pw3); \
    VRD(7); SBAR(); GAPA(C1=__builtin_amdgcn_mfma_f32_32x32x16_bf16(kf[7],qr[3],C1,0,0,0),   P1[14],P1[15],0.f,0.f,       pw3[2]=PKW(P1,12),pw3[3]=PKW(P1,14), pw3); \
    l_reg+=sacc; \
    if(GK){DMA_K((t)+3,sl_cur);} if(GV){DMA_V((t)+1,sl_next);} \
    CMASK(C0,C1,t); \
    { float a=MX3(C0[0],C0[1],C1[0]),b=MX3(C0[2],C0[3],C1[1]); a=MX3(a,C1[2],C1[3]); \
      _Pragma("unroll") for(int r=4;r<16;r+=4){a=MX3(a,C0[r],C0[r+1]);b=MX3(b,C0[r+2],C0[r+3]);a=MX3(a,C1[r],C1[r+1]);b=MX3(b,C1[r+2],C1[r+3]);} \
      float rm=__builtin_fmaxf(a,b); { auto rr=__builtin_amdgcn_permlane32_swap(__float_as_uint(rm),__float_as_uint(rm),false,false); rm=__builtin_fmaxf(__uint_as_float(rr[0]),__uint_as_float(rr[1])); } \
      resc=false; \
      if(__builtin_expect(__any(rm>(float)THRL),0)){ const float dl=__builtin_fmaxf(rm,0.f); mhat+=dl; \
        _Pragma("unroll") for(int r=0;r<16;++r){C0[r]-=dl;C1[r]-=dl;} \
        _Pragma("unroll") for(int r=0;r<16;++r)negm[r]=-mhat; asm volatile("":"+v"(negm)); \
        const float f=__builtin_amdgcn_exp2f(-dl); l_reg*=f; if(hi==0)wsf[r32]=f; resc=true; } } \
    SBAR(); \
    GAPB(o[0]=__builtin_amdgcn_mfma_f32_32x32x16_bf16(PAF(0),VFR(0),o[0],0,0,0), C0,0); \
    GAPB(o[1]=__builtin_amdgcn_mfma_f32_32x32x16_bf16(PAF(0),VFR(4),o[1],0,0,0), C0,4); \
    KRD(GL,0); GAPB(o[0]=__builtin_amdgcn_mfma_f32_32x32x16_bf16(PAF(1),VFR(1),o[0],0,0,0), C0,8); \
    KRD(GL,1); GAPB(o[1]=__builtin_amdgcn_mfma_f32_32x32x16_bf16(PAF(1),VFR(5),o[1],0,0,0), C0,12); \
    KRD(GL,2); GAPB(o[0]=__builtin_amdgcn_mfma_f32_32x32x16_bf16(PAF(2),VFR(2),o[0],0,0,0), C1,0); \
    KRD(GL,3); GAPB(o[1]=__builtin_amdgcn_mfma_f32_32x32x16_bf16(PAF(2),VFR(6),o[1],0,0,0), C1,4); \
    GAPB(o[0]=__builtin_amdgcn_mfma_f32_32x32x16_bf16(PAF(3),VFR(3),o[0],0,0,0), C1,8); \
    GAPB(o[1]=__builtin_amdgcn_mfma_f32_32x32x16_bf16(PAF(3),VFR(7),o[1],0,0,0), C1,12); \
    }while(0)
  int t=1;
  #undef CMASK
  #define CMASK(P0,P1,t) do{}while(0)
  for(;t+5<NT;t+=2){
    STEP(pB0,pB1,pA0,pA1,t,true,true,true);     WAIT_BAR(2); RESC(); ROT();
    STEP(pA0,pA1,pB0,pB1,t+1,true,true,true);   WAIT_BAR(2); RESC(); ROT();
  }
  #undef CMASK
  #define CMASK(P0,P1,t) do{int jb_=(t)-(NT-4); if(jb_>=0)cmask(P0,P1,jb_,qrel,hi);}while(0)
  #define ENDW(tt) do{ if((tt)+3<NT){WAIT_BAR(2);} else if((tt)+2<NT){WAIT_BAR(1);} else {WAIT_BAR(0);} }while(0)
  for(;t+1<NT;t+=2){
    STEP(pB0,pB1,pA0,pA1,t,(t+3<NT),(t+1<NT),(t+1<NT));       ENDW(t);   RESC(); ROT();
    STEP(pA0,pA1,pB0,pB1,t+1,(t+4<NT),(t+2<NT),(t+2<NT));     ENDW(t+1); RESC(); ROT();
  }
  STEP(pB0,pB1,pA0,pA1,NT-1,false,false,false); RESC();
  { float sacc=pB0[0]+pB0[1]; _Pragma("unroll") for(int r=2;r<16;++r)sacc+=pB0[r]; _Pragma("unroll") for(int r=0;r<16;++r)sacc+=pB1[r]; l_reg+=sacc;
    pw0=(u32x4){PKW(pB0,0),PKW(pB0,2),PKW(pB0,4),PKW(pB0,6)};pw1=(u32x4){PKW(pB0,8),PKW(pB0,10),PKW(pB0,12),PKW(pB0,14)};pw2=(u32x4){PKW(pB1,0),PKW(pB1,2),PKW(pB1,4),PKW(pB1,6)};pw3=(u32x4){PKW(pB1,8),PKW(pB1,10),PKW(pB1,12),PKW(pB1,14)};
    SBAR(); pv(o,vb0+sl_cur,PAF(0),PAF(1),PAF(2),PAF(3)); }
  #undef PKW
  #undef PAF
  #undef VFR
  #undef PIN
  #undef MX3
  #undef GAPA
  #undef GAPB
  #undef EX
  #undef VRD
  #undef KRD
  #undef STEP
  #undef ENDW
  {auto rr=__builtin_amdgcn_permlane32_swap(__float_as_uint(l_reg),__float_as_uint(l_reg),false,false);l_reg=__uint_as_float(rr[0])+__uint_as_float(rr[1]);}
  if(hi==0)wsf[32+r32]=l_reg;asm volatile("s_waitcnt lgkmcnt(0)":::"memory");
  float rli[16];
  #pragma unroll
  for(int r=0;r<16;++r)rli[r]=__builtin_amdgcn_rcpf(wsf[32+crow(r,hi)]);
  bf16*Ow=O+(rowbase+q0+wid*QBLK)*DM+h*D;
  { bf16*stg=(bf16*)(shm+LDS_OST)+wid*2048;
    #pragma unroll
    for(int r=0;r<16;++r){const int orow=crow(r,hi);
      #pragma unroll
      for(int d0=0;d0<2;++d0)stg[orow*64+d0*32+r32]=__float2bfloat16(o[d0][r]*rli[r]);}
    asm volatile("s_waitcnt lgkmcnt(0)":::"memory");
    #pragma unroll
    for(int i=0;i<4;++i){const int row=i*8+(lane>>3),ch=lane&7; const u32x4 v=*(const u32x4*)(stg+row*64+ch*8); ATTN_STORE16(Ow+(long)row*DM+ch*8,v);} }
  asm volatile("s_waitcnt lgkmcnt(0)\n\ts_barrier":::"memory");
  #undef DMA_K
  #undef DMA_V
  #undef CMASK
  #undef START
  #undef RESC
  #undef ROT
}
constexpr int ATTN_LDS_BYTES=LDS_BYTES;
struct AttnTensors { const bf16* Q; const bf16* K; const bf16* V; bf16* O; };
struct AttnUnit { int bh; int qb; };
template<class Sched,int THRL=8> __device__ __forceinline__ void attn_phase(char*lds,const AttnTensors&T,const Sched&S,const int tid_in){
  AttnUnit u;
  for(int i=0;S.next(i,u);++i){ S.a_ready(u); attn_unit<THRL>(u.bh/NHEAD,u.bh%NHEAD,u.qb,T.Q,T.K,T.V,T.O,lds,tid_in); S.done(u); }
}
#undef SBAR
#undef WAIT_BAR
}
constexpr int NWAVES = 8;
constexpr int BATCH = 8, SEQ = 4096, DM = 1024, M = BATCH * SEQ;
constexpr int IN_COLS = 2560, PLE_DIM = 256, NEXP = 16384, QCOLS = 2048;
constexpr float EPS = 1e-6f;
#ifndef MK_N_LAUNCHES
#define MK_N_LAUNCHES 1
#endif
constexpr int N_PHASES = 8;
constexpr size_t MiB = 1u << 20;
constexpr size_t WS_CTL = 0, CTL_ZERO_BYTES = 1 * MiB;
constexpr size_t WS_ROPEC = 1 * MiB, WS_ROPES = 1 * MiB + 512 * 1024;
constexpr size_t WS_KEYS = 2 * MiB;
constexpr size_t WS_WPROJ = 3 * MiB;
constexpr size_t WS_WIN = 4 * MiB;
constexpr size_t WS_WOUT = 10 * MiB, WS_WQ = 12 * MiB, WS_WGATE = 16 * MiB;
constexpr size_t WS_SSQ1 = 18 * MiB;
constexpr size_t WS_PB = 24 * MiB;
constexpr size_t WS_E = 40 * MiB;
constexpr size_t WS_UT = 104 * MiB, WS_VT = 120 * MiB;
constexpr size_t WS_SU = 136 * MiB, WS_SV = 137 * MiB;
constexpr size_t WS_XN = 168 * MiB;
constexpr size_t WS_QO = 232 * MiB, WS_K = 296 * MiB, WS_V = 360 * MiB;
constexpr size_t WS_U = 424 * MiB;
constexpr size_t WS_H1B = 232 * MiB;
constexpr size_t WS_QP = 296 * MiB;
constexpr size_t WS_XN2 = 424 * MiB;
constexpr size_t WS_END = 488 * MiB;
constexpr int RING_BYTES = 131072, LDS_BYTES = 147456;
constexpr int MISC_OFF = LDS_BYTES - 256;
constexpr int CW_BAR = 4096;

#define GAS __attribute__((address_space(1)))
#define LAS __attribute__((address_space(3)))
typedef unsigned short bf16;
typedef unsigned v4u __attribute__((ext_vector_type(4)));
typedef float f32x4 __attribute__((ext_vector_type(4)));
typedef float f32x16 __attribute__((ext_vector_type(16)));
typedef short bf16x8 __attribute__((ext_vector_type(8)));
typedef __bf16 bf16x2_t __attribute__((ext_vector_type(2)));
#define LDS_WAIT() asm volatile("s_waitcnt lgkmcnt(0)" ::: "memory")
#define VM_WAIT() asm volatile("s_waitcnt vmcnt(0)" ::: "memory")
__device__ __forceinline__ unsigned f2bf(float f) { unsigned u = __builtin_bit_cast(unsigned, f); return (u + 0x7fffu + ((u >> 16) & 1u)) >> 16; }
__device__ __forceinline__ unsigned pk2(float lo, float hi) { return f2bf(lo) | (f2bf(hi) << 16); }
__device__ __forceinline__ v4u pk8(const f32x4 a, const f32x4 b) { v4u w; w.x = pk2(a[0], a[1]); w.y = pk2(a[2], a[3]); w.z = pk2(b[0], b[1]); w.w = pk2(b[2], b[3]); return w; }
__device__ __forceinline__ float bflo(unsigned w) { return __uint_as_float(w << 16); }
__device__ __forceinline__ float bfhi(unsigned w) { return __uint_as_float(w & 0xffff0000u); }
__device__ __forceinline__ float dot4s_(const f32x4 a) { return (a[0] * a[0] + a[1] * a[1]) + (a[2] * a[2] + a[3] * a[3]); }
__device__ __forceinline__ float wave_sum(float v) {
#pragma unroll
    for (int o = 1; o < 64; o <<= 1) v += __shfl_xor(v, o);
    return v;
}
__device__ __forceinline__ float dot2bf(unsigned w, unsigned x, float acc) { return __builtin_amdgcn_fdot2_f32_bf16(__builtin_bit_cast(bf16x2_t, w), __builtin_bit_cast(bf16x2_t, x), acc, false); }

typedef GAS unsigned gu32;
#define RLX_AGENT __ATOMIC_RELAXED, __HIP_MEMORY_SCOPE_AGENT
#define XB_TMO      128
#define XB_XCNT(j)  (256  + 64 * (j))
#define XB_XSUB(j)  (1280 + 64 * (j))
#define XB_XGEN(j)  (2304 + 64 * (j))
#define XB_TOP      3328
#define XB_TOPGEN   3392
#define XCD_BAR_WORDS 3456
#define XB_SPIN_CAP (1u << 18)

__device__ __forceinline__ unsigned xb_ld(unsigned* p)              { return __hip_atomic_load(p, __ATOMIC_RELAXED, __HIP_MEMORY_SCOPE_AGENT); }
__device__ __forceinline__ unsigned xb_add(unsigned* p, unsigned v) { return __hip_atomic_fetch_add(p, v, __ATOMIC_RELAXED, __HIP_MEMORY_SCOPE_AGENT); }
__device__ __forceinline__ unsigned xb_xcc_id() { return (unsigned)__builtin_amdgcn_s_getreg((3 << 11) | 20) & 0xFu; }
#define XB_SPIN(cond, bar) do { unsigned _sp = 0; while (cond) { __builtin_amdgcn_s_sleep(1); \
    if ((++_sp & 255u) == 0u) { if (xb_ld(&(bar)[XB_TMO])) break; if (_sp > XB_SPIN_CAP) { atomicAdd(&(bar)[XB_TMO], 1u); break; } } } } while (0)

struct XcdBarrier {
    unsigned* bar; unsigned x;
    volatile LAS unsigned* st;
};

__device__ __forceinline__ XcdBarrier xcd_barrier_post(unsigned* bar, volatile LAS unsigned* st, const bool leader) {
    XcdBarrier b; b.bar = bar; b.x = xb_xcc_id(); b.st = st;
    if (leader) (void)xb_add(&bar[XB_XCNT(b.x)], 1u);
    return b;
}
__device__ __forceinline__ void xcd_barrier_complete(unsigned* bar, unsigned x, unsigned& nloc, unsigned& nx) {
    const unsigned G = gridDim.x * gridDim.y * gridDim.z;
    unsigned sum, cnt, mine, sp = 0u;
    for (;;) {
        sum = 0u; cnt = 0u; mine = 0u;
#pragma unroll
        for (unsigned j = 0; j < 16; ++j) { const unsigned c = xb_ld(&bar[XB_XCNT(j)]); sum += c; cnt += (c > 0u) ? 1u : 0u; mine = (j == x) ? c : mine; }
        if (sum == G) break;
        __builtin_amdgcn_s_sleep(1);
        if ((++sp & 255u) == 0u) { if (xb_ld(&bar[XB_TMO])) break; if (sp > XB_SPIN_CAP) { atomicAdd(&bar[XB_TMO], 1u); break; } }
    }
    nloc = mine > 0u ? mine : 1u; nx = cnt > 0u ? cnt : 1u;
}

__device__ __forceinline__ void xcd_barrier(const XcdBarrier& b, const bool leader  ) {
    asm volatile("s_waitcnt vmcnt(0)" ::: "memory");
    __syncthreads();
    if (leader) {
        unsigned* bar = b.bar;
        __builtin_amdgcn_s_waitcnt(0);
        unsigned nloc = b.st[0], nx = b.st[1];
        if (nloc == 0u) { xcd_barrier_complete(bar, b.x, nloc, nx); b.st[0] = nloc; b.st[1] = nx; }
        const unsigned old = xb_add(&bar[XB_XSUB(b.x)], 1u);
        const unsigned gen = old / nloc;
        if (old + 1u == (gen + 1u) * nloc) {
            __builtin_amdgcn_fence(__ATOMIC_RELEASE, "agent");
            asm volatile("s_waitcnt vmcnt(0)" ::: "memory");
            const unsigned og = xb_add(&bar[XB_TOP], 1u);
            const unsigned tg = og / nx;
            if (og + 1u == (tg + 1u) * nx) xb_add(&bar[XB_TOPGEN], 1u);
            else XB_SPIN(xb_ld(&bar[XB_TOPGEN]) == tg, bar);
            __builtin_amdgcn_fence(__ATOMIC_ACQUIRE, "agent");
            xb_add(&bar[XB_XGEN(b.x)], 1u);
            asm volatile("s_waitcnt vmcnt(0)" ::: "memory");
        } else {
            XB_SPIN(xb_ld(&bar[XB_XGEN(b.x)]) == gen, bar);
            __builtin_amdgcn_fence(__ATOMIC_ACQUIRE, "agent");
            asm volatile("s_waitcnt vmcnt(0)" ::: "memory");
        }
    }
    __syncthreads();
}

__device__ __forceinline__ int lane_id() { int l; asm volatile("v_mbcnt_lo_u32_b32 %0, -1, 0\n\tv_mbcnt_hi_u32_b32 %0, -1, %0" : "=v"(l)); return l; }
struct Frame {
    LAS unsigned char* lds; unsigned char* ldsg;
    int wave, vcu, G;
    float* out; unsigned char* ws;
};
template <int I> __device__ __forceinline__ const float* inptr() {
    const float* p = nullptr;
#if defined(__HIP_DEVICE_COMPILE__)
    const void* ka = (const void*)__builtin_amdgcn_kernarg_segment_ptr();
    asm volatile("s_load_dwordx2 %0, %1, %2\n\ts_waitcnt lgkmcnt(0)" : "=s"(p) : "s"(ka), "i"(I * 8) : "memory");
#endif
    return p;
}
#define INP(i) inptr<i>()

__device__ const double INVREV[32] = {0.15915494309189535, 0.11934937021124886, 0.089499401608891013, 0.067115083005227255, 0.050329212104487035, 0.037741584717419771, 0.028302195830623399, 0.02122365276477766,
    0.015915494309189534, 0.011934937021124886, 0.0089499401608891024, 0.0067115083005227253, 0.0050329212104487037, 0.0037741584717419772, 0.0028302195830623399, 0.0021223652764777662,
    0.0015915494309189536, 0.0011934937021124885, 0.00089499401608891024, 0.0006711508300522726, 0.00050329212104487033, 0.00037741584717419774, 0.00028302195830623395, 0.00021223652764777661,
    0.00015915494309189535, 0.00011934937021124886, 8.9499401608891018e-05, 6.7115083005227254e-05, 5.0329212104487035e-05, 3.7741584717419777e-05, 2.8302195830623396e-05, 2.1223652764777659e-05};
__device__ __forceinline__ int win_rowmap(int n) {
    if (n < 1024) { const int region = n >> 9, r = n & 511, tile = r >> 8, w = r & 255, blk = w >> 6, d = w & 63, bj = d >> 5, dlo = d & 31; return region * 512 + tile * 256 + bj * 128 + blk * 32 + dlo; }
    if (n < 1536) return n;
    const int cc = n - 1536, isg = cc >> 9, ch = cc & 511, j = ch >> 7, c2 = ch & 127; return 1536 + j * 256 + isg * 128 + c2;
}
template <bool MAP>
__device__ __forceinline__ void p0_transpose_item(const float* W, int K, int N, bf16* WT, const float* gk, LAS float* scr, int item, int lane) {
    const int nblk = N / 32, kb = item / nblk, nb = item % nblk, k0 = 64 * kb, n0 = 32 * nb;
#pragma unroll 8
    for (int i = 0; i < 32; ++i) { const int kk = 2 * i + (lane >> 5); float v = W[(size_t)(k0 + kk) * N + n0 + (lane & 31)]; if (gk) v *= gk[k0 + kk]; scr[kk * 33 + (lane & 31)] = v; }
    LDS_WAIT(); asm volatile("" ::: "memory");
    const int c = lane & 7; const int r0 = MAP ? win_rowmap(n0) : n0;
#pragma unroll
    for (int j = 0; j < 4; ++j) { const int n = (lane >> 3) + 8 * j; const LAS float* s = scr + (8 * c) * 33 + n;
        v4u o; o.x = pk2(s[0 * 33], s[1 * 33]); o.y = pk2(s[2 * 33], s[3 * 33]); o.z = pk2(s[4 * 33], s[5 * 33]); o.w = pk2(s[6 * 33], s[7 * 33]);
        *(GAS v4u*)(WT + (size_t)(r0 + n) * K + k0 + 8 * c) = o; }
    LDS_WAIT(); asm volatile("" ::: "memory");
}
__device__ __forceinline__ void cvt_stream(const float* src, bf16* dst, size_t n8, int gw, int NGW, int lane) {
    for (size_t c = (size_t)gw * 64 + lane; c < n8; c += (size_t)NGW * 64) { const f32x4 a = *(const GAS f32x4*)(src + c * 8), b = *(const GAS f32x4*)(src + c * 8 + 4); *(GAS v4u*)(dst + c * 8) = pk8(a, b); }
}
__device__ __forceinline__ void p0_prologue(Frame& F) {
    const int lane = lane_id();
    LAS float* scr = (LAS float*)(F.lds + F.wave * 16384);
    const int gw = F.vcu * NWAVES + F.wave, NGW = F.G * NWAVES;
    bf16* WIN = (bf16*)(F.ws + WS_WIN); bf16* WOUT = (bf16*)(F.ws + WS_WOUT); bf16* WQ = (bf16*)(F.ws + WS_WQ); bf16* WGATE = (bf16*)(F.ws + WS_WGATE); bf16* WPROJ = (bf16*)(F.ws + WS_WPROJ);
    constexpr int I_IN = (DM / 64) * (IN_COLS / 32), I_OUT = (DM / 64) * (DM / 32), I_Q = (DM / 64) * (QCOLS / 32), I_G = I_OUT, I_P = (PLE_DIM / 64) * (DM / 32);
    constexpr int NITEMS = I_IN + I_OUT + I_Q + I_G + I_P;
    for (int it = gw; it < NITEMS; it += NGW) {
        int r = it;
        if (r < I_IN) { p0_transpose_item<true>(INP(3), DM, IN_COLS, WIN, nullptr, scr, r, lane); continue; } r -= I_IN;
        if (r < I_OUT) { p0_transpose_item<false>(INP(13), DM, DM, WOUT, nullptr, scr, r, lane); continue; } r -= I_OUT;
        if (r < I_Q) { p0_transpose_item<false>(INP(15), DM, QCOLS, WQ, INP(14), scr, r, lane); continue; } r -= I_Q;
        if (r < I_G) { p0_transpose_item<false>(INP(20), DM, DM, WGATE, nullptr, scr, r, lane); continue; } r -= I_G;
        p0_transpose_item<false>(INP(21), PLE_DIM, DM, WPROJ, nullptr, scr, r, lane);
    }
    cvt_stream(INP(16), (bf16*)(F.ws + WS_KEYS), (size_t)2 * 128 * 128 / 8, gw, NGW, lane);
    { const float* ut = INP(17); const float* vt = INP(18); float* SU = (float*)(F.ws + WS_SU); float* SV = (float*)(F.ws + WS_SV);
      for (int r = gw; r < 2 * NEXP; r += NGW) { const bool isv = r >= NEXP; const int e = isv ? r - NEXP : r; const float* src = (isv ? vt : ut) + (size_t)e * DM + 16 * lane;
          f32x4 v[4]; float amax = 0.f;
#pragma unroll
          for (int i = 0; i < 4; ++i) { v[i] = *(const GAS f32x4*)(src + 4 * i); amax = fmaxf(amax, fmaxf(fmaxf(__builtin_fabsf(v[i][0]), __builtin_fabsf(v[i][1])), fmaxf(__builtin_fabsf(v[i][2]), __builtin_fabsf(v[i][3])))); }
#pragma unroll
          for (int o = 1; o < 64; o <<= 1) amax = fmaxf(amax, __shfl_xor(amax, o));
          const float inv = 127.f / fmaxf(amax, 1e-30f); const int off = isv ? 128 : 0; v4u w;
#pragma unroll
          for (int i = 0; i < 4; ++i) { const int a = (int)__builtin_rintf(v[i][0] * inv) + off, b = (int)__builtin_rintf(v[i][1] * inv) + off, c = (int)__builtin_rintf(v[i][2] * inv) + off, d = (int)__builtin_rintf(v[i][3] * inv) + off;
              w[i] = (unsigned)(a & 0xff) | ((unsigned)(b & 0xff) << 8) | ((unsigned)(c & 0xff) << 16) | ((unsigned)d << 24); }
          *(GAS v4u*)(F.ws + (isv ? WS_VT : WS_UT) + (size_t)e * 1024 + 16 * lane) = w;
          if (lane == 0) (isv ? SV : SU)[e] = amax * (1.f / 127.f); } }
    cvt_stream(INP(1), (bf16*)(F.ws + WS_PB), (size_t)M * PLE_DIM / 8, gw, NGW, lane);
    { float* rc = (float*)(F.ws + WS_ROPEC); float* rs = (float*)(F.ws + WS_ROPES);
      for (int idx = gw * 64 + lane; idx < SEQ * 32; idx += NGW * 64) { const int pos = idx >> 5, i = idx & 31; const double rev = (double)pos * INVREV[i]; const float fr = (float)(rev - __builtin_floor(rev));
          rc[idx] = __builtin_amdgcn_cosf(fr); rs[idx] = __builtin_amdgcn_sinf(fr); } }
    { const float* x = INP(0); const float* g = INP(2); bf16* XN = (bf16*)(F.ws + WS_XN);
      f32x4 gv[4];
#pragma unroll
      for (int j = 0; j < 4; ++j) gv[j] = ((const GAS f32x4*)g)[64 * j + lane];
      for (int m = gw; m < M; m += NGW) { const GAS f32x4* xr = (const GAS f32x4*)(x + (size_t)m * DM) + lane; f32x4 v[4]; float s2 = 0.f;
#pragma unroll
          for (int j = 0; j < 4; ++j) { v[j] = xr[64 * j]; s2 += (v[j].x * v[j].x + v[j].y * v[j].y) + (v[j].z * v[j].z + v[j].w * v[j].w); }
          const float rstd = rsqrtf(wave_sum(s2) * (1.f / DM) + EPS);
          GAS unsigned long long* o8 = (GAS unsigned long long*)(XN + (size_t)m * DM) + lane;
#pragma unroll
          for (int j = 0; j < 4; ++j) { const f32x4 w = v[j] * rstd * gv[j]; o8[64 * j] = (unsigned long long)pk2(w.x, w.y) | ((unsigned long long)pk2(w.z, w.w) << 32); } } }
}

struct AttnOrder {
    int vcu;
    __device__ __forceinline__ bool next(int i, attn_body::AttnUnit& u) const { if (i >= 8) return false; const int s = vcu & 7; u.bh = (vcu >> 5) * 16 + ((vcu >> 3) & 3) * 4 + (i & 3); u.qb = (i < 4) ? 15 - s : s; return true; }
    __device__ __forceinline__ void a_ready(const attn_body::AttnUnit&) const {}
    __device__ __forceinline__ void done(const attn_body::AttnUnit&) const {}
};
__device__ __forceinline__ void p2_attention(Frame& F) {
    { const attn_body::AttnTensors AT{(const attn_body::bf16*)(F.ws + WS_QO), (const attn_body::bf16*)(F.ws + WS_K), (const attn_body::bf16*)(F.ws + WS_V), (attn_body::bf16*)(F.ws + WS_QO)};
      const AttnOrder S{F.vcu};
      attn_body::attn_phase<AttnOrder>((char*)F.ldsg, AT, S, F.wave * 64 + lane_id()); }
    VM_WAIT(); __syncthreads();
    const int lane = lane_id();
    const float s1 = wave_sum(INP(4)[lane] * INP(5)[lane]), s2 = wave_sum(INP(6)[lane] * INP(7)[lane]);
    const float lam = __expf(s1) - __expf(s2) + 0.2f;
    const float* sg = INP(8); const float g0 = sg[2 * lane] * 0.8f, g1 = sg[2 * lane + 1] * 0.8f;
    const unsigned* O32 = (const unsigned*)(F.ws + WS_QO); unsigned* A2 = (unsigned*)(F.ws + WS_XN);
    const int b = F.vcu >> 5, h = (F.vcu >> 3) & 3, s = F.vcu & 7;
    for (int i = 0; i < 2; ++i) { const int qb = (i == 0) ? 15 - s : s;
        const size_t rbase = (size_t)b * SEQ + (size_t)qb * 256 + F.wave * 32;
        for (int r = 0; r < 32; ++r) { const size_t row = rbase + r;
            const unsigned w0 = __builtin_nontemporal_load(O32 + row * 512 + (h * 4 + 0 + (lane >> 5)) * 32 + (lane & 31)), w1 = __builtin_nontemporal_load(O32 + row * 512 + (h * 4 + 2 + (lane >> 5)) * 32 + (lane & 31));
            const float d0 = bflo(w0) - lam * bflo(w1), d1 = bfhi(w0) - lam * bfhi(w1);
            const float rstd = rsqrtf(wave_sum(d0 * d0 + d1 * d1) * (1.f / 128.f) + EPS);
            A2[row * 512 + h * 64 + lane] = pk2(d0 * rstd * g0, d1 * rstd * g1); } }
}
__device__ __forceinline__ void p2_conv(Frame& F) {
    const bf16* Ub = (const bf16*)(F.ws + WS_U); bf16* A2 = (bf16*)(F.ws + WS_XN);
    LAS float* yl = (LAS float*)F.lds;
    const int lane = lane_id(); const int c = F.wave * 64 + lane;
    float w[31];
    { const float* cw = INP(9);
#pragma unroll
      for (int j = 0; j < 31; ++j) w[j] = cw[j * 512 + c]; }
    const float bias = INP(10)[c];
    const float* lng = INP(11); const float* lnb = INP(12);
    const f32x4 lg0 = *(const f32x4*)(lng + 8 * lane), lg1 = *(const f32x4*)(lng + 8 * lane + 4), lb0 = *(const f32x4*)(lnb + 8 * lane), lb1 = *(const f32x4*)(lnb + 8 * lane + 4);
    for (int tile = F.vcu; tile < M / 32; tile += F.G) {
        const int t0 = tile * 32, pos0 = t0 & (SEQ - 1);
        float xin[62];
#pragma unroll
        for (int r = 0; r < 62; ++r) { const int p = pos0 - 30 + r; xin[r] = (p >= 0) ? __uint_as_float((unsigned)Ub[(size_t)(t0 - 30 + r) * 512 + c] << 16) : 0.f; }
#pragma unroll
        for (int t = 0; t < 32; ++t) { float y = bias;
#pragma unroll
            for (int j = 0; j < 31; ++j) y += w[j] * xin[t + j];
            yl[t * 512 + c] = y; }
        __syncthreads();
#pragma unroll
        for (int q = 0; q < 4; ++q) { const int t = F.wave * 4 + q;
            const f32x4 a = *(const LAS f32x4*)(yl + t * 512 + 8 * lane), b2 = *(const LAS f32x4*)(yl + t * 512 + 8 * lane + 4);
            const float mean = wave_sum((a[0] + a[1]) + (a[2] + a[3]) + (b2[0] + b2[1]) + (b2[2] + b2[3])) * (1.f / 512.f);
            const f32x4 da = a - mean, db = b2 - mean;
            const float var = wave_sum((da[0] * da[0] + da[1] * da[1]) + (da[2] * da[2] + da[3] * da[3]) + (db[0] * db[0] + db[1] * db[1]) + (db[2] * db[2] + db[3] * db[3])) * (1.f / 512.f);
            const float rstd = rsqrtf(var + EPS);
            f32x4 oa = da * rstd * lg0 + lb0, ob = db * rstd * lg1 + lb1;
#pragma unroll
            for (int e = 0; e < 4; ++e) { oa[e] = oa[e] * __builtin_amdgcn_rcpf(1.0f + __expf(-oa[e])); ob[e] = ob[e] * __builtin_amdgcn_rcpf(1.0f + __expf(-ob[e])); }
            *(GAS v4u*)(A2 + (size_t)(t0 + t) * 1024 + 512 + 8 * lane) = pk8(oa, ob); }
        __syncthreads();
    }
}
__device__ __forceinline__ int crow16(int r, int hi) { return (r & 3) + 8 * (r >> 2) + 4 * hi; }
__device__ __forceinline__ unsigned enc_key(float f, unsigned tag, unsigned mask) { unsigned u = __float_as_uint(f); u = (u & 0x80000000u) ? ~u : (u | 0x80000000u); return (u & ~mask) | tag; }
__device__ __forceinline__ float dec_key(unsigned k, unsigned mask) { unsigned u = k & ~mask; u = (u & 0x80000000u) ? (u & 0x7fffffffu) : ~u; return __uint_as_float(u); }
__device__ __forceinline__ void ce_desc(unsigned& a, unsigned& b) { const unsigned mx = a > b ? a : b, mn = a > b ? b : a; a = mx; b = mn; }
template <int K, int J> __device__ __forceinline__ void bitonic_stage16(unsigned (&a)[16]) {
#pragma unroll
    for (int i = 0; i < 16; ++i) { const int l = i ^ J; if (l > i) { if ((i & K) == 0) ce_desc(a[i], a[l]); else ce_desc(a[l], a[i]); } }
}
__device__ __forceinline__ void sort16_desc(unsigned (&a)[16]) {
    bitonic_stage16<2, 1>(a); bitonic_stage16<4, 2>(a); bitonic_stage16<4, 1>(a); bitonic_stage16<8, 4>(a); bitonic_stage16<8, 2>(a); bitonic_stage16<8, 1>(a);
    bitonic_stage16<16, 8>(a); bitonic_stage16<16, 4>(a); bitonic_stage16<16, 2>(a); bitonic_stage16<16, 1>(a);
}
__device__ __forceinline__ void merge16_desc(unsigned (&a)[16], const unsigned (&b)[16]) {
#pragma unroll
    for (int i = 0; i < 16; ++i) a[i] = a[i] > b[15 - i] ? a[i] : b[15 - i];
    bitonic_stage16<16, 8>(a); bitonic_stage16<16, 4>(a); bitonic_stage16<16, 2>(a); bitonic_stage16<16, 1>(a);
}
__device__ __forceinline__ void top16_of_64(unsigned (&k)[4][16]) {
    sort16_desc(k[0]); sort16_desc(k[1]); sort16_desc(k[2]); sort16_desc(k[3]);
    merge16_desc(k[0], k[1]); merge16_desc(k[2], k[3]); merge16_desc(k[0], k[2]);
}
__host__ __device__ constexpr int cand_i(int s) { int c = 0; for (int i = 0; i < 16; ++i) { const int nj = 16 / (i + 1); if (s < c + nj) return i; c += nj; } return -1; }
__host__ __device__ constexpr int cand_j(int s) { int c = 0; for (int i = 0; i < 16; ++i) { const int nj = 16 / (i + 1); if (s < c + nj) return s - c; c += nj; } return -1; }
template <int S> __device__ __forceinline__ void cand_fill(unsigned (&c)[4][16], const float (&v0)[16], const float (&v1)[16]) {
    if constexpr (S < 64) { constexpr int i = cand_i(S), j = cand_j(S);
        if constexpr (i >= 0) c[S >> 4][S & 15] = enc_key(v0[i] + v1[j], 255u - (unsigned)(i * 16 + j), 255u); else c[S >> 4][S & 15] = 0u;
        cand_fill<S + 1>(c, v0, v1); }
}
__device__ __forceinline__ float gelu_exact(float v) {
    const float av = __builtin_fabsf(v), d = av * 0.2316418882f + 1.0f, t = __builtin_amdgcn_rcpf(d);
    float q = t * 0.5307027145f + (-0.7265760135f); q = q * t + 0.7107068705f; q = q * t + (-0.142248368f); q = q * t + 0.127414796f; q = q * t;
    const float e = __builtin_amdgcn_exp2f((v * v) * (-0.72134752044f)); const float m = v * (q * e); return v < 0.f ? m : v - m;
}
typedef float f32x2 __attribute__((ext_vector_type(2)));
__device__ __forceinline__ float ub0(unsigned w) { return (float)(w & 0xffu); }
__device__ __forceinline__ float ub1(unsigned w) { return (float)((w >> 8) & 0xffu); }
__device__ __forceinline__ float ub2(unsigned w) { return (float)((w >> 16) & 0xffu); }
__device__ __forceinline__ float ub3(unsigned w) { return (float)(w >> 24); }
__device__ __forceinline__ float wave_max(float v) {
#pragma unroll
    for (int o = 1; o < 64; o <<= 1) v = fmaxf(v, __shfl_xor(v, o));
    return v;
}
__device__ __forceinline__ int reduce8(const int (&p)[8], int lane) {
    const bool b0 = lane & 1, b1 = lane & 2, b2 = lane & 4;
    int q[4], r[2];
#pragma unroll
    for (int i = 0; i < 4; ++i) { const int keep = b0 ? p[2 * i + 1] : p[2 * i], send = b0 ? p[2 * i] : p[2 * i + 1]; q[i] = keep + __builtin_amdgcn_update_dpp(0, send, 0xB1, 0xF, 0xF, true); }
#pragma unroll
    for (int i = 0; i < 2; ++i) { const int keep = b1 ? q[2 * i + 1] : q[2 * i], send = b1 ? q[2 * i] : q[2 * i + 1]; r[i] = keep + __builtin_amdgcn_update_dpp(0, send, 0x4E, 0xF, 0xF, true); }
    int s; { const int keep = b2 ? r[1] : r[0], send = b2 ? r[0] : r[1]; s = keep + __builtin_amdgcn_ds_swizzle(send, 0x101F); }
    s += __builtin_amdgcn_ds_swizzle(s, 0x201F); s += __builtin_amdgcn_ds_swizzle(s, 0x401F);
    { const auto rr = __builtin_amdgcn_permlane32_swap((unsigned)s, (unsigned)s, false, false); s = (int)rr[0] + (int)rr[1]; }
    return s;
}
constexpr int P5_TOK = 32;
constexpr int P5_KEYS = 0, P5_LS = 65536, P5_EID = 65536 + 33792, P5_GATE = 65536 + 33792 + 16384;
__device__ __forceinline__ void p5_peer(Frame& F) {
    const bf16* QP = (const bf16*)(F.ws + WS_QP); const bf16* KEYS = (const bf16*)(F.ws + WS_KEYS);
    const unsigned char* UT = F.ws + WS_UT; const unsigned char* VT = F.ws + WS_VT; bf16* XN2 = (bf16*)(F.ws + WS_XN2);
    const float* SU = (const float*)(F.ws + WS_SU); const float* SV = (const float*)(F.ws + WS_SV);
    LAS unsigned* lsc = (LAS unsigned*)(F.lds + P5_LS) + (F.wave * 32 + (lane_id() & 31)) * 33; LAS unsigned* eidL = (LAS unsigned*)(F.lds + P5_EID); LAS float* gateL = (LAS float*)(F.lds + P5_GATE);
    const int lane = lane_id(), tid = F.wave * 64 + lane, r32 = lane & 31, hi = lane >> 5, h = F.wave;
    const float* gffn = INP(14); const float* gple = INP(19);
#pragma unroll
    for (int i = 0; i < 8; ++i) { const int q = tid + 512 * i, row = q >> 4, ch = q & 15; *(LAS v4u*)(F.lds + P5_KEYS + row * 256 + ((ch ^ (row & 15)) << 4)) = *(const GAS v4u*)(KEYS + row * 128 + ch * 8); }
    __syncthreads();
    const LAS unsigned char* kl = F.lds + P5_KEYS + r32 * 256;
    for (int tile = F.vcu; tile < M / P5_TOK; tile += F.G) {
        const size_t t0 = (size_t)tile * P5_TOK;
        float sv[2][16];
#pragma unroll
        for (int c = 0; c < 2; ++c) {
            bf16x8 qf[8];
#pragma unroll
            for (int ks = 0; ks < 8; ++ks) qf[ks] = *(const bf16x8*)(QP + (t0 + r32) * QCOLS + h * 256 + c * 128 + ks * 16 + hi * 8);
            unsigned key[4][16];
#pragma unroll
            for (int nb = 0; nb < 4; ++nb) { f32x16 acc = {}; asm volatile("" ::: "memory");
#pragma unroll
                for (int ks = 0; ks < 8; ++ks) { const bf16x8 kf = *(const LAS bf16x8*)(kl + (c * 128 + nb * 32) * 256 + (((ks * 2 + hi) ^ (r32 & 15)) << 4)); acc = __builtin_amdgcn_mfma_f32_32x32x16_bf16(kf, qf[ks], acc, 0, 0, 0); }
#pragma unroll
                for (int r = 0; r < 16; ++r) key[nb][r] = enc_key(acc[r], 127u - (unsigned)(nb * 32 + crow16(r, hi)), 127u); }
            top16_of_64(key);
            unsigned other[16];
#pragma unroll
            for (int i = 0; i < 16; ++i) other[i] = __shfl_xor(key[0][i], 32);
            merge16_desc(key[0], other);
#pragma unroll
            for (int i = 0; i < 16; ++i) { sv[c][i] = dec_key(key[0][i], 127u); if (hi == 0) lsc[c * 16 + i] = key[0][i]; }
        }
        asm volatile("" ::: "memory");
        unsigned cand[4][16];
        cand_fill<0>(cand, sv[0], sv[1]);
        top16_of_64(cand);
        LDS_WAIT();
        { float wv[16]; float wsum = 0.f; const float mx = dec_key(cand[0][0], 255u);
#pragma unroll
          for (int k = 0; k < 16; ++k) { wv[k] = __expf(dec_key(cand[0][k], 255u) - mx); wsum += wv[k]; }
          const float rs = 1.0f / wsum;
#pragma unroll
          for (int k = 0; k < 16; ++k) { const unsigned id = 255u - (cand[0][k] & 255u); const unsigned k0 = lsc[id >> 4], k1 = lsc[16 + (id & 15u)];
              const unsigned e = (127u - (k0 & 127u)) * 128u + (127u - (k1 & 127u));
              if (hi == 0) { eidL[r32 * 128 + h * 16 + k] = e; gateL[r32 * 128 + h * 16 + k] = wv[k] * rs; } } }
        __syncthreads();
#pragma unroll 1
        for (int j = 0; j < 4; ++j) {
            const int tl = F.wave * 4 + j; const size_t tok = t0 + tl; float* hrow = F.out + tok * DM;
            f32x4 hv[4];
#pragma unroll
            for (int i = 0; i < 4; ++i) hv[i] = *(const f32x4*)(hrow + 16 * lane + 4 * i);
            const float rstd1 = rsqrtf(wave_sum(dot4s_(hv[0]) + dot4s_(hv[1]) + dot4s_(hv[2]) + dot4s_(hv[3])) * (1.f / DM) + EPS);
            int qm[4]; float sm;
            { f32x4 mv[4]; float amax = 0.f;
#pragma unroll
              for (int i = 0; i < 4; ++i) { mv[i] = hv[i] * rstd1 * *(const f32x4*)(gffn + 16 * lane + 4 * i);
                  amax = fmaxf(amax, fmaxf(fmaxf(__builtin_fabsf(mv[i][0]), __builtin_fabsf(mv[i][1])), fmaxf(__builtin_fabsf(mv[i][2]), __builtin_fabsf(mv[i][3])))); }
              amax = wave_max(amax); sm = amax * (1.f / 127.f); const float inv = 127.f / fmaxf(amax, 1e-30f);
#pragma unroll
              for (int i = 0; i < 4; ++i) { const int a = (int)__builtin_rintf(mv[i][0] * inv), b = (int)__builtin_rintf(mv[i][1] * inv), c = (int)__builtin_rintf(mv[i][2] * inv), d = (int)__builtin_rintf(mv[i][3] * inv);
                  qm[i] = (a & 0xff) | ((b & 0xff) << 8) | ((c & 0xff) << 16) | (d << 24); } }
            const unsigned ev0 = eidL[tl * 128 + lane], ev1 = eidL[tl * 128 + 64 + lane];
            const float su0 = SU[ev0], su1 = SU[ev1], sv0 = SV[ev0], sv1 = SV[ev1];
            int alo = 0, ahi = 0;
#define P5_LOAD(buf, TAB, g) do { const unsigned evs_ = (g) < 8 ? ev0 : ev1; _Pragma("unroll") for (int q = 0; q < 8; ++q) { const unsigned e_ = __builtin_amdgcn_readlane(evs_, ((g) * 8 + q) & 63); \
                buf[q] = *(const GAS v4u*)(TAB + (size_t)e_ * 1024 + lane * 16); } } while (0)
#define P5_UCOMP(buf, g) do { int p_[8]; _Pragma("unroll") for (int q = 0; q < 8; ++q) p_[q] = __builtin_amdgcn_sdot4((int)buf[q].x, qm[0], __builtin_amdgcn_sdot4((int)buf[q].y, qm[1], __builtin_amdgcn_sdot4((int)buf[q].z, qm[2], __builtin_amdgcn_sdot4((int)buf[q].w, qm[3], 0, false), false), false), false); \
                const int s_ = reduce8(p_, lane); const bool mine_ = (lane >> 3) == ((g) & 7); alo = (mine_ && (g) < 8) ? s_ : alo; ahi = (mine_ && (g) >= 8) ? s_ : ahi; } while (0)
            { v4u ra[8], rb[8];
              P5_LOAD(ra, UT, 0);
#pragma unroll 1
              for (int g = 0; g < 16; g += 2) { P5_LOAD(rb, UT, g + 1); P5_UCOMP(ra, g); if (g + 2 < 16) P5_LOAD(ra, UT, g + 2); P5_UCOMP(rb, g + 1); } }
            const float hlo = gelu_exact((float)alo * sm * su0) * gateL[tl * 128 + lane] * sv0, hhi = gelu_exact((float)ahi * sm * su1) * gateL[tl * 128 + 64 + lane] * sv1;
            const float hsum = wave_sum(hlo + hhi);
            f32x2 y[8];
#pragma unroll
            for (int i = 0; i < 8; ++i) y[i] = (f32x2){0.f, 0.f};
#define P5_VCOMP(buf, g) do { const float hvs_ = (g) < 8 ? hlo : hhi; _Pragma("unroll") for (int q = 0; q < 8; ++q) { const float hk_ = __uint_as_float(__builtin_amdgcn_readlane(__float_as_uint(hvs_), ((g) * 8 + q) & 63)); const f32x2 hk2_ = {hk_, hk_}; \
                y[0] += hk2_ * (f32x2){ub0(buf[q].x), ub1(buf[q].x)}; y[1] += hk2_ * (f32x2){ub2(buf[q].x), ub3(buf[q].x)}; y[2] += hk2_ * (f32x2){ub0(buf[q].y), ub1(buf[q].y)}; y[3] += hk2_ * (f32x2){ub2(buf[q].y), ub3(buf[q].y)}; \
                y[4] += hk2_ * (f32x2){ub0(buf[q].z), ub1(buf[q].z)}; y[5] += hk2_ * (f32x2){ub2(buf[q].z), ub3(buf[q].z)}; y[6] += hk2_ * (f32x2){ub0(buf[q].w), ub1(buf[q].w)}; y[7] += hk2_ * (f32x2){ub2(buf[q].w), ub3(buf[q].w)}; } } while (0)
            { v4u ra[8], rb[8];
              P5_LOAD(ra, VT, 0);
#pragma unroll 1
              for (int g = 0; g < 16; g += 2) { P5_LOAD(rb, VT, g + 1); P5_VCOMP(ra, g); if (g + 2 < 16) P5_LOAD(ra, VT, g + 2); P5_VCOMP(rb, g + 1); } }
#undef P5_LOAD
#undef P5_UCOMP
#undef P5_VCOMP
            const float corr = 128.f * hsum;
            f32x4 nv[4];
#pragma unroll
            for (int i = 0; i < 4; ++i) nv[i] = hv[i] + ((f32x4){y[2 * i][0], y[2 * i][1], y[2 * i + 1][0], y[2 * i + 1][1]} - corr);
            const float rstd2 = rsqrtf(wave_sum(dot4s_(nv[0]) + dot4s_(nv[1]) + dot4s_(nv[2]) + dot4s_(nv[3])) * (1.f / DM) + EPS);
#pragma unroll
            for (int i = 0; i < 4; ++i) *(f32x4*)(hrow + 16 * lane + 4 * i) = nv[i];
            const v4u o0 = pk8(nv[0] * rstd2 * *(const f32x4*)(gple + 16 * lane), nv[1] * rstd2 * *(const f32x4*)(gple + 16 * lane + 4)), o1 = pk8(nv[2] * rstd2 * *(const f32x4*)(gple + 16 * lane + 8), nv[3] * rstd2 * *(const f32x4*)(gple + 16 * lane + 12));
            *(GAS v4u*)(XN2 + tok * DM + 16 * lane) = o0; *(GAS v4u*)(XN2 + tok * DM + 16 * lane + 8) = o1;
        }
        __syncthreads();
    }
}
__device__ __forceinline__ void p7_final(Frame& F) {
    const int lane = lane_id(); const int gw = F.vcu * NWAVES + F.wave, NGW = F.G * NWAVES; const float* g = INP(22);
    f32x4 gv[4];
#pragma unroll
    for (int j = 0; j < 4; ++j) gv[j] = ((const GAS f32x4*)g)[64 * j + lane];
    for (int m = gw; m < M; m += NGW) { GAS f32x4* xr = (GAS f32x4*)(F.out + (size_t)m * DM) + lane; f32x4 v[4]; float s2 = 0.f;
#pragma unroll
        for (int j = 0; j < 4; ++j) { v[j] = xr[64 * j]; s2 += (v[j].x * v[j].x + v[j].y * v[j].y) + (v[j].z * v[j].z + v[j].w * v[j].w); }
        const float rstd = rsqrtf(wave_sum(s2) * (1.f / DM) + EPS);
#pragma unroll
        for (int j = 0; j < 4; ++j) xr[64 * j] = v[j] * rstd * gv[j]; }
}
struct Args { const float* in[23]; float* out; unsigned char* ws; int ph_lo, ph_hi; };
__global__ void __launch_bounds__(NWAVES * 64, 2) hymba_fwd(Args args) {
    extern __shared__ __attribute__((aligned(16))) unsigned char lds[];
    cg::grid_group grid = cg::this_grid();
    Frame F;
    F.lds = (LAS unsigned char*)lds; F.ldsg = lds;
    F.wave = __builtin_amdgcn_readfirstlane(threadIdx.x >> 6);
    F.G = gridDim.x; { const int bx = blockIdx.x; F.vcu = (F.G % 8 == 0) ? (bx % 8) * (F.G / 8) + bx / 8 : bx; }
    F.out = args.out; F.ws = args.ws;
    const int lo = args.ph_lo, hi = args.ph_hi;
#ifdef ONLY_PH
#define IN(k) ((k) == ONLY_PH)
#else
#define IN(k) (lo <= (k) && (k) < hi)
#endif
#define BOTH(k) (IN(k) && IN((k) + 1))
    { const int l0 = lane_id(); if (F.wave == 0) ((volatile LAS unsigned*)(F.lds + MISC_OFF))[l0] = 0u; }
    __syncthreads();
    const XcdBarrier bar = xcd_barrier_post((unsigned*)(F.ws + WS_CTL) + CW_BAR, (volatile LAS unsigned*)(F.lds + MISC_OFF) + 8, F.wave == 0 && lane_id() == 0);
#define GRID_BAR(k) do { if ((k) == 0) grid.sync(); else xcd_barrier(bar, F.wave == 0 && lane_id() == 0); } while (0)
    if (IN(0)) { p0_prologue(F); if (BOTH(0)) GRID_BAR(0); }
    if (IN(1)) {
        { pg8::Gemm g{(const pg8::bf16_t*)(F.ws + WS_XN), (const pg8::bf16_t*)(F.ws + WS_WIN), M, IN_COLS, DM}; pg8::StaticOrder S; S.init(M, IN_COLS, F.G, (int)blockIdx.x);
          pg8::EpiIn E{(pg8::bf16_t*)(F.ws + WS_QO), (pg8::bf16_t*)(F.ws + WS_K), (pg8::bf16_t*)(F.ws + WS_V), (pg8::bf16_t*)(F.ws + WS_U), (const float*)(F.ws + WS_ROPEC), (const float*)(F.ws + WS_ROPES), attn_body::C2};
          pg8::gemm_phase<pg8::EpiIn, pg8::StaticOrder, true, true>(F.lds, g, S, E, F.wave); }
        { pg8::Gemm g{(const pg8::bf16_t*)(F.ws + WS_PB), (const pg8::bf16_t*)(F.ws + WS_WPROJ), M, DM, PLE_DIM}; pg8::StaticOrder S; S.init(M, DM, F.G, (int)blockIdx.x);
          pg8::EpiBf16<0> E{(pg8::bf16_t*)(F.ws + WS_E), DM, nullptr, 0, 0, 1.f};
          pg8::gemm_phase<pg8::EpiBf16<0>, pg8::StaticOrder, true, true>(F.lds, g, S, E, F.wave); }
        if (BOTH(1)) GRID_BAR(1);
    }
    if (IN(2)) { p2_attention(F); p2_conv(F); if (BOTH(2)) GRID_BAR(2); }
    if (IN(3)) {
        pg8::Gemm g{(const pg8::bf16_t*)(F.ws + WS_XN), (const pg8::bf16_t*)(F.ws + WS_WOUT), M, DM, DM}; pg8::StaticOrder S; S.init(M, DM, F.G, (int)blockIdx.x);
        pg8::EpiOut E{INP(0), F.out, (pg8::bf16_t*)(F.ws + WS_H1B), (float*)(F.ws + WS_SSQ1)};
        pg8::gemm_phase<pg8::EpiOut, pg8::StaticOrder, true, true>(F.lds, g, S, E, F.wave);
        if (BOTH(3)) GRID_BAR(3);
    }
    if (IN(4)) {
        pg8::Gemm g{(const pg8::bf16_t*)(F.ws + WS_H1B), (const pg8::bf16_t*)(F.ws + WS_WQ), M, QCOLS, DM}; pg8::StaticOrder S; S.init(M, QCOLS, F.G, (int)blockIdx.x);
        pg8::EpiQ E{(const float*)(F.ws + WS_SSQ1), (pg8::bf16_t*)(F.ws + WS_QP), EPS};
        pg8::gemm_phase<pg8::EpiQ, pg8::StaticOrder, true, true>(F.lds, g, S, E, F.wave);
        if (BOTH(4)) GRID_BAR(4);
    }
    if (IN(5)) { p5_peer(F); if (BOTH(5)) GRID_BAR(5); }
    if (IN(6)) {
        pg8::Gemm g{(const pg8::bf16_t*)(F.ws + WS_XN2), (const pg8::bf16_t*)(F.ws + WS_WGATE), M, DM, DM}; pg8::StaticOrder S; S.init(M, DM, F.G, (int)blockIdx.x);
        pg8::EpiGate E{F.out, (const pg8::bf16_t*)(F.ws + WS_E)};
        pg8::gemm_phase<pg8::EpiGate, pg8::StaticOrder, true, true>(F.lds, g, S, E, F.wave);
        if (BOTH(6)) GRID_BAR(6);
    }
    if (IN(7)) p7_final(F);
#undef IN
#undef BOTH
}

extern "C" void kernel_launch(void* const* d_in, const int* in_sizes, int n_in, void* d_out, int out_size, void* d_ws, size_t ws_size, hipStream_t stream) {
    static int grid = 0;
    if (grid == 0) {
        if (n_in != 23 || in_sizes[0] != M * DM || out_size != M * DM || ws_size < WS_END) { fprintf(stderr, "kernel_launch: unexpected shapes (n_in %d, in0 %d, out %d, ws %zu); nothing launched\n", n_in, n_in > 0 ? in_sizes[0] : -1, out_size, ws_size); grid = -1; return; }
        int dev = 0, cus = 0, per_cu = 0;
        if (hipGetDevice(&dev) != hipSuccess || hipDeviceGetAttribute(&cus, hipDeviceAttributeMultiprocessorCount, dev) != hipSuccess) { fprintf(stderr, "kernel_launch: device query failed\n"); grid = -1; return; }
        if (hipFuncSetAttribute((const void*)hymba_fwd, hipFuncAttributeMaxDynamicSharedMemorySize, LDS_BYTES) != hipSuccess) { fprintf(stderr, "kernel_launch: hipFuncSetAttribute failed\n"); grid = -1; return; }
        if (hipOccupancyMaxActiveBlocksPerMultiprocessor(&per_cu, (const void*)hymba_fwd, NWAVES * 64, LDS_BYTES) != hipSuccess || per_cu < 1) { fprintf(stderr, "kernel_launch: occupancy query says %d blocks per CU\n", per_cu); (void)hipGetLastError(); grid = -1; return; }
        grid = cus * per_cu;
        if (grid != 256) { fprintf(stderr, "kernel_launch: this kernel's attention order needs exactly 256 resident workgroups (got %d x %d); nothing launched\n", cus, per_cu); grid = -1; return; }
    }
    if (grid < 0) return;
    if (hipMemsetAsync((char*)d_ws + WS_CTL, 0, CTL_ZERO_BYTES, stream) != hipSuccess) { fprintf(stderr, "kernel_launch: hipMemsetAsync failed\n"); return; }
    Args a{};
    for (int i = 0; i < 23; ++i) a.in[i] = (const float*)d_in[i];
    a.out = (float*)d_out; a.ws = (unsigned char*)d_ws;
#if MK_N_LAUNCHES == 1
    a.ph_lo = 0; a.ph_hi = N_PHASES;
    void* kargs[] = {&a};
    hipError_t e = hipLaunchCooperativeKernel((const void*)hymba_fwd, dim3(grid), dim3(NWAVES * 64), kargs, LDS_BYTES, stream);
    if (e != hipSuccess) fprintf(stderr, "kernel_launch: cooperative launch failed: %s (grid %d)\n", hipGetErrorString(e), grid);
#else
    for (int li = 0; li < N_PHASES; ++li) { a.ph_lo = li; a.ph_hi = li + 1;
        hipLaunchKernelGGL(hymba_fwd, dim3(grid), dim3(NWAVES * 64), LDS_BYTES, stream, a);
        const hipError_t le = hipPeekAtLastError(); if (le != hipSuccess) { fprintf(stderr, "kernel_launch: launch %d failed: %s\n", li, hipGetErrorName(le)); break; } }
#endif
}
```

```cpp
#include <hip/hip_runtime.h>
#include <hip/hip_cooperative_groups.h>
#include <cstdio>
#include <cstdint>
namespace cg = cooperative_groups;
namespace pg8 {
#define PG8_LAS __attribute__((address_space(3)))
typedef unsigned short bf16_t;
typedef short bf16x8 __attribute__((ext_vector_type(8)));
typedef float f32x4 __attribute__((ext_vector_type(4)));
typedef unsigned u32x4 __attribute__((ext_vector_type(4)));
constexpr int BM = 256, BK = 64, HALF = 128, HTB = HALF * BK * 2  , STAGE_BYTES = 8 * HTB, NXCD = 8, WGM = 8;

__host__ __device__ __forceinline__ int lds_byte(int r, int c) { const int st = (r >> 4) * 2 + (c >> 5), rr = r & 15, cc = c & 31, ob = rr * 64 + cc * 2; return st * 1024 + (ob ^ (((ob >> 9) & 1) << 5)); }
__host__ __device__ __forceinline__ void stage_rc(int b, int& R, int& C) { const int st = b / 1024, sb = b % 1024, swz = sb ^ (((sb >> 9) & 1) << 5); R = (st >> 1) * 16 + swz / 64; C = (st & 1) * 32 + (swz % 64) / 2; }
__host__ __device__ __forceinline__ int perm32(int rho) { const int n = rho >> 4, i = rho & 15; return 8 * (i >> 2) + 4 * n + (i & 3); }

struct Unit { int pm, pn; };
struct Gemm { const bf16_t* A; const bf16_t* Bt; int M, N, K; };

struct StaticOrder {
    int nM, nN, nwg, G, c;
    __host__ __device__ void init(int M, int N, int G_, int c_) { nM = M / BM; nN = N / BM; nwg = nM * nN; G = G_; c = c_; }
    __host__ __device__ bool next(int i, Unit& u) const {
        const long L = (long)i * G + c; if (L >= nwg) return false;
        int wgid = (int)L; { const int q = nwg / NXCD, r = nwg % NXCD, xcd = wgid % NXCD, off = wgid / NXCD; wgid = (xcd < r ? xcd * (q + 1) : r * (q + 1) + (xcd - r) * q) + off; }
        const int nig = WGM * nN, gid = wgid / nig, fm = gid * WGM, gsz = (nM - fm) < WGM ? (nM - fm) : WGM;
        u.pm = fm + ((wgid % nig) % gsz); u.pn = (wgid % nig) / gsz; return true;
    }
    __device__ __forceinline__ void a_ready(const Unit&) const {}
    __device__ __forceinline__ void done(const Unit&) const {}
};

__device__ __forceinline__ unsigned cvt_pk_bf16(float lo, float hi) { unsigned r; asm volatile("v_cvt_pk_bf16_f32 %0, %1, %2" : "=v"(r) : "v"(lo), "v"(hi)); return r; }
typedef float f32x2 __attribute__((ext_vector_type(2)));
__device__ __forceinline__ f32x2 gelu_pk(f32x2 v) {
    const f32x2 av = __builtin_elementwise_abs(v), d = av * 0.2316418882f + 1.0f;
    f32x2 t; t.x = __builtin_amdgcn_rcpf(d.x); t.y = __builtin_amdgcn_rcpf(d.y);
    f32x2 q = t * 0.5307027145f + (-0.7265760135f); q = q * t + 0.7107068705f; q = q * t + (-0.142248368f); q = q * t + 0.127414796f; q = q * t;
    const f32x2 s = (v * v) * (-0.72134752044f);
    f32x2 e; e.x = __builtin_amdgcn_exp2f(s.x); e.y = __builtin_amdgcn_exp2f(s.y);
    const f32x2 m = v * (q * e), r = v - m;
    f32x2 o; o.x = v.x < 0.f ? m.x : r.x; o.y = v.y < 0.f ? m.y : r.y; return o;
}

template <int ACT  > struct EpiBf16 {
    static constexpr bool PERM = true, AFTER_DRAIN = false; static_assert(ACT == 0 || ACT == 1, "EpiBf16: ACT is 0 (none) or 1 (gelu_pk)");
    bf16_t* O; int ldc; const float* bias; int split_cols; size_t split_stride; float scale0;
    __device__ __forceinline__ void operator()(const f32x4 (&acc)[2][2][4][2], const Unit& u, int wr, int wc, int fr, int fq) const {
        const int row0 = u.pm * BM + wr * 64 + fr; int colt = u.pn * BM; bf16_t* base = O;
        float sc = 1.f; if (split_cols) { const int t = colt / split_cols; base += (size_t)t * split_stride; colt -= t * split_cols; if (t == 0) sc = scale0; }
        const int col0 = colt + wc * 32 + 8 * fq, bcol0 = u.pn * BM + wc * 32 + 8 * fq;
        f32x4 bv[2][2];
#pragma unroll
        for (int bj = 0; bj < 2; ++bj)
#pragma unroll
            for (int n = 0; n < 2; ++n) bv[bj][n] = bias ? *(const f32x4*)(bias + bcol0 + bj * HALF + 4 * n) : (f32x4){0.f, 0.f, 0.f, 0.f};
#pragma unroll
        for (int ai = 0; ai < 2; ++ai)
#pragma unroll
            for (int m = 0; m < 4; ++m) { bf16_t* rowp = base + (size_t)(row0 + ai * HALF + m * 16) * ldc + col0;
#pragma unroll
                for (int bj = 0; bj < 2; ++bj) { f32x4 v0 = acc[ai][bj][m][0] + bv[bj][0], v1 = acc[ai][bj][m][1] + bv[bj][1];
                    if (ACT == 1) { f32x2 a = gelu_pk((f32x2){v0[0], v0[1]}), b = gelu_pk((f32x2){v0[2], v0[3]}), c = gelu_pk((f32x2){v1[0], v1[1]}), d = gelu_pk((f32x2){v1[2], v1[3]});
                        v0 = (f32x4){a.x, a.y, b.x, b.y}; v1 = (f32x4){c.x, c.y, d.x, d.y}; }
                    v0 = v0 * sc; v1 = v1 * sc; u32x4 w; w.x = cvt_pk_bf16(v0[0], v0[1]); w.y = cvt_pk_bf16(v0[2], v0[3]); w.z = cvt_pk_bf16(v1[0], v1[1]); w.w = cvt_pk_bf16(v1[2], v1[3]);
                    *(u32x4*)(rowp + bj * HALF) = w; } }
    }
};
__device__ __forceinline__ float sigmoid_fast(float x) { return __builtin_amdgcn_rcpf(1.0f + __expf(-x)); }
__device__ __forceinline__ f32x4 sigmoid4(f32x4 x) { f32x4 r; r[0] = sigmoid_fast(x[0]); r[1] = sigmoid_fast(x[1]); r[2] = sigmoid_fast(x[2]); r[3] = sigmoid_fast(x[3]); return r; }
__device__ __forceinline__ u32x4 pack8(const f32x4 a, const f32x4 b) { u32x4 w; w.x = cvt_pk_bf16(a[0], a[1]); w.y = cvt_pk_bf16(a[2], a[3]); w.z = cvt_pk_bf16(b[0], b[1]); w.w = cvt_pk_bf16(b[2], b[3]); return w; }
__device__ __forceinline__ float dot4s(const f32x4 a) { return (a[0] * a[0] + a[1] * a[1]) + (a[2] * a[2] + a[3] * a[3]); }

struct EpiIn {
    static constexpr bool PERM = true, AFTER_DRAIN = false;
    bf16_t *Q, *Kk, *V, *U; const float* ropec; const float* ropes; float qscale;
    __device__ __forceinline__ void operator()(const f32x4 (&acc)[2][2][4][2], const Unit& u, int wr, int wc, int fr, int fq) const {
        const int row0 = u.pm * BM + wr * 64 + fr; const int pn = u.pn;
        if (pn < 4) {
            bf16_t* dst = (pn < 2) ? Q : Kk; const float sc = (pn < 2) ? qscale : 1.0f; const int colb = ((pn & 1) * 4 + wc) * 128 + 8 * fq;
#pragma unroll
            for (int ai = 0; ai < 2; ++ai)
#pragma unroll
                for (int m = 0; m < 4; ++m) { const int row = row0 + ai * HALF + m * 16; const int pos = row & 4095;
                    const f32x4 c0 = *(const f32x4*)(ropec + pos * 32 + 8 * fq), c1 = *(const f32x4*)(ropec + pos * 32 + 8 * fq + 4);
                    const f32x4 s0 = *(const f32x4*)(ropes + pos * 32 + 8 * fq), s1 = *(const f32x4*)(ropes + pos * 32 + 8 * fq + 4);
                    const f32x4 x10 = acc[ai][0][m][0], x11 = acc[ai][0][m][1], x20 = acc[ai][1][m][0], x21 = acc[ai][1][m][1];
                    const f32x4 o10 = (x10 * c0 - x20 * s0) * sc, o11 = (x11 * c1 - x21 * s1) * sc, o20 = (x20 * c0 + x10 * s0) * sc, o21 = (x21 * c1 + x11 * s1) * sc;
                    bf16_t* rp = dst + (size_t)row * 1024 + colb; const u32x4 w1 = pack8(o10, o11), w2 = pack8(o20, o21);
                    *(u32x4*)rp = w1; *(u32x4*)(rp + 32) = w2; *(u32x4*)(rp + 64) = w1; *(u32x4*)(rp + 96) = w2; }
        } else if (pn < 6) {
#pragma unroll
            for (int ai = 0; ai < 2; ++ai)
#pragma unroll
                for (int m = 0; m < 4; ++m) { const int row = row0 + ai * HALF + m * 16;
#pragma unroll
                    for (int bj = 0; bj < 2; ++bj) { const int hh = (pn - 4) * 2 + bj, vh = wc >> 1, d = (wc & 1) * 32 + 8 * fq;
                        const u32x4 w = pack8(acc[ai][bj][m][0], acc[ai][bj][m][1]); bf16_t* rp = V + (size_t)row * 1024 + (hh * 4 + vh) * 64 + d; *(u32x4*)rp = w; *(u32x4*)(rp + 128) = w; } }
        } else {
#pragma unroll
            for (int ai = 0; ai < 2; ++ai)
#pragma unroll
                for (int m = 0; m < 4; ++m) { const int row = row0 + ai * HALF + m * 16;
                    const f32x4 u0 = acc[ai][0][m][0] * sigmoid4(acc[ai][1][m][0]), u1 = acc[ai][0][m][1] * sigmoid4(acc[ai][1][m][1]);
                    *(u32x4*)(U + (size_t)row * 512 + (pn - 6) * 128 + wc * 32 + 8 * fq) = pack8(u0, u1); }
        }
    }
};
struct EpiOut {
    static constexpr bool PERM = true, AFTER_DRAIN = false;
    const float* x; float* out; bf16_t* hb; float* ssq;
    __device__ __forceinline__ void operator()(const f32x4 (&acc)[2][2][4][2], const Unit& u, int wr, int wc, int fr, int fq) const {
        const int row0 = u.pm * BM + wr * 64 + fr;
#pragma unroll
        for (int ai = 0; ai < 2; ++ai)
#pragma unroll
            for (int m = 0; m < 4; ++m) { const int row = row0 + ai * HALF + m * 16; float ss = 0.f;
#pragma unroll
                for (int bj = 0; bj < 2; ++bj) { const size_t off = (size_t)row * 1024 + u.pn * BM + bj * HALF + wc * 32 + 8 * fq;
                    const f32x4 h0 = acc[ai][bj][m][0] + *(const f32x4*)(x + off), h1 = acc[ai][bj][m][1] + *(const f32x4*)(x + off + 4);
                    *(f32x4*)(out + off) = h0; *(f32x4*)(out + off + 4) = h1; *(u32x4*)(hb + off) = pack8(h0, h1); ss += dot4s(h0) + dot4s(h1); }
                ss += __shfl_xor(ss, 16); ss += __shfl_xor(ss, 32);
                if (fq == 0) ssq[(size_t)row * 16 + u.pn * 4 + wc] = ss; }
    }
};
struct EpiQ {
    static constexpr bool PERM = true, AFTER_DRAIN = false;
    const float* ssq; bf16_t* qp; float eps;
    __device__ __forceinline__ void operator()(const f32x4 (&acc)[2][2][4][2], const Unit& u, int wr, int wc, int fr, int fq) const {
        const int row0 = u.pm * BM + wr * 64 + fr;
#pragma unroll
        for (int ai = 0; ai < 2; ++ai)
#pragma unroll
            for (int m = 0; m < 4; ++m) { const int row = row0 + ai * HALF + m * 16; const f32x4* sp = (const f32x4*)(ssq + (size_t)row * 16);
                const f32x4 a = sp[0], b = sp[1], c = sp[2], d = sp[3]; const f32x4 t = (a + b) + (c + d);
                const float rstd = rsqrtf(((t[0] + t[1]) + (t[2] + t[3])) * (1.0f / 1024.0f) + eps);
#pragma unroll
                for (int bj = 0; bj < 2; ++bj) *(u32x4*)(qp + (size_t)row * 2048 + u.pn * BM + bj * HALF + wc * 32 + 8 * fq) = pack8(acc[ai][bj][m][0] * rstd, acc[ai][bj][m][1] * rstd); }
    }
};
__device__ __forceinline__ f32x4 bf_lo4(unsigned a, unsigned b) { f32x4 r; r[0] = __uint_as_float(a << 16); r[1] = __uint_as_float(a & 0xffff0000u); r[2] = __uint_as_float(b << 16); r[3] = __uint_as_float(b & 0xffff0000u); return r; }
struct EpiGate {
    static constexpr bool PERM = true, AFTER_DRAIN = false;
    float* out; const bf16_t* e; const float* ssq; float eps;
    __device__ __forceinline__ void operator()(const f32x4 (&acc)[2][2][4][2], const Unit& u, int wr, int wc, int fr, int fq) const {
        const int row0 = u.pm * BM + wr * 64 + fr;
#pragma unroll
        for (int ai = 0; ai < 2; ++ai)
#pragma unroll
            for (int m = 0; m < 4; ++m) { const int row = row0 + ai * HALF + m * 16; const f32x4* sp = (const f32x4*)(ssq + (size_t)row * 8); const f32x4 t = sp[0] + sp[1];
                const float rstd = rsqrtf(((t[0] + t[1]) + (t[2] + t[3])) * (1.0f / 1024.0f) + eps);
#pragma unroll
                for (int bj = 0; bj < 2; ++bj) { const size_t off = (size_t)row * 1024 + u.pn * BM + bj * HALF + wc * 32 + 8 * fq;
                    const u32x4 ev = *(const u32x4*)(e + off); const f32x4 e0 = bf_lo4(ev.x, ev.y), e1 = bf_lo4(ev.z, ev.w);
                    const f32x4 h0 = *(const f32x4*)(out + off) + e0 * sigmoid4(acc[ai][bj][m][0] * rstd), h1 = *(const f32x4*)(out + off + 4) + e1 * sigmoid4(acc[ai][bj][m][1] * rstd);
                    *(f32x4*)(out + off) = h0; *(f32x4*)(out + off + 4) = h1; } }
    }
};
template <class Epi, class Sched, bool ALIGN_EPI = false, bool SP2 = false>
__device__ __forceinline__ void gemm_phase(PG8_LAS unsigned char* lds, const Gemm g, const Sched& S, const Epi& E, const int wid  ) {
    int lane; asm volatile("v_mbcnt_lo_u32_b32 %0, -1, 0\n\tv_mbcnt_hi_u32_b32 %0, -1, %0" : "=v"(lane));
    const int tid = wid * 64 + lane, wr = wid >> 2, wc = wid & 3, fr = lane & 15, fq = lane >> 4;
    const int K = g.K, nt = K / BK;
    unsigned voffA[2], voffB[2];
#pragma unroll
    for (int i = 0; i < 2; ++i) { int R, C; stage_rc(tid * 16 + i * 8192, R, C); const int Rb = Epi::PERM ? ((R & ~31) + perm32(R & 31)) : R;
        voffA[i] = (unsigned)(R * K + C) * 2u; voffB[i] = (unsigned)(Rb * K + C) * 2u; }
    const size_t kstep = (size_t)(BK * 2);
    const size_t hstep = (size_t)HALF * K * 2;
    const size_t tstep = 2 * hstep;
    const unsigned ldsw = (unsigned)wid * 1024u;
    const int aoff = lds_byte(wr * 64 + fr, fq * 8), boff = lds_byte(wc * 32 + fr, fq * 8);
#define PG8_SA(b, h) (((b) * 2 + (h)) * HTB)
#define PG8_SB(b, h) ((4 + (b) * 2 + (h)) * HTB)
#define PG8_STAGE(bufoff, gbase, voff) do { _Pragma("unroll") for (int _i = 0; _i < 2; ++_i) \
        __builtin_amdgcn_global_load_lds((const unsigned*)((const char*)(gbase) + (voff)[_i]), (PG8_LAS unsigned*)(lds + (bufoff) + ldsw + _i * 8192), 16, 0, 0); } while (0)
#define PG8_LDA(dst, b, h) do { _Pragma("unroll") for (int m = 0; m < 4; ++m) _Pragma("unroll") for (int k = 0; k < 2; ++k) dst[m][k] = *(const PG8_LAS bf16x8*)(lds + PG8_SA(b, h) + aoff + m * 2048 + k * 1024); } while (0)
#define PG8_LDB(dst, b, h) do { _Pragma("unroll") for (int n = 0; n < 2; ++n) _Pragma("unroll") for (int k = 0; k < 2; ++k) dst[n][k] = *(const PG8_LAS bf16x8*)(lds + PG8_SB(b, h) + boff + n * 2048 + k * 1024); } while (0)
#define PG8_MMA(ai, bj, At, Bt) do { __builtin_amdgcn_s_setprio(1); _Pragma("unroll") for (int m = 0; m < 4; ++m) _Pragma("unroll") for (int n = 0; n < 2; ++n) _Pragma("unroll") for (int k = 0; k < 2; ++k) \
        acc[ai][bj][m][n] = __builtin_amdgcn_mfma_f32_16x16x32_bf16(Bt[n][k], At[m][k], acc[ai][bj][m][n], 0, 0, 0); __builtin_amdgcn_s_setprio(0); } while (0)
#define PG8_WAIT_V(n) asm volatile("s_waitcnt vmcnt(" #n ")" ::: "memory")
#define PG8_WAIT_L(n) asm volatile("s_waitcnt lgkmcnt(" #n ")" ::: "memory")
#define PG8_BAR __builtin_amdgcn_s_barrier()
#define PG8_SCHED __builtin_amdgcn_sched_barrier(0)
    Unit cur, nxt; int ui = 0;
    if (!S.next(0, cur)) return;
    f32x4 acc[2][2][4][2];
#pragma unroll
    for (int a = 0; a < 2; ++a)
#pragma unroll
        for (int b = 0; b < 2; ++b)
#pragma unroll
            for (int m = 0; m < 4; ++m)
#pragma unroll
                for (int n = 0; n < 2; ++n) acc[a][b][m][n] = (f32x4){0.f, 0.f, 0.f, 0.f};
    bf16x8 At[4][2], B0[2][2], B1[2][2];
    const char* cA = (const char*)g.A + (size_t)cur.pm * tstep; const char* cB = (const char*)g.Bt + (size_t)cur.pn * tstep;
    S.a_ready(cur);
    if constexpr (SP2) {
        PG8_STAGE(PG8_SB(0, 0), cB, voffB); PG8_STAGE(PG8_SB(0, 1), cB + hstep, voffB); PG8_STAGE(PG8_SA(0, 0), cA, voffA); PG8_STAGE(PG8_SA(0, 1), cA + hstep, voffA);
        if (wr == 1) PG8_BAR;
        PG8_WAIT_V(2); PG8_BAR;
        PG8_STAGE(PG8_SB(1, 0), cB + kstep, voffB); PG8_STAGE(PG8_SA(1, 0), cA + kstep, voffA); PG8_STAGE(PG8_SB(1, 1), cB + hstep + kstep, voffB);
        PG8_WAIT_V(6); PG8_BAR;
    } else {
        PG8_STAGE(PG8_SB(0, 0), cB, voffB); PG8_STAGE(PG8_SA(0, 0), cA, voffA); PG8_STAGE(PG8_SB(0, 1), cB + hstep, voffB); PG8_STAGE(PG8_SA(0, 1), cA + hstep, voffA);
        if (wr == 1) PG8_BAR;
        PG8_WAIT_V(4); PG8_BAR;
        PG8_STAGE(PG8_SB(1, 0), cB + kstep, voffB); PG8_STAGE(PG8_SA(1, 0), cA + kstep, voffA); PG8_STAGE(PG8_SB(1, 1), cB + hstep + kstep, voffB);
        PG8_WAIT_V(6); PG8_BAR;
    }
    for (;;) {
        const bool has_next = S.next(ui + 1, nxt);
        const char* nA = has_next ? (const char*)g.A + (size_t)nxt.pm * tstep : cA; const char* nB = has_next ? (const char*)g.Bt + (size_t)nxt.pn * tstep : cB;
        for (int t = 0; t < nt; t += 2) {
            const bool last = (t == nt - 2);
            const char* a1 = cA + (size_t)(t + 1) * kstep;
            const char* a2 = last ? nA : cA + (size_t)(t + 2) * kstep; const char* b2 = last ? nB : cB + (size_t)(t + 2) * kstep;
            const char* a3 = a2 + kstep; const char* b3 = b2 + kstep;
            if (last && has_next) S.a_ready(nxt);
            if constexpr (SP2) {
            PG8_LDB(B0, 0, 0); PG8_LDB(B1, 0, 1); PG8_SCHED; PG8_LDA(At, 0, 0); PG8_STAGE(PG8_SA(1, 1), a1 + hstep, voffA);
            PG8_WAIT_V(8); PG8_WAIT_L(0); PG8_BAR; PG8_MMA(0, 0, At, B0); PG8_MMA(0, 1, At, B1); PG8_BAR; PG8_SCHED;
            PG8_LDA(At, 0, 1); PG8_STAGE(PG8_SB(0, 0), b2, voffB); PG8_STAGE(PG8_SB(0, 1), b2 + hstep, voffB); PG8_STAGE(PG8_SA(0, 0), a2, voffA);
            PG8_WAIT_V(8); PG8_WAIT_L(0); PG8_BAR; PG8_MMA(1, 0, At, B0); PG8_MMA(1, 1, At, B1); PG8_BAR; PG8_SCHED;
            PG8_LDB(B0, 1, 0); PG8_LDB(B1, 1, 1); PG8_SCHED; PG8_LDA(At, 1, 0); PG8_STAGE(PG8_SA(0, 1), a2 + hstep, voffA);
            PG8_WAIT_V(8); PG8_WAIT_L(0); PG8_BAR; PG8_MMA(0, 0, At, B0); PG8_MMA(0, 1, At, B1); PG8_BAR; PG8_SCHED;
            PG8_LDA(At, 1, 1); PG8_STAGE(PG8_SB(1, 0), b3, voffB); PG8_STAGE(PG8_SB(1, 1), b3 + hstep, voffB); PG8_STAGE(PG8_SA(1, 0), a3, voffA);
            PG8_WAIT_V(8); PG8_WAIT_L(0); PG8_BAR; PG8_MMA(1, 0, At, B0); PG8_MMA(1, 1, At, B1); PG8_BAR; PG8_SCHED;
            } else {
            PG8_LDB(B0, 0, 0); PG8_SCHED; PG8_LDA(At, 0, 0); PG8_STAGE(PG8_SA(1, 1), a1 + hstep, voffA);
            PG8_WAIT_L(8); PG8_BAR; PG8_WAIT_L(0); PG8_MMA(0, 0, At, B0); PG8_BAR; PG8_SCHED;
            PG8_LDB(B1, 0, 1); PG8_STAGE(PG8_SB(0, 0), b2, voffB);
            PG8_BAR; PG8_WAIT_L(0); PG8_MMA(0, 1, At, B1); PG8_BAR;
            PG8_LDA(At, 0, 1); PG8_STAGE(PG8_SA(0, 0), a2, voffA);
            PG8_BAR; PG8_WAIT_L(0); PG8_MMA(1, 0, At, B0); PG8_BAR; PG8_SCHED;
            PG8_STAGE(PG8_SB(0, 1), b2 + hstep, voffB);
            PG8_WAIT_V(6); PG8_BAR; PG8_MMA(1, 1, At, B1); PG8_BAR;
            PG8_LDB(B0, 1, 0); PG8_SCHED; PG8_LDA(At, 1, 0); PG8_STAGE(PG8_SA(0, 1), a2 + hstep, voffA);
            PG8_WAIT_L(8); PG8_BAR; PG8_WAIT_L(0); PG8_MMA(0, 0, At, B0); PG8_BAR; PG8_SCHED;
            PG8_LDB(B1, 1, 1); PG8_STAGE(PG8_SB(1, 0), b3, voffB);
            PG8_BAR; PG8_WAIT_L(0); PG8_MMA(0, 1, At, B1); PG8_BAR;
            PG8_LDA(At, 1, 1); PG8_STAGE(PG8_SA(1, 0), a3, voffA);
            PG8_BAR; PG8_WAIT_L(0); PG8_MMA(1, 0, At, B0); PG8_BAR; PG8_SCHED;
            PG8_STAGE(PG8_SB(1, 1), b3 + hstep, voffB);
            PG8_WAIT_V(6); PG8_BAR; PG8_MMA(1, 1, At, B1); PG8_BAR;
            }
        }
        if constexpr (ALIGN_EPI) { if (wr == 0) PG8_BAR; }
        if constexpr (!Epi::AFTER_DRAIN) { E(acc, cur, wr, wc, fr, fq); S.done(cur); }
        if (!has_next) break;
#pragma unroll
        for (int a = 0; a < 2; ++a)
#pragma unroll
            for (int b = 0; b < 2; ++b)
#pragma unroll
                for (int m = 0; m < 4; ++m)
#pragma unroll
                    for (int n = 0; n < 2; ++n) acc[a][b][m][n] = (f32x4){0.f, 0.f, 0.f, 0.f};
        cur = nxt; cA = nA; cB = nB; ++ui;
        if constexpr (ALIGN_EPI) { if (wr == 1) PG8_BAR; }
    }
    PG8_WAIT_V(0);
    if constexpr (!ALIGN_EPI) { if (wr == 0) PG8_BAR; }
    PG8_BAR;
    if constexpr (Epi::AFTER_DRAIN) { E.fused(acc, cur, wr, wc, fr, fq, lds, wid, lane); S.done(cur); }
#undef PG8_SA
#undef PG8_SB
#undef PG8_STAGE
#undef PG8_LDA
#undef PG8_LDB
#undef PG8_MMA
#undef PG8_WAIT_V
#undef PG8_WAIT_L
#undef PG8_BAR
#undef PG8_SCHED
}
}
#include <hip/hip_bf16.h>
#include <cmath>
namespace attn_body {
using bf16=__hip_bfloat16;
using bf16x8=__attribute__((ext_vector_type(8)))short;
using s16x4=__attribute__((ext_vector_type(4)))short;
using f32x16=__attribute__((ext_vector_type(16)))float;
using u32x4=__attribute__((ext_vector_type(4)))unsigned;
constexpr int BATCH=8,NHEAD=16,SEQ=4096,D=64,DM=NHEAD*D;
constexpr int NW=8,QBLK=32,QB=QBLK*NW,KVBLK=64,NQB=SEQ/QB;
constexpr int ATTN_PITCH=DM, ATTN_UNIT_ROWS=QB;
__device__ __forceinline__ int crow(int r,int hi){return (r&3)+8*(r>>2)+4*hi;}
#define SBAR() __builtin_amdgcn_sched_barrier(0)
__device__ __forceinline__ void cmask(f32x16&p0,f32x16&p1,int jb,int qrel,int hi){
  const float NEG=-INFINITY; int kb=64*jb+4*hi;
  #pragma unroll
  for(int r=0;r<16;++r){int kv=kb+(r&3)+8*(r>>2); if(kv>qrel)p0[r]=NEG; if(kv+32>qrel)p1[r]=NEG;}
}

constexpr int NSLOT=3, SLOTB=8192;
constexpr int LDS_K=0, LDS_V=NSLOT*SLOTB, LDS_WS=2*NSLOT*SLOTB, LDS_OST=LDS_WS+NW*64*4, LDS_BYTES=LDS_OST+NW*4096;
constexpr float C2=0.125f*1.4426950408889634f;
__device__ __forceinline__ void glds16(const void*gsrc,unsigned lds_dst){unsigned keep;
  asm volatile("s_mov_b32 %0, m0\n\ts_mov_b32 m0, %2\n\ts_nop 0\n\tglobal_load_lds_dwordx4 %1, off\n\ts_mov_b32 m0, %0":"=&s"(keep):"v"(gsrc),"s"(lds_dst):"memory");}
__device__ __forceinline__ float max3f(float a,float b,float c){float r;asm("v_max3_f32 %0, %1, %2, %3":"=v"(r):"v"(a),"v"(b),"v"(c));return r;}
__device__ __forceinline__ float max2f(float a,float b){float r;asm("v_max_f32_e32 %0, %1, %2":"=v"(r):"v"(a),"v"(b));return r;}
__device__ __forceinline__ float fadd_s(float a,float b){float r;asm("v_add_f32_e32 %0, %1, %2":"=v"(r):"v"(a),"v"(b));return r;}
__device__ __forceinline__ float fsub_s(float a,float b){float r;asm("v_sub_f32_e32 %0, %1, %2":"=v"(r):"v"(a),"v"(b));return r;}
typedef float f32x2_t __attribute__((ext_vector_type(2))); typedef __bf16 bf16x2_t __attribute__((ext_vector_type(2)));
__device__ __forceinline__ unsigned cvtpk_s(float lo,float hi){f32x2_t v={lo,hi};bf16x2_t b=__builtin_convertvector(v,bf16x2_t);return __builtin_bit_cast(unsigned,b);}
#define WAIT_BAR(N) asm volatile("s_waitcnt vmcnt(" #N ") lgkmcnt(0)\n\ts_barrier":::"memory")

__device__ __forceinline__ void qkt(f32x16&p0,f32x16&p1,const char*Kslot,const bf16x8*qr,const f32x16&negm,int r32,int hi){
  const char*kb=Kslot+hi*1024+r32*16;
  #pragma unroll
  for(int d0=0;d0<4;++d0){
    const bf16x8 b0=*reinterpret_cast<const bf16x8*>(kb+d0*2048);
    const bf16x8 b1=*reinterpret_cast<const bf16x8*>(kb+d0*2048+512);
    if(d0==0){p0=__builtin_amdgcn_mfma_f32_32x32x16_bf16(b0,qr[0],negm,0,0,0);p1=__builtin_amdgcn_mfma_f32_32x32x16_bf16(b1,qr[0],negm,0,0,0);}
    else{p0=__builtin_amdgcn_mfma_f32_32x32x16_bf16(b0,qr[d0],p0,0,0,0);p1=__builtin_amdgcn_mfma_f32_32x32x16_bf16(b1,qr[d0],p1,0,0,0);}}
}
typedef __attribute__((address_space(3))) const char* lds_cptr;
typedef short v4i16_t __attribute__((ext_vector_type(4)));
__device__ __forceinline__ void kload8(bf16x8*kf,lds_cptr kp){
  kf[0]=*(const __attribute__((address_space(3))) bf16x8*)(kp);      kf[1]=*(const __attribute__((address_space(3))) bf16x8*)(kp+512);
  kf[2]=*(const __attribute__((address_space(3))) bf16x8*)(kp+2048); kf[3]=*(const __attribute__((address_space(3))) bf16x8*)(kp+2560);
  kf[4]=*(const __attribute__((address_space(3))) bf16x8*)(kp+4096); kf[5]=*(const __attribute__((address_space(3))) bf16x8*)(kp+4608);
  kf[6]=*(const __attribute__((address_space(3))) bf16x8*)(kp+6144); kf[7]=*(const __attribute__((address_space(3))) bf16x8*)(kp+6656);
}
__device__ __forceinline__ void kload2(bf16x8*kf,lds_cptr kp,int j){ kf[2*j]=*(const __attribute__((address_space(3))) bf16x8*)(kp+j*2048); kf[2*j+1]=*(const __attribute__((address_space(3))) bf16x8*)(kp+j*2048+512); }
__device__ __forceinline__ s16x4 vtr(lds_cptr p){ return __builtin_bit_cast(s16x4,__builtin_amdgcn_ds_read_tr16_b64_v4i16((__attribute__((address_space(3))) v4i16_t*)p)); }
__device__ __forceinline__ float rowmax(const f32x16&p0,const f32x16&p1){
  float a=max3f(p0[0],p0[1],p1[0]),b=max3f(p0[2],p0[3],p1[1]);a=max3f(a,p1[2],p1[3]);
  #pragma unroll
  for(int r=4;r<16;r+=4){a=max3f(a,p0[r],p0[r+1]);b=max3f(b,p0[r+2],p0[r+3]);a=max3f(a,p1[r],p1[r+1]);b=max3f(b,p1[r+2],p1[r+3]);}
  const float m=max2f(a,b);
  auto rr=__builtin_amdgcn_permlane32_swap(__float_as_uint(m),__float_as_uint(m),false,false);
  return max2f(__uint_as_float(rr[0]),__uint_as_float(rr[1]));
}
__device__ __forceinline__ void pv(f32x16*o,int vb,bf16x8 pa0,bf16x8 pa1,bf16x8 pa2,bf16x8 pa3){
  #pragma unroll
  for(int d0=0;d0<2;++d0){s16x4 lo[4],hi[4];
    #pragma unroll
    for(int ks=0;ks<4;++ks){
      asm volatile("ds_read_b64_tr_b16 %0,%1 offset:%c2":"=&v"(lo[ks]):"v"(vb),"i"(d0*4096+ks*1024):"memory");
      asm volatile("ds_read_b64_tr_b16 %0,%1 offset:%c2":"=&v"(hi[ks]):"v"(vb),"i"(d0*4096+ks*1024+512):"memory");}
    asm volatile("s_waitcnt lgkmcnt(0)":::"memory");SBAR();
    #define PK(k) (bf16x8){lo[k][0],lo[k][1],lo[k][2],lo[k][3],hi[k][0],hi[k][1],hi[k][2],hi[k][3]}
    o[d0]=__builtin_amdgcn_mfma_f32_32x32x16_bf16(pa0,PK(0),o[d0],0,0,0);
    o[d0]=__builtin_amdgcn_mfma_f32_32x32x16_bf16(pa1,PK(1),o[d0],0,0,0);
    o[d0]=__builtin_amdgcn_mfma_f32_32x32x16_bf16(pa2,PK(2),o[d0],0,0,0);
    o[d0]=__builtin_amdgcn_mfma_f32_32x32x16_bf16(pa3,PK(3),o[d0],0,0,0);
    #undef PK
  }
}

#ifndef ATTN_STORE16
#define ATTN_STORE16(p,v) (*(u32x4*)(p)=(v))
#endif
template<int THRL> __device__ __forceinline__ void attn_unit(int b,int h,int qb,const bf16*Q,const bf16*__restrict__ K,const bf16*__restrict__ V,bf16*O,char*shm,const int tid_in){
  const int tid=tid_in,lane=tid&63,r32=lane&31,hi=lane>>5; const int wid=__builtin_amdgcn_readfirstlane(tid>>6);
  const long rowbase=(long)b*SEQ; const int q0=qb*QB;
  const bf16*Qw=Q+(rowbase+q0+wid*QBLK)*DM+h*D;
  const bf16*Kh=K+rowbase*DM+h*D,*Vh=V+rowbase*DM+h*D;
  const unsigned lds0=(unsigned)(uintptr_t)shm;
  float*wsf=(float*)(shm+LDS_WS)+wid*64;
  const bf16*ksrc=Kh+(long)lane*DM+wid*8;
  const bf16*vsrc=Vh+(long)(16*(wid&3)+(lane>>2))*DM+(wid>>2)*32+(lane&3)*8;
  const unsigned kdst=lds0+LDS_K+wid*1024, vdst=lds0+LDS_V+wid*1024;
  #define DMA_K(t,slot) glds16(ksrc+(long)(t)*KVBLK*DM,(unsigned)__builtin_amdgcn_readfirstlane(kdst+(slot)))
  #define DMA_V(t,slot) glds16(vsrc+(long)(t)*KVBLK*DM,(unsigned)__builtin_amdgcn_readfirstlane(vdst+(slot)))
  const int vb0=(int)(lds0+LDS_V)+((lane>>4)&1)*32+(lane&3)*8+(4*hi+((lane&15)>>2))*64;
  const char*Kbase=shm+LDS_K; bf16x8 kf[8];
  const lds_cptr shm3=(lds_cptr)shm; const lds_cptr kp0=shm3+LDS_K+hi*1024+r32*16; const lds_cptr vp0=shm3+LDS_V+((lane>>4)&1)*32+(lane&3)*8+(4*hi+((lane&15)>>2))*64;
  const int NT=(q0+QB)/KVBLK;
  DMA_K(0,0);DMA_V(0,0);DMA_K(1,SLOTB);
  bf16x8 qr[4];
  #pragma unroll
  for(int d0=0;d0<4;++d0)qr[d0]=*reinterpret_cast<const bf16x8*>(&Qw[(long)r32*DM+d0*16+hi*8]);
  float mhat=0.f,l_reg=0.f;f32x16 o[2];o[0]=f32x16{};o[1]=f32x16{};f32x16 negm=f32x16{};asm volatile("":"+v"(negm));
  const int qrel=wid*QBLK+r32;
  #define CMASK(P0,P1,t) do{int jb_=(t)-(NT-4); if(jb_>=0)cmask(P0,P1,jb_,qrel,hi);}while(0)
  bool resc=false;
  #define START(P0,P1) do{ const float rm=rowmax(P0,P1); resc=false; \
    { const float dl=rm; mhat=fadd_s(mhat,dl); \
      _Pragma("unroll") for(int r=0;r<16;++r){P0[r]=fsub_s(P0[r],dl);P1[r]=fsub_s(P1[r],dl);} \
      _Pragma("unroll") for(int r=0;r<16;++r)negm[r]=-mhat; asm volatile("":"+v"(negm)); } \
    _Pragma("unroll") for(int r=0;r<16;++r)P0[r]=__builtin_amdgcn_exp2f(P0[r]); }while(0)
  #define RESC() do{ if(resc){ asm volatile("s_waitcnt lgkmcnt(0)":::"memory"); \
      _Pragma("unroll") for(int d_=0;d_<2;++d_) _Pragma("unroll") for(int r=0;r<16;++r)o[d_][r]*=wsf[crow(r,hi)]; } }while(0)
  f32x16 pA0,pA1,pB0,pB1;
  int sl_prev=0,sl_cur=0,sl_next=SLOTB;
  #define ROT() do{sl_prev=sl_cur;sl_cur=sl_next;sl_next=(sl_next==(NSLOT-1)*SLOTB)?0:sl_next+SLOTB;}while(0)
  DMA_K(2,2*SLOTB);
  WAIT_BAR(3);
  qkt(pA0,pA1,Kbase,qr,negm,r32,hi);asm volatile("s_nop 15\n\ts_nop 7":"+v"(pA0),"+v"(pA1));CMASK(pA0,pA1,0);
  START(pA0,pA1);
  _Pragma("unroll") for(int r=0;r<16;++r)pA1[r]=__builtin_amdgcn_exp2f(pA1[r]);
  WAIT_BAR(0);
  DMA_K(3,0);DMA_V(1,SLOTB);
  ROT();
  kload8(kf,kp0+sl_cur);
  WAIT_BAR(2);
  s16x4 vlo[8],vhi[8]; u32x4 pw0,pw1,pw2,pw3;
  #define PKW(P,B) cvtpk_s(P[B],P[B+1])
  #define PAF(k) __builtin_bit_cast(bf16x8,pw##k)
  #define VFR(i) (bf16x8){vlo[i][0],vlo[i][1],vlo[i][2],vlo[i][3],vhi[i][0],vhi[i][1],vhi[i][2],vhi[i][3]}
  #define PIN(x) asm volatile("":"+v"(x))
  #define MX3(a,b,c) __builtin_fmaxf(__builtin_fmaxf((a),(b)),(c))
  #define GAPA(MF,A0,A1,A2,A3,W0,W1,PW) do{ MF; sacc+=A0; sacc+=A1; sacc+=A2; sacc+=A3; PIN(sacc); W0; W1; PIN(PW); SBAR(); }while(0)
  #define EX(v) __builtin_amdgcn_exp2f(v)
  #define GAPB(MF,X,B) do{ MF; X[B]=EX(X[B]); X[B+1]=EX(X[B+1]); X[B+2]=EX(X[B+2]); X[B+3]=EX(X[B+3]); PIN(X); SBAR(); }while(0)
  #define VRD(i) do{ vlo[i]=vtr(vp_+(((i)>>2)*4096+((i)&3)*1024)); vhi[i]=vtr(vp_+(((i)>>2)*4096+((i)&3)*1024+512)); }while(0)
  #define KRD(G,j) do{ if(G){ kload2(kf,kp0+sl_next,j); SBAR(); } }while(0)
  #define STEP(C0,C1,P0,P1,t,GK,GV,GL) do{ SBAR(); \
    const lds_cptr vp_=vp0+sl_prev; \
    VRD(0); SBAR(); float sacc=(P0[0]+P0[1]); \
    GAPA(C0=__builtin_amdgcn_mfma_f32_32x32x16_bf16(kf[0],qr[0],negm,0,0,0), P0[2],P0[3],P0[4],P0[5],     pw0[0]=PKW(P0,0), pw0[1]=PKW(P0,2), pw0); \
    VRD(4); SBAR(); GAPA(C1=__builtin_amdgcn_mfma_f32_32x32x16_bf16(kf[1],qr[0],negm,0,0,0), P0[6],P0[7],P0[8],P0[9],     pw0[2]=PKW(P0,4), pw0[3]=PKW(P0,6), pw0); \
    VRD(1); SBAR(); GAPA(C0=__builtin_amdgcn_mfma_f32_32x32x16_bf16(kf[2],qr[1],C0,0,0,0),   P0[10],P0[11],P0[12],P0[13], pw1[0]=PKW(P0,8), pw1[1]=PKW(P0,10), pw1); \
    VRD(5); SBAR(); GAPA(C1=__builtin_amdgcn_mfma_f32_32x32x16_bf16(kf[3],qr[1],C1,0,0,0),   P0[14],P0[15],P1[0],P1[1],   pw1[2]=PKW(P0,12),pw1[3]=PKW(P0,14), pw1); \
    VRD(2); SBAR(); GAPA(C0=__builtin_amdgcn_mfma_f32_32x32x16_bf16(kf[4],qr[2],C0,0,0,0),   P1[2],P1[3],P1[4],P1[5],     pw2[0]=PKW(P1,0), pw2[1]=PKW(P1,2), pw2); \
    VRD(6); SBAR(); GAPA(C1=__builtin_amdgcn_mfma_f32_32x32x16_bf16(kf[5],qr[2],C1,0,0,0),   P1[6],P1[7],P1[8],P1[9],     pw2[2]=PKW(P1,4), pw2[3]=PKW(P1,6), pw2); \
    VRD(3); SBAR(); GAPA(C0=__builtin_amdgcn_mfma_f32_32x32x16_bf16(kf[6],qr[3],C0,0,0,0),   P1[10],P1[11],P1[12],P1[13], pw3[0]=PKW(P1,8), pw3[1]=PKW(P1,10), pw3); \
    VRD(7); SBAR(); GAPA(C1=__builtin_amdgcn_mfma_f32_32x32x16_bf16(kf[7],qr[3],C1,0,0,0),   P1[14],P1[15],0.f,0.f,       pw3[2]=PKW(P1,12),pw3[3]=PKW(P1,14), pw3); \
    l_reg+=sacc; \
    if(GK){DMA_K((t)+3,sl_cur);} if(GV){DMA_V((t)+1,sl_next);} \
    CMASK(C0,C1,t); \
    { float a=MX3(C0[0],C0[1],C1[0]),b=MX3(C0[2],C0[3],C1[1]); a=MX3(a,C1[2],C1[3]); \
      _Pragma("unroll") for(int r=4;r<16;r+=4){a=MX3(a,C0[r],C0[r+1]);b=MX3(b,C0[r+2],C0[r+3]);a=MX3(a,C1[r],C1[r+1]);b=MX3(b,C1[r+2],C1[r+3]);} \
      float rm=__builtin_fmaxf(a,b); { auto rr=__builtin_amdgcn_permlane32_swap(__float_as_uint(rm),__float_as_uint(rm),false,false); rm=__builtin_fmaxf(__uint_as_float(rr[0]),__uint_as_float(rr[1])); } \
      resc=false; \
      if(__builtin_expect(__any(rm>(float)THRL),0)){ const float dl=__builtin_fmaxf(rm,0.f); mhat+=dl; \
        _Pragma("unroll") for(int r=0;r<16;++r){C0[r]-=dl;C1[r]-=dl;} \
        _Pragma("unroll") for(int r=0;r<16;++r)negm[r]=-mhat; asm volatile("":"+v"(negm)); \
        const float f=__builtin_amdgcn_exp2f(-dl); l_reg*=f; if(hi==0)wsf[r32]=f; resc=true; } } \
    SBAR(); \
    GAPB(o[0]=__builtin_amdgcn_mfma_f32_32x32x16_bf16(PAF(0),VFR(0),o[0],0,0,0), C0,0); \
    GAPB(o[1]=__builtin_amdgcn_mfma_f32_32x32x16_bf16(PAF(0),VFR(4),o[1],0,0,0), C0,4); \
    KRD(GL,0); GAPB(o[0]=__builtin_amdgcn_mfma_f32_32x32x16_bf16(PAF(1),VFR(1),o[0],0,0,0), C0,8); \
    KRD(GL,1); GAPB(o[1]=__builtin_amdgcn_mfma_f32_32x32x16_bf16(PAF(1),VFR(5),o[1],0,0,0), C0,12); \
    KRD(GL,2); GAPB(o[0]=__builtin_amdgcn_mfma_f32_32x32x16_bf16(PAF(2),VFR(2),o[0],0,0,0), C1,0); \
    KRD(GL,3); GAPB(o[1]=__builtin_amdgcn_mfma_f32_32x32x16_bf16(PAF(2),VFR(6),o[1],0,0,0), C1,4); \
    GAPB(o[0]=__builtin_amdgcn_mfma_f32_32x32x16_bf16(PAF(3),VFR(3),o[0],0,0,0), C1,8); \
    GAPB(o[1]=__builtin_amdgcn_mfma_f32_32x32x16_bf16(PAF(3),VFR(7),o[1],0,0,0), C1,12); \
    }while(0)
  int t=1;
  #undef CMASK
  #define CMASK(P0,P1,t) do{}while(0)
  for(;t+5<NT;t+=2){
    STEP(pB0,pB1,pA0,pA1,t,true,true,true);     WAIT_BAR(2); RESC(); ROT();
    STEP(pA0,pA1,pB0,pB1,t+1,true,true,true);   WAIT_BAR(2); RESC(); ROT();
  }
  #undef CMASK
  #define CMASK(P0,P1,t) do{int jb_=(t)-(NT-4); if(jb_>=0)cmask(P0,P1,jb_,qrel,hi);}while(0)
  #define ENDW(tt) do{ if((tt)+3<NT){WAIT_BAR(2);} else if((tt)+2<NT){WAIT_BAR(1);} else {WAIT_BAR(0);} }while(0)
  for(;t+1<NT;t+=2){
    STEP(pB0,pB1,pA0,pA1,t,(t+3<NT),(t+1<NT),(t+1<NT));       ENDW(t);   RESC(); ROT();
    STEP(pA0,pA1,pB0,pB1,t+1,(t+4<NT),(t+2<NT),(t+2<NT));     ENDW(t+1); RESC(); ROT();
  }
  STEP(pB0,pB1,pA0,pA1,NT-1,false,false,false); RESC();
  { float sacc=pB0[0]+pB0[1]; _Pragma("unroll") for(int r=2;r<16;++r)sacc+=pB0[r]; _Pragma("unroll") for(int r=0;r<16;++r)sacc+=pB1[r]; l_reg+=sacc;
    pw0=(u32x4){PKW(pB0,0),PKW(pB0,2),PKW(pB0,4),PKW(pB0,6)};pw1=(u32x4){PKW(pB0,8),PKW(pB0,10),PKW(pB0,12),PKW(pB0,14)};pw2=(u32x4){PKW(pB1,0),PKW(pB1,2),PKW(pB1,4),PKW(pB1,6)};pw3=(u32x4){PKW(pB1,8),PKW(pB1,10),PKW(pB1,12),PKW(pB1,14)};
    SBAR(); pv(o,vb0+sl_cur,PAF(0),PAF(1),PAF(2),PAF(3)); }
  #undef PKW
  #undef PAF
  #undef VFR
  #undef PIN
  #undef MX3
  #undef GAPA
  #undef GAPB
  #undef EX
  #undef VRD
  #undef KRD
  #undef STEP
  #undef ENDW
  {auto rr=__builtin_amdgcn_permlane32_swap(__float_as_uint(l_reg),__float_as_uint(l_reg),false,false);l_reg=__uint_as_float(rr[0])+__uint_as_float(rr[1]);}
  if(hi==0)wsf[32+r32]=l_reg;asm volatile("s_waitcnt lgkmcnt(0)":::"memory");
  float rli[16];
  #pragma unroll
  for(int r=0;r<16;++r)rli[r]=__builtin_amdgcn_rcpf(wsf[32+crow(r,hi)]);
  bf16*Ow=O+(rowbase+q0+wid*QBLK)*DM+h*D;
  { bf16*stg=(bf16*)(shm+LDS_OST)+wid*2048;
    #pragma unroll
    for(int r=0;r<16;++r){const int orow=crow(r,hi);
      #pragma unroll
      for(int d0=0;d0<2;++d0)stg[orow*64+d0*32+r32]=__float2bfloat16(o[d0][r]*rli[r]);}
    asm volatile("s_waitcnt lgkmcnt(0)":::"memory");
    #pragma unroll
    for(int i=0;i<4;++i){const int row=i*8+(lane>>3),ch=lane&7; const u32x4 v=*(const u32x4*)(stg+row*64+ch*8); ATTN_STORE16(Ow+(long)row*DM+ch*8,v);} }
  asm volatile("s_waitcnt lgkmcnt(0)\n\ts_barrier":::"memory");
  #undef DMA_K
  #undef DMA_V
  #undef CMASK
  #undef START
  #undef RESC
  #undef ROT
}
constexpr int ATTN_LDS_BYTES=LDS_BYTES;
struct AttnTensors { const bf16* Q; const bf16* K; const bf16* V; bf16* O; };
struct AttnUnit { int bh; int qb; };
template<class Sched,int THRL=8> __device__ __forceinline__ void attn_phase(char*lds,const AttnTensors&T,const Sched&S,const int tid_in){
  AttnUnit u;
  for(int i=0;S.next(i,u);++i){ S.a_ready(u); attn_unit<THRL>(u.bh/NHEAD,u.bh%NHEAD,u.qb,T.Q,T.K,T.V,T.O,lds,tid_in); S.done(u); }
}
#undef SBAR
#undef WAIT_BAR
}
constexpr int NWAVES = 8;
constexpr int BATCH = 8, SEQ = 4096, DM = 1024, M = BATCH * SEQ;
constexpr int IN_COLS = 2560, PLE_DIM = 256, NEXP = 16384, QCOLS = 2048;
constexpr float EPS = 1e-6f;
#ifndef MK_N_LAUNCHES
#define MK_N_LAUNCHES 1
#endif
constexpr int N_PHASES = 11;
constexpr size_t MiB = 1u << 20;
constexpr size_t WS_CTL = 0, CTL_ZERO_BYTES = 1 * MiB;
constexpr size_t WS_ROPEC = 1 * MiB, WS_ROPES = 1 * MiB + 512 * 1024;
constexpr size_t WS_KEYS = 2 * MiB;
constexpr size_t WS_WPROJ = 3 * MiB;
constexpr size_t WS_WIN = 4 * MiB;
constexpr size_t WS_WOUT = 10 * MiB, WS_WQ = 12 * MiB, WS_WGATE = 16 * MiB;
constexpr size_t WS_SSQ1 = 18 * MiB;
constexpr size_t WS_PB = 24 * MiB;
constexpr size_t WS_E = 40 * MiB;
constexpr size_t WS_UT = 104 * MiB, WS_VT = 120 * MiB;
constexpr size_t WS_SU = 136 * MiB, WS_SV = 137 * MiB;
constexpr size_t WS_XN = 168 * MiB;
constexpr size_t WS_QO = 232 * MiB, WS_K = 296 * MiB, WS_V = 360 * MiB;
constexpr size_t WS_U = 424 * MiB;
constexpr size_t WS_H1B = 232 * MiB;
constexpr size_t WS_QP = 296 * MiB;
constexpr size_t WS_XN2 = 424 * MiB;
constexpr size_t WS_SM = 138 * MiB, WS_HS = 139 * MiB, WS_SSQ2 = 140 * MiB;
constexpr size_t WS_HQ = 24 * MiB;
constexpr size_t WS_APART = 168 * MiB;
constexpr size_t WS_QM = 424 * MiB;
constexpr size_t WS_EID = 488 * MiB, WS_GATE = 496 * MiB;
constexpr size_t WS_END = 512 * MiB;
constexpr int RING_BYTES = 131072, LDS_BYTES = 147456;
constexpr int MISC_OFF = LDS_BYTES - 256;
constexpr int CW_BAR = 4096;

#define GAS __attribute__((address_space(1)))
#define LAS __attribute__((address_space(3)))
typedef unsigned short bf16;
typedef unsigned v4u __attribute__((ext_vector_type(4)));
typedef float f32x4 __attribute__((ext_vector_type(4)));
typedef float f32x16 __attribute__((ext_vector_type(16)));
typedef short bf16x8 __attribute__((ext_vector_type(8)));
typedef __bf16 bf16x2_t __attribute__((ext_vector_type(2)));
#define LDS_WAIT() asm volatile("s_waitcnt lgkmcnt(0)" ::: "memory")
#define VM_WAIT() asm volatile("s_waitcnt vmcnt(0)" ::: "memory")
__device__ __forceinline__ unsigned f2bf(float f) { unsigned u = __builtin_bit_cast(unsigned, f); return (u + 0x7fffu + ((u >> 16) & 1u)) >> 16; }
__device__ __forceinline__ unsigned pk2(float lo, float hi) { return f2bf(lo) | (f2bf(hi) << 16); }
__device__ __forceinline__ v4u pk8(const f32x4 a, const f32x4 b) { v4u w; w.x = pk2(a[0], a[1]); w.y = pk2(a[2], a[3]); w.z = pk2(b[0], b[1]); w.w = pk2(b[2], b[3]); return w; }
__device__ __forceinline__ float bflo(unsigned w) { return __uint_as_float(w << 16); }
__device__ __forceinline__ float bfhi(unsigned w) { return __uint_as_float(w & 0xffff0000u); }
__device__ __forceinline__ float dot4s_(const f32x4 a) { return (a[0] * a[0] + a[1] * a[1]) + (a[2] * a[2] + a[3] * a[3]); }
__device__ __forceinline__ float wave_sum(float v) {
#pragma unroll
    for (int o = 1; o < 64; o <<= 1) v += __shfl_xor(v, o);
    return v;
}
__device__ __forceinline__ float dot2bf(unsigned w, unsigned x, float acc) { return __builtin_amdgcn_fdot2_f32_bf16(__builtin_bit_cast(bf16x2_t, w), __builtin_bit_cast(bf16x2_t, x), acc, false); }

typedef GAS unsigned gu32;
#define RLX_AGENT __ATOMIC_RELAXED, __HIP_MEMORY_SCOPE_AGENT
#define XB_TMO      128
#define XB_XCNT(j)  (256  + 64 * (j))
#define XB_XSUB(j)  (1280 + 64 * (j))
#define XB_XGEN(j)  (2304 + 64 * (j))
#define XB_TOP      3328
#define XB_TOPGEN   3392
#define XCD_BAR_WORDS 3456
#define XB_SPIN_CAP (1u << 18)

__device__ __forceinline__ unsigned xb_ld(unsigned* p)              { return __hip_atomic_load(p, __ATOMIC_RELAXED, __HIP_MEMORY_SCOPE_AGENT); }
__device__ __forceinline__ unsigned xb_add(unsigned* p, unsigned v) { return __hip_atomic_fetch_add(p, v, __ATOMIC_RELAXED, __HIP_MEMORY_SCOPE_AGENT); }
__device__ __forceinline__ unsigned xb_xcc_id() { return (unsigned)__builtin_amdgcn_s_getreg((3 << 11) | 20) & 0xFu; }
#define XB_SPIN(cond, bar) do { unsigned _sp = 0; while (cond) { __builtin_amdgcn_s_sleep(1); \
    if ((++_sp & 255u) == 0u) { if (xb_ld(&(bar)[XB_TMO])) break; if (_sp > XB_SPIN_CAP) { atomicAdd(&(bar)[XB_TMO], 1u); break; } } } } while (0)

struct XcdBarrier {
    unsigned* bar; unsigned x;
    volatile LAS unsigned* st;
};

__device__ __forceinline__ XcdBarrier xcd_barrier_post(unsigned* bar, volatile LAS unsigned* st, const bool leader) {
    XcdBarrier b; b.bar = bar; b.x = xb_xcc_id(); b.st = st;
    if (leader) (void)xb_add(&bar[XB_XCNT(b.x)], 1u);
    return b;
}
__device__ __forceinline__ void xcd_barrier_complete(unsigned* bar, unsigned x, unsigned& nloc, unsigned& nx) {
    const unsigned G = gridDim.x * gridDim.y * gridDim.z;
    unsigned sum, cnt, mine, sp = 0u;
    for (;;) {
        sum = 0u; cnt = 0u; mine = 0u;
#pragma unroll
        for (unsigned j = 0; j < 16; ++j) { const unsigned c = xb_ld(&bar[XB_XCNT(j)]); sum += c; cnt += (c > 0u) ? 1u : 0u; mine = (j == x) ? c : mine; }
        if (sum == G) break;
        __builtin_amdgcn_s_sleep(1);
        if ((++sp & 255u) == 0u) { if (xb_ld(&bar[XB_TMO])) break; if (sp > XB_SPIN_CAP) { atomicAdd(&bar[XB_TMO], 1u); break; } }
    }
    nloc = mine > 0u ? mine : 1u; nx = cnt > 0u ? cnt : 1u;
}

__device__ __forceinline__ void xcd_barrier(const XcdBarrier& b, const bool leader  ) {
    asm volatile("s_waitcnt vmcnt(0)" ::: "memory");
    __syncthreads();
    if (leader) {
        unsigned* bar = b.bar;
        __builtin_amdgcn_s_waitcnt(0);
        unsigned nloc = b.st[0], nx = b.st[1];
        if (nloc == 0u) { xcd_barrier_complete(bar, b.x, nloc, nx); b.st[0] = nloc; b.st[1] = nx; }
        const unsigned old = xb_add(&bar[XB_XSUB(b.x)], 1u);
        const unsigned gen = old / nloc;
        if (old + 1u == (gen + 1u) * nloc) {
            __builtin_amdgcn_fence(__ATOMIC_RELEASE, "agent");
            asm volatile("s_waitcnt vmcnt(0)" ::: "memory");
            const unsigned og = xb_add(&bar[XB_TOP], 1u);
            const unsigned tg = og / nx;
            if (og + 1u == (tg + 1u) * nx) xb_add(&bar[XB_TOPGEN], 1u);
            else XB_SPIN(xb_ld(&bar[XB_TOPGEN]) == tg, bar);
            __builtin_amdgcn_fence(__ATOMIC_ACQUIRE, "agent");
            xb_add(&bar[XB_XGEN(b.x)], 1u);
            asm volatile("s_waitcnt vmcnt(0)" ::: "memory");
        } else {
            XB_SPIN(xb_ld(&bar[XB_XGEN(b.x)]) == gen, bar);
            __builtin_amdgcn_fence(__ATOMIC_ACQUIRE, "agent");
            asm volatile("s_waitcnt vmcnt(0)" ::: "memory");
        }
    }
    __syncthreads();
}

__device__ __forceinline__ int lane_id() { int l; asm volatile("v_mbcnt_lo_u32_b32 %0, -1, 0\n\tv_mbcnt_hi_u32_b32 %0, -1, %0" : "=v"(l)); return l; }
#if defined(PROBE_A)
#define STAMP(i) do { if (F.wave == 0) { const unsigned long long t_ = __builtin_amdgcn_s_memrealtime(); volatile LAS unsigned* ms_ = (volatile LAS unsigned*)(F.lds + MISC_OFF) + 16 + 2 * (i); ms_[0] = (unsigned)t_; ms_[1] = (unsigned)(t_ >> 32); } } while (0)
#else
#define STAMP(i) do {} while (0)
#endif
struct Frame {
    LAS unsigned char* lds; unsigned char* ldsg;
    int wave, vcu, G;
    float* out; unsigned char* ws;
};
template <int I> __device__ __forceinline__ const float* inptr() {
    const float* p = nullptr;
#if defined(__HIP_DEVICE_COMPILE__)
    const void* ka = (const void*)__builtin_amdgcn_kernarg_segment_ptr();
    asm volatile("s_load_dwordx2 %0, %1, %2\n\ts_waitcnt lgkmcnt(0)" : "=s"(p) : "s"(ka), "i"(I * 8) : "memory");
#endif
    return p;
}
#define INP(i) inptr<i>()

__device__ const double INVREV[32] = {0.15915494309189535, 0.11934937021124886, 0.089499401608891013, 0.067115083005227255, 0.050329212104487035, 0.037741584717419771, 0.028302195830623399, 0.02122365276477766,
    0.015915494309189534, 0.011934937021124886, 0.0089499401608891024, 0.0067115083005227253, 0.0050329212104487037, 0.0037741584717419772, 0.0028302195830623399, 0.0021223652764777662,
    0.0015915494309189536, 0.0011934937021124885, 0.00089499401608891024, 0.0006711508300522726, 0.00050329212104487033, 0.00037741584717419774, 0.00028302195830623395, 0.00021223652764777661,
    0.00015915494309189535, 0.00011934937021124886, 8.9499401608891018e-05, 6.7115083005227254e-05, 5.0329212104487035e-05, 3.7741584717419777e-05, 2.8302195830623396e-05, 2.1223652764777659e-05};
__device__ __forceinline__ int win_rowmap(int n) {
    if (n < 1024) { const int region = n >> 9, r = n & 511, tile = r >> 8, w = r & 255, blk = w >> 6, d = w & 63, bj = d >> 5, dlo = d & 31; return region * 512 + tile * 256 + bj * 128 + blk * 32 + dlo; }
    if (n < 1536) return n;
    const int cc = n - 1536, isg = cc >> 9, ch = cc & 511, j = ch >> 7, c2 = ch & 127; return 1536 + j * 256 + isg * 128 + c2;
}
template <bool MAP>
__device__ __forceinline__ void p0_transpose_item(const float* W, int K, int N, bf16* WT, const float* gk, LAS float* scr, int item, int lane) {
    const int nblk = N / 32, kb = item / nblk, nb = item % nblk, k0 = 64 * kb, n0 = 32 * nb;
#pragma unroll 8
    for (int i = 0; i < 32; ++i) { const int kk = 2 * i + (lane >> 5); float v = W[(size_t)(k0 + kk) * N + n0 + (lane & 31)]; if (gk) v *= gk[k0 + kk]; scr[kk * 33 + (lane & 31)] = v; }
    LDS_WAIT(); asm volatile("" ::: "memory");
    const int c = lane & 7; const int r0 = MAP ? win_rowmap(n0) : n0;
#pragma unroll
    for (int j = 0; j < 4; ++j) { const int n = (lane >> 3) + 8 * j; const LAS float* s = scr + (8 * c) * 33 + n;
        v4u o; o.x = pk2(s[0 * 33], s[1 * 33]); o.y = pk2(s[2 * 33], s[3 * 33]); o.z = pk2(s[4 * 33], s[5 * 33]); o.w = pk2(s[6 * 33], s[7 * 33]);
        *(GAS v4u*)(WT + (size_t)(r0 + n) * K + k0 + 8 * c) = o; }
    LDS_WAIT(); asm volatile("" ::: "memory");
}
__device__ __forceinline__ void cvt_stream(const float* src, bf16* dst, size_t n8, int gw, int NGW, int lane) {
    for (size_t c = (size_t)gw * 64 + lane; c < n8; c += (size_t)NGW * 64) { const f32x4 a = *(const GAS f32x4*)(src + c * 8), b = *(const GAS f32x4*)(src + c * 8 + 4); *(GAS v4u*)(dst + c * 8) = pk8(a, b); }
}
__device__ __forceinline__ void p0_prologue(Frame& F) {
    const int lane = lane_id();
    LAS float* scr = (LAS float*)(F.lds + F.wave * 16384);
    const int gw = F.vcu * NWAVES + F.wave, NGW = F.G * NWAVES;
    bf16* WIN = (bf16*)(F.ws + WS_WIN); bf16* WOUT = (bf16*)(F.ws + WS_WOUT); bf16* WQ = (bf16*)(F.ws + WS_WQ); bf16* WGATE = (bf16*)(F.ws + WS_WGATE); bf16* WPROJ = (bf16*)(F.ws + WS_WPROJ);
    constexpr int I_IN = (DM / 64) * (IN_COLS / 32), I_OUT = (DM / 64) * (DM / 32), I_Q = (DM / 64) * (QCOLS / 32), I_G = I_OUT, I_P = (PLE_DIM / 64) * (DM / 32);
    constexpr int NITEMS = I_IN + I_OUT + I_Q + I_G + I_P;
    for (int it = gw; it < NITEMS; it += NGW) {
        int r = it;
        if (r < I_IN) { p0_transpose_item<true>(INP(3), DM, IN_COLS, WIN, nullptr, scr, r, lane); continue; } r -= I_IN;
        if (r < I_OUT) { p0_transpose_item<false>(INP(13), DM, DM, WOUT, nullptr, scr, r, lane); continue; } r -= I_OUT;
        if (r < I_Q) { p0_transpose_item<false>(INP(15), DM, QCOLS, WQ, INP(14), scr, r, lane); continue; } r -= I_Q;
        if (r < I_G) { p0_transpose_item<false>(INP(20), DM, DM, WGATE, INP(19), scr, r, lane); continue; } r -= I_G;
        p0_transpose_item<false>(INP(21), PLE_DIM, DM, WPROJ, nullptr, scr, r, lane);
    }
    cvt_stream(INP(16), (bf16*)(F.ws + WS_KEYS), (size_t)2 * 128 * 128 / 8, gw, NGW, lane);
    { const float* ut = INP(17); const float* vt = INP(18); float* SU = (float*)(F.ws + WS_SU); float* SV = (float*)(F.ws + WS_SV);
      for (int r = gw; r < 2 * NEXP; r += NGW) { const bool isv = r >= NEXP; const int e = isv ? r - NEXP : r; const float* src = (isv ? vt : ut) + (size_t)e * DM + 16 * lane;
          f32x4 v[4]; float amax = 0.f;
#pragma unroll
          for (int i = 0; i < 4; ++i) { v[i] = *(const GAS f32x4*)(src + 4 * i); amax = fmaxf(amax, fmaxf(fmaxf(__builtin_fabsf(v[i][0]), __builtin_fabsf(v[i][1])), fmaxf(__builtin_fabsf(v[i][2]), __builtin_fabsf(v[i][3])))); }
#pragma unroll
          for (int o = 1; o < 64; o <<= 1) amax = fmaxf(amax, __shfl_xor(amax, o));
          const float inv = 127.f / fmaxf(amax, 1e-30f); const int off = 0; v4u w;
#pragma unroll
          for (int i = 0; i < 4; ++i) { const int a = (int)__builtin_rintf(v[i][0] * inv) + off, b = (int)__builtin_rintf(v[i][1] * inv) + off, c = (int)__builtin_rintf(v[i][2] * inv) + off, d = (int)__builtin_rintf(v[i][3] * inv) + off;
              w[i] = (unsigned)(a & 0xff) | ((unsigned)(b & 0xff) << 8) | ((unsigned)(c & 0xff) << 16) | ((unsigned)d << 24); }
          *(GAS v4u*)(F.ws + (isv ? WS_VT : WS_UT) + ((size_t)(lane >> 3) * NEXP + e) * 128 + 16 * (lane & 7)) = w;
          if (lane == 0) (isv ? SV : SU)[e] = amax * (1.f / 127.f); } }
    cvt_stream(INP(1), (bf16*)(F.ws + WS_PB), (size_t)M * PLE_DIM / 8, gw, NGW, lane);
    { float* rc = (float*)(F.ws + WS_ROPEC); float* rs = (float*)(F.ws + WS_ROPES);
      for (int idx = gw * 64 + lane; idx < SEQ * 32; idx += NGW * 64) { const int pos = idx >> 5, i = idx & 31; const double rev = (double)pos * INVREV[i]; const float fr = (float)(rev - __builtin_floor(rev));
          rc[idx] = __builtin_amdgcn_cosf(fr); rs[idx] = __builtin_amdgcn_sinf(fr); } }
    { const float* x = INP(0); const float* g = INP(2); bf16* XN = (bf16*)(F.ws + WS_XN);
      f32x4 gv[4];
#pragma unroll
      for (int j = 0; j < 4; ++j) gv[j] = ((const GAS f32x4*)g)[64 * j + lane];
      for (int m = gw; m < M; m += NGW) { const GAS f32x4* xr = (const GAS f32x4*)(x + (size_t)m * DM) + lane; f32x4 v[4]; float s2 = 0.f;
#pragma unroll
          for (int j = 0; j < 4; ++j) { v[j] = xr[64 * j]; s2 += (v[j].x * v[j].x + v[j].y * v[j].y) + (v[j].z * v[j].z + v[j].w * v[j].w); }
          const float rstd = rsqrtf(wave_sum(s2) * (1.f / DM) + EPS);
          GAS unsigned long long* o8 = (GAS unsigned long long*)(XN + (size_t)m * DM) + lane;
#pragma unroll
          for (int j = 0; j < 4; ++j) { const f32x4 w = v[j] * rstd * gv[j]; o8[64 * j] = (unsigned long long)pk2(w.x, w.y) | ((unsigned long long)pk2(w.z, w.w) << 32); } } }
}

struct AttnOrder {
    int vcu;
    __device__ __forceinline__ bool next(int i, attn_body::AttnUnit& u) const { if (i >= 8) return false; const int s = vcu & 7; u.bh = (vcu >> 5) * 16 + ((vcu >> 3) & 3) * 4 + (i & 3); u.qb = (i < 4) ? 15 - s : s; return true; }
    __device__ __forceinline__ void a_ready(const attn_body::AttnUnit&) const {}
    __device__ __forceinline__ void done(const attn_body::AttnUnit&) const {}
};
__device__ __forceinline__ void p2_attention(Frame& F) {
    { const attn_body::AttnTensors AT{(const attn_body::bf16*)(F.ws + WS_QO), (const attn_body::bf16*)(F.ws + WS_K), (const attn_body::bf16*)(F.ws + WS_V), (attn_body::bf16*)(F.ws + WS_QO)};
      const AttnOrder S{F.vcu};
      attn_body::attn_phase<AttnOrder>((char*)F.ldsg, AT, S, F.wave * 64 + lane_id()); }
    VM_WAIT(); __syncthreads(); STAMP(12);
    const int lane = lane_id();
    const float s1 = wave_sum(INP(4)[lane] * INP(5)[lane]), s2 = wave_sum(INP(6)[lane] * INP(7)[lane]);
    const float lam = __expf(s1) - __expf(s2) + 0.2f;
    const float* sg = INP(8); const float g0 = sg[2 * lane] * 0.8f, g1 = sg[2 * lane + 1] * 0.8f;
    const unsigned* O32 = (const unsigned*)(F.ws + WS_QO); unsigned* A2 = (unsigned*)(F.ws + WS_XN);
    const int b = F.vcu >> 5, h = (F.vcu >> 3) & 3, s = F.vcu & 7;
    for (int i = 0; i < 2; ++i) { const int qb = (i == 0) ? 15 - s : s;
        const size_t rbase = (size_t)b * SEQ + (size_t)qb * 256 + F.wave * 32;
        for (int r = 0; r < 32; ++r) { const size_t row = rbase + r;
            const unsigned w0 = __builtin_nontemporal_load(O32 + row * 512 + (h * 4 + 0 + (lane >> 5)) * 32 + (lane & 31)), w1 = __builtin_nontemporal_load(O32 + row * 512 + (h * 4 + 2 + (lane >> 5)) * 32 + (lane & 31));
            const float d0 = bflo(w0) - lam * bflo(w1), d1 = bfhi(w0) - lam * bfhi(w1);
            const float rstd = rsqrtf(wave_sum(d0 * d0 + d1 * d1) * (1.f / 128.f) + EPS);
            A2[row * 512 + h * 64 + lane] = pk2(d0 * rstd * g0, d1 * rstd * g1); } }
}
__device__ __forceinline__ void p2_conv(Frame& F) {
    const bf16* Ub = (const bf16*)(F.ws + WS_U); bf16* A2 = (bf16*)(F.ws + WS_XN);
    LAS float* yl = (LAS float*)F.lds;
    const int lane = lane_id(); const int c = F.wave * 64 + lane;
    float w[31];
    { const float* cw = INP(9);
#pragma unroll
      for (int j = 0; j < 31; ++j) w[j] = cw[j * 512 + c]; }
    const float bias = INP(10)[c];
    const float* lng = INP(11); const float* lnb = INP(12);
    const f32x4 lg0 = *(const f32x4*)(lng + 8 * lane), lg1 = *(const f32x4*)(lng + 8 * lane + 4), lb0 = *(const f32x4*)(lnb + 8 * lane), lb1 = *(const f32x4*)(lnb + 8 * lane + 4);
    for (int tile = F.vcu; tile < M / 32; tile += F.G) {
        const int t0 = tile * 32, pos0 = t0 & (SEQ - 1);
        float xin[62];
#pragma unroll
        for (int r = 0; r < 62; ++r) { const int p = pos0 - 30 + r; xin[r] = (p >= 0) ? __uint_as_float((unsigned)Ub[(size_t)(t0 - 30 + r) * 512 + c] << 16) : 0.f; }
#pragma unroll
        for (int t = 0; t < 32; ++t) { float y = bias;
#pragma unroll
            for (int j = 0; j < 31; ++j) y += w[j] * xin[t + j];
            yl[t * 512 + c] = y; }
        __syncthreads();
#pragma unroll
        for (int q = 0; q < 4; ++q) { const int t = F.wave * 4 + q;
            const f32x4 a = *(const LAS f32x4*)(yl + t * 512 + 8 * lane), b2 = *(const LAS f32x4*)(yl + t * 512 + 8 * lane + 4);
            const float mean = wave_sum((a[0] + a[1]) + (a[2] + a[3]) + (b2[0] + b2[1]) + (b2[2] + b2[3])) * (1.f / 512.f);
            const f32x4 da = a - mean, db = b2 - mean;
            const float var = wave_sum((da[0] * da[0] + da[1] * da[1]) + (da[2] * da[2] + da[3] * da[3]) + (db[0] * db[0] + db[1] * db[1]) + (db[2] * db[2] + db[3] * db[3])) * (1.f / 512.f);
            const float rstd = rsqrtf(var + EPS);
            f32x4 oa = da * rstd * lg0 + lb0, ob = db * rstd * lg1 + lb1;
#pragma unroll
            for (int e = 0; e < 4; ++e) { oa[e] = oa[e] * __builtin_amdgcn_rcpf(1.0f + __expf(-oa[e])); ob[e] = ob[e] * __builtin_amdgcn_rcpf(1.0f + __expf(-ob[e])); }
            *(GAS v4u*)(A2 + (size_t)(t0 + t) * 1024 + 512 + 8 * lane) = pk8(oa, ob); }
        __syncthreads();
    }
}
__device__ __forceinline__ int crow16(int r, int hi) { return (r & 3) + 8 * (r >> 2) + 4 * hi; }
__device__ __forceinline__ unsigned enc_key(float f, unsigned tag, unsigned mask) { unsigned u = __float_as_uint(f); u = (u & 0x80000000u) ? ~u : (u | 0x80000000u); return (u & ~mask) | tag; }
__device__ __forceinline__ float dec_key(unsigned k, unsigned mask) { unsigned u = k & ~mask; u = (u & 0x80000000u) ? (u & 0x7fffffffu) : ~u; return __uint_as_float(u); }
__device__ __forceinline__ void ce_desc(unsigned& a, unsigned& b) { const unsigned mx = a > b ? a : b, mn = a > b ? b : a; a = mx; b = mn; }
template <int K, int J> __device__ __forceinline__ void bitonic_stage16(unsigned (&a)[16]) {
#pragma unroll
    for (int i = 0; i < 16; ++i) { const int l = i ^ J; if (l > i) { if ((i & K) == 0) ce_desc(a[i], a[l]); else ce_desc(a[l], a[i]); } }
}
__device__ __forceinline__ void sort16_desc(unsigned (&a)[16]) {
    bitonic_stage16<2, 1>(a); bitonic_stage16<4, 2>(a); bitonic_stage16<4, 1>(a); bitonic_stage16<8, 4>(a); bitonic_stage16<8, 2>(a); bitonic_stage16<8, 1>(a);
    bitonic_stage16<16, 8>(a); bitonic_stage16<16, 4>(a); bitonic_stage16<16, 2>(a); bitonic_stage16<16, 1>(a);
}
__device__ __forceinline__ void merge16_desc(unsigned (&a)[16], const unsigned (&b)[16]) {
#pragma unroll
    for (int i = 0; i < 16; ++i) a[i] = a[i] > b[15 - i] ? a[i] : b[15 - i];
    bitonic_stage16<16, 8>(a); bitonic_stage16<16, 4>(a); bitonic_stage16<16, 2>(a); bitonic_stage16<16, 1>(a);
}
__device__ __forceinline__ void top16_of_64(unsigned (&k)[4][16]) {
    sort16_desc(k[0]); sort16_desc(k[1]); sort16_desc(k[2]); sort16_desc(k[3]);
    merge16_desc(k[0], k[1]); merge16_desc(k[2], k[3]); merge16_desc(k[0], k[2]);
}
__host__ __device__ constexpr int cand_i(int s) { int c = 0; for (int i = 0; i < 16; ++i) { const int nj = 16 / (i + 1); if (s < c + nj) return i; c += nj; } return -1; }
__host__ __device__ constexpr int cand_j(int s) { int c = 0; for (int i = 0; i < 16; ++i) { const int nj = 16 / (i + 1); if (s < c + nj) return s - c; c += nj; } return -1; }
template <int S> __device__ __forceinline__ void cand_fill(unsigned (&c)[4][16], const float (&v0)[16], const float (&v1)[16]) {
    if constexpr (S < 64) { constexpr int i = cand_i(S), j = cand_j(S);
        if constexpr (i >= 0) c[S >> 4][S & 15] = enc_key(v0[i] + v1[j], 255u - (unsigned)(i * 16 + j), 255u); else c[S >> 4][S & 15] = 0u;
        cand_fill<S + 1>(c, v0, v1); }
}
__device__ __forceinline__ float gelu_exact(float v) {
    const float av = __builtin_fabsf(v), d = av * 0.2316418882f + 1.0f, t = __builtin_amdgcn_rcpf(d);
    float q = t * 0.5307027145f + (-0.7265760135f); q = q * t + 0.7107068705f; q = q * t + (-0.142248368f); q = q * t + 0.127414796f; q = q * t;
    const float e = __builtin_amdgcn_exp2f((v * v) * (-0.72134752044f)); const float m = v * (q * e); return v < 0.f ? m : v - m;
}
typedef float f32x2 __attribute__((ext_vector_type(2)));
__device__ __forceinline__ float ub0(unsigned w) { return (float)(w & 0xffu); }
__device__ __forceinline__ float ub1(unsigned w) { return (float)((w >> 8) & 0xffu); }
__device__ __forceinline__ float ub2(unsigned w) { return (float)((w >> 16) & 0xffu); }
__device__ __forceinline__ float ub3(unsigned w) { return (float)(w >> 24); }
__device__ __forceinline__ float wave_max(float v) {
#pragma unroll
    for (int o = 1; o < 64; o <<= 1) v = fmaxf(v, __shfl_xor(v, o));
    return v;
}
__device__ __forceinline__ int reduce8(const int (&p)[8], int lane) {
    const bool b0 = lane & 1, b1 = lane & 2, b2 = lane & 4;
    int q[4], r[2];
#pragma unroll
    for (int i = 0; i < 4; ++i) { const int keep = b0 ? p[2 * i + 1] : p[2 * i], send = b0 ? p[2 * i] : p[2 * i + 1]; q[i] = keep + __builtin_amdgcn_update_dpp(0, send, 0xB1, 0xF, 0xF, true); }
#pragma unroll
    for (int i = 0; i < 2; ++i) { const int keep = b1 ? q[2 * i + 1] : q[2 * i], send = b1 ? q[2 * i] : q[2 * i + 1]; r[i] = keep + __builtin_amdgcn_update_dpp(0, send, 0x4E, 0xF, 0xF, true); }
    int s; { const int keep = b2 ? r[1] : r[0], send = b2 ? r[0] : r[1]; s = keep + __builtin_amdgcn_ds_swizzle(send, 0x101F); }
    s += __builtin_amdgcn_ds_swizzle(s, 0x201F); s += __builtin_amdgcn_ds_swizzle(s, 0x401F);
    { const auto rr = __builtin_amdgcn_permlane32_swap((unsigned)s, (unsigned)s, false, false); s = (int)rr[0] + (int)rr[1]; }
    return s;
}
constexpr int P5_TOK = 32;
constexpr int P5_KEYS = 0, P5_LS = 65536, P5_EID = 65536 + 33792, P5_GATE = 65536 + 33792 + 16384;
__device__ __forceinline__ void p5a_topk(Frame& F) {
    const bf16* QP = (const bf16*)(F.ws + WS_QP); const bf16* KEYS = (const bf16*)(F.ws + WS_KEYS);
    LAS unsigned* lsc = (LAS unsigned*)(F.lds + P5_LS) + (F.wave * 32 + (lane_id() & 31)) * 33; LAS unsigned* eidL = (LAS unsigned*)(F.lds + P5_EID); LAS float* gateL = (LAS float*)(F.lds + P5_GATE);
    const int lane = lane_id(), tid = F.wave * 64 + lane, r32 = lane & 31, hi = lane >> 5, h = F.wave;
    const float* gffn = INP(14);
#pragma unroll
    for (int i = 0; i < 8; ++i) { const int q = tid + 512 * i, row = q >> 4, ch = q & 15; *(LAS v4u*)(F.lds + P5_KEYS + row * 256 + ((ch ^ (row & 15)) << 4)) = *(const GAS v4u*)(KEYS + row * 128 + ch * 8); }
    __syncthreads();
    const LAS unsigned char* kl = F.lds + P5_KEYS + r32 * 256;
    for (int tile = F.vcu; tile < M / P5_TOK; tile += F.G) {
        const size_t t0 = (size_t)tile * P5_TOK;
        float sv[2][16];
#pragma unroll
        for (int c = 0; c < 2; ++c) {
            bf16x8 qf[8];
#pragma unroll
            for (int ks = 0; ks < 8; ++ks) qf[ks] = *(const bf16x8*)(QP + (t0 + r32) * QCOLS + h * 256 + c * 128 + ks * 16 + hi * 8);
            unsigned key[4][16];
#pragma unroll
            for (int nb = 0; nb < 4; ++nb) { f32x16 acc = {}; asm volatile("" ::: "memory");
#pragma unroll
                for (int ks = 0; ks < 8; ++ks) { const bf16x8 kf = *(const LAS bf16x8*)(kl + (c * 128 + nb * 32) * 256 + (((ks * 2 + hi) ^ (r32 & 15)) << 4)); acc = __builtin_amdgcn_mfma_f32_32x32x16_bf16(kf, qf[ks], acc, 0, 0, 0); }
#pragma unroll
                for (int r = 0; r < 16; ++r) key[nb][r] = enc_key(acc[r], 127u - (unsigned)(nb * 32 + crow16(r, hi)), 127u); }
            top16_of_64(key);
            unsigned other[16];
#pragma unroll
            for (int i = 0; i < 16; ++i) other[i] = __shfl_xor(key[0][i], 32);
            merge16_desc(key[0], other);
#pragma unroll
            for (int i = 0; i < 16; ++i) { sv[c][i] = dec_key(key[0][i], 127u); if (hi == 0) lsc[c * 16 + i] = key[0][i]; }
        }
        asm volatile("" ::: "memory");
        unsigned cand[4][16];
        cand_fill<0>(cand, sv[0], sv[1]);
        top16_of_64(cand);
        LDS_WAIT();
        { float wv[16]; float wsum = 0.f; const float mx = dec_key(cand[0][0], 255u);
#pragma unroll
          for (int k = 0; k < 16; ++k) { wv[k] = __expf(dec_key(cand[0][k], 255u) - mx); wsum += wv[k]; }
          const float rs = 1.0f / wsum;
#pragma unroll
          for (int k = 0; k < 16; ++k) { const unsigned id = 255u - (cand[0][k] & 255u); const unsigned k0 = lsc[id >> 4], k1 = lsc[16 + (id & 15u)];
              const unsigned e = (127u - (k0 & 127u)) * 128u + (127u - (k1 & 127u));
              if (hi == 0) { eidL[r32 * 128 + h * 16 + k] = e; gateL[r32 * 128 + h * 16 + k] = wv[k] * rs; } } }
        __syncthreads();
        { const int token = tid >> 4, seg = tid & 15; const LAS unsigned* es = eidL + token * 128 + seg * 8; const LAS float* gs = gateL + token * 128 + seg * 8;
          v4u w; w.x = es[0] | (es[1] << 16); w.y = es[2] | (es[3] << 16); w.z = es[4] | (es[5] << 16); w.w = es[6] | (es[7] << 16);
          *(GAS v4u*)(F.ws + WS_EID + (t0 + token) * 256 + seg * 16) = w;
          *(GAS f32x4*)(F.ws + WS_GATE + (t0 + token) * 512 + seg * 32) = *(const LAS f32x4*)gs; *(GAS f32x4*)(F.ws + WS_GATE + (t0 + token) * 512 + seg * 32 + 16) = *(const LAS f32x4*)(gs + 4); }
#pragma unroll 1
        for (int j = 0; j < 4; ++j) {
            const size_t tok = t0 + F.wave * 4 + j; const float* hrow = F.out + tok * DM;
            f32x4 hv[4];
#pragma unroll
            for (int i = 0; i < 4; ++i) hv[i] = *(const f32x4*)(hrow + 16 * lane + 4 * i);
            const float rstd1 = rsqrtf(wave_sum(dot4s_(hv[0]) + dot4s_(hv[1]) + dot4s_(hv[2]) + dot4s_(hv[3])) * (1.f / DM) + EPS);
            f32x4 mv[4]; float amax = 0.f;
#pragma unroll
            for (int i = 0; i < 4; ++i) { mv[i] = hv[i] * rstd1 * *(const f32x4*)(gffn + 16 * lane + 4 * i);
                amax = fmaxf(amax, fmaxf(fmaxf(__builtin_fabsf(mv[i][0]), __builtin_fabsf(mv[i][1])), fmaxf(__builtin_fabsf(mv[i][2]), __builtin_fabsf(mv[i][3])))); }
            amax = wave_max(amax); const float inv = 127.f / fmaxf(amax, 1e-30f); v4u qm;
#pragma unroll
            for (int i = 0; i < 4; ++i) { const int a = (int)__builtin_rintf(mv[i][0] * inv), b = (int)__builtin_rintf(mv[i][1] * inv), c = (int)__builtin_rintf(mv[i][2] * inv), d = (int)__builtin_rintf(mv[i][3] * inv);
                qm[i] = (unsigned)(a & 0xff) | ((unsigned)(b & 0xff) << 8) | ((unsigned)(c & 0xff) << 16) | ((unsigned)d << 24); }
            *(GAS v4u*)(F.ws + WS_QM + ((size_t)(lane >> 3) * M + tok) * 128 + 16 * (lane & 7)) = qm;
            if (lane == 0) ((float*)(F.ws + WS_SM))[tok] = amax * (1.f / 127.f);
        }
        __syncthreads();
    }
}
__device__ __forceinline__ int xl1(int v) { return __builtin_amdgcn_update_dpp(0, v, 0xB1, 0xF, 0xF, true); }
__device__ __forceinline__ int xl2(int v) { return __builtin_amdgcn_update_dpp(0, v, 0x4E, 0xF, 0xF, true); }
__device__ __forceinline__ int xl4(int v) { return __builtin_amdgcn_ds_swizzle(v, 0x101F); }
__device__ __forceinline__ int xl8(int v) { return __builtin_amdgcn_ds_swizzle(v, 0x201F); }
__device__ __forceinline__ int xl16(int v) { return __builtin_amdgcn_ds_swizzle(v, 0x401F); }
__device__ __forceinline__ int xl32(int v, bool hi) { const auto rr = __builtin_amdgcn_permlane32_swap((unsigned)v, (unsigned)v, false, false); return (int)(hi ? rr[0] : rr[1]); }
__device__ __forceinline__ float fxl8(float v) { return __int_as_float(xl8(__float_as_int(v))); }
__device__ __forceinline__ float fxl16(float v) { return __int_as_float(xl16(__float_as_int(v))); }
__device__ __forceinline__ float fxl32(float v, bool hi) { return __int_as_float(xl32(__float_as_int(v), hi)); }
#define TSTEP(dst, src, n, c, XF) _Pragma("unroll") for (int ni_ = 0; ni_ < (n) / 2; ++ni_) { const int i_ = (ni_ & 1) | ((ni_ >> 1) << 2); const auto lo_ = src[i_], hi_ = src[i_ + 2]; dst[ni_] = ((c) ? hi_ : lo_) + XF((c) ? lo_ : hi_); }

#define ASM_LD16(dst, ptr) asm volatile("global_load_dwordx4 %0, %1, off" : "+v"(dst) : "v"(ptr) : "memory")
#define ASM_LD8(dst, ptr) asm volatile("global_load_dwordx2 %0, %1, off" : "+v"(dst) : "v"(ptr) : "memory")
#define ASM_LD4(dst, ptr) asm volatile("global_load_dword %0, %1, off" : "+v"(dst) : "v"(ptr) : "memory")
#define ASM_WAIT4(N, a, b, c, d) asm volatile("s_waitcnt vmcnt(" #N ")" : "+v"(a), "+v"(b), "+v"(c), "+v"(d) :: "memory")
#define ASM_WAIT5(N, a, b, c, d, e) asm volatile("s_waitcnt vmcnt(" #N ")" : "+v"(a), "+v"(b), "+v"(c), "+v"(d), "+v"(e) :: "memory")
__device__ __forceinline__ void p5b_udot(Frame& F) {
    const int lane = lane_id(), g = lane >> 3, s = lane & 7; const int x = blockIdx.x & 7, rk = blockIdx.x >> 3, nrk = F.G >> 3;
    const unsigned char* UTs = F.ws + WS_UT + (size_t)x * NEXP * 128 + 16 * s; const unsigned char* QMs = F.ws + WS_QM + (size_t)x * M * 128 + 16 * s; const unsigned char* EIDs = F.ws + WS_EID + 32 * g;
    int* AP = (int*)(F.ws + WS_APART) + (size_t)x * M * 128 + 2 * lane;
    const bool c0 = s & 1, c1 = s & 2, c2 = s & 4;
    const int tstep = nrk * NWAVES, t0 = rk * NWAVES + F.wave, n = (M - t0 + tstep - 1) / tstep;
#define P5B_E(i, E0, E1) ((((i) & 1) ? (((i) < 8 ? E0[(i) >> 1] : E1[((i) - 8) >> 1]) >> 16) : (((i) < 8 ? E0[(i) >> 1] : E1[((i) - 8) >> 1]) & 0xffffu)))
#define P5B_TOK(i) (t0 + ((i) < n ? (i) : n - 1) * tstep)
#define P5B_LDMETA(E0, E1, Q, i) do { const int tq_ = P5B_TOK(i), te_ = P5B_TOK((i) + 2); ASM_LD16(E0, EIDs + (size_t)te_ * 256); ASM_LD16(E1, EIDs + (size_t)te_ * 256 + 16); ASM_LD16(Q, QMs + (size_t)tq_ * 128); } while (0)
#define P5B_ITER(RR, E0, E1, Q, itx) do { const int t_ = P5B_TOK(itx); int p_[16]; \
        asm volatile("s_waitcnt vmcnt(19)" : "+v"(E0), "+v"(E1), "+v"(Q) :: "memory"); \
        _Pragma("unroll") for (int b = 0; b < 4; ++b) { \
            ASM_WAIT4(34, RR[4 * b], RR[4 * b + 1], RR[4 * b + 2], RR[4 * b + 3]); __builtin_amdgcn_sched_barrier(0); \
            _Pragma("unroll") for (int j = 0; j < 4; ++j) { const int i = 4 * b + j; p_[i] = __builtin_amdgcn_sdot4((int)RR[i].x, (int)Q.x, __builtin_amdgcn_sdot4((int)RR[i].y, (int)Q.y, __builtin_amdgcn_sdot4((int)RR[i].z, (int)Q.z, __builtin_amdgcn_sdot4((int)RR[i].w, (int)Q.w, 0, false), false), false), false); } \
            __builtin_amdgcn_sched_barrier(0); \
            _Pragma("unroll") for (int j = 0; j < 4; ++j) { const int i = 4 * b + j; ASM_LD16(RR[i], UTs + (size_t)P5B_E(i, E0, E1) * 128); } \
            __builtin_amdgcn_sched_barrier(0); } \
        int a8_[8], a4_[4], a2_[2]; TSTEP(a8_, p_, 16, c0, xl1) TSTEP(a4_, a8_, 8, c1, xl2) TSTEP(a2_, a4_, 4, c2, xl4) \
        *(GAS unsigned long long*)(AP + (size_t)t_ * 128) = (unsigned long long)(unsigned)a2_[0] | ((unsigned long long)(unsigned)a2_[1] << 32); \
        __builtin_amdgcn_sched_barrier(0); P5B_LDMETA(E0, E1, Q, (itx) + 2); __builtin_amdgcn_sched_barrier(0); } while (0)
    v4u RA[16], RB[16], eA0, eA1, qA, eB0, eB1, qB;
    { const int t1 = P5B_TOK(1);
      const v4u e0 = *(const GAS v4u*)(EIDs + (size_t)t0 * 256), e1 = *(const GAS v4u*)(EIDs + (size_t)t0 * 256 + 16), f0 = *(const GAS v4u*)(EIDs + (size_t)t1 * 256), f1 = *(const GAS v4u*)(EIDs + (size_t)t1 * 256 + 16);
      eA0 = e0; eA1 = e1; qA = e0; eB0 = e0; eB1 = e1; qB = e0;
#pragma unroll
      for (int i = 0; i < 16; ++i) { RA[i] = e0; RB[i] = e0; }
      asm volatile("s_waitcnt vmcnt(0)" ::: "memory");
#pragma unroll
      for (int i = 0; i < 16; ++i) ASM_LD16(RA[i], UTs + (size_t)P5B_E(i, e0, e1) * 128);
#pragma unroll
      for (int i = 0; i < 16; ++i) ASM_LD16(RB[i], UTs + (size_t)P5B_E(i, f0, f1) * 128); }
    P5B_LDMETA(eA0, eA1, qA, 0); P5B_LDMETA(eB0, eB1, qB, 1);
    asm volatile("s_waitcnt vmcnt(0)" ::: "memory");
#pragma unroll 1
    for (int it = 0; it < n; it += 2) { P5B_ITER(RA, eA0, eA1, qA, it); P5B_ITER(RB, eB0, eB1, qB, it + 1); }
    asm volatile("s_waitcnt vmcnt(0)" ::: "memory");
#undef P5B_E
#undef P5B_TOK
#undef P5B_LDMETA
#undef P5B_ITER
}
__device__ __forceinline__ void p5b2_gelu(Frame& F) {
    const int lane = lane_id(); const int gw = F.vcu * NWAVES + F.wave, NGW = F.G * NWAVES;
    const float* SU = (const float*)(F.ws + WS_SU); const float* SV = (const float*)(F.ws + WS_SV); const float* SM = (const float*)(F.ws + WS_SM);
    for (int t = gw; t < M; t += NGW) {
        int a0 = 0, a1 = 0;
#pragma unroll
        for (int xx = 0; xx < 8; ++xx) { const unsigned long long w = *(const GAS unsigned long long*)((const int*)(F.ws + WS_APART) + (size_t)xx * M * 128 + (size_t)t * 128 + 2 * lane); a0 += (int)(unsigned)w; a1 += (int)(unsigned)(w >> 32); }
        const unsigned ew = *(const GAS unsigned*)(F.ws + WS_EID + (size_t)t * 256 + 4 * lane); const unsigned e0 = ew & 0xffffu, e1 = ew >> 16;
        const f32x2 gt = *(const GAS f32x2*)(F.ws + WS_GATE + (size_t)t * 512 + 8 * lane); const float sm = SM[t];
        const float h0 = gelu_exact((float)a0 * sm * SU[e0]) * gt[0] * SV[e0], h1 = gelu_exact((float)a1 * sm * SU[e1]) * gt[1] * SV[e1];
        const float hmax = wave_max(fmaxf(__builtin_fabsf(h0), __builtin_fabsf(h1))); const float inv = 127.f / fmaxf(hmax, 1e-30f);
        const int q0 = (int)__builtin_rintf(h0 * inv), q1 = (int)__builtin_rintf(h1 * inv);
        *(GAS unsigned short*)(F.ws + WS_HQ + (size_t)t * 128 + 2 * lane) = (unsigned short)((q0 & 0xff) | ((q1 & 0xff) << 8));
        if (lane == 0) ((float*)(F.ws + WS_HS))[t] = hmax * (1.f / 127.f);
    }
}
template <int VAR> __device__ __forceinline__ void p5c_vacc(Frame& F) {
    const int lane = lane_id(), g = lane >> 3, s = lane & 7; const int x = blockIdx.x & 7, rk = blockIdx.x >> 3, nrk = F.G >> 3;
    const unsigned char* VTs = F.ws + WS_VT + (size_t)x * NEXP * 128 + 16 * s; const unsigned char* EIDs = F.ws + WS_EID + 32 * g; const unsigned char* HQs = F.ws + WS_HQ + 16 * g;
    const float* SH = (const float*)(F.ws + WS_HS); float* ssq2 = (float*)(F.ws + (VAR ? WS_APART + 100 * MiB : WS_SSQ2)); unsigned* H2B = (unsigned*)(F.ws + (VAR ? WS_APART + 64 * MiB : WS_XN2)); float* outw = VAR ? (float*)(F.ws + WS_APART) : F.out;
    const int dcol = 128 * x + 16 * s + 2 * g;
    const bool c3 = g & 1, c4 = g & 2, c5 = g & 4; const bool hi32 = lane >= 32;
    const int tstep = nrk * NWAVES, t0 = rk * NWAVES + F.wave, n = (M - t0 + tstep - 1) / tstep;
#define P5C_E(i, E0, E1) ((((i) & 1) ? (((i) < 8 ? E0[(i) >> 1] : E1[((i) - 8) >> 1]) >> 16) : (((i) < 8 ? E0[(i) >> 1] : E1[((i) - 8) >> 1]) & 0xffffu)))
#define P5C_TOK(i) (t0 + ((i) < n ? (i) : n - 1) * tstep)
#define P5C_LDMETA(E0, E1, HB, H1, SHv, i) do { const int tq_ = P5C_TOK(i), te_ = P5C_TOK((i) + 2); ASM_LD16(E0, EIDs + (size_t)te_ * 256); ASM_LD16(E1, EIDs + (size_t)te_ * 256 + 16); \
        ASM_LD16(HB, HQs + (size_t)tq_ * 128); ASM_LD8(H1, F.out + (size_t)tq_ * DM + dcol); ASM_LD4(SHv, SH + tq_); } while (0)
#define IX32(v) xl32(v, hi32)
#define P5C_ITER(RR, E0, E1, HB, H1, SHv, itx) do { const int t_ = P5C_TOK(itx); int yi_[16]; _Pragma("unroll") for (int i = 0; i < 16; ++i) yi_[i] = 0; \
        asm volatile("s_waitcnt vmcnt(21)" : "+v"(E0), "+v"(E1), "+v"(HB), "+v"(H1), "+v"(SHv) :: "memory"); \
        _Pragma("unroll") for (int b = 0; b < 4; ++b) { const int hb_ = (int)HB[b]; \
            ASM_WAIT4(38, RR[4 * b], RR[4 * b + 1], RR[4 * b + 2], RR[4 * b + 3]); __builtin_amdgcn_sched_barrier(0); \
            if (VAR != 3) _Pragma("unroll") for (int c = 0; c < 4; ++c) { \
                const unsigned ra_ = RR[4 * b][c], rb_ = RR[4 * b + 1][c], rc_ = RR[4 * b + 2][c], rd_ = RR[4 * b + 3][c]; \
                const unsigned p_ = __builtin_amdgcn_perm(rb_, ra_, 0x05010400u), q_ = __builtin_amdgcn_perm(rb_, ra_, 0x07030602u), r_ = __builtin_amdgcn_perm(rd_, rc_, 0x05010400u), s_ = __builtin_amdgcn_perm(rd_, rc_, 0x07030602u); \
                yi_[4 * c + 0] = __builtin_amdgcn_sdot4((int)__builtin_amdgcn_perm(r_, p_, 0x05040100u), hb_, yi_[4 * c + 0], false); yi_[4 * c + 1] = __builtin_amdgcn_sdot4((int)__builtin_amdgcn_perm(r_, p_, 0x07060302u), hb_, yi_[4 * c + 1], false); \
                yi_[4 * c + 2] = __builtin_amdgcn_sdot4((int)__builtin_amdgcn_perm(s_, q_, 0x05040100u), hb_, yi_[4 * c + 2], false); yi_[4 * c + 3] = __builtin_amdgcn_sdot4((int)__builtin_amdgcn_perm(s_, q_, 0x07060302u), hb_, yi_[4 * c + 3], false); } \
            __builtin_amdgcn_sched_barrier(0); \
            _Pragma("unroll") for (int j = 0; j < 4; ++j) { const int i = 4 * b + j; ASM_LD16(RR[i], VTs + (size_t)(VAR == 4 ? 0u : P5C_E(i, E0, E1)) * 128); } \
            __builtin_amdgcn_sched_barrier(0); } \
        int y8_[8], y4_[4], y2_[2]; TSTEP(y8_, yi_, 16, c3, xl8) TSTEP(y4_, y8_, 8, c4, xl16) TSTEP(y2_, y4_, 4, c5, IX32) \
        const f32x2 n_ = {H1[0] + SHv * (float)y2_[0], H1[1] + SHv * (float)y2_[1]}; \
        if (VAR != 3) { *(GAS f32x2*)(outw + (size_t)t_ * DM + dcol) = n_; H2B[((size_t)t_ * DM + dcol) >> 1] = pk2(n_[0], n_[1]); \
        const float ss_ = wave_sum(n_[0] * n_[0] + n_[1] * n_[1]); if (lane == 0) ssq2[(size_t)t_ * 8 + x] = ss_; } \
        __builtin_amdgcn_sched_barrier(0); P5C_LDMETA(E0, E1, HB, H1, SHv, (itx) + 2); __builtin_amdgcn_sched_barrier(0); } while (0)
    v4u RA[16], RB[16], eA0, eA1, hbA, eB0, eB1, hbB; f32x2 h1A = {0.f, 0.f}, h1B = {0.f, 0.f}; float shA = 0.f, shB = 0.f;
    { const int t1 = P5C_TOK(1);
      const v4u e0 = *(const GAS v4u*)(EIDs + (size_t)t0 * 256), e1 = *(const GAS v4u*)(EIDs + (size_t)t0 * 256 + 16), f0 = *(const GAS v4u*)(EIDs + (size_t)t1 * 256), f1 = *(const GAS v4u*)(EIDs + (size_t)t1 * 256 + 16);
      eA0 = e0; eA1 = e1; hbA = e0; eB0 = e0; eB1 = e1; hbB = e0;
#pragma unroll
      for (int i = 0; i < 16; ++i) { RA[i] = e0; RB[i] = e0; }
      asm volatile("s_waitcnt vmcnt(0)" ::: "memory");
#pragma unroll
      for (int i = 0; i < 16; ++i) ASM_LD16(RA[i], VTs + (size_t)P5C_E(i, e0, e1) * 128);
#pragma unroll
      for (int i = 0; i < 16; ++i) ASM_LD16(RB[i], VTs + (size_t)P5C_E(i, f0, f1) * 128); }
    P5C_LDMETA(eA0, eA1, hbA, h1A, shA, 0); P5C_LDMETA(eB0, eB1, hbB, h1B, shB, 1);
    asm volatile("s_waitcnt vmcnt(0)" ::: "memory");
#pragma unroll 1
    for (int it = 0; it < n; it += 2) { P5C_ITER(RA, eA0, eA1, hbA, h1A, shA, it); P5C_ITER(RB, eB0, eB1, hbB, h1B, shB, it + 1); }
    asm volatile("s_waitcnt vmcnt(0)" ::: "memory");
#undef P5C_E
#undef P5C_TOK
#undef P5C_LDMETA
#undef P5C_ITER
#undef IX32
}
__device__ __forceinline__ void p7_final(Frame& F) {
    const int lane = lane_id(); const int gw = F.vcu * NWAVES + F.wave, NGW = F.G * NWAVES; const float* g = INP(22);
    f32x4 gv[4];
#pragma unroll
    for (int j = 0; j < 4; ++j) gv[j] = ((const GAS f32x4*)g)[64 * j + lane];
    for (int m = gw; m < M; m += NGW) { GAS f32x4* xr = (GAS f32x4*)(F.out + (size_t)m * DM) + lane; f32x4 v[4]; float s2 = 0.f;
#pragma unroll
        for (int j = 0; j < 4; ++j) { v[j] = xr[64 * j]; s2 += (v[j].x * v[j].x + v[j].y * v[j].y) + (v[j].z * v[j].z + v[j].w * v[j].w); }
        const float rstd = rsqrtf(wave_sum(s2) * (1.f / DM) + EPS);
#pragma unroll
        for (int j = 0; j < 4; ++j) xr[64 * j] = v[j] * rstd * gv[j]; }
}
struct Args { const float* in[23]; float* out; unsigned char* ws; int ph_lo, ph_hi; };
__global__ void __launch_bounds__(NWAVES * 64, 2) hymba_fwd(Args args) {
    extern __shared__ __attribute__((aligned(16))) unsigned char lds[];
    cg::grid_group grid = cg::this_grid();
    Frame F;
    F.lds = (LAS unsigned char*)lds; F.ldsg = lds;
    F.wave = __builtin_amdgcn_readfirstlane(threadIdx.x >> 6);
    F.G = gridDim.x; { const int bx = blockIdx.x; F.vcu = (F.G % 8 == 0) ? (bx % 8) * (F.G / 8) + bx / 8 : bx; }
    F.out = args.out; F.ws = args.ws;
    const int lo = args.ph_lo, hi = args.ph_hi;
#ifdef ONLY_PH
#define IN(k) ((k) == ONLY_PH)
#else
#define IN(k) (lo <= (k) && (k) < hi)
#endif
#define BOTH(k) (IN(k) && IN((k) + 1))
    { const int l0 = lane_id(); if (F.wave == 0) ((volatile LAS unsigned*)(F.lds + MISC_OFF))[l0] = 0u; }
    __syncthreads();
    const XcdBarrier bar = xcd_barrier_post((unsigned*)(F.ws + WS_CTL) + CW_BAR, (volatile LAS unsigned*)(F.lds + MISC_OFF) + 8, F.wave == 0 && lane_id() == 0);
#if defined(PROBE_BARSUM)
#define GRID_BAR(k) do { STAMP(20); if ((k) == 0) grid.sync(); else xcd_barrier(bar, F.wave == 0 && lane_id() == 0); STAMP((k) + 1); \
    if (F.wave == 0 && ((PROBE_BARSUM >> (k)) & 1)) { volatile LAS unsigned* ms_ = (volatile LAS unsigned*)(F.lds + MISC_OFF) + 16; ms_[2 * 21] += ms_[2 * ((k) + 1)] - ms_[2 * 20]; } } while (0)
#else
#define GRID_BAR(k) do { if ((k) == 0) grid.sync(); else xcd_barrier(bar, F.wave == 0 && lane_id() == 0); STAMP((k) + 1); } while (0)
#endif
    STAMP(0);
    if (IN(0)) { p0_prologue(F); if (BOTH(0)) GRID_BAR(0); }
    if (IN(1)) {
        { pg8::Gemm g{(const pg8::bf16_t*)(F.ws + WS_XN), (const pg8::bf16_t*)(F.ws + WS_WIN), M, IN_COLS, DM}; pg8::StaticOrder S; S.init(M, IN_COLS, F.G, (int)blockIdx.x);
          pg8::EpiIn E{(pg8::bf16_t*)(F.ws + WS_QO), (pg8::bf16_t*)(F.ws + WS_K), (pg8::bf16_t*)(F.ws + WS_V), (pg8::bf16_t*)(F.ws + WS_U), (const float*)(F.ws + WS_ROPEC), (const float*)(F.ws + WS_ROPES), attn_body::C2};
          pg8::gemm_phase<pg8::EpiIn, pg8::StaticOrder, true, true>(F.lds, g, S, E, F.wave); }
        { pg8::Gemm g{(const pg8::bf16_t*)(F.ws + WS_PB), (const pg8::bf16_t*)(F.ws + WS_WPROJ), M, DM, PLE_DIM}; pg8::StaticOrder S; S.init(M, DM, F.G, (int)blockIdx.x);
          pg8::EpiBf16<0> E{(pg8::bf16_t*)(F.ws + WS_E), DM, nullptr, 0, 0, 1.f};
          pg8::gemm_phase<pg8::EpiBf16<0>, pg8::StaticOrder, true, true>(F.lds, g, S, E, F.wave); }
        if (BOTH(1)) GRID_BAR(1);
    }
    if (IN(2)) { p2_attention(F); STAMP(13); p2_conv(F); STAMP(14); if (BOTH(2)) GRID_BAR(2); }
    if (IN(3)) {
        pg8::Gemm g{(const pg8::bf16_t*)(F.ws + WS_XN), (const pg8::bf16_t*)(F.ws + WS_WOUT), M, DM, DM}; pg8::StaticOrder S; S.init(M, DM, F.G, (int)blockIdx.x);
        pg8::EpiOut E{INP(0), F.out, (pg8::bf16_t*)(F.ws + WS_H1B), (float*)(F.ws + WS_SSQ1)};
        pg8::gemm_phase<pg8::EpiOut, pg8::StaticOrder, true, true>(F.lds, g, S, E, F.wave);
        if (BOTH(3)) GRID_BAR(3);
    }
    if (IN(4)) {
        pg8::Gemm g{(const pg8::bf16_t*)(F.ws + WS_H1B), (const pg8::bf16_t*)(F.ws + WS_WQ), M, QCOLS, DM}; pg8::StaticOrder S; S.init(M, QCOLS, F.G, (int)blockIdx.x);
        pg8::EpiQ E{(const float*)(F.ws + WS_SSQ1), (pg8::bf16_t*)(F.ws + WS_QP), EPS};
        pg8::gemm_phase<pg8::EpiQ, pg8::StaticOrder, true, true>(F.lds, g, S, E, F.wave);
        if (BOTH(4)) GRID_BAR(4);
    }
    if (IN(5)) { p5a_topk(F); if (BOTH(5)) GRID_BAR(5); }
    if (IN(6)) { p5b_udot(F); if (BOTH(6)) GRID_BAR(6); }
    if (IN(7)) { p5b2_gelu(F); if (BOTH(7)) GRID_BAR(7); }
    if (IN(8)) { p5c_vacc<0>(F); if (BOTH(8)) GRID_BAR(8);
#if defined(P5C_EXP)
        STAMP(15); p5c_vacc<P5C_EXP>(F); xcd_barrier(bar, F.wave == 0 && lane_id() == 0); STAMP(16);
#endif
    }
    if (IN(9)) {
        pg8::Gemm g{(const pg8::bf16_t*)(F.ws + WS_XN2), (const pg8::bf16_t*)(F.ws + WS_WGATE), M, DM, DM}; pg8::StaticOrder S; S.init(M, DM, F.G, (int)blockIdx.x);
        pg8::EpiGate E{F.out, (const pg8::bf16_t*)(F.ws + WS_E), (const float*)(F.ws + WS_SSQ2), EPS};
        pg8::gemm_phase<pg8::EpiGate, pg8::StaticOrder, true, true>(F.lds, g, S, E, F.wave);
        if (BOTH(9)) GRID_BAR(9);
    }
    if (IN(10)) p7_final(F);
#if defined(MBENCH)
    { xcd_barrier(bar, F.wave == 0 && lane_id() == 0); STAMP(15);
      unsigned r[32]; const unsigned l0 = (unsigned)lane_id();
#pragma unroll
      for (int i = 0; i < 32; ++i) r[i] = l0 * 2654435761u + i;
      float* rf = (float*)r;
#pragma unroll 1
      for (int it = 0; it < 1024; ++it) {
#pragma unroll
          for (int i = 0; i < 32; ++i) {
#if MBENCH == 1
              asm volatile("v_dot4c_i32_i8 %0, %1, %2" : "+v"(r[i]) : "v"(r[(i + 1) & 31]), "v"(r[(i + 2) & 31]));
#elif MBENCH == 2
              asm volatile("v_perm_b32 %0, %1, %2, %3" : "=v"(r[i]) : "v"(r[(i + 1) & 31]), "v"(r[(i + 2) & 31]), "v"(r[(i + 3) & 31]));
#elif MBENCH == 3
              asm volatile("v_fma_f32 %0, %1, %2, %0" : "+v"(r[i]) : "v"(r[(i + 1) & 31]), "v"(r[(i + 2) & 31]));
#elif MBENCH == 4
              asm volatile("v_cvt_f32_ubyte1 %0, %1" : "=v"(r[i]) : "v"(r[(i + 1) & 31]));
#elif MBENCH == 5
              asm volatile("v_pk_fma_f32 %0, %1, %2, %0" : "+v"(*(unsigned long long*)&r[2 * (i & 15)]) : "v"(*(unsigned long long*)&r[2 * ((i + 1) & 15)]), "v"(*(unsigned long long*)&r[2 * ((i + 2) & 15)]));
#elif MBENCH == 6
              asm volatile("v_add_u32 %0, %1, %2" : "=v"(r[i]) : "v"(r[(i + 1) & 31]), "v"(r[(i + 2) & 31]));
#elif MBENCH == 7
              asm volatile("v_mad_i32_i24 %0, %1, %2, %0" : "+v"(r[i]) : "v"(r[(i + 1) & 31]), "v"(r[(i + 2) & 31]));
#endif
          } }
      unsigned acc = 0;
#pragma unroll
      for (int i = 0; i < 32; ++i) acc ^= r[i];
      if (acc == 0x12345678u) ((unsigned*)(F.ws + WS_CTL))[2000 + l0] = acc;
      STAMP(16); }
#endif
#if defined(PROBE_A)
    STAMP(11);
    if (blockIdx.x == 0 && F.wave == 0) { volatile LAS unsigned* ms_ = (volatile LAS unsigned*)(F.lds + MISC_OFF) + 16;
        const unsigned long long ta = ((unsigned long long)ms_[2 * PROBE_A + 1] << 32) | ms_[2 * PROBE_A], tb = ((unsigned long long)ms_[2 * PROBE_B + 1] << 32) | ms_[2 * PROBE_B];
#if defined(PROBE_BARSUM)
        const unsigned long long span_ = ms_[2 * 21];
#else
        const unsigned long long span_ = tb - ta;
#endif
        const unsigned long long t0_ = __builtin_amdgcn_s_memrealtime(); while (__builtin_amdgcn_s_memrealtime() - t0_ < span_) __builtin_amdgcn_s_sleep(8); }
#endif
#undef IN
#undef BOTH
}

extern "C" void kernel_launch(void* const* d_in, const int* in_sizes, int n_in, void* d_out, int out_size, void* d_ws, size_t ws_size, hipStream_t stream) {
    static int grid = 0;
    if (grid == 0) {
        if (n_in != 23 || in_sizes[0] != M * DM || out_size != M * DM || ws_size < WS_END) { fprintf(stderr, "kernel_launch: unexpected shapes (n_in %d, in0 %d, out %d, ws %zu); nothing launched\n", n_in, n_in > 0 ? in_sizes[0] : -1, out_size, ws_size); grid = -1; return; }
        int dev = 0, cus = 0, per_cu = 0;
        if (hipGetDevice(&dev) != hipSuccess || hipDeviceGetAttribute(&cus, hipDeviceAttributeMultiprocessorCount, dev) != hipSuccess) { fprintf(stderr, "kernel_launch: device query failed\n"); grid = -1; return; }
        if (hipFuncSetAttribute((const void*)hymba_fwd, hipFuncAttributeMaxDynamicSharedMemorySize, LDS_BYTES) != hipSuccess) { fprintf(stderr, "kernel_launch: hipFuncSetAttribute failed\n"); grid = -1; return; }
        if (hipOccupancyMaxActiveBlocksPerMultiprocessor(&per_cu, (const void*)hymba_fwd, NWAVES * 64, LDS_BYTES) != hipSuccess || per_cu < 1) { fprintf(stderr, "kernel_launch: occupancy query says %d blocks per CU\n", per_cu); (void)hipGetLastError(); grid = -1; return; }
        grid = cus * per_cu;
        if (grid != 256) { fprintf(stderr, "kernel_launch: this kernel's attention order needs exactly 256 resident workgroups (got %d x %d); nothing launched\n", cus, per_cu); grid = -1; return; }
    }
    if (grid < 0) return;
    if (hipMemsetAsync((char*)d_ws + WS_CTL, 0, CTL_ZERO_BYTES, stream) != hipSuccess) { fprintf(stderr, "kernel_launch: hipMemsetAsync failed\n"); return; }
    Args a{};
    for (int i = 0; i < 23; ++i) a.in[i] = (const float*)d_in[i];
    a.out = (float*)d_out; a.ws = (unsigned char*)d_ws;
#if MK_N_LAUNCHES == 1
    a.ph_lo = 0; a.ph_hi = N_PHASES;
    void* kargs[] = {&a};
    hipError_t e = hipLaunchCooperativeKernel((const void*)hymba_fwd, dim3(grid), dim3(NWAVES * 64), kargs, LDS_BYTES, stream);
    if (e != hipSuccess) fprintf(stderr, "kernel_launch: cooperative launch failed: %s (grid %d)\n", hipGetErrorString(e), grid);
#else
    for (int li = 0; li < N_PHASES; ++li) { a.ph_lo = li; a.ph_hi = li + 1;
        hipLaunchKernelGGL(hymba_fwd, dim3(grid), dim3(NWAVES * 64), LDS_BYTES, stream, a);
        const hipError_t le = hipPeekAtLastError(); if (le != hipSuccess) { fprintf(stderr, "kernel_launch: launch %d failed: %s\n", li, hipGetErrorName(le)); break; } }
#endif
}
```

```cpp
#include <hip/hip_runtime.h>
#include <hip/hip_cooperative_groups.h>
#include <cstdio>
#include <cstdint>
namespace cg = cooperative_groups;
namespace pg8 {
#define PG8_LAS __attribute__((address_space(3)))
typedef unsigned short bf16_t;
typedef short bf16x8 __attribute__((ext_vector_type(8)));
typedef float f32x4 __attribute__((ext_vector_type(4)));
typedef unsigned u32x4 __attribute__((ext_vector_type(4)));
constexpr int BM = 256, BK = 64, HALF = 128, HTB = HALF * BK * 2  , STAGE_BYTES = 8 * HTB, NXCD = 8, WGM = 8;

__host__ __device__ __forceinline__ int lds_byte(int r, int c) { const int st = (r >> 4) * 2 + (c >> 5), rr = r & 15, cc = c & 31, ob = rr * 64 + cc * 2; return st * 1024 + (ob ^ (((ob >> 9) & 1) << 5)); }
__host__ __device__ __forceinline__ void stage_rc(int b, int& R, int& C) { const int st = b / 1024, sb = b % 1024, swz = sb ^ (((sb >> 9) & 1) << 5); R = (st >> 1) * 16 + swz / 64; C = (st & 1) * 32 + (swz % 64) / 2; }
__host__ __device__ __forceinline__ int perm32(int rho) { const int n = rho >> 4, i = rho & 15; return 8 * (i >> 2) + 4 * n + (i & 3); }

struct Unit { int pm, pn; };
struct Gemm { const bf16_t* A; const bf16_t* Bt; int M, N, K; };

struct StaticOrder {
    int nM, nN, nwg, G, c;
    __host__ __device__ void init(int M, int N, int G_, int c_) { nM = M / BM; nN = N / BM; nwg = nM * nN; G = G_; c = c_; }
    __host__ __device__ bool next(int i, Unit& u) const {
        const long L = (long)i * G + c; if (L >= nwg) return false;
        int wgid = (int)L; { const int q = nwg / NXCD, r = nwg % NXCD, xcd = wgid % NXCD, off = wgid / NXCD; wgid = (xcd < r ? xcd * (q + 1) : r * (q + 1) + (xcd - r) * q) + off; }
        const int nig = WGM * nN, gid = wgid / nig, fm = gid * WGM, gsz = (nM - fm) < WGM ? (nM - fm) : WGM;
        u.pm = fm + ((wgid % nig) % gsz); u.pn = (wgid % nig) / gsz; return true;
    }
    __device__ __forceinline__ void a_ready(const Unit&) const {}
    __device__ __forceinline__ void done(const Unit&) const {}
};

__device__ __forceinline__ unsigned cvt_pk_bf16(float lo, float hi) { unsigned r; asm volatile("v_cvt_pk_bf16_f32 %0, %1, %2" : "=v"(r) : "v"(lo), "v"(hi)); return r; }
typedef float f32x2 __attribute__((ext_vector_type(2)));
__device__ __forceinline__ f32x2 gelu_pk(f32x2 v) {
    const f32x2 av = __builtin_elementwise_abs(v), d = av * 0.2316418882f + 1.0f;
    f32x2 t; t.x = __builtin_amdgcn_rcpf(d.x); t.y = __builtin_amdgcn_rcpf(d.y);
    f32x2 q = t * 0.5307027145f + (-0.7265760135f); q = q * t + 0.7107068705f; q = q * t + (-0.142248368f); q = q * t + 0.127414796f; q = q * t;
    const f32x2 s = (v * v) * (-0.72134752044f);
    f32x2 e; e.x = __builtin_amdgcn_exp2f(s.x); e.y = __builtin_amdgcn_exp2f(s.y);
    const f32x2 m = v * (q * e), r = v - m;
    f32x2 o; o.x = v.x < 0.f ? m.x : r.x; o.y = v.y < 0.f ? m.y : r.y; return o;
}

template <int ACT  > struct EpiBf16 {
    static constexpr bool PERM = true, AFTER_DRAIN = false; static_assert(ACT == 0 || ACT == 1, "EpiBf16: ACT is 0 (none) or 1 (gelu_pk)");
    bf16_t* O; int ldc; const float* bias; int split_cols; size_t split_stride; float scale0;
    __device__ __forceinline__ void operator()(const f32x4 (&acc)[2][2][4][2], const Unit& u, int wr, int wc, int fr, int fq) const {
        const int row0 = u.pm * BM + wr * 64 + fr; int colt = u.pn * BM; bf16_t* base = O;
        float sc = 1.f; if (split_cols) { const int t = colt / split_cols; base += (size_t)t * split_stride; colt -= t * split_cols; if (t == 0) sc = scale0; }
        const int col0 = colt + wc * 32 + 8 * fq, bcol0 = u.pn * BM + wc * 32 + 8 * fq;
        f32x4 bv[2][2];
#pragma unroll
        for (int bj = 0; bj < 2; ++bj)
#pragma unroll
            for (int n = 0; n < 2; ++n) bv[bj][n] = bias ? *(const f32x4*)(bias + bcol0 + bj * HALF + 4 * n) : (f32x4){0.f, 0.f, 0.f, 0.f};
#pragma unroll
        for (int ai = 0; ai < 2; ++ai)
#pragma unroll
            for (int m = 0; m < 4; ++m) { bf16_t* rowp = base + (size_t)(row0 + ai * HALF + m * 16) * ldc + col0;
#pragma unroll
                for (int bj = 0; bj < 2; ++bj) { f32x4 v0 = acc[ai][bj][m][0] + bv[bj][0], v1 = acc[ai][bj][m][1] + bv[bj][1];
                    if (ACT == 1) { f32x2 a = gelu_pk((f32x2){v0[0], v0[1]}), b = gelu_pk((f32x2){v0[2], v0[3]}), c = gelu_pk((f32x2){v1[0], v1[1]}), d = gelu_pk((f32x2){v1[2], v1[3]});
                        v0 = (f32x4){a.x, a.y, b.x, b.y}; v1 = (f32x4){c.x, c.y, d.x, d.y}; }
                    v0 = v0 * sc; v1 = v1 * sc; u32x4 w; w.x = cvt_pk_bf16(v0[0], v0[1]); w.y = cvt_pk_bf16(v0[2], v0[3]); w.z = cvt_pk_bf16(v1[0], v1[1]); w.w = cvt_pk_bf16(v1[2], v1[3]);
                    *(u32x4*)(rowp + bj * HALF) = w; } }
    }
};
__device__ __forceinline__ float sigmoid_fast(float x) { return __builtin_amdgcn_rcpf(1.0f + __expf(-x)); }
__device__ __forceinline__ f32x4 sigmoid4(f32x4 x) { f32x4 r; r[0] = sigmoid_fast(x[0]); r[1] = sigmoid_fast(x[1]); r[2] = sigmoid_fast(x[2]); r[3] = sigmoid_fast(x[3]); return r; }
__device__ __forceinline__ u32x4 pack8(const f32x4 a, const f32x4 b) { u32x4 w; w.x = cvt_pk_bf16(a[0], a[1]); w.y = cvt_pk_bf16(a[2], a[3]); w.z = cvt_pk_bf16(b[0], b[1]); w.w = cvt_pk_bf16(b[2], b[3]); return w; }
__device__ __forceinline__ float dot4s(const f32x4 a) { return (a[0] * a[0] + a[1] * a[1]) + (a[2] * a[2] + a[3] * a[3]); }

struct EpiIn {
    static constexpr bool PERM = true, AFTER_DRAIN = false;
    bf16_t *Q, *Kk, *V, *U; const float* ropec; const float* ropes; float qscale;
    __device__ __forceinline__ void operator()(const f32x4 (&acc)[2][2][4][2], const Unit& u, int wr, int wc, int fr, int fq) const {
        const int row0 = u.pm * BM + wr * 64 + fr; const int pn = u.pn;
        if (pn < 4) {
            bf16_t* dst = (pn < 2) ? Q : Kk; const float sc = (pn < 2) ? qscale : 1.0f; const int colb = ((pn & 1) * 4 + wc) * 128 + 8 * fq;
#pragma unroll
            for (int ai = 0; ai < 2; ++ai)
#pragma unroll
                for (int m = 0; m < 4; ++m) { const int row = row0 + ai * HALF + m * 16; const int pos = row & 4095;
                    const f32x4 c0 = *(const f32x4*)(ropec + pos * 32 + 8 * fq), c1 = *(const f32x4*)(ropec + pos * 32 + 8 * fq + 4);
                    const f32x4 s0 = *(const f32x4*)(ropes + pos * 32 + 8 * fq), s1 = *(const f32x4*)(ropes + pos * 32 + 8 * fq + 4);
                    const f32x4 x10 = acc[ai][0][m][0], x11 = acc[ai][0][m][1], x20 = acc[ai][1][m][0], x21 = acc[ai][1][m][1];
                    const f32x4 o10 = (x10 * c0 - x20 * s0) * sc, o11 = (x11 * c1 - x21 * s1) * sc, o20 = (x20 * c0 + x10 * s0) * sc, o21 = (x21 * c1 + x11 * s1) * sc;
                    bf16_t* rp = dst + (size_t)row * 1024 + colb; const u32x4 w1 = pack8(o10, o11), w2 = pack8(o20, o21);
                    *(u32x4*)rp = w1; *(u32x4*)(rp + 32) = w2; *(u32x4*)(rp + 64) = w1; *(u32x4*)(rp + 96) = w2; }
        } else if (pn < 6) {
#pragma unroll
            for (int ai = 0; ai < 2; ++ai)
#pragma unroll
                for (int m = 0; m < 4; ++m) { const int row = row0 + ai * HALF + m * 16;
#pragma unroll
                    for (int bj = 0; bj < 2; ++bj) { const int hh = (pn - 4) * 2 + bj, vh = wc >> 1, d = (wc & 1) * 32 + 8 * fq;
                        const u32x4 w = pack8(acc[ai][bj][m][0], acc[ai][bj][m][1]); bf16_t* rp = V + (size_t)row * 1024 + (hh * 4 + vh) * 64 + d; *(u32x4*)rp = w; *(u32x4*)(rp + 128) = w; } }
        } else {
#pragma unroll
            for (int ai = 0; ai < 2; ++ai)
#pragma unroll
                for (int m = 0; m < 4; ++m) { const int row = row0 + ai * HALF + m * 16;
                    const f32x4 u0 = acc[ai][0][m][0] * sigmoid4(acc[ai][1][m][0]), u1 = acc[ai][0][m][1] * sigmoid4(acc[ai][1][m][1]);
                    *(u32x4*)(U + (size_t)row * 512 + (pn - 6) * 128 + wc * 32 + 8 * fq) = pack8(u0, u1); }
        }
    }
};
struct EpiOut {
    static constexpr bool PERM = true, AFTER_DRAIN = false;
    const float* x; float* out; bf16_t* hb; float* ssq;
    __device__ __forceinline__ void operator()(const f32x4 (&acc)[2][2][4][2], const Unit& u, int wr, int wc, int fr, int fq) const {
        const int row0 = u.pm * BM + wr * 64 + fr;
#pragma unroll
        for (int ai = 0; ai < 2; ++ai)
#pragma unroll
            for (int m = 0; m < 4; ++m) { const int row = row0 + ai * HALF + m * 16; float ss = 0.f;
#pragma unroll
                for (int bj = 0; bj < 2; ++bj) { const size_t off = (size_t)row * 1024 + u.pn * BM + bj * HALF + wc * 32 + 8 * fq;
                    const f32x4 h0 = acc[ai][bj][m][0] + *(const f32x4*)(x + off), h1 = acc[ai][bj][m][1] + *(const f32x4*)(x + off + 4);
                    *(f32x4*)(out + off) = h0; *(f32x4*)(out + off + 4) = h1; *(u32x4*)(hb + off) = pack8(h0, h1); ss += dot4s(h0) + dot4s(h1); }
                ss += __shfl_xor(ss, 16); ss += __shfl_xor(ss, 32);
                if (fq == 0) ssq[(size_t)row * 16 + u.pn * 4 + wc] = ss; }
    }
};
struct EpiQ {
    static constexpr bool PERM = true, AFTER_DRAIN = false;
    const float* ssq; bf16_t* qp; float eps;
    __device__ __forceinline__ void operator()(const f32x4 (&acc)[2][2][4][2], const Unit& u, int wr, int wc, int fr, int fq) const {
        const int row0 = u.pm * BM + wr * 64 + fr;
#pragma unroll
        for (int ai = 0; ai < 2; ++ai)
#pragma unroll
            for (int m = 0; m < 4; ++m) { const int row = row0 + ai * HALF + m * 16; const f32x4* sp = (const f32x4*)(ssq + (size_t)row * 16);
                const f32x4 a = sp[0], b = sp[1], c = sp[2], d = sp[3]; const f32x4 t = (a + b) + (c + d);
                const float rstd = rsqrtf(((t[0] + t[1]) + (t[2] + t[3])) * (1.0f / 1024.0f) + eps);
#pragma unroll
                for (int bj = 0; bj < 2; ++bj) *(u32x4*)(qp + (size_t)row * 2048 + u.pn * BM + bj * HALF + wc * 32 + 8 * fq) = pack8(acc[ai][bj][m][0] * rstd, acc[ai][bj][m][1] * rstd); }
    }
};
__device__ __forceinline__ f32x4 bf_lo4(unsigned a, unsigned b) { f32x4 r; r[0] = __uint_as_float(a << 16); r[1] = __uint_as_float(a & 0xffff0000u); r[2] = __uint_as_float(b << 16); r[3] = __uint_as_float(b & 0xffff0000u); return r; }
struct EpiGate {
    static constexpr bool PERM = true, AFTER_DRAIN = false;
    float* out; const bf16_t* e; const float* ssq; float eps;
    __device__ __forceinline__ void operator()(const f32x4 (&acc)[2][2][4][2], const Unit& u, int wr, int wc, int fr, int fq) const {
        const int row0 = u.pm * BM + wr * 64 + fr;
#pragma unroll
        for (int ai = 0; ai < 2; ++ai)
#pragma unroll
            for (int m = 0; m < 4; ++m) { const int row = row0 + ai * HALF + m * 16; const f32x4* sp = (const f32x4*)(ssq + (size_t)row * 8); const f32x4 t = sp[0] + sp[1];
                const float rstd = rsqrtf(((t[0] + t[1]) + (t[2] + t[3])) * (1.0f / 1024.0f) + eps);
#pragma unroll
                for (int bj = 0; bj < 2; ++bj) { const size_t off = (size_t)row * 1024 + u.pn * BM + bj * HALF + wc * 32 + 8 * fq;
                    const u32x4 ev = *(const u32x4*)(e + off); const f32x4 e0 = bf_lo4(ev.x, ev.y), e1 = bf_lo4(ev.z, ev.w);
                    const f32x4 h0 = *(const f32x4*)(out + off) + e0 * sigmoid4(acc[ai][bj][m][0] * rstd), h1 = *(const f32x4*)(out + off + 4) + e1 * sigmoid4(acc[ai][bj][m][1] * rstd);
                    *(f32x4*)(out + off) = h0; *(f32x4*)(out + off + 4) = h1; } }
    }
};
template <class Epi, class Sched, bool ALIGN_EPI = false, bool SP2 = false>
__device__ __forceinline__ void gemm_phase(PG8_LAS unsigned char* lds, const Gemm g, const Sched& S, const Epi& E, const int wid  ) {
    int lane; asm volatile("v_mbcnt_lo_u32_b32 %0, -1, 0\n\tv_mbcnt_hi_u32_b32 %0, -1, %0" : "=v"(lane));
    const int tid = wid * 64 + lane, wr = wid >> 2, wc = wid & 3, fr = lane & 15, fq = lane >> 4;
    const int K = g.K, nt = K / BK;
    unsigned voffA[2], voffB[2];
#pragma unroll
    for (int i = 0; i < 2; ++i) { int R, C; stage_rc(tid * 16 + i * 8192, R, C); const int Rb = Epi::PERM ? ((R & ~31) + perm32(R & 31)) : R;
        voffA[i] = (unsigned)(R * K + C) * 2u; voffB[i] = (unsigned)(Rb * K + C) * 2u; }
    const size_t kstep = (size_t)(BK * 2);
    const size_t hstep = (size_t)HALF * K * 2;
    const size_t tstep = 2 * hstep;
    const unsigned ldsw = (unsigned)wid * 1024u;
    const int aoff = lds_byte(wr * 64 + fr, fq * 8), boff = lds_byte(wc * 32 + fr, fq * 8);
#define PG8_SA(b, h) (((b) * 2 + (h)) * HTB)
#define PG8_SB(b, h) ((4 + (b) * 2 + (h)) * HTB)
#define PG8_STAGE(bufoff, gbase, voff) do { _Pragma("unroll") for (int _i = 0; _i < 2; ++_i) \
        __builtin_amdgcn_global_load_lds((const unsigned*)((const char*)(gbase) + (voff)[_i]), (PG8_LAS unsigned*)(lds + (bufoff) + ldsw + _i * 8192), 16, 0, 0); } while (0)
#define PG8_LDA(dst, b, h) do { _Pragma("unroll") for (int m = 0; m < 4; ++m) _Pragma("unroll") for (int k = 0; k < 2; ++k) dst[m][k] = *(const PG8_LAS bf16x8*)(lds + PG8_SA(b, h) + aoff + m * 2048 + k * 1024); } while (0)
#define PG8_LDB(dst, b, h) do { _Pragma("unroll") for (int n = 0; n < 2; ++n) _Pragma("unroll") for (int k = 0; k < 2; ++k) dst[n][k] = *(const PG8_LAS bf16x8*)(lds + PG8_SB(b, h) + boff + n * 2048 + k * 1024); } while (0)
#define PG8_MMA(ai, bj, At, Bt) do { __builtin_amdgcn_s_setprio(1); _Pragma("unroll") for (int m = 0; m < 4; ++m) _Pragma("unroll") for (int n = 0; n < 2; ++n) _Pragma("unroll") for (int k = 0; k < 2; ++k) \
        acc[ai][bj][m][n] = __builtin_amdgcn_mfma_f32_16x16x32_bf16(Bt[n][k], At[m][k], acc[ai][bj][m][n], 0, 0, 0); __builtin_amdgcn_s_setprio(0); } while (0)
#define PG8_WAIT_V(n) asm volatile("s_waitcnt vmcnt(" #n ")" ::: "memory")
#define PG8_WAIT_L(n) asm volatile("s_waitcnt lgkmcnt(" #n ")" ::: "memory")
#define PG8_BAR __builtin_amdgcn_s_barrier()
#define PG8_SCHED __builtin_amdgcn_sched_barrier(0)
    Unit cur, nxt; int ui = 0;
    if (!S.next(0, cur)) return;
    f32x4 acc[2][2][4][2];
#pragma unroll
    for (int a = 0; a < 2; ++a)
#pragma unroll
        for (int b = 0; b < 2; ++b)
#pragma unroll
            for (int m = 0; m < 4; ++m)
#pragma unroll
                for (int n = 0; n < 2; ++n) acc[a][b][m][n] = (f32x4){0.f, 0.f, 0.f, 0.f};
    bf16x8 At[4][2], B0[2][2], B1[2][2];
    const char* cA = (const char*)g.A + (size_t)cur.pm * tstep; const char* cB = (const char*)g.Bt + (size_t)cur.pn * tstep;
    S.a_ready(cur);
    if constexpr (SP2) {
        PG8_STAGE(PG8_SB(0, 0), cB, voffB); PG8_STAGE(PG8_SB(0, 1), cB + hstep, voffB); PG8_STAGE(PG8_SA(0, 0), cA, voffA); PG8_STAGE(PG8_SA(0, 1), cA + hstep, voffA);
        if (wr == 1) PG8_BAR;
        PG8_WAIT_V(2); PG8_BAR;
        PG8_STAGE(PG8_SB(1, 0), cB + kstep, voffB); PG8_STAGE(PG8_SA(1, 0), cA + kstep, voffA); PG8_STAGE(PG8_SB(1, 1), cB + hstep + kstep, voffB);
        PG8_WAIT_V(6); PG8_BAR;
    } else {
        PG8_STAGE(PG8_SB(0, 0), cB, voffB); PG8_STAGE(PG8_SA(0, 0), cA, voffA); PG8_STAGE(PG8_SB(0, 1), cB + hstep, voffB); PG8_STAGE(PG8_SA(0, 1), cA + hstep, voffA);
        if (wr == 1) PG8_BAR;
        PG8_WAIT_V(4); PG8_BAR;
        PG8_STAGE(PG8_SB(1, 0), cB + kstep, voffB); PG8_STAGE(PG8_SA(1, 0), cA + kstep, voffA); PG8_STAGE(PG8_SB(1, 1), cB + hstep + kstep, voffB);
        PG8_WAIT_V(6); PG8_BAR;
    }
    for (;;) {
        const bool has_next = S.next(ui + 1, nxt);
        const char* nA = has_next ? (const char*)g.A + (size_t)nxt.pm * tstep : cA; const char* nB = has_next ? (const char*)g.Bt + (size_t)nxt.pn * tstep : cB;
        for (int t = 0; t < nt; t += 2) {
            const bool last = (t == nt - 2);
            const char* a1 = cA + (size_t)(t + 1) * kstep;
            const char* a2 = last ? nA : cA + (size_t)(t + 2) * kstep; const char* b2 = last ? nB : cB + (size_t)(t + 2) * kstep;
            const char* a3 = a2 + kstep; const char* b3 = b2 + kstep;
            if (last && has_next) S.a_ready(nxt);
            if constexpr (SP2) {
            PG8_LDB(B0, 0, 0); PG8_LDB(B1, 0, 1); PG8_SCHED; PG8_LDA(At, 0, 0); PG8_STAGE(PG8_SA(1, 1), a1 + hstep, voffA);
            PG8_WAIT_V(8); PG8_WAIT_L(0); PG8_BAR; PG8_MMA(0, 0, At, B0); PG8_MMA(0, 1, At, B1); PG8_BAR; PG8_SCHED;
            PG8_LDA(At, 0, 1); PG8_STAGE(PG8_SB(0, 0), b2, voffB); PG8_STAGE(PG8_SB(0, 1), b2 + hstep, voffB); PG8_STAGE(PG8_SA(0, 0), a2, voffA);
            PG8_WAIT_V(8); PG8_WAIT_L(0); PG8_BAR; PG8_MMA(1, 0, At, B0); PG8_MMA(1, 1, At, B1); PG8_BAR; PG8_SCHED;
            PG8_LDB(B0, 1, 0); PG8_LDB(B1, 1, 1); PG8_SCHED; PG8_LDA(At, 1, 0); PG8_STAGE(PG8_SA(0, 1), a2 + hstep, voffA);
            PG8_WAIT_V(8); PG8_WAIT_L(0); PG8_BAR; PG8_MMA(0, 0, At, B0); PG8_MMA(0, 1, At, B1); PG8_BAR; PG8_SCHED;
            PG8_LDA(At, 1, 1); PG8_STAGE(PG8_SB(1, 0), b3, voffB); PG8_STAGE(PG8_SB(1, 1), b3 + hstep, voffB); PG8_STAGE(PG8_SA(1, 0), a3, voffA);
            PG8_WAIT_V(8); PG8_WAIT_L(0); PG8_BAR; PG8_MMA(1, 0, At, B0); PG8_MMA(1, 1, At, B1); PG8_BAR; PG8_SCHED;
            } else {
            PG8_LDB(B0, 0, 0); PG8_SCHED; PG8_LDA(At, 0, 0); PG8_STAGE(PG8_SA(1, 1), a1 + hstep, voffA);
            PG8_WAIT_L(8); PG8_BAR; PG8_WAIT_L(0); PG8_MMA(0, 0, At, B0); PG8_BAR; PG8_SCHED;
            PG8_LDB(B1, 0, 1); PG8_STAGE(PG8_SB(0, 0), b2, voffB);
            PG8_BAR; PG8_WAIT_L(0); PG8_MMA(0, 1, At, B1); PG8_BAR;
            PG8_LDA(At, 0, 1); PG8_STAGE(PG8_SA(0, 0), a2, voffA);
            PG8_BAR; PG8_WAIT_L(0); PG8_MMA(1, 0, At, B0); PG8_BAR; PG8_SCHED;
            PG8_STAGE(PG8_SB(0, 1), b2 + hstep, voffB);
            PG8_WAIT_V(6); PG8_BAR; PG8_MMA(1, 1, At, B1); PG8_BAR;
            PG8_LDB(B0, 1, 0); PG8_SCHED; PG8_LDA(At, 1, 0); PG8_STAGE(PG8_SA(0, 1), a2 + hstep, voffA);
            PG8_WAIT_L(8); PG8_BAR; PG8_WAIT_L(0); PG8_MMA(0, 0, At, B0); PG8_BAR; PG8_SCHED;
            PG8_LDB(B1, 1, 1); PG8_STAGE(PG8_SB(1, 0), b3, voffB);
            PG8_BAR; PG8_WAIT_L(0); PG8_MMA(0, 1, At, B1); PG8_BAR;
            PG8_LDA(At, 1, 1); PG8_STAGE(PG8_SA(1, 0), a3, voffA);
            PG8_BAR; PG8_WAIT_L(0); PG8_MMA(1, 0, At, B0); PG8_BAR; PG8_SCHED;
            PG8_STAGE(PG8_SB(1, 1), b3 + hstep, voffB);
            PG8_WAIT_V(6); PG8_BAR; PG8_MMA(1, 1, At, B1); PG8_BAR;
            }
        }
        if constexpr (ALIGN_EPI) { if (wr == 0) PG8_BAR; }
        if constexpr (!Epi::AFTER_DRAIN) { E(acc, cur, wr, wc, fr, fq); S.done(cur); }
        if (!has_next) break;
#pragma unroll
        for (int a = 0; a < 2; ++a)
#pragma unroll
            for (int b = 0; b < 2; ++b)
#pragma unroll
                for (int m = 0; m < 4; ++m)
#pragma unroll
                    for (int n = 0; n < 2; ++n) acc[a][b][m][n] = (f32x4){0.f, 0.f, 0.f, 0.f};
        cur = nxt; cA = nA; cB = nB; ++ui;
        if constexpr (ALIGN_EPI) { if (wr == 1) PG8_BAR; }
    }
    PG8_WAIT_V(0);
    if constexpr (!ALIGN_EPI) { if (wr == 0) PG8_BAR; }
    PG8_BAR;
    if constexpr (Epi::AFTER_DRAIN) { E.fused(acc, cur, wr, wc, fr, fq, lds, wid, lane); S.done(cur); }
#undef PG8_SA
#undef PG8_SB
#undef PG8_STAGE
#undef PG8_LDA
#undef PG8_LDB
#undef PG8_MMA
#undef PG8_WAIT_V
#undef PG8_WAIT_L
#undef PG8_BAR
#undef PG8_SCHED
}
}
#include <hip/hip_bf16.h>
#include <cmath>
namespace attn_body {
using bf16=__hip_bfloat16;
using bf16x8=__attribute__((ext_vector_type(8)))short;
using s16x4=__attribute__((ext_vector_type(4)))short;
using f32x16=__attribute__((ext_vector_type(16)))float;
using u32x4=__attribute__((ext_vector_type(4)))unsigned;
constexpr int BATCH=8,NHEAD=16,SEQ=4096,D=64,DM=NHEAD*D;
constexpr int NW=8,QBLK=32,QB=QBLK*NW,KVBLK=64,NQB=SEQ/QB;
constexpr int ATTN_PITCH=DM, ATTN_UNIT_ROWS=QB;
__device__ __forceinline__ int crow(int r,int hi){return (r&3)+8*(r>>2)+4*hi;}
#define SBAR() __builtin_amdgcn_sched_barrier(0)
__device__ __forceinline__ void cmask(f32x16&p0,f32x16&p1,int jb,int qrel,int hi){
  const float NEG=-INFINITY; int kb=64*jb+4*hi;
  #pragma unroll
  for(int r=0;r<16;++r){int kv=kb+(r&3)+8*(r>>2); if(kv>qrel)p0[r]=NEG; if(kv+32>qrel)p1[r]=NEG;}
}

constexpr int NSLOT=3, SLOTB=8192;
constexpr int LDS_K=0, LDS_V=NSLOT*SLOTB, LDS_WS=2*NSLOT*SLOTB, LDS_OST=LDS_WS+NW*64*4, LDS_BYTES=LDS_OST+NW*4096;
constexpr float C2=0.125f*1.4426950408889634f;
__device__ __forceinline__ void glds16(const void*gsrc,unsigned lds_dst){unsigned keep;
  asm volatile("s_mov_b32 %0, m0\n\ts_mov_b32 m0, %2\n\ts_nop 0\n\tglobal_load_lds_dwordx4 %1, off\n\ts_mov_b32 m0, %0":"=&s"(keep):"v"(gsrc),"s"(lds_dst):"memory");}
__device__ __forceinline__ float max3f(float a,float b,float c){float r;asm("v_max3_f32 %0, %1, %2, %3":"=v"(r):"v"(a),"v"(b),"v"(c));return r;}
__device__ __forceinline__ float max2f(float a,float b){float r;asm("v_max_f32_e32 %0, %1, %2":"=v"(r):"v"(a),"v"(b));return r;}
__device__ __forceinline__ float fadd_s(float a,float b){float r;asm("v_add_f32_e32 %0, %1, %2":"=v"(r):"v"(a),"v"(b));return r;}
__device__ __forceinline__ float fsub_s(float a,float b){float r;asm("v_sub_f32_e32 %0, %1, %2":"=v"(r):"v"(a),"v"(b));return r;}
typedef float f32x2_t __attribute__((ext_vector_type(2))); typedef __bf16 bf16x2_t __attribute__((ext_vector_type(2)));
__device__ __forceinline__ unsigned cvtpk_s(float lo,float hi){f32x2_t v={lo,hi};bf16x2_t b=__builtin_convertvector(v,bf16x2_t);return __builtin_bit_cast(unsigned,b);}
#define WAIT_BAR(N) asm volatile("s_waitcnt vmcnt(" #N ") lgkmcnt(0)\n\ts_barrier":::"memory")

__device__ __forceinline__ void qkt(f32x16&p0,f32x16&p1,const char*Kslot,const bf16x8*qr,const f32x16&negm,int r32,int hi){
  const char*kb=Kslot+hi*1024+r32*16;
  #pragma unroll
  for(int d0=0;d0<4;++d0){
    const bf16x8 b0=*reinterpret_cast<const bf16x8*>(kb+d0*2048);
    const bf16x8 b1=*reinterpret_cast<const bf16x8*>(kb+d0*2048+512);
    if(d0==0){p0=__builtin_amdgcn_mfma_f32_32x32x16_bf16(b0,qr[0],negm,0,0,0);p1=__builtin_amdgcn_mfma_f32_32x32x16_bf16(b1,qr[0],negm,0,0,0);}
    else{p0=__builtin_amdgcn_mfma_f32_32x32x16_bf16(b0,qr[d0],p0,0,0,0);p1=__builtin_amdgcn_mfma_f32_32x32x16_bf16(b1,qr[d0],p1,0,0,0);}}
}
typedef __attribute__((address_space(3))) const char* lds_cptr;
typedef short v4i16_t __attribute__((ext_vector_type(4)));
__device__ __forceinline__ void kload8(bf16x8*kf,lds_cptr kp){
  kf[0]=*(const __attribute__((address_space(3))) bf16x8*)(kp);      kf[1]=*(const __attribute__((address_space(3))) bf16x8*)(kp+512);
  kf[2]=*(const __attribute__((address_space(3))) bf16x8*)(kp+2048); kf[3]=*(const __attribute__((address_space(3))) bf16x8*)(kp+2560);
  kf[4]=*(const __attribute__((address_space(3))) bf16x8*)(kp+4096); kf[5]=*(const __attribute__((address_space(3))) bf16x8*)(kp+4608);
  kf[6]=*(const __attribute__((address_space(3))) bf16x8*)(kp+6144); kf[7]=*(const __attribute__((address_space(3))) bf16x8*)(kp+6656);
}
__device__ __forceinline__ void kload2(bf16x8*kf,lds_cptr kp,int j){ kf[2*j]=*(const __attribute__((address_space(3))) bf16x8*)(kp+j*2048); kf[2*j+1]=*(const __attribute__((address_space(3))) bf16x8*)(kp+j*2048+512); }
__device__ __forceinline__ s16x4 vtr(lds_cptr p){ return __builtin_bit_cast(s16x4,__builtin_amdgcn_ds_read_tr16_b64_v4i16((__attribute__((address_space(3))) v4i16_t*)p)); }
__device__ __forceinline__ float rowmax(const f32x16&p0,const f32x16&p1){
  float a=max3f(p0[0],p0[1],p1[0]),b=max3f(p0[2],p0[3],p1[1]);a=max3f(a,p1[2],p1[3]);
  #pragma unroll
  for(int r=4;r<16;r+=4){a=max3f(a,p0[r],p0[r+1]);b=max3f(b,p0[r+2],p0[r+3]);a=max3f(a,p1[r],p1[r+1]);b=max3f(b,p1[r+2],p1[r+3]);}
  const float m=max2f(a,b);
  auto rr=__builtin_amdgcn_permlane32_swap(__float_as_uint(m),__float_as_uint(m),false,false);
  return max2f(__uint_as_float(rr[0]),__uint_as_float(rr[1]));
}
__device__ __forceinline__ void pv(f32x16*o,int vb,bf16x8 pa0,bf16x8 pa1,bf16x8 pa2,bf16x8 pa3){
  #pragma unroll
  for(int d0=0;d0<2;++d0){s16x4 lo[4],hi[4];
    #pragma unroll
    for(int ks=0;ks<4;++ks){
      asm volatile("ds_read_b64_tr_b16 %0,%1 offset:%c2":"=&v"(lo[ks]):"v"(vb),"i"(d0*4096+ks*1024):"memory");
      asm volatile("ds_read_b64_tr_b16 %0,%1 offset:%c2":"=&v"(hi[ks]):"v"(vb),"i"(d0*4096+ks*1024+512):"memory");}
    asm volatile("s_waitcnt lgkmcnt(0)":::"memory");SBAR();
    #define PK(k) (bf16x8){lo[k][0],lo[k][1],lo[k][2],lo[k][3],hi[k][0],hi[k][1],hi[k][2],hi[k][3]}
    o[d0]=__builtin_amdgcn_mfma_f32_32x32x16_bf16(pa0,PK(0),o[d0],0,0,0);
    o[d0]=__builtin_amdgcn_mfma_f32_32x32x16_bf16(pa1,PK(1),o[d0],0,0,0);
    o[d0]=__builtin_amdgcn_mfma_f32_32x32x16_bf16(pa2,PK(2),o[d0],0,0,0);
    o[d0]=__builtin_amdgcn_mfma_f32_32x32x16_bf16(pa3,PK(3),o[d0],0,0,0);
    #undef PK
  }
}

#ifndef ATTN_STORE16
#define ATTN_STORE16(p,v) (*(u32x4*)(p)=(v))
#endif
template<int THRL> __device__ __forceinline__ void attn_unit(int b,int h,int qb,const bf16*Q,const bf16*__restrict__ K,const bf16*__restrict__ V,bf16*O,char*shm,const int tid_in){
  const int tid=tid_in,lane=tid&63,r32=lane&31,hi=lane>>5; const int wid=__builtin_amdgcn_readfirstlane(tid>>6);
  const long rowbase=(long)b*SEQ; const int q0=qb*QB;
  const bf16*Qw=Q+(rowbase+q0+wid*QBLK)*DM+h*D;
  const bf16*Kh=K+rowbase*DM+h*D,*Vh=V+rowbase*DM+h*D;
  const unsigned lds0=(unsigned)(uintptr_t)shm;
  float*wsf=(float*)(shm+LDS_WS)+wid*64;
  const bf16*ksrc=Kh+(long)lane*DM+wid*8;
  const bf16*vsrc=Vh+(long)(16*(wid&3)+(lane>>2))*DM+(wid>>2)*32+(lane&3)*8;
  const unsigned kdst=lds0+LDS_K+wid*1024, vdst=lds0+LDS_V+wid*1024;
  #define DMA_K(t,slot) glds16(ksrc+(long)(t)*KVBLK*DM,(unsigned)__builtin_amdgcn_readfirstlane(kdst+(slot)))
  #define DMA_V(t,slot) glds16(vsrc+(long)(t)*KVBLK*DM,(unsigned)__builtin_amdgcn_readfirstlane(vdst+(slot)))
  const int vb0=(int)(lds0+LDS_V)+((lane>>4)&1)*32+(lane&3)*8+(4*hi+((lane&15)>>2))*64;
  const char*Kbase=shm+LDS_K; bf16x8 kf[8];
  const lds_cptr shm3=(lds_cptr)shm; const lds_cptr kp0=shm3+LDS_K+hi*1024+r32*16; const lds_cptr vp0=shm3+LDS_V+((lane>>4)&1)*32+(lane&3)*8+(4*hi+((lane&15)>>2))*64;
  const int NT=(q0+QB)/KVBLK;
  DMA_K(0,0);DMA_V(0,0);DMA_K(1,SLOTB);
  bf16x8 qr[4];
  #pragma unroll
  for(int d0=0;d0<4;++d0)qr[d0]=*reinterpret_cast<const bf16x8*>(&Qw[(long)r32*DM+d0*16+hi*8]);
  float mhat=0.f,l_reg=0.f;f32x16 o[2];o[0]=f32x16{};o[1]=f32x16{};f32x16 negm=f32x16{};asm volatile("":"+v"(negm));
  const int qrel=wid*QBLK+r32;
  #define CMASK(P0,P1,t) do{int jb_=(t)-(NT-4); if(jb_>=0)cmask(P0,P1,jb_,qrel,hi);}while(0)
  bool resc=false;
  #define START(P0,P1) do{ const float rm=rowmax(P0,P1); resc=false; \
    { const float dl=rm; mhat=fadd_s(mhat,dl); \
      _Pragma("unroll") for(int r=0;r<16;++r){P0[r]=fsub_s(P0[r],dl);P1[r]=fsub_s(P1[r],dl);} \
      _Pragma("unroll") for(int r=0;r<16;++r)negm[r]=-mhat; asm volatile("":"+v"(negm)); } \
    _Pragma("unroll") for(int r=0;r<16;++r)P0[r]=__builtin_amdgcn_exp2f(P0[r]); }while(0)
  #define RESC() do{ if(resc){ asm volatile("s_waitcnt lgkmcnt(0)":::"memory"); \
      _Pragma("unroll") for(int d_=0;d_<2;++d_) _Pragma("unroll") for(int r=0;r<16;++r)o[d_][r]*=wsf[crow(r,hi)]; } }while(0)
  f32x16 pA0,pA1,pB0,pB1;
  int sl_prev=0,sl_cur=0,sl_next=SLOTB;
  #define ROT() do{sl_prev=sl_cur;sl_cur=sl_next;sl_next=(sl_next==(NSLOT-1)*SLOTB)?0:sl_next+SLOTB;}while(0)
  DMA_K(2,2*SLOTB);
  WAIT_BAR(3);
  qkt(pA0,pA1,Kbase,qr,negm,r32,hi);asm volatile("s_nop 15\n\ts_nop 7":"+v"(pA0),"+v"(pA1));CMASK(pA0,pA1,0);
  START(pA0,pA1);
  _Pragma("unroll") for(int r=0;r<16;++r)pA1[r]=__builtin_amdgcn_exp2f(pA1[r]);
  WAIT_BAR(0);
  DMA_K(3,0);DMA_V(1,SLOTB);
  ROT();
  kload8(kf,kp0+sl_cur);
  WAIT_BAR(2);
  s16x4 vlo[8],vhi[8]; u32x4 pw0,pw1,pw2,pw3;
  #define PKW(P,B) cvtpk_s(P[B],P[B+1])
  #define PAF(k) __builtin_bit_cast(bf16x8,pw##k)
  #define VFR(i) (bf16x8){vlo[i][0],vlo[i][1],vlo[i][2],vlo[i][3],vhi[i][0],vhi[i][1],vhi[i][2],vhi[i][3]}
  #define PIN(x) asm volatile("":"+v"(x))
  #define MX3(a,b,c) __builtin_fmaxf(__builtin_fmaxf((a),(b)),(c))
  #define GAPA(MF,A0,A1,A2,A3,W0,W1,PW) do{ MF; sacc+=A0; sacc+=A1; sacc+=A2; sacc+=A3; PIN(sacc); W0; W1; PIN(PW); SBAR(); }while(0)
  #define EX(v) __builtin_amdgcn_exp2f(v)
  #define GAPB(MF,X,B) do{ MF; X[B]=EX(X[B]); X[B+1]=EX(X[B+1]); X[B+2]=EX(X[B+2]); X[B+3]=EX(X[B+3]); PIN(X); SBAR(); }while(0)
  #define VRD(i) do{ vlo[i]=vtr(vp_+(((i)>>2)*4096+((i)&3)*1024)); vhi[i]=vtr(vp_+(((i)>>2)*4096+((i)&3)*1024+512)); }while(0)
  #define KRD(G,j) do{ if(G){ kload2(kf,kp0+sl_next,j); SBAR(); } }while(0)
  #define STEP(C0,C1,P0,P1,t,GK,GV,GL) do{ SBAR(); \
    const lds_cptr vp_=vp0+sl_prev; \
    VRD(0); SBAR(); float sacc=(P0[0]+P0[1]); \
    GAPA(C0=__builtin_amdgcn_mfma_f32_32x32x16_bf16(kf[0],qr[0],negm,0,0,0), P0[2],P0[3],P0[4],P0[5],     pw0[0]=PKW(P0,0), pw0[1]=PKW(P0,2), pw0); \
    VRD(4); SBAR(); GAPA(C1=__builtin_amdgcn_mfma_f32_32x32x16_bf16(kf[1],qr[0],negm,0,0,0), P0[6],P0[7],P0[8],P0[9],     pw0[2]=PKW(P0,4), pw0[3]=PKW(P0,6), pw0); \
    VRD(1); SBAR(); GAPA(C0=__builtin_amdgcn_mfma_f32_32x32x16_bf16(kf[2],qr[1],C0,0,0,0),   P0[10],P0[11],P0[12],P0[13], pw1[0]=PKW(P0,8), pw1[1]=PKW(P0,10), pw1); \
    VRD(5); SBAR(); GAPA(C1=__builtin_amdgcn_mfma_f32_32x32x16_bf16(kf[3],qr[1],C1,0,0,0),   P0[14],P0[15],P1[0],P1[1],   pw1[2]=PKW(P0,12),pw1[3]=PKW(P0,14), pw1); \
    VRD(2); SBAR(); GAPA(C0=__builtin_amdgcn_mfma_f32_32x32x16_bf16(kf[4],qr[2],C0,0,0,0),   P1[2],P1[3],P1[4],P1[5],     pw2[0]=PKW(P1,0), pw2[1]=PKW(P1,2), pw2); \
    VRD(6); SBAR(); GAPA(C1=__builtin_amdgcn_mfma_f32_32x32x16_bf16(kf[5],qr[2],C1,0,0,0),   P1[6],P1[7],P1[8],P1[9],     pw2[2]=PKW(P1,4), pw2[3]=PKW(P1,6), pw2); \
    VRD(3); SBAR(); GAPA(C0=__builtin_amdgcn_mfma_f32_32x32x16_bf16(kf[6],qr[3],C0,0,0,0),   P1[10],P1[11],P1[12],P1[13], pw3[0]=PKW(P1,8), pw3[1]=PKW(P1,10), pw3); \
    VRD(7); SBAR(); GAPA(C1=__builtin_amdgcn_mfma_f32_32x32x16_bf16(kf[7],qr[3],C1,0,0,0),   P1[14],P1[15],0.f,0.f,       pw3[2]=PKW(P1,12),pw3[3]=PKW(P1,14), pw3); \
    l_reg+=sacc; \
    if(GK){DMA_K((t)+3,sl_cur);} if(GV){DMA_V((t)+1,sl_next);} \
    CMASK(C0,C1,t); \
    { float a=MX3(C0[0],C0[1],C1[0]),b=MX3(C0[2],C0[3],C1[1]); a=MX3(a,C1[2],C1[3]); \
      _Pragma("unroll") for(int r=4;r<16;r+=4){a=MX3(a,C0[r],C0[r+1]);b=MX3(b,C0[r+2],C0[r+3]);a=MX3(a,C1[r],C1[r+1]);b=MX3(b,C1[r+2],C1[r+3]);} \
      float rm=__builtin_fmaxf(a,b); { auto rr=__builtin_amdgcn_permlane32_swap(__float_as_uint(rm),__float_as_uint(rm),false,false); rm=__builtin_fmaxf(__uint_as_float(rr[0]),__uint_as_float(rr[1])); } \
      resc=false; \
      if(__builtin_expect(__any(rm>(float)THRL),0)){ const float dl=__builtin_fmaxf(rm,0.f); mhat+=dl; \
        _Pragma("unroll") for(int r=0;r<16;++r){C0[r]-=dl;C1[r]-=dl;} \
        _Pragma("unroll") for(int r=0;r<16;++r)negm[r]=-mhat; asm volatile("":"+v"(negm)); \
        const float f=__builtin_amdgcn_exp2f(-dl); l_reg*=f; if(hi==0)wsf[r32]=f; resc=true; } } \
    SBAR(); \
    GAPB(o[0]=__builtin_amdgcn_mfma_f32_32x32x16_bf16(PAF(0),VFR(0),o[0],0,0,0), C0,0); \
    GAPB(o[1]=__builtin_amdgcn_mfma_f32_32x32x16_bf16(PAF(0),VFR(4),o[1],0,0,0), C0,4); \
    KRD(GL,0); GAPB(o[0]=__builtin_amdgcn_mfma_f32_32x32x16_bf16(PAF(1),VFR(1),o[0],0,0,0), C0,8); \
    KRD(GL,1); GAPB(o[1]=__builtin_amdgcn_mfma_f32_32x32x16_bf16(PAF(1),VFR(5),o[1],0,0,0), C0,12); \
    KRD(GL,2); GAPB(o[0]=__builtin_amdgcn_mfma_f32_32x32x16_bf16(PAF(2),VFR(2),o[0],0,0,0), C1,0); \
    KRD(GL,3); GAPB(o[1]=__builtin_amdgcn_mfma_f32_32x32x16_bf16(PAF(2),VFR(6),o[1],0,0,0), C1,4); \
    GAPB(o[0]=__builtin_amdgcn_mfma_f32_32x32x16_bf16(PAF(3),VFR(3),o[0],0,0,0), C1,8); \
    GAPB(o[1]=__builtin_amdgcn_mfma_f32_32x32x16_bf16(PAF(3),VFR(7),o[1],0,0,0), C1,12); \
    }while(0)
  int t=1;
  #undef CMASK
  #define CMASK(P0,P1,t) do{}while(0)
  for(;t+5<NT;t+=2){
    STEP(pB0,pB1,pA0,pA1,t,true,true,true);     WAIT_BAR(2); RESC(); ROT();
    STEP(pA0,pA1,pB0,pB1,t+1,true,true,true);   WAIT_BAR(2); RESC(); ROT();
  }
  #undef CMASK
  #define CMASK(P0,P1,t) do{int jb_=(t)-(NT-4); if(jb_>=0)cmask(P0,P1,jb_,qrel,hi);}while(0)
  #define ENDW(tt) do{ if((tt)+3<NT){WAIT_BAR(2);} else if((tt)+2<NT){WAIT_BAR(1);} else {WAIT_BAR(0);} }while(0)
  for(;t+1<NT;t+=2){
    STEP(pB0,pB1,pA0,pA1,t,(t+3<NT),(t+1<NT),(t+1<NT));       ENDW(t);   RESC(); ROT();
    STEP(pA0,pA1,pB0,pB1,t+1,(t+4<NT),(t+2<NT),(t+2<NT));     ENDW(t+1); RESC(); ROT();
  }
  STEP(pB0,pB1,pA0,pA1,NT-1,false,false,false); RESC();
  { float sacc=pB0[0]+pB0[1]; _Pragma("unroll") for(int r=2;r<16;++r)sacc+=pB0[r]; _Pragma("unroll") for(int r=0;r<16;++r)sacc+=pB1[r]; l_reg+=sacc;
    pw0=(u32x4){PKW(pB0,0),PKW(pB0,2),PKW(pB0,4),PKW(pB0,6)};pw1=(u32x4){PKW(pB0,8),PKW(pB0,10),PKW(pB0,12),PKW(pB0,14)};pw2=(u32x4){PKW(pB1,0),PKW(pB1,2),PKW(pB1,4),PKW(pB1,6)};pw3=(u32x4){PKW(pB1,8),PKW(pB1,10),PKW(pB1,12),PKW(pB1,14)};
    SBAR(); pv(o,vb0+sl_cur,PAF(0),PAF(1),PAF(2),PAF(3)); }
  #undef PKW
  #undef PAF
  #undef VFR
  #undef PIN
  #undef MX3
  #undef GAPA
  #undef GAPB
  #undef EX
  #undef VRD
  #undef KRD
  #undef STEP
  #undef ENDW
  {auto rr=__builtin_amdgcn_permlane32_swap(__float_as_uint(l_reg),__float_as_uint(l_reg),false,false);l_reg=__uint_as_float(rr[0])+__uint_as_float(rr[1]);}
  if(hi==0)wsf[32+r32]=l_reg;asm volatile("s_waitcnt lgkmcnt(0)":::"memory");
  float rli[16];
  #pragma unroll
  for(int r=0;r<16;++r)rli[r]=__builtin_amdgcn_rcpf(wsf[32+crow(r,hi)]);
  bf16*Ow=O+(rowbase+q0+wid*QBLK)*DM+h*D;
  { bf16*stg=(bf16*)(shm+LDS_OST)+wid*2048;
    #pragma unroll
    for(int r=0;r<16;++r){const int orow=crow(r,hi);
      #pragma unroll
      for(int d0=0;d0<2;++d0)stg[orow*64+d0*32+r32]=__float2bfloat16(o[d0][r]*rli[r]);}
    asm volatile("s_waitcnt lgkmcnt(0)":::"memory");
    #pragma unroll
    for(int i=0;i<4;++i){const int row=i*8+(lane>>3),ch=lane&7; const u32x4 v=*(const u32x4*)(stg+row*64+ch*8); ATTN_STORE16(Ow+(long)row*DM+ch*8,v);} }
  asm volatile("s_waitcnt lgkmcnt(0)\n\ts_barrier":::"memory");
  #undef DMA_K
  #undef DMA_V
  #undef CMASK
  #undef START
  #undef RESC
  #undef ROT
}
constexpr int ATTN_LDS_BYTES=LDS_BYTES;
struct AttnTensors { const bf16* Q; const bf16* K; const bf16* V; bf16* O; };
struct AttnUnit { int bh; int qb; };
template<class Sched,int THRL=8> __device__ __forceinline__ void attn_phase(char*lds,const AttnTensors&T,const Sched&S,const int tid_in){
  AttnUnit u;
  for(int i=0;S.next(i,u);++i){ S.a_ready(u); attn_unit<THRL>(u.bh/NHEAD,u.bh%NHEAD,u.qb,T.Q,T.K,T.V,T.O,lds,tid_in); S.done(u); }
}
#undef SBAR
#undef WAIT_BAR
}
constexpr int NWAVES = 8;
constexpr int BATCH = 8, SEQ = 4096, DM = 1024, M = BATCH * SEQ;
constexpr int IN_COLS = 2560, PLE_DIM = 256, NEXP = 16384, QCOLS = 2048;
constexpr float EPS = 1e-6f;
#ifndef MK_N_LAUNCHES
#define MK_N_LAUNCHES 1
#endif
constexpr int N_PHASES = 11;
constexpr size_t MiB = 1u << 20;
constexpr size_t WS_CTL = 0, CTL_ZERO_BYTES = 1 * MiB;
constexpr size_t WS_ROPEC = 1 * MiB, WS_ROPES = 1 * MiB + 512 * 1024;
constexpr size_t WS_KEYS = 2 * MiB;
constexpr size_t WS_WPROJ = 3 * MiB;
constexpr size_t WS_WIN = 4 * MiB;
constexpr size_t WS_WOUT = 10 * MiB, WS_WQ = 12 * MiB, WS_WGATE = 16 * MiB;
constexpr size_t WS_SSQ1 = 18 * MiB;
constexpr size_t WS_PB = 24 * MiB;
constexpr size_t WS_E = 40 * MiB;
constexpr size_t WS_UT = 104 * MiB, WS_VT = 120 * MiB;
constexpr size_t WS_SU = 136 * MiB, WS_SV = 137 * MiB;
constexpr size_t WS_XN = 168 * MiB;
constexpr size_t WS_QO = 232 * MiB, WS_K = 296 * MiB, WS_V = 360 * MiB;
constexpr size_t WS_U = 424 * MiB;
constexpr size_t WS_H1B = 232 * MiB;
constexpr size_t WS_QP = 296 * MiB;
constexpr size_t WS_XN2 = 424 * MiB;
constexpr size_t WS_SM = 138 * MiB, WS_HS = 139 * MiB, WS_SSQ2 = 140 * MiB;
constexpr size_t WS_HQ = 24 * MiB;
constexpr size_t WS_APART = 168 * MiB;
constexpr size_t WS_QM = 424 * MiB;
constexpr size_t WS_EID = 488 * MiB, WS_GATE = 496 * MiB;
constexpr size_t WS_END = 512 * MiB;
constexpr int RING_BYTES = 131072, LDS_BYTES = 147456;
constexpr int MISC_OFF = LDS_BYTES - 256;
constexpr int CW_BAR = 4096;

#define GAS __attribute__((address_space(1)))
#define LAS __attribute__((address_space(3)))
typedef unsigned short bf16;
typedef unsigned v4u __attribute__((ext_vector_type(4)));
typedef float f32x4 __attribute__((ext_vector_type(4)));
typedef float f32x16 __attribute__((ext_vector_type(16)));
typedef short bf16x8 __attribute__((ext_vector_type(8)));
typedef __bf16 bf16x2_t __attribute__((ext_vector_type(2)));
#define LDS_WAIT() asm volatile("s_waitcnt lgkmcnt(0)" ::: "memory")
#define VM_WAIT() asm volatile("s_waitcnt vmcnt(0)" ::: "memory")
__device__ __forceinline__ unsigned f2bf(float f) { unsigned u = __builtin_bit_cast(unsigned, f); return (u + 0x7fffu + ((u >> 16) & 1u)) >> 16; }
__device__ __forceinline__ unsigned pk2(float lo, float hi) { return f2bf(lo) | (f2bf(hi) << 16); }
__device__ __forceinline__ v4u pk8(const f32x4 a, const f32x4 b) { v4u w; w.x = pk2(a[0], a[1]); w.y = pk2(a[2], a[3]); w.z = pk2(b[0], b[1]); w.w = pk2(b[2], b[3]); return w; }
__device__ __forceinline__ float bflo(unsigned w) { return __uint_as_float(w << 16); }
__device__ __forceinline__ float bfhi(unsigned w) { return __uint_as_float(w & 0xffff0000u); }
__device__ __forceinline__ float dot4s_(const f32x4 a) { return (a[0] * a[0] + a[1] * a[1]) + (a[2] * a[2] + a[3] * a[3]); }
__device__ __forceinline__ float wave_sum(float v) {
#pragma unroll
    for (int o = 1; o < 64; o <<= 1) v += __shfl_xor(v, o);
    return v;
}
__device__ __forceinline__ float dot2bf(unsigned w, unsigned x, float acc) { return __builtin_amdgcn_fdot2_f32_bf16(__builtin_bit_cast(bf16x2_t, w), __builtin_bit_cast(bf16x2_t, x), acc, false); }

typedef GAS unsigned gu32;
#define RLX_AGENT __ATOMIC_RELAXED, __HIP_MEMORY_SCOPE_AGENT
#define XB_TMO      128
#define XB_XCNT(j)  (256  + 64 * (j))
#define XB_XSUB(j)  (1280 + 64 * (j))
#define XB_XGEN(j)  (2304 + 64 * (j))
#define XB_TOP      3328
#define XB_TOPGEN   3392
#define XCD_BAR_WORDS 3456
#define XB_SPIN_CAP (1u << 18)

__device__ __forceinline__ unsigned xb_ld(unsigned* p)              { return __hip_atomic_load(p, __ATOMIC_RELAXED, __HIP_MEMORY_SCOPE_AGENT); }
__device__ __forceinline__ unsigned xb_add(unsigned* p, unsigned v) { return __hip_atomic_fetch_add(p, v, __ATOMIC_RELAXED, __HIP_MEMORY_SCOPE_AGENT); }
__device__ __forceinline__ unsigned xb_xcc_id() { return (unsigned)__builtin_amdgcn_s_getreg((3 << 11) | 20) & 0xFu; }
#define XB_SPIN(cond, bar) do { unsigned _sp = 0; while (cond) { __builtin_amdgcn_s_sleep(1); \
    if ((++_sp & 255u) == 0u) { if (xb_ld(&(bar)[XB_TMO])) break; if (_sp > XB_SPIN_CAP) { atomicAdd(&(bar)[XB_TMO], 1u); break; } } } } while (0)

struct XcdBarrier {
    unsigned* bar; unsigned x;
    volatile LAS unsigned* st;
};

__device__ __forceinline__ XcdBarrier xcd_barrier_post(unsigned* bar, volatile LAS unsigned* st, const bool leader) {
    XcdBarrier b; b.bar = bar; b.x = xb_xcc_id(); b.st = st;
    if (leader) (void)xb_add(&bar[XB_XCNT(b.x)], 1u);
    return b;
}
__device__ __forceinline__ void xcd_barrier_complete(unsigned* bar, unsigned x, unsigned& nloc, unsigned& nx) {
    const unsigned G = gridDim.x * gridDim.y * gridDim.z;
    unsigned sum, cnt, mine, sp = 0u;
    for (;;) {
        sum = 0u; cnt = 0u; mine = 0u;
#pragma unroll
        for (unsigned j = 0; j < 16; ++j) { const unsigned c = xb_ld(&bar[XB_XCNT(j)]); sum += c; cnt += (c > 0u) ? 1u : 0u; mine = (j == x) ? c : mine; }
        if (sum == G) break;
        __builtin_amdgcn_s_sleep(1);
        if ((++sp & 255u) == 0u) { if (xb_ld(&bar[XB_TMO])) break; if (sp > XB_SPIN_CAP) { atomicAdd(&bar[XB_TMO], 1u); break; } }
    }
    nloc = mine > 0u ? mine : 1u; nx = cnt > 0u ? cnt : 1u;
}

__device__ __forceinline__ void xcd_barrier(const XcdBarrier& b, const bool leader  ) {
    asm volatile("s_waitcnt vmcnt(0)" ::: "memory");
    __syncthreads();
    if (leader) {
        unsigned* bar = b.bar;
        __builtin_amdgcn_s_waitcnt(0);
        unsigned nloc = b.st[0], nx = b.st[1];
        if (nloc == 0u) { xcd_barrier_complete(bar, b.x, nloc, nx); b.st[0] = nloc; b.st[1] = nx; }
        const unsigned old = xb_add(&bar[XB_XSUB(b.x)], 1u);
        const unsigned gen = old / nloc;
        if (old + 1u == (gen + 1u) * nloc) {
            __builtin_amdgcn_fence(__ATOMIC_RELEASE, "agent");
            asm volatile("s_waitcnt vmcnt(0)" ::: "memory");
            const unsigned og = xb_add(&bar[XB_TOP], 1u);
            const unsigned tg = og / nx;
            if (og + 1u == (tg + 1u) * nx) xb_add(&bar[XB_TOPGEN], 1u);
            else XB_SPIN(xb_ld(&bar[XB_TOPGEN]) == tg, bar);
            __builtin_amdgcn_fence(__ATOMIC_ACQUIRE, "agent");
            xb_add(&bar[XB_XGEN(b.x)], 1u);
            asm volatile("s_waitcnt vmcnt(0)" ::: "memory");
        } else {
            XB_SPIN(xb_ld(&bar[XB_XGEN(b.x)]) == gen, bar);
            __builtin_amdgcn_fence(__ATOMIC_ACQUIRE, "agent");
            asm volatile("s_waitcnt vmcnt(0)" ::: "memory");
        }
    }
    __syncthreads();
}

__device__ __forceinline__ int lane_id() { int l; asm volatile("v_mbcnt_lo_u32_b32 %0, -1, 0\n\tv_mbcnt_hi_u32_b32 %0, -1, %0" : "=v"(l)); return l; }
#if defined(PROBE_A)
#define STAMP(i) do { if (F.wave == 0) { const unsigned long long t_ = __builtin_amdgcn_s_memrealtime(); volatile LAS unsigned* ms_ = (volatile LAS unsigned*)(F.lds + MISC_OFF) + 16 + 2 * (i); ms_[0] = (unsigned)t_; ms_[1] = (unsigned)(t_ >> 32); } } while (0)
#else
#define STAMP(i) do {} while (0)
#endif
struct Frame {
    LAS unsigned char* lds; unsigned char* ldsg;
    int wave, vcu, G;
    float* out; unsigned char* ws;
};
template <int I> __device__ __forceinline__ const float* inptr() {
    const float* p = nullptr;
#if defined(__HIP_DEVICE_COMPILE__)
    const void* ka = (const void*)__builtin_amdgcn_kernarg_segment_ptr();
    asm volatile("s_load_dwordx2 %0, %1, %2\n\ts_waitcnt lgkmcnt(0)" : "=s"(p) : "s"(ka), "i"(I * 8) : "memory");
#endif
    return p;
}
#define INP(i) inptr<i>()

__device__ const double INVREV[32] = {0.15915494309189535, 0.11934937021124886, 0.089499401608891013, 0.067115083005227255, 0.050329212104487035, 0.037741584717419771, 0.028302195830623399, 0.02122365276477766,
    0.015915494309189534, 0.011934937021124886, 0.0089499401608891024, 0.0067115083005227253, 0.0050329212104487037, 0.0037741584717419772, 0.0028302195830623399, 0.0021223652764777662,
    0.0015915494309189536, 0.0011934937021124885, 0.00089499401608891024, 0.0006711508300522726, 0.00050329212104487033, 0.00037741584717419774, 0.00028302195830623395, 0.00021223652764777661,
    0.00015915494309189535, 0.00011934937021124886, 8.9499401608891018e-05, 6.7115083005227254e-05, 5.0329212104487035e-05, 3.7741584717419777e-05, 2.8302195830623396e-05, 2.1223652764777659e-05};
__device__ __forceinline__ int win_rowmap(int n) {
    if (n < 1024) { const int region = n >> 9, r = n & 511, tile = r >> 8, w = r & 255, blk = w >> 6, d = w & 63, bj = d >> 5, dlo = d & 31; return region * 512 + tile * 256 + bj * 128 + blk * 32 + dlo; }
    if (n < 1536) return n;
    const int cc = n - 1536, isg = cc >> 9, ch = cc & 511, j = ch >> 7, c2 = ch & 127; return 1536 + j * 256 + isg * 128 + c2;
}
template <bool MAP>
__device__ __forceinline__ void p0_transpose_item(const float* W, int K, int N, bf16* WT, const float* gk, LAS float* scr, int item, int lane) {
    const int nblk = N / 32, kb = item / nblk, nb = item % nblk, k0 = 64 * kb, n0 = 32 * nb;
    float wv[32];
#pragma unroll
    for (int i = 0; i < 32; ++i) { const int kk = 2 * i + (lane >> 5); wv[i] = W[(size_t)(k0 + kk) * N + n0 + (lane & 31)]; }
    if (gk) {
#pragma unroll
        for (int i = 0; i < 32; ++i) wv[i] *= gk[k0 + 2 * i + (lane >> 5)]; }
#pragma unroll
    for (int i = 0; i < 32; ++i) { const int kk = 2 * i + (lane >> 5); scr[kk * 33 + (lane & 31)] = wv[i]; }
    LDS_WAIT(); asm volatile("" ::: "memory");
    const int c = lane & 7; const int r0 = MAP ? win_rowmap(n0) : n0;
#pragma unroll
    for (int j = 0; j < 4; ++j) { const int n = (lane >> 3) + 8 * j; const LAS float* s = scr + (8 * c) * 33 + n;
        v4u o; o.x = pk2(s[0 * 33], s[1 * 33]); o.y = pk2(s[2 * 33], s[3 * 33]); o.z = pk2(s[4 * 33], s[5 * 33]); o.w = pk2(s[6 * 33], s[7 * 33]);
        *(GAS v4u*)(WT + (size_t)(r0 + n) * K + k0 + 8 * c) = o; }
    LDS_WAIT(); asm volatile("" ::: "memory");
}
__device__ __forceinline__ void cvt_stream(const float* src, bf16* dst, size_t n8, int gw, int NGW, int lane) {
    for (size_t c = (size_t)gw * 64 + lane; c < n8; c += (size_t)NGW * 64) { const f32x4 a = *(const GAS f32x4*)(src + c * 8), b = *(const GAS f32x4*)(src + c * 8 + 4); *(GAS v4u*)(dst + c * 8) = pk8(a, b); }
}
__device__ __forceinline__ void p0_prologue(Frame& F) {
    const int lane = lane_id();
    LAS float* scr = (LAS float*)(F.lds + F.wave * 16384);
    const int gw = F.vcu * NWAVES + F.wave, NGW = F.G * NWAVES;
    bf16* WIN = (bf16*)(F.ws + WS_WIN); bf16* WOUT = (bf16*)(F.ws + WS_WOUT); bf16* WQ = (bf16*)(F.ws + WS_WQ); bf16* WGATE = (bf16*)(F.ws + WS_WGATE); bf16* WPROJ = (bf16*)(F.ws + WS_WPROJ);
    constexpr int I_IN = (DM / 64) * (IN_COLS / 32), I_OUT = (DM / 64) * (DM / 32), I_Q = (DM / 64) * (QCOLS / 32), I_G = I_OUT, I_P = (PLE_DIM / 64) * (DM / 32);
    constexpr int NITEMS = I_IN + I_OUT + I_Q + I_G + I_P;
    for (int it = gw; it < NITEMS; it += NGW) {
        int r = it;
        if (r < I_IN) { p0_transpose_item<true>(INP(3), DM, IN_COLS, WIN, nullptr, scr, r, lane); continue; } r -= I_IN;
        if (r < I_OUT) { p0_transpose_item<false>(INP(13), DM, DM, WOUT, nullptr, scr, r, lane); continue; } r -= I_OUT;
        if (r < I_Q) { p0_transpose_item<false>(INP(15), DM, QCOLS, WQ, INP(14), scr, r, lane); continue; } r -= I_Q;
        if (r < I_G) { p0_transpose_item<false>(INP(20), DM, DM, WGATE, INP(19), scr, r, lane); continue; } r -= I_G;
        p0_transpose_item<false>(INP(21), PLE_DIM, DM, WPROJ, nullptr, scr, r, lane);
    }
    STAMP(17);
    cvt_stream(INP(16), (bf16*)(F.ws + WS_KEYS), (size_t)2 * 128 * 128 / 8, gw, NGW, lane);
    { const float* ut = INP(17); const float* vt = INP(18); float* SU = (float*)(F.ws + WS_SU); float* SV = (float*)(F.ws + WS_SV);
      for (int r0 = gw; r0 < 2 * NEXP; r0 += 4 * NGW) {
          f32x4 v[4][4];
#pragma unroll
          for (int u = 0; u < 4; ++u) { const int r = r0 + u * NGW; const bool isv = r >= NEXP; const int e = isv ? r - NEXP : r; const float* src = (isv ? vt : ut) + (size_t)e * DM + 16 * lane;
#pragma unroll
              for (int i = 0; i < 4; ++i) v[u][i] = *(const GAS f32x4*)(src + 4 * i); }
#pragma unroll
          for (int u = 0; u < 4; ++u) { const int r = r0 + u * NGW; const bool isv = r >= NEXP; const int e = isv ? r - NEXP : r; float amax = 0.f;
#pragma unroll
              for (int i = 0; i < 4; ++i) amax = fmaxf(amax, fmaxf(fmaxf(__builtin_fabsf(v[u][i][0]), __builtin_fabsf(v[u][i][1])), fmaxf(__builtin_fabsf(v[u][i][2]), __builtin_fabsf(v[u][i][3]))));
#pragma unroll
              for (int o = 1; o < 64; o <<= 1) amax = fmaxf(amax, __shfl_xor(amax, o));
              const float inv = 127.f / fmaxf(amax, 1e-30f); v4u w;
#pragma unroll
              for (int i = 0; i < 4; ++i) { const int a = (int)__builtin_rintf(v[u][i][0] * inv), b = (int)__builtin_rintf(v[u][i][1] * inv), c = (int)__builtin_rintf(v[u][i][2] * inv), d = (int)__builtin_rintf(v[u][i][3] * inv);
                  w[i] = (unsigned)(a & 0xff) | ((unsigned)(b & 0xff) << 8) | ((unsigned)(c & 0xff) << 16) | ((unsigned)d << 24); }
              *(GAS v4u*)(F.ws + (isv ? WS_VT : WS_UT) + ((size_t)(lane >> 3) * NEXP + e) * 128 + 16 * (lane & 7)) = w;
              if (lane == 0) (isv ? SV : SU)[e] = amax * (1.f / 127.f); } } }
    STAMP(18);
    cvt_stream(INP(1), (bf16*)(F.ws + WS_PB), (size_t)M * PLE_DIM / 8, gw, NGW, lane);
    STAMP(19);
    { float* rc = (float*)(F.ws + WS_ROPEC); float* rs = (float*)(F.ws + WS_ROPES);
      for (int idx = gw * 64 + lane; idx < SEQ * 32; idx += NGW * 64) { const int pos = idx >> 5, i = idx & 31; const double rev = (double)pos * INVREV[i]; const float fr = (float)(rev - __builtin_floor(rev));
          rc[idx] = __builtin_amdgcn_cosf(fr); rs[idx] = __builtin_amdgcn_sinf(fr); } }
    STAMP(20);
    { const float* x = INP(0); const float* g = INP(2); bf16* XN = (bf16*)(F.ws + WS_XN);
      f32x4 gv[4];
#pragma unroll
      for (int j = 0; j < 4; ++j) gv[j] = ((const GAS f32x4*)g)[64 * j + lane];
      for (int m0 = gw; m0 < M; m0 += 4 * NGW) {
          f32x4 v[4][4];
#pragma unroll
          for (int u = 0; u < 4; ++u) { const GAS f32x4* xr = (const GAS f32x4*)(x + (size_t)(m0 + u * NGW) * DM) + lane;
#pragma unroll
              for (int j = 0; j < 4; ++j) v[u][j] = xr[64 * j]; }
#pragma unroll
          for (int u = 0; u < 4; ++u) { float s2 = 0.f;
#pragma unroll
              for (int j = 0; j < 4; ++j) s2 += (v[u][j].x * v[u][j].x + v[u][j].y * v[u][j].y) + (v[u][j].z * v[u][j].z + v[u][j].w * v[u][j].w);
              const float rstd = rsqrtf(wave_sum(s2) * (1.f / DM) + EPS);
              GAS unsigned long long* o8 = (GAS unsigned long long*)(XN + (size_t)(m0 + u * NGW) * DM) + lane;
#pragma unroll
              for (int j = 0; j < 4; ++j) { const f32x4 w = v[u][j] * rstd * gv[j]; o8[64 * j] = (unsigned long long)pk2(w.x, w.y) | ((unsigned long long)pk2(w.z, w.w) << 32); } } } }
}

struct AttnOrder {
    int vcu;
    __device__ __forceinline__ bool next(int i, attn_body::AttnUnit& u) const { if (i >= 8) return false; const int s = vcu & 7; u.bh = (vcu >> 5) * 16 + ((vcu >> 3) & 3) * 4 + (i & 3); u.qb = (i < 4) ? 15 - s : s; return true; }
    __device__ __forceinline__ void a_ready(const attn_body::AttnUnit&) const {}
    __device__ __forceinline__ void done(const attn_body::AttnUnit&) const {}
};
__device__ __forceinline__ void p2_attention(Frame& F) {
    { const attn_body::AttnTensors AT{(const attn_body::bf16*)(F.ws + WS_QO), (const attn_body::bf16*)(F.ws + WS_K), (const attn_body::bf16*)(F.ws + WS_V), (attn_body::bf16*)(F.ws + WS_QO)};
      const AttnOrder S{F.vcu};
      attn_body::attn_phase<AttnOrder>((char*)F.ldsg, AT, S, F.wave * 64 + lane_id()); }
    VM_WAIT(); __syncthreads(); STAMP(12);
    const int lane = lane_id();
    const float s1 = wave_sum(INP(4)[lane] * INP(5)[lane]), s2 = wave_sum(INP(6)[lane] * INP(7)[lane]);
    const float lam = __expf(s1) - __expf(s2) + 0.2f;
    const float* sg = INP(8); const float g0 = sg[2 * lane] * 0.8f, g1 = sg[2 * lane + 1] * 0.8f;
    const unsigned* O32 = (const unsigned*)(F.ws + WS_QO); unsigned* A2 = (unsigned*)(F.ws + WS_XN);
    const int b = F.vcu >> 5, h = (F.vcu >> 3) & 3, s = F.vcu & 7;
    for (int i = 0; i < 2; ++i) { const int qb = (i == 0) ? 15 - s : s;
        const size_t rbase = (size_t)b * SEQ + (size_t)qb * 256 + F.wave * 32;
        for (int r = 0; r < 32; r += 4) {
            unsigned w0[4], w1[4];
#pragma unroll
            for (int u = 0; u < 4; ++u) { const size_t row = rbase + r + u; w0[u] = __builtin_nontemporal_load(O32 + row * 512 + (h * 4 + 0 + (lane >> 5)) * 32 + (lane & 31)); w1[u] = __builtin_nontemporal_load(O32 + row * 512 + (h * 4 + 2 + (lane >> 5)) * 32 + (lane & 31)); }
#pragma unroll
            for (int u = 0; u < 4; ++u) { const size_t row = rbase + r + u;
                const float d0 = bflo(w0[u]) - lam * bflo(w1[u]), d1 = bfhi(w0[u]) - lam * bfhi(w1[u]);
                const float rstd = rsqrtf(wave_sum(d0 * d0 + d1 * d1) * (1.f / 128.f) + EPS);
                A2[row * 512 + h * 64 + lane] = pk2(d0 * rstd * g0, d1 * rstd * g1); } } }
}
__device__ __forceinline__ void p2_conv(Frame& F) {
    const bf16* Ub = (const bf16*)(F.ws + WS_U); bf16* A2 = (bf16*)(F.ws + WS_XN);
    LAS float* yl = (LAS float*)F.lds;
    const int lane = lane_id(); const int c = F.wave * 64 + lane;
    float w[31];
    { const float* cw = INP(9);
#pragma unroll
      for (int j = 0; j < 31; ++j) w[j] = cw[j * 512 + c]; }
    const float bias = INP(10)[c];
    const float* lng = INP(11); const float* lnb = INP(12);
    const f32x4 lg0 = *(const f32x4*)(lng + 8 * lane), lg1 = *(const f32x4*)(lng + 8 * lane + 4), lb0 = *(const f32x4*)(lnb + 8 * lane), lb1 = *(const f32x4*)(lnb + 8 * lane + 4);
    for (int tile = F.vcu; tile < M / 32; tile += F.G) {
        const int t0 = tile * 32, pos0 = t0 & (SEQ - 1);
        float xin[62];
#pragma unroll
        for (int r = 0; r < 62; ++r) { const int p = pos0 - 30 + r; xin[r] = (p >= 0) ? __uint_as_float((unsigned)Ub[(size_t)(t0 - 30 + r) * 512 + c] << 16) : 0.f; }
#pragma unroll
        for (int t = 0; t < 32; ++t) { float y = bias;
#pragma unroll
            for (int j = 0; j < 31; ++j) y += w[j] * xin[t + j];
            yl[t * 512 + c] = y; }
        __syncthreads();
#pragma unroll
        for (int q = 0; q < 4; ++q) { const int t = F.wave * 4 + q;
            const f32x4 a = *(const LAS f32x4*)(yl + t * 512 + 8 * lane), b2 = *(const LAS f32x4*)(yl + t * 512 + 8 * lane + 4);
            const float mean = wave_sum((a[0] + a[1]) + (a[2] + a[3]) + (b2[0] + b2[1]) + (b2[2] + b2[3])) * (1.f / 512.f);
            const f32x4 da = a - mean, db = b2 - mean;
            const float var = wave_sum((da[0] * da[0] + da[1] * da[1]) + (da[2] * da[2] + da[3] * da[3]) + (db[0] * db[0] + db[1] * db[1]) + (db[2] * db[2] + db[3] * db[3])) * (1.f / 512.f);
            const float rstd = rsqrtf(var + EPS);
            f32x4 oa = da * rstd * lg0 + lb0, ob = db * rstd * lg1 + lb1;
#pragma unroll
            for (int e = 0; e < 4; ++e) { oa[e] = oa[e] * __builtin_amdgcn_rcpf(1.0f + __expf(-oa[e])); ob[e] = ob[e] * __builtin_amdgcn_rcpf(1.0f + __expf(-ob[e])); }
            *(GAS v4u*)(A2 + (size_t)(t0 + t) * 1024 + 512 + 8 * lane) = pk8(oa, ob); }
        __syncthreads();
    }
}
__device__ __forceinline__ int crow16(int r, int hi) { return (r & 3) + 8 * (r >> 2) + 4 * hi; }
__device__ __forceinline__ unsigned enc_key(float f, unsigned tag, unsigned mask) { unsigned u = __float_as_uint(f); u = (u & 0x80000000u) ? ~u : (u | 0x80000000u); return (u & ~mask) | tag; }
__device__ __forceinline__ float dec_key(unsigned k, unsigned mask) { unsigned u = k & ~mask; u = (u & 0x80000000u) ? (u & 0x7fffffffu) : ~u; return __uint_as_float(u); }
__device__ __forceinline__ void ce_desc(unsigned& a, unsigned& b) { const unsigned mx = a > b ? a : b, mn = a > b ? b : a; a = mx; b = mn; }
template <int K, int J> __device__ __forceinline__ void bitonic_stage16(unsigned (&a)[16]) {
#pragma unroll
    for (int i = 0; i < 16; ++i) { const int l = i ^ J; if (l > i) { if ((i & K) == 0) ce_desc(a[i], a[l]); else ce_desc(a[l], a[i]); } }
}
__device__ __forceinline__ void sort16_desc(unsigned (&a)[16]) {
    bitonic_stage16<2, 1>(a); bitonic_stage16<4, 2>(a); bitonic_stage16<4, 1>(a); bitonic_stage16<8, 4>(a); bitonic_stage16<8, 2>(a); bitonic_stage16<8, 1>(a);
    bitonic_stage16<16, 8>(a); bitonic_stage16<16, 4>(a); bitonic_stage16<16, 2>(a); bitonic_stage16<16, 1>(a);
}
__device__ __forceinline__ void merge16_desc(unsigned (&a)[16], const unsigned (&b)[16]) {
#pragma unroll
    for (int i = 0; i < 16; ++i) a[i] = a[i] > b[15 - i] ? a[i] : b[15 - i];
    bitonic_stage16<16, 8>(a); bitonic_stage16<16, 4>(a); bitonic_stage16<16, 2>(a); bitonic_stage16<16, 1>(a);
}
__device__ __forceinline__ void top16_of_64(unsigned (&k)[4][16]) {
    sort16_desc(k[0]); sort16_desc(k[1]); sort16_desc(k[2]); sort16_desc(k[3]);
    merge16_desc(k[0], k[1]); merge16_desc(k[2], k[3]); merge16_desc(k[0], k[2]);
}
__host__ __device__ constexpr int cand_i(int s) { int c = 0; for (int i = 0; i < 16; ++i) { const int nj = 16 / (i + 1); if (s < c + nj) return i; c += nj; } return -1; }
__host__ __device__ constexpr int cand_j(int s) { int c = 0; for (int i = 0; i < 16; ++i) { const int nj = 16 / (i + 1); if (s < c + nj) return s - c; c += nj; } return -1; }
template <int S> __device__ __forceinline__ void cand_fill(unsigned (&c)[4][16], const float (&v0)[16], const float (&v1)[16]) {
    if constexpr (S < 64) { constexpr int i = cand_i(S), j = cand_j(S);
        if constexpr (i >= 0) c[S >> 4][S & 15] = enc_key(v0[i] + v1[j], 255u - (unsigned)(i * 16 + j), 255u); else c[S >> 4][S & 15] = 0u;
        cand_fill<S + 1>(c, v0, v1); }
}
__device__ __forceinline__ float gelu_exact(float v) {
    const float av = __builtin_fabsf(v), d = av * 0.2316418882f + 1.0f, t = __builtin_amdgcn_rcpf(d);
    float q = t * 0.5307027145f + (-0.7265760135f); q = q * t + 0.7107068705f; q = q * t + (-0.142248368f); q = q * t + 0.127414796f; q = q * t;
    const float e = __builtin_amdgcn_exp2f((v * v) * (-0.72134752044f)); const float m = v * (q * e); return v < 0.f ? m : v - m;
}
typedef float f32x2 __attribute__((ext_vector_type(2)));
__device__ __forceinline__ float ub0(unsigned w) { return (float)(w & 0xffu); }
__device__ __forceinline__ float ub1(unsigned w) { return (float)((w >> 8) & 0xffu); }
__device__ __forceinline__ float ub2(unsigned w) { return (float)((w >> 16) & 0xffu); }
__device__ __forceinline__ float ub3(unsigned w) { return (float)(w >> 24); }
__device__ __forceinline__ float wave_max(float v) {
#pragma unroll
    for (int o = 1; o < 64; o <<= 1) v = fmaxf(v, __shfl_xor(v, o));
    return v;
}
__device__ __forceinline__ int reduce8(const int (&p)[8], int lane) {
    const bool b0 = lane & 1, b1 = lane & 2, b2 = lane & 4;
    int q[4], r[2];
#pragma unroll
    for (int i = 0; i < 4; ++i) { const int keep = b0 ? p[2 * i + 1] : p[2 * i], send = b0 ? p[2 * i] : p[2 * i + 1]; q[i] = keep + __builtin_amdgcn_update_dpp(0, send, 0xB1, 0xF, 0xF, true); }
#pragma unroll
    for (int i = 0; i < 2; ++i) { const int keep = b1 ? q[2 * i + 1] : q[2 * i], send = b1 ? q[2 * i] : q[2 * i + 1]; r[i] = keep + __builtin_amdgcn_update_dpp(0, send, 0x4E, 0xF, 0xF, true); }
    int s; { const int keep = b2 ? r[1] : r[0], send = b2 ? r[0] : r[1]; s = keep + __builtin_amdgcn_ds_swizzle(send, 0x101F); }
    s += __builtin_amdgcn_ds_swizzle(s, 0x201F); s += __builtin_amdgcn_ds_swizzle(s, 0x401F);
    { const auto rr = __builtin_amdgcn_permlane32_swap((unsigned)s, (unsigned)s, false, false); s = (int)rr[0] + (int)rr[1]; }
    return s;
}
constexpr int P5_TOK = 32;
constexpr int P5_KEYS = 0, P5_LS = 65536, P5_EID = 65536 + 33792, P5_GATE = 65536 + 33792 + 16384;
__device__ __forceinline__ void p5a_topk(Frame& F) {
    const bf16* QP = (const bf16*)(F.ws + WS_QP); const bf16* KEYS = (const bf16*)(F.ws + WS_KEYS);
    LAS unsigned* lsc = (LAS unsigned*)(F.lds + P5_LS) + (F.wave * 32 + (lane_id() & 31)) * 33; LAS unsigned* eidL = (LAS unsigned*)(F.lds + P5_EID); LAS float* gateL = (LAS float*)(F.lds + P5_GATE);
    const int lane = lane_id(), tid = F.wave * 64 + lane, r32 = lane & 31, hi = lane >> 5, h = F.wave;
    const float* gffn = INP(14);
#pragma unroll
    for (int i = 0; i < 8; ++i) { const int q = tid + 512 * i, row = q >> 4, ch = q & 15; *(LAS v4u*)(F.lds + P5_KEYS + row * 256 + ((ch ^ (row & 15)) << 4)) = *(const GAS v4u*)(KEYS + row * 128 + ch * 8); }
    __syncthreads();
    const LAS unsigned char* kl = F.lds + P5_KEYS + r32 * 256;
    for (int tile = F.vcu; tile < M / P5_TOK; tile += F.G) {
        const size_t t0 = (size_t)tile * P5_TOK;
        float sv[2][16];
#pragma unroll
        for (int c = 0; c < 2; ++c) {
            bf16x8 qf[8];
#pragma unroll
            for (int ks = 0; ks < 8; ++ks) qf[ks] = *(const bf16x8*)(QP + (t0 + r32) * QCOLS + h * 256 + c * 128 + ks * 16 + hi * 8);
            unsigned key[4][16];
#pragma unroll
            for (int nb = 0; nb < 4; ++nb) { f32x16 acc = {}; asm volatile("" ::: "memory");
#pragma unroll
                for (int ks = 0; ks < 8; ++ks) { const bf16x8 kf = *(const LAS bf16x8*)(kl + (c * 128 + nb * 32) * 256 + (((ks * 2 + hi) ^ (r32 & 15)) << 4)); acc = __builtin_amdgcn_mfma_f32_32x32x16_bf16(kf, qf[ks], acc, 0, 0, 0); }
#pragma unroll
                for (int r = 0; r < 16; ++r) key[nb][r] = enc_key(acc[r], 127u - (unsigned)(nb * 32 + crow16(r, hi)), 127u); }
            top16_of_64(key);
            unsigned other[16];
#pragma unroll
            for (int i = 0; i < 16; ++i) other[i] = __shfl_xor(key[0][i], 32);
            merge16_desc(key[0], other);
#pragma unroll
            for (int i = 0; i < 16; ++i) { sv[c][i] = dec_key(key[0][i], 127u); if (hi == 0) lsc[c * 16 + i] = key[0][i]; }
        }
        asm volatile("" ::: "memory");
        unsigned cand[4][16];
        cand_fill<0>(cand, sv[0], sv[1]);
        top16_of_64(cand);
        LDS_WAIT();
        { float wv[16]; float wsum = 0.f; const float mx = dec_key(cand[0][0], 255u);
#pragma unroll
          for (int k = 0; k < 16; ++k) { wv[k] = __expf(dec_key(cand[0][k], 255u) - mx); wsum += wv[k]; }
          const float rs = 1.0f / wsum;
#pragma unroll
          for (int k = 0; k < 16; ++k) { const unsigned id = 255u - (cand[0][k] & 255u); const unsigned k0 = lsc[id >> 4], k1 = lsc[16 + (id & 15u)];
              const unsigned e = (127u - (k0 & 127u)) * 128u + (127u - (k1 & 127u));
              if (hi == 0) { eidL[r32 * 128 + h * 16 + k] = e; gateL[r32 * 128 + h * 16 + k] = wv[k] * rs; } } }
        __syncthreads();
        { const int token = tid >> 4, seg = tid & 15; const LAS unsigned* es = eidL + token * 128 + seg * 8; const LAS float* gs = gateL + token * 128 + seg * 8;
          v4u w; w.x = es[0] | (es[1] << 16); w.y = es[2] | (es[3] << 16); w.z = es[4] | (es[5] << 16); w.w = es[6] | (es[7] << 16);
          *(GAS v4u*)(F.ws + WS_EID + (t0 + token) * 256 + seg * 16) = w;
          *(GAS f32x4*)(F.ws + WS_GATE + (t0 + token) * 512 + seg * 32) = *(const LAS f32x4*)gs; *(GAS f32x4*)(F.ws + WS_GATE + (t0 + token) * 512 + seg * 32 + 16) = *(const LAS f32x4*)(gs + 4); }
        { f32x4 hv[4][4];
#pragma unroll
          for (int j = 0; j < 4; ++j) { const float* hrow = F.out + (t0 + F.wave * 4 + j) * DM;
#pragma unroll
              for (int i = 0; i < 4; ++i) hv[j][i] = *(const f32x4*)(hrow + 16 * lane + 4 * i); }
          f32x4 gv[4];
#pragma unroll
          for (int i = 0; i < 4; ++i) gv[i] = *(const f32x4*)(gffn + 16 * lane + 4 * i);
#pragma unroll
          for (int j = 0; j < 4; ++j) { const size_t tok = t0 + F.wave * 4 + j;
            const float rstd1 = rsqrtf(wave_sum(dot4s_(hv[j][0]) + dot4s_(hv[j][1]) + dot4s_(hv[j][2]) + dot4s_(hv[j][3])) * (1.f / DM) + EPS);
            f32x4 mv[4]; float amax = 0.f;
#pragma unroll
            for (int i = 0; i < 4; ++i) { mv[i] = hv[j][i] * rstd1 * gv[i];
                amax = fmaxf(amax, fmaxf(fmaxf(__builtin_fabsf(mv[i][0]), __builtin_fabsf(mv[i][1])), fmaxf(__builtin_fabsf(mv[i][2]), __builtin_fabsf(mv[i][3])))); }
            amax = wave_max(amax); const float inv = 127.f / fmaxf(amax, 1e-30f); v4u qm;
#pragma unroll
            for (int i = 0; i < 4; ++i) { const int a = (int)__builtin_rintf(mv[i][0] * inv), b = (int)__builtin_rintf(mv[i][1] * inv), c = (int)__builtin_rintf(mv[i][2] * inv), d = (int)__builtin_rintf(mv[i][3] * inv);
                qm[i] = (unsigned)(a & 0xff) | ((unsigned)(b & 0xff) << 8) | ((unsigned)(c & 0xff) << 16) | ((unsigned)d << 24); }
            *(GAS v4u*)(F.ws + WS_QM + ((size_t)(lane >> 3) * M + tok) * 128 + 16 * (lane & 7)) = qm;
            if (lane == 0) ((float*)(F.ws + WS_SM))[tok] = amax * (1.f / 127.f);
          } }
        __syncthreads();
    }
}
__device__ __forceinline__ int xl1(int v) { return __builtin_amdgcn_update_dpp(0, v, 0xB1, 0xF, 0xF, true); }
__device__ __forceinline__ int xl2(int v) { return __builtin_amdgcn_update_dpp(0, v, 0x4E, 0xF, 0xF, true); }
__device__ __forceinline__ int xl4(int v) { return __builtin_amdgcn_ds_swizzle(v, 0x101F); }
__device__ __forceinline__ int xl8(int v) { return __builtin_amdgcn_ds_swizzle(v, 0x201F); }
__device__ __forceinline__ int xl16(int v) { return __builtin_amdgcn_ds_swizzle(v, 0x401F); }
__device__ __forceinline__ int xl32(int v, bool hi) { const auto rr = __builtin_amdgcn_permlane32_swap((unsigned)v, (unsigned)v, false, false); return (int)(hi ? rr[0] : rr[1]); }
__device__ __forceinline__ float fxl8(float v) { return __int_as_float(xl8(__float_as_int(v))); }
__device__ __forceinline__ float fxl16(float v) { return __int_as_float(xl16(__float_as_int(v))); }
__device__ __forceinline__ float fxl32(float v, bool hi) { return __int_as_float(xl32(__float_as_int(v), hi)); }
#define TSTEP(dst, src, n, c, XF) _Pragma("unroll") for (int ni_ = 0; ni_ < (n) / 2; ++ni_) { const int i_ = (ni_ & 1) | ((ni_ >> 1) << 2); const auto lo_ = src[i_], hi_ = src[i_ + 2]; dst[ni_] = ((c) ? hi_ : lo_) + XF((c) ? lo_ : hi_); }

#define ASM_LD16(dst, ptr) asm volatile("global_load_dwordx4 %0, %1, off" : "+v"(dst) : "v"(ptr) : "memory")
#define ASM_LD8(dst, ptr) asm volatile("global_load_dwordx2 %0, %1, off" : "+v"(dst) : "v"(ptr) : "memory")
#define ASM_LD4(dst, ptr) asm volatile("global_load_dword %0, %1, off" : "+v"(dst) : "v"(ptr) : "memory")
#define ASM_WAIT4(N, a, b, c, d) asm volatile("s_waitcnt vmcnt(" #N ")" : "+v"(a), "+v"(b), "+v"(c), "+v"(d) :: "memory")
#define ASM_WAIT5(N, a, b, c, d, e) asm volatile("s_waitcnt vmcnt(" #N ")" : "+v"(a), "+v"(b), "+v"(c), "+v"(d), "+v"(e) :: "memory")
__device__ __forceinline__ void p5b_udot(Frame& F) {
    const int lane = lane_id(), g = lane >> 3, s = lane & 7;
    const int x = blockIdx.x & 7, rk = blockIdx.x >> 3, nrk = F.G >> 3;
    const unsigned char* UTs = F.ws + WS_UT + (size_t)x * NEXP * 128 + 16 * s; const unsigned char* QMs = F.ws + WS_QM + (size_t)x * M * 128 + 16 * s; const unsigned char* EIDs = F.ws + WS_EID + 32 * g;
    int* AP = (int*)(F.ws + WS_APART) + (size_t)x * M * 128 + 2 * lane;
    const bool c0 = s & 1, c1 = s & 2, c2 = s & 4;
    const int nT = M / nrk; LAS unsigned* qctr = (LAS unsigned*)(F.lds + MISC_OFF) + 62;
#define P5_PULL(jv, tv) do { unsigned j_ = 0; if (lane == 0) j_ = __hip_atomic_fetch_add(qctr, 1u, __ATOMIC_RELAXED, __HIP_MEMORY_SCOPE_WORKGROUP); jv = (int)__builtin_amdgcn_readfirstlane(j_); tv = rk + nrk * (jv < nT ? jv : nT - 1); } while (0)
#define P5B_E(i, E0, E1) ((((i) & 1) ? (((i) < 8 ? E0[(i) >> 1] : E1[((i) - 8) >> 1]) >> 16) : (((i) < 8 ? E0[(i) >> 1] : E1[((i) - 8) >> 1]) & 0xffffu)))
#define P5B_LDMETA(E0, E1, Q, tq_, te_) do { ASM_LD16(E0, EIDs + (size_t)(te_) * 256); ASM_LD16(E1, EIDs + (size_t)(te_) * 256 + 16); ASM_LD16(Q, QMs + (size_t)(tq_) * 128); } while (0)
#define P5B_ITER(RR, E0, E1, Q, tcur, tq, te) do { int p_[16]; \
        asm volatile("s_waitcnt vmcnt(19)" : "+v"(E0), "+v"(E1), "+v"(Q) :: "memory"); \
        _Pragma("unroll") for (int b = 0; b < 4; ++b) { \
            ASM_WAIT4(34, RR[4 * b], RR[4 * b + 1], RR[4 * b + 2], RR[4 * b + 3]); __builtin_amdgcn_sched_barrier(0); \
            _Pragma("unroll") for (int j = 0; j < 4; ++j) { const int i = 4 * b + j; p_[i] = __builtin_amdgcn_sdot4((int)RR[i].x, (int)Q.x, __builtin_amdgcn_sdot4((int)RR[i].y, (int)Q.y, __builtin_amdgcn_sdot4((int)RR[i].z, (int)Q.z, __builtin_amdgcn_sdot4((int)RR[i].w, (int)Q.w, 0, false), false), false), false); } \
            __builtin_amdgcn_sched_barrier(0); \
            _Pragma("unroll") for (int j = 0; j < 4; ++j) { const int i = 4 * b + j; ASM_LD16(RR[i], UTs + (size_t)P5B_E(i, E0, E1) * 128); } \
            __builtin_amdgcn_sched_barrier(0); } \
        int a8_[8], a4_[4], a2_[2]; TSTEP(a8_, p_, 16, c0, xl1) TSTEP(a4_, a8_, 8, c1, xl2) TSTEP(a2_, a4_, 4, c2, xl4) \
        *(GAS unsigned long long*)(AP + (size_t)(tcur) * 128) = (unsigned long long)(unsigned)a2_[0] | ((unsigned long long)(unsigned)a2_[1] << 32); \
        __builtin_amdgcn_sched_barrier(0); P5B_LDMETA(E0, E1, Q, tq, te); __builtin_amdgcn_sched_barrier(0); } while (0)
    int j0, j1, j2, j3, j4, j5, p0, p1, p2, p3, p4, p5;
    P5_PULL(j0, p0); P5_PULL(j1, p1); P5_PULL(j2, p2); P5_PULL(j3, p3);
    v4u RA[16], RB[16], eA0, eA1, qA, eB0, eB1, qB;
    { const v4u e0 = *(const GAS v4u*)(EIDs + (size_t)p0 * 256), e1 = *(const GAS v4u*)(EIDs + (size_t)p0 * 256 + 16), f0 = *(const GAS v4u*)(EIDs + (size_t)p1 * 256), f1 = *(const GAS v4u*)(EIDs + (size_t)p1 * 256 + 16);
      eA0 = e0; eA1 = e1; qA = e0; eB0 = e0; eB1 = e1; qB = e0;
#pragma unroll
      for (int i = 0; i < 16; ++i) { RA[i] = e0; RB[i] = e0; }
      asm volatile("s_waitcnt vmcnt(0)" ::: "memory");
#pragma unroll
      for (int i = 0; i < 16; ++i) ASM_LD16(RA[i], UTs + (size_t)P5B_E(i, e0, e1) * 128);
#pragma unroll
      for (int i = 0; i < 16; ++i) ASM_LD16(RB[i], UTs + (size_t)P5B_E(i, f0, f1) * 128); }
    P5B_LDMETA(eA0, eA1, qA, p0, p2); P5B_LDMETA(eB0, eB1, qB, p1, p3);
    asm volatile("s_waitcnt vmcnt(0)" ::: "memory");
#pragma unroll 1
    while (j0 < nT) {
        P5_PULL(j4, p4); P5B_ITER(RA, eA0, eA1, qA, p0, p2, p4);
        P5_PULL(j5, p5); P5B_ITER(RB, eB0, eB1, qB, p1, p3, p5);
        j0 = j2; j1 = j3; j2 = j4; j3 = j5; p0 = p2; p1 = p3; p2 = p4; p3 = p5;
    }
    asm volatile("s_waitcnt vmcnt(0)" ::: "memory");
#undef P5B_E
#undef P5B_LDMETA
#undef P5B_ITER
}
__device__ __forceinline__ void p5b2_gelu(Frame& F) {
    const int lane = lane_id(); const int gw = F.vcu * NWAVES + F.wave, NGW = F.G * NWAVES;
    const float* SU = (const float*)(F.ws + WS_SU); const float* SV = (const float*)(F.ws + WS_SV); const float* SM = (const float*)(F.ws + WS_SM);
    for (int t = gw; t < M; t += NGW) {
        int a0 = 0, a1 = 0;
#pragma unroll
        for (int xx = 0; xx < 8; ++xx) { const unsigned long long w = *(const GAS unsigned long long*)((const int*)(F.ws + WS_APART) + (size_t)xx * M * 128 + (size_t)t * 128 + 2 * lane); a0 += (int)(unsigned)w; a1 += (int)(unsigned)(w >> 32); }
        const unsigned ew = *(const GAS unsigned*)(F.ws + WS_EID + (size_t)t * 256 + 4 * lane); const unsigned e0 = ew & 0xffffu, e1 = ew >> 16;
        const f32x2 gt = *(const GAS f32x2*)(F.ws + WS_GATE + (size_t)t * 512 + 8 * lane); const float sm = SM[t];
        const float h0 = gelu_exact((float)a0 * sm * SU[e0]) * gt[0] * SV[e0], h1 = gelu_exact((float)a1 * sm * SU[e1]) * gt[1] * SV[e1];
        const float hmax = wave_max(fmaxf(__builtin_fabsf(h0), __builtin_fabsf(h1))); const float inv = 127.f / fmaxf(hmax, 1e-30f);
        const int q0 = (int)__builtin_rintf(h0 * inv), q1 = (int)__builtin_rintf(h1 * inv);
        *(GAS unsigned short*)(F.ws + WS_HQ + (size_t)t * 128 + 2 * lane) = (unsigned short)((q0 & 0xff) | ((q1 & 0xff) << 8));
        if (lane == 0) ((float*)(F.ws + WS_HS))[t] = hmax * (1.f / 127.f);
    }
}
__device__ __forceinline__ void p5c_vacc(Frame& F) {
    const int lane = lane_id(), g = lane >> 3, s = lane & 7;
    const int x = blockIdx.x & 7, rk = blockIdx.x >> 3, nrk = F.G >> 3;
    const unsigned char* VTs = F.ws + WS_VT + (size_t)x * NEXP * 128 + 16 * s; const unsigned char* EIDs = F.ws + WS_EID + 32 * g; const unsigned char* HQs = F.ws + WS_HQ + 16 * g;
    const float* SH = (const float*)(F.ws + WS_HS); float* ssq2 = (float*)(F.ws + WS_SSQ2); unsigned* H2B = (unsigned*)(F.ws + WS_XN2);
    const int dcol = 128 * x + 16 * s + 2 * g;
    const bool c3 = g & 1, c4 = g & 2, c5 = g & 4; const bool hi32 = lane >= 32;
    const int nT = M / nrk; LAS unsigned* qctr = (LAS unsigned*)(F.lds + MISC_OFF) + 63;
#define P5C_E(i, E0, E1) ((((i) & 1) ? (((i) < 8 ? E0[(i) >> 1] : E1[((i) - 8) >> 1]) >> 16) : (((i) < 8 ? E0[(i) >> 1] : E1[((i) - 8) >> 1]) & 0xffffu)))
#define P5C_LDMETA(E0, E1, HB, H1, SHv, tq_, te_) do { ASM_LD16(E0, EIDs + (size_t)(te_) * 256); ASM_LD16(E1, EIDs + (size_t)(te_) * 256 + 16); \
        ASM_LD16(HB, HQs + (size_t)(tq_) * 128); ASM_LD8(H1, F.out + (size_t)(tq_) * DM + dcol); ASM_LD4(SHv, SH + (tq_)); } while (0)
#define IX32(v) xl32(v, hi32)
#define P5C_ITER(RR, E0, E1, HB, H1, SHv, tcur, vcur, tq, te) do { int yi_[16]; _Pragma("unroll") for (int i = 0; i < 16; ++i) yi_[i] = 0; \
        asm volatile("s_waitcnt vmcnt(21)" : "+v"(E0), "+v"(E1), "+v"(HB), "+v"(H1), "+v"(SHv) :: "memory"); \
        _Pragma("unroll") for (int b = 0; b < 4; ++b) { const int hb_ = (int)HB[b]; \
            ASM_WAIT4(38, RR[4 * b], RR[4 * b + 1], RR[4 * b + 2], RR[4 * b + 3]); __builtin_amdgcn_sched_barrier(0); \
            _Pragma("unroll") for (int c = 0; c < 4; ++c) { \
                const unsigned ra_ = RR[4 * b][c], rb_ = RR[4 * b + 1][c], rc_ = RR[4 * b + 2][c], rd_ = RR[4 * b + 3][c]; \
                const unsigned p_ = __builtin_amdgcn_perm(rb_, ra_, 0x05010400u), q_ = __builtin_amdgcn_perm(rb_, ra_, 0x07030602u), r_ = __builtin_amdgcn_perm(rd_, rc_, 0x05010400u), s_ = __builtin_amdgcn_perm(rd_, rc_, 0x07030602u); \
                yi_[4 * c + 0] = __builtin_amdgcn_sdot4((int)__builtin_amdgcn_perm(r_, p_, 0x05040100u), hb_, yi_[4 * c + 0], false); yi_[4 * c + 1] = __builtin_amdgcn_sdot4((int)__builtin_amdgcn_perm(r_, p_, 0x07060302u), hb_, yi_[4 * c + 1], false); \
                yi_[4 * c + 2] = __builtin_amdgcn_sdot4((int)__builtin_amdgcn_perm(s_, q_, 0x05040100u), hb_, yi_[4 * c + 2], false); yi_[4 * c + 3] = __builtin_amdgcn_sdot4((int)__builtin_amdgcn_perm(s_, q_, 0x07060302u), hb_, yi_[4 * c + 3], false); } \
            __builtin_amdgcn_sched_barrier(0); \
            _Pragma("unroll") for (int j = 0; j < 4; ++j) { const int i = 4 * b + j; ASM_LD16(RR[i], VTs + (size_t)P5C_E(i, E0, E1) * 128); } \
            __builtin_amdgcn_sched_barrier(0); } \
        int y8_[8], y4_[4], y2_[2]; TSTEP(y8_, yi_, 16, c3, xl8) TSTEP(y4_, y8_, 8, c4, xl16) TSTEP(y2_, y4_, 4, c5, IX32) \
        const f32x2 n_ = {H1[0] + SHv * (float)y2_[0], H1[1] + SHv * (float)y2_[1]}; \
        const float ss_ = wave_sum(n_[0] * n_[0] + n_[1] * n_[1]); \
        if (vcur) { *(GAS f32x2*)(F.out + (size_t)(tcur) * DM + dcol) = n_; H2B[((size_t)(tcur) * DM + dcol) >> 1] = pk2(n_[0], n_[1]); if (lane == 0) ssq2[(size_t)(tcur) * 8 + x] = ss_; }     \
        __builtin_amdgcn_sched_barrier(0); P5C_LDMETA(E0, E1, HB, H1, SHv, tq, te); __builtin_amdgcn_sched_barrier(0); } while (0)
    int j0, j1, j2, j3, j4, j5, p0, p1, p2, p3, p4, p5;
    P5_PULL(j0, p0); P5_PULL(j1, p1); P5_PULL(j2, p2); P5_PULL(j3, p3);
    v4u RA[16], RB[16], eA0, eA1, hbA, eB0, eB1, hbB; f32x2 h1A = {0.f, 0.f}, h1B = {0.f, 0.f}; float shA = 0.f, shB = 0.f;
    { const v4u e0 = *(const GAS v4u*)(EIDs + (size_t)p0 * 256), e1 = *(const GAS v4u*)(EIDs + (size_t)p0 * 256 + 16), f0 = *(const GAS v4u*)(EIDs + (size_t)p1 * 256), f1 = *(const GAS v4u*)(EIDs + (size_t)p1 * 256 + 16);
      eA0 = e0; eA1 = e1; hbA = e0; eB0 = e0; eB1 = e1; hbB = e0;
#pragma unroll
      for (int i = 0; i < 16; ++i) { RA[i] = e0; RB[i] = e0; }
      asm volatile("s_waitcnt vmcnt(0)" ::: "memory");
#pragma unroll
      for (int i = 0; i < 16; ++i) ASM_LD16(RA[i], VTs + (size_t)P5C_E(i, e0, e1) * 128);
#pragma unroll
      for (int i = 0; i < 16; ++i) ASM_LD16(RB[i], VTs + (size_t)P5C_E(i, f0, f1) * 128); }
    P5C_LDMETA(eA0, eA1, hbA, h1A, shA, p0, p2); P5C_LDMETA(eB0, eB1, hbB, h1B, shB, p1, p3);
    asm volatile("s_waitcnt vmcnt(0)" ::: "memory");
#pragma unroll 1
    while (j0 < nT) {
        P5_PULL(j4, p4); P5C_ITER(RA, eA0, eA1, hbA, h1A, shA, p0, true, p2, p4);
        P5_PULL(j5, p5); P5C_ITER(RB, eB0, eB1, hbB, h1B, shB, p1, (j1 < nT), p3, p5);
        j0 = j2; j1 = j3; j2 = j4; j3 = j5; p0 = p2; p1 = p3; p2 = p4; p3 = p5;
    }
    asm volatile("s_waitcnt vmcnt(0)" ::: "memory");
#undef P5C_E
#undef P5C_LDMETA
#undef P5C_ITER
#undef IX32
}
__device__ __forceinline__ void p7_final(Frame& F) {
    const int lane = lane_id(); const int gw = F.vcu * NWAVES + F.wave, NGW = F.G * NWAVES; const float* g = INP(22);
    f32x4 gv[4];
#pragma unroll
    for (int j = 0; j < 4; ++j) gv[j] = ((const GAS f32x4*)g)[64 * j + lane];
    for (int m = gw; m < M; m += NGW) { GAS f32x4* xr = (GAS f32x4*)(F.out + (size_t)m * DM) + lane; f32x4 v[4]; float s2 = 0.f;
#pragma unroll
        for (int j = 0; j < 4; ++j) { v[j] = xr[64 * j]; s2 += (v[j].x * v[j].x + v[j].y * v[j].y) + (v[j].z * v[j].z + v[j].w * v[j].w); }
        const float rstd = rsqrtf(wave_sum(s2) * (1.f / DM) + EPS);
#pragma unroll
        for (int j = 0; j < 4; ++j) xr[64 * j] = v[j] * rstd * gv[j]; }
}
struct Args { const float* in[23]; float* out; unsigned char* ws; int ph_lo, ph_hi; };
__global__ void __launch_bounds__(NWAVES * 64, 2) hymba_fwd(Args args) {
    extern __shared__ __attribute__((aligned(16))) unsigned char lds[];
    cg::grid_group grid = cg::this_grid();
    Frame F;
    F.lds = (LAS unsigned char*)lds; F.ldsg = lds;
    F.wave = __builtin_amdgcn_readfirstlane(threadIdx.x >> 6);
    F.G = gridDim.x; { const int bx = blockIdx.x; F.vcu = (F.G % 8 == 0) ? (bx % 8) * (F.G / 8) + bx / 8 : bx; }
    F.out = args.out; F.ws = args.ws;
    const int lo = args.ph_lo, hi = args.ph_hi;
#ifdef ONLY_PH
#define IN(k) ((k) == ONLY_PH)
#else
#define IN(k) (lo <= (k) && (k) < hi)
#endif
#define BOTH(k) (IN(k) && IN((k) + 1))
    { const int l0 = lane_id(); if (F.wave == 0) ((volatile LAS unsigned*)(F.lds + MISC_OFF))[l0] = 0u; }
    __syncthreads();
    const XcdBarrier bar = xcd_barrier_post((unsigned*)(F.ws + WS_CTL) + CW_BAR, (volatile LAS unsigned*)(F.lds + MISC_OFF) + 8, F.wave == 0 && lane_id() == 0);
    if (hi > N_PHASES) grid.sync();
#if defined(PROBE_BARSUM)
#define GRID_BAR(k) do { STAMP(20); xcd_barrier(bar, F.wave == 0 && lane_id() == 0); STAMP((k) + 1); \
    if (F.wave == 0 && ((PROBE_BARSUM >> (k)) & 1)) { volatile LAS unsigned* ms_ = (volatile LAS unsigned*)(F.lds + MISC_OFF) + 16; ms_[2 * 21] += ms_[2 * ((k) + 1)] - ms_[2 * 20]; } } while (0)
#else
#define GRID_BAR(k) do { xcd_barrier(bar, F.wave == 0 && lane_id() == 0); STAMP((k) + 1); } while (0)
#endif
    STAMP(0);
    if (IN(0)) { p0_prologue(F); STAMP(21); if (BOTH(0)) GRID_BAR(0); }
    if (IN(1)) {
        { pg8::Gemm g{(const pg8::bf16_t*)(F.ws + WS_XN), (const pg8::bf16_t*)(F.ws + WS_WIN), M, IN_COLS, DM}; pg8::StaticOrder S; S.init(M, IN_COLS, F.G, (int)blockIdx.x);
          pg8::EpiIn E{(pg8::bf16_t*)(F.ws + WS_QO), (pg8::bf16_t*)(F.ws + WS_K), (pg8::bf16_t*)(F.ws + WS_V), (pg8::bf16_t*)(F.ws + WS_U), (const float*)(F.ws + WS_ROPEC), (const float*)(F.ws + WS_ROPES), attn_body::C2};
          pg8::gemm_phase<pg8::EpiIn, pg8::StaticOrder, true, true>(F.lds, g, S, E, F.wave); }
        { pg8::Gemm g{(const pg8::bf16_t*)(F.ws + WS_PB), (const pg8::bf16_t*)(F.ws + WS_WPROJ), M, DM, PLE_DIM}; pg8::StaticOrder S; S.init(M, DM, F.G, (int)blockIdx.x);
          pg8::EpiBf16<0> E{(pg8::bf16_t*)(F.ws + WS_E), DM, nullptr, 0, 0, 1.f};
          pg8::gemm_phase<pg8::EpiBf16<0>, pg8::StaticOrder, true, true>(F.lds, g, S, E, F.wave); }
        if (BOTH(1)) GRID_BAR(1);
    }
    if (IN(2)) { p2_attention(F); STAMP(13); p2_conv(F); STAMP(14); if (BOTH(2)) GRID_BAR(2); }
    if (IN(3)) {
        pg8::Gemm g{(const pg8::bf16_t*)(F.ws + WS_XN), (const pg8::bf16_t*)(F.ws + WS_WOUT), M, DM, DM}; pg8::StaticOrder S; S.init(M, DM, F.G, (int)blockIdx.x);
        pg8::EpiOut E{INP(0), F.out, (pg8::bf16_t*)(F.ws + WS_H1B), (float*)(F.ws + WS_SSQ1)};
        pg8::gemm_phase<pg8::EpiOut, pg8::StaticOrder, true, true>(F.lds, g, S, E, F.wave);
        if (BOTH(3)) GRID_BAR(3);
    }
    if (IN(4)) {
        pg8::Gemm g{(const pg8::bf16_t*)(F.ws + WS_H1B), (const pg8::bf16_t*)(F.ws + WS_WQ), M, QCOLS, DM}; pg8::StaticOrder S; S.init(M, QCOLS, F.G, (int)blockIdx.x);
        pg8::EpiQ E{(const float*)(F.ws + WS_SSQ1), (pg8::bf16_t*)(F.ws + WS_QP), EPS};
        pg8::gemm_phase<pg8::EpiQ, pg8::StaticOrder, true, true>(F.lds, g, S, E, F.wave);
        if (BOTH(4)) GRID_BAR(4);
    }
    if (IN(5)) { p5a_topk(F); if (BOTH(5)) GRID_BAR(5); }
    if (IN(6)) { p5b_udot(F); if (BOTH(6)) GRID_BAR(6); }
    if (IN(7)) { p5b2_gelu(F); if (BOTH(7)) GRID_BAR(7); }
    if (IN(8)) { p5c_vacc(F); if (BOTH(8)) GRID_BAR(8); }
    if (IN(9)) {
        pg8::Gemm g{(const pg8::bf16_t*)(F.ws + WS_XN2), (const pg8::bf16_t*)(F.ws + WS_WGATE), M, DM, DM}; pg8::StaticOrder S; S.init(M, DM, F.G, (int)blockIdx.x);
        pg8::EpiGate E{F.out, (const pg8::bf16_t*)(F.ws + WS_E), (const float*)(F.ws + WS_SSQ2), EPS};
        pg8::gemm_phase<pg8::EpiGate, pg8::StaticOrder, true, true>(F.lds, g, S, E, F.wave);
        if (BOTH(9)) GRID_BAR(9);
    }
    if (IN(10)) p7_final(F);
#if defined(MBENCH)
    { xcd_barrier(bar, F.wave == 0 && lane_id() == 0); STAMP(15);
      unsigned r[32]; const unsigned l0 = (unsigned)lane_id();
#pragma unroll
      for (int i = 0; i < 32; ++i) r[i] = l0 * 2654435761u + i;
      float* rf = (float*)r;
#pragma unroll 1
      for (int it = 0; it < 1024; ++it) {
#pragma unroll
          for (int i = 0; i < 32; ++i) {
#if MBENCH == 1
              asm volatile("v_dot4c_i32_i8 %0, %1, %2" : "+v"(r[i]) : "v"(r[(i + 1) & 31]), "v"(r[(i + 2) & 31]));
#elif MBENCH == 2
              asm volatile("v_perm_b32 %0, %1, %2, %3" : "=v"(r[i]) : "v"(r[(i + 1) & 31]), "v"(r[(i + 2) & 31]), "v"(r[(i + 3) & 31]));
#elif MBENCH == 3
              asm volatile("v_fma_f32 %0, %1, %2, %0" : "+v"(r[i]) : "v"(r[(i + 1) & 31]), "v"(r[(i + 2) & 31]));
#elif MBENCH == 4
              asm volatile("v_cvt_f32_ubyte1 %0, %1" : "=v"(r[i]) : "v"(r[(i + 1) & 31]));
#elif MBENCH == 5
              asm volatile("v_pk_fma_f32 %0, %1, %2, %0" : "+v"(*(unsigned long long*)&r[2 * (i & 15)]) : "v"(*(unsigned long long*)&r[2 * ((i + 1) & 15)]), "v"(*(unsigned long long*)&r[2 * ((i + 2) & 15)]));
#elif MBENCH == 6
              asm volatile("v_add_u32 %0, %1, %2" : "=v"(r[i]) : "v"(r[(i + 1) & 31]), "v"(r[(i + 2) & 31]));
#elif MBENCH == 7
              asm volatile("v_mad_i32_i24 %0, %1, %2, %0" : "+v"(r[i]) : "v"(r[(i + 1) & 31]), "v"(r[(i + 2) & 31]));
#endif
          } }
      unsigned acc = 0;
#pragma unroll
      for (int i = 0; i < 32; ++i) acc ^= r[i];
      if (acc == 0x12345678u) ((unsigned*)(F.ws + WS_CTL))[2000 + l0] = acc;
      STAMP(16); }
#endif
#if defined(PROBE_A)
    STAMP(11);
#if !defined(PROBE_BLK)
#define PROBE_BLK 0
#endif
    if (blockIdx.x == PROBE_BLK && F.wave == 0) { volatile LAS unsigned* ms_ = (volatile LAS unsigned*)(F.lds + MISC_OFF) + 16;
        const unsigned long long ta = ((unsigned long long)ms_[2 * PROBE_A + 1] << 32) | ms_[2 * PROBE_A], tb = ((unsigned long long)ms_[2 * PROBE_B + 1] << 32) | ms_[2 * PROBE_B];
#if defined(PROBE_BARSUM)
        const unsigned long long span_ = ms_[2 * 21];
#else
        const unsigned long long span_ = tb - ta;
#endif
        const unsigned long long t0_ = __builtin_amdgcn_s_memrealtime(); while (__builtin_amdgcn_s_memrealtime() - t0_ < span_) __builtin_amdgcn_s_sleep(8); }
#endif
#undef IN
#undef BOTH
}

extern "C" void kernel_launch(void* const* d_in, const int* in_sizes, int n_in, void* d_out, int out_size, void* d_ws, size_t ws_size, hipStream_t stream) {
    static int grid = 0;
    if (grid == 0) {
        if (n_in != 23 || in_sizes[0] != M * DM || out_size != M * DM || ws_size < WS_END) { fprintf(stderr, "kernel_launch: unexpected shapes (n_in %d, in0 %d, out %d, ws %zu); nothing launched\n", n_in, n_in > 0 ? in_sizes[0] : -1, out_size, ws_size); grid = -1; return; }
        int dev = 0, cus = 0, per_cu = 0;
        if (hipGetDevice(&dev) != hipSuccess || hipDeviceGetAttribute(&cus, hipDeviceAttributeMultiprocessorCount, dev) != hipSuccess) { fprintf(stderr, "kernel_launch: device query failed\n"); grid = -1; return; }
        if (hipFuncSetAttribute((const void*)hymba_fwd, hipFuncAttributeMaxDynamicSharedMemorySize, LDS_BYTES) != hipSuccess) { fprintf(stderr, "kernel_launch: hipFuncSetAttribute failed\n"); grid = -1; return; }
        if (hipOccupancyMaxActiveBlocksPerMultiprocessor(&per_cu, (const void*)hymba_fwd, NWAVES * 64, LDS_BYTES) != hipSuccess || per_cu < 1) { fprintf(stderr, "kernel_launch: occupancy query says %d blocks per CU\n", per_cu); (void)hipGetLastError(); grid = -1; return; }
        grid = cus * per_cu;
        if (grid != 256) { fprintf(stderr, "kernel_launch: this kernel's attention order needs exactly 256 resident workgroups (got %d x %d); nothing launched\n", cus, per_cu); grid = -1; return; }
    }
    if (grid < 0) return;
    if (hipMemsetAsync((char*)d_ws + WS_CTL, 0, CTL_ZERO_BYTES, stream) != hipSuccess) { fprintf(stderr, "kernel_launch: hipMemsetAsync failed\n"); return; }
    Args a{};
    for (int i = 0; i < 23; ++i) a.in[i] = (const float*)d_in[i];
    a.out = (float*)d_out; a.ws = (unsigned char*)d_ws;
#if MK_N_LAUNCHES == 1
    a.ph_lo = 0; a.ph_hi = N_PHASES;
    void* kargs[] = {&a};
    hipError_t e = hipLaunchCooperativeKernel((const void*)hymba_fwd, dim3(grid), dim3(NWAVES * 64), kargs, LDS_BYTES, stream);
    if (e != hipSuccess) fprintf(stderr, "kernel_launch: cooperative launch failed: %s (grid %d)\n", hipGetErrorString(e), grid);
#else
    for (int li = 0; li < N_PHASES; ++li) { a.ph_lo = li; a.ph_hi = li + 1;
        hipLaunchKernelGGL(hymba_fwd, dim3(grid), dim3(NWAVES * 64), LDS_BYTES, stream, a);
        const hipError_t le = hipPeekAtLastError(); if (le != hipSuccess) { fprintf(stderr, "kernel_launch: launch %d failed: %s\n", li, hipGetErrorName(le)); break; } }
#endif
}
```

```cpp
#include <hip/hip_runtime.h>
#include <hip/hip_cooperative_groups.h>
#include <cstdio>
#include <cstdint>
namespace cg = cooperative_groups;
namespace pg8 {
#define PG8_LAS __attribute__((address_space(3)))
typedef unsigned short bf16_t;
typedef short bf16x8 __attribute__((ext_vector_type(8)));
typedef float f32x4 __attribute__((ext_vector_type(4)));
typedef unsigned u32x4 __attribute__((ext_vector_type(4)));
constexpr int BM = 256, BK = 64, HALF = 128, HTB = HALF * BK * 2  , STAGE_BYTES = 8 * HTB, NXCD = 8, WGM = 8;

__host__ __device__ __forceinline__ int lds_byte(int r, int c) { const int st = (r >> 4) * 2 + (c >> 5), rr = r & 15, cc = c & 31, ob = rr * 64 + cc * 2; return st * 1024 + (ob ^ (((ob >> 9) & 1) << 5)); }
__host__ __device__ __forceinline__ void stage_rc(int b, int& R, int& C) { const int st = b / 1024, sb = b % 1024, swz = sb ^ (((sb >> 9) & 1) << 5); R = (st >> 1) * 16 + swz / 64; C = (st & 1) * 32 + (swz % 64) / 2; }
__host__ __device__ __forceinline__ int perm32(int rho) { const int n = rho >> 4, i = rho & 15; return 8 * (i >> 2) + 4 * n + (i & 3); }

struct Unit { int pm, pn; };
struct Gemm { const bf16_t* A; const bf16_t* Bt; int M, N, K; };

struct StaticOrder {
    int nM, nN, nwg, G, c;
    __host__ __device__ void init(int M, int N, int G_, int c_) { nM = M / BM; nN = N / BM; nwg = nM * nN; G = G_; c = c_; }
    __host__ __device__ bool next(int i, Unit& u) const {
        const long L = (long)i * G + c; if (L >= nwg) return false;
        int wgid = (int)L; { const int q = nwg / NXCD, r = nwg % NXCD, xcd = wgid % NXCD, off = wgid / NXCD; wgid = (xcd < r ? xcd * (q + 1) : r * (q + 1) + (xcd - r) * q) + off; }
        const int nig = WGM * nN, gid = wgid / nig, fm = gid * WGM, gsz = (nM - fm) < WGM ? (nM - fm) : WGM;
        u.pm = fm + ((wgid % nig) % gsz); u.pn = (wgid % nig) / gsz; return true;
    }
    __device__ __forceinline__ void a_ready(const Unit&) const {}
    __device__ __forceinline__ void done(const Unit&) const {}
};

__device__ __forceinline__ unsigned cvt_pk_bf16(float lo, float hi) { unsigned r; asm volatile("v_cvt_pk_bf16_f32 %0, %1, %2" : "=v"(r) : "v"(lo), "v"(hi)); return r; }
typedef float f32x2 __attribute__((ext_vector_type(2)));
__device__ __forceinline__ f32x2 gelu_pk(f32x2 v) {
    const f32x2 av = __builtin_elementwise_abs(v), d = av * 0.2316418882f + 1.0f;
    f32x2 t; t.x = __builtin_amdgcn_rcpf(d.x); t.y = __builtin_amdgcn_rcpf(d.y);
    f32x2 q = t * 0.5307027145f + (-0.7265760135f); q = q * t + 0.7107068705f; q = q * t + (-0.142248368f); q = q * t + 0.127414796f; q = q * t;
    const f32x2 s = (v * v) * (-0.72134752044f);
    f32x2 e; e.x = __builtin_amdgcn_exp2f(s.x); e.y = __builtin_amdgcn_exp2f(s.y);
    const f32x2 m = v * (q * e), r = v - m;
    f32x2 o; o.x = v.x < 0.f ? m.x : r.x; o.y = v.y < 0.f ? m.y : r.y; return o;
}

template <int ACT  > struct EpiBf16 {
    static constexpr bool PERM = true, AFTER_DRAIN = false; static_assert(ACT == 0 || ACT == 1, "EpiBf16: ACT is 0 (none) or 1 (gelu_pk)");
    bf16_t* O; int ldc; const float* bias; int split_cols; size_t split_stride; float scale0;
    __device__ __forceinline__ void operator()(const f32x4 (&acc)[2][2][4][2], const Unit& u, int wr, int wc, int fr, int fq) const {
        const int row0 = u.pm * BM + wr * 64 + fr; int colt = u.pn * BM; bf16_t* base = O;
        float sc = 1.f; if (split_cols) { const int t = colt / split_cols; base += (size_t)t * split_stride; colt -= t * split_cols; if (t == 0) sc = scale0; }
        const int col0 = colt + wc * 32 + 8 * fq, bcol0 = u.pn * BM + wc * 32 + 8 * fq;
        f32x4 bv[2][2];
#pragma unroll
        for (int bj = 0; bj < 2; ++bj)
#pragma unroll
            for (int n = 0; n < 2; ++n) bv[bj][n] = bias ? *(const f32x4*)(bias + bcol0 + bj * HALF + 4 * n) : (f32x4){0.f, 0.f, 0.f, 0.f};
#pragma unroll
        for (int ai = 0; ai < 2; ++ai)
#pragma unroll
            for (int m = 0; m < 4; ++m) { bf16_t* rowp = base + (size_t)(row0 + ai * HALF + m * 16) * ldc + col0;
#pragma unroll
                for (int bj = 0; bj < 2; ++bj) { f32x4 v0 = acc[ai][bj][m][0] + bv[bj][0], v1 = acc[ai][bj][m][1] + bv[bj][1];
                    if (ACT == 1) { f32x2 a = gelu_pk((f32x2){v0[0], v0[1]}), b = gelu_pk((f32x2){v0[2], v0[3]}), c = gelu_pk((f32x2){v1[0], v1[1]}), d = gelu_pk((f32x2){v1[2], v1[3]});
                        v0 = (f32x4){a.x, a.y, b.x, b.y}; v1 = (f32x4){c.x, c.y, d.x, d.y}; }
                    v0 = v0 * sc; v1 = v1 * sc; u32x4 w; w.x = cvt_pk_bf16(v0[0], v0[1]); w.y = cvt_pk_bf16(v0[2], v0[3]); w.z = cvt_pk_bf16(v1[0], v1[1]); w.w = cvt_pk_bf16(v1[2], v1[3]);
                    *(u32x4*)(rowp + bj * HALF) = w; } }
    }
};
__device__ __forceinline__ float sigmoid_fast(float x) { return __builtin_amdgcn_rcpf(1.0f + __expf(-x)); }
__device__ __forceinline__ f32x4 sigmoid4(f32x4 x) { f32x4 r; r[0] = sigmoid_fast(x[0]); r[1] = sigmoid_fast(x[1]); r[2] = sigmoid_fast(x[2]); r[3] = sigmoid_fast(x[3]); return r; }
__device__ __forceinline__ u32x4 pack8(const f32x4 a, const f32x4 b) { u32x4 w; w.x = cvt_pk_bf16(a[0], a[1]); w.y = cvt_pk_bf16(a[2], a[3]); w.z = cvt_pk_bf16(b[0], b[1]); w.w = cvt_pk_bf16(b[2], b[3]); return w; }
__device__ __forceinline__ float dot4s(const f32x4 a) { return (a[0] * a[0] + a[1] * a[1]) + (a[2] * a[2] + a[3] * a[3]); }

struct EpiIn {
    static constexpr bool PERM = true, AFTER_DRAIN = false;
    bf16_t *Q, *Kk, *V, *U; const float* ropec; const float* ropes; float qscale;
    __device__ __forceinline__ void operator()(const f32x4 (&acc)[2][2][4][2], const Unit& u, int wr, int wc, int fr, int fq) const {
        const int row0 = u.pm * BM + wr * 64 + fr; const int pn = u.pn;
        if (pn < 4) {
            bf16_t* dst = (pn < 2) ? Q : Kk; const float sc = (pn < 2) ? qscale : 1.0f; const int colb = ((pn & 1) * 4 + wc) * 128 + 8 * fq;
#pragma unroll
            for (int ai = 0; ai < 2; ++ai)
#pragma unroll
                for (int m = 0; m < 4; ++m) { const int row = row0 + ai * HALF + m * 16; const int pos = row & 4095;
                    const f32x4 c0 = *(const f32x4*)(ropec + pos * 32 + 8 * fq), c1 = *(const f32x4*)(ropec + pos * 32 + 8 * fq + 4);
                    const f32x4 s0 = *(const f32x4*)(ropes + pos * 32 + 8 * fq), s1 = *(const f32x4*)(ropes + pos * 32 + 8 * fq + 4);
                    const f32x4 x10 = acc[ai][0][m][0], x11 = acc[ai][0][m][1], x20 = acc[ai][1][m][0], x21 = acc[ai][1][m][1];
                    const f32x4 o10 = (x10 * c0 - x20 * s0) * sc, o11 = (x11 * c1 - x21 * s1) * sc, o20 = (x20 * c0 + x10 * s0) * sc, o21 = (x21 * c1 + x11 * s1) * sc;
                    bf16_t* rp = dst + (size_t)row * 1024 + colb; const u32x4 w1 = pack8(o10, o11), w2 = pack8(o20, o21);
                    *(u32x4*)rp = w1; *(u32x4*)(rp + 32) = w2; *(u32x4*)(rp + 64) = w1; *(u32x4*)(rp + 96) = w2; }
        } else if (pn < 6) {
#pragma unroll
            for (int ai = 0; ai < 2; ++ai)
#pragma unroll
                for (int m = 0; m < 4; ++m) { const int row = row0 + ai * HALF + m * 16;
#pragma unroll
                    for (int bj = 0; bj < 2; ++bj) { const int hh = (pn - 4) * 2 + bj, vh = wc >> 1, d = (wc & 1) * 32 + 8 * fq;
                        const u32x4 w = pack8(acc[ai][bj][m][0], acc[ai][bj][m][1]); bf16_t* rp = V + (size_t)row * 1024 + (hh * 4 + vh) * 64 + d; *(u32x4*)rp = w; *(u32x4*)(rp + 128) = w; } }
        } else {
#pragma unroll
            for (int ai = 0; ai < 2; ++ai)
#pragma unroll
                for (int m = 0; m < 4; ++m) { const int row = row0 + ai * HALF + m * 16;
                    const f32x4 u0 = acc[ai][0][m][0] * sigmoid4(acc[ai][1][m][0]), u1 = acc[ai][0][m][1] * sigmoid4(acc[ai][1][m][1]);
                    *(u32x4*)(U + (size_t)row * 512 + (pn - 6) * 128 + wc * 32 + 8 * fq) = pack8(u0, u1); }
        }
    }
};
struct EpiOut {
    static constexpr bool PERM = true, AFTER_DRAIN = false;
    const float* x; bf16_t* hb; float* ssq;
    __device__ __forceinline__ void operator()(const f32x4 (&acc)[2][2][4][2], const Unit& u, int wr, int wc, int fr, int fq) const {
        const int row0 = u.pm * BM + wr * 64 + fr;
#pragma unroll
        for (int ai = 0; ai < 2; ++ai)
#pragma unroll
            for (int m = 0; m < 4; ++m) { const int row = row0 + ai * HALF + m * 16; float ss = 0.f;
#pragma unroll
                for (int bj = 0; bj < 2; ++bj) { const size_t off = (size_t)row * 1024 + u.pn * BM + bj * HALF + wc * 32 + 8 * fq;
                    const f32x4 h0 = acc[ai][bj][m][0] + *(const f32x4*)(x + off), h1 = acc[ai][bj][m][1] + *(const f32x4*)(x + off + 4);
                    *(u32x4*)(hb + off) = pack8(h0, h1); ss += dot4s(h0) + dot4s(h1); }
                ss += __shfl_xor(ss, 16); ss += __shfl_xor(ss, 32);
                if (fq == 0) ssq[(size_t)row * 16 + u.pn * 4 + wc] = ss; }
    }
};
struct EpiQ {
    static constexpr bool PERM = true, AFTER_DRAIN = false;
    const float* ssq; bf16_t* qp; float eps;
    __device__ __forceinline__ void operator()(const f32x4 (&acc)[2][2][4][2], const Unit& u, int wr, int wc, int fr, int fq) const {
        const int row0 = u.pm * BM + wr * 64 + fr;
#pragma unroll
        for (int ai = 0; ai < 2; ++ai)
#pragma unroll
            for (int m = 0; m < 4; ++m) { const int row = row0 + ai * HALF + m * 16; const f32x4* sp = (const f32x4*)(ssq + (size_t)row * 16);
                const f32x4 a = sp[0], b = sp[1], c = sp[2], d = sp[3]; const f32x4 t = (a + b) + (c + d);
                const float rstd = rsqrtf(((t[0] + t[1]) + (t[2] + t[3])) * (1.0f / 1024.0f) + eps);
#pragma unroll
                for (int bj = 0; bj < 2; ++bj) *(u32x4*)(qp + (size_t)row * 2048 + u.pn * BM + bj * HALF + wc * 32 + 8 * fq) = pack8(acc[ai][bj][m][0] * rstd, acc[ai][bj][m][1] * rstd); }
    }
};
__device__ __forceinline__ f32x4 bf_lo4(unsigned a, unsigned b) { f32x4 r; r[0] = __uint_as_float(a << 16); r[1] = __uint_as_float(a & 0xffff0000u); r[2] = __uint_as_float(b << 16); r[3] = __uint_as_float(b & 0xffff0000u); return r; }
struct EpiGate {
    static constexpr bool PERM = true, AFTER_DRAIN = false;
    float* out; const bf16_t* h2b; const bf16_t* e; const float* ssq; float eps;
    __device__ __forceinline__ void operator()(const f32x4 (&acc)[2][2][4][2], const Unit& u, int wr, int wc, int fr, int fq) const {
        const int row0 = u.pm * BM + wr * 64 + fr;
#pragma unroll
        for (int ai = 0; ai < 2; ++ai)
#pragma unroll
            for (int m = 0; m < 4; ++m) { const int row = row0 + ai * HALF + m * 16; const f32x4* sp = (const f32x4*)(ssq + (size_t)row * 8); const f32x4 t = sp[0] + sp[1];
                const float rstd = rsqrtf(((t[0] + t[1]) + (t[2] + t[3])) * (1.0f / 1024.0f) + eps);
#pragma unroll
                for (int bj = 0; bj < 2; ++bj) { const size_t off = (size_t)row * 1024 + u.pn * BM + bj * HALF + wc * 32 + 8 * fq;
                    const u32x4 ev = *(const u32x4*)(e + off), hv = *(const u32x4*)(h2b + off);
                    const f32x4 h0 = bf_lo4(hv.x, hv.y) + bf_lo4(ev.x, ev.y) * sigmoid4(acc[ai][bj][m][0] * rstd), h1 = bf_lo4(hv.z, hv.w) + bf_lo4(ev.z, ev.w) * sigmoid4(acc[ai][bj][m][1] * rstd);
                    *(f32x4*)(out + off) = h0; *(f32x4*)(out + off + 4) = h1; } }
    }
};
template <class Epi, class Sched, bool ALIGN_EPI = false, bool SP2 = false>
__device__ __forceinline__ void gemm_phase(PG8_LAS unsigned char* lds, const Gemm g, const Sched& S, const Epi& E, const int wid  ) {
    int lane; asm volatile("v_mbcnt_lo_u32_b32 %0, -1, 0\n\tv_mbcnt_hi_u32_b32 %0, -1, %0" : "=v"(lane));
    const int tid = wid * 64 + lane, wr = wid >> 2, wc = wid & 3, fr = lane & 15, fq = lane >> 4;
    const int K = g.K, nt = K / BK;
    unsigned voffA[2], voffB[2];
#pragma unroll
    for (int i = 0; i < 2; ++i) { int R, C; stage_rc(tid * 16 + i * 8192, R, C); const int Rb = Epi::PERM ? ((R & ~31) + perm32(R & 31)) : R;
        voffA[i] = (unsigned)(R * K + C) * 2u; voffB[i] = (unsigned)(Rb * K + C) * 2u; }
    const size_t kstep = (size_t)(BK * 2);
    const size_t hstep = (size_t)HALF * K * 2;
    const size_t tstep = 2 * hstep;
    const unsigned ldsw = (unsigned)wid * 1024u;
    const int aoff = lds_byte(wr * 64 + fr, fq * 8), boff = lds_byte(wc * 32 + fr, fq * 8);
#define PG8_SA(b, h) (((b) * 2 + (h)) * HTB)
#define PG8_SB(b, h) ((4 + (b) * 2 + (h)) * HTB)
#define PG8_STAGE(bufoff, gbase, voff) do { _Pragma("unroll") for (int _i = 0; _i < 2; ++_i) \
        __builtin_amdgcn_global_load_lds((const unsigned*)((const char*)(gbase) + (voff)[_i]), (PG8_LAS unsigned*)(lds + (bufoff) + ldsw + _i * 8192), 16, 0, 0); } while (0)
#define PG8_LDA(dst, b, h) do { _Pragma("unroll") for (int m = 0; m < 4; ++m) _Pragma("unroll") for (int k = 0; k < 2; ++k) dst[m][k] = *(const PG8_LAS bf16x8*)(lds + PG8_SA(b, h) + aoff + m * 2048 + k * 1024); } while (0)
#define PG8_LDB(dst, b, h) do { _Pragma("unroll") for (int n = 0; n < 2; ++n) _Pragma("unroll") for (int k = 0; k < 2; ++k) dst[n][k] = *(const PG8_LAS bf16x8*)(lds + PG8_SB(b, h) + boff + n * 2048 + k * 1024); } while (0)
#define PG8_MMA(ai, bj, At, Bt) do { __builtin_amdgcn_s_setprio(1); _Pragma("unroll") for (int m = 0; m < 4; ++m) _Pragma("unroll") for (int n = 0; n < 2; ++n) _Pragma("unroll") for (int k = 0; k < 2; ++k) \
        acc[ai][bj][m][n] = __builtin_amdgcn_mfma_f32_16x16x32_bf16(Bt[n][k], At[m][k], acc[ai][bj][m][n], 0, 0, 0); __builtin_amdgcn_s_setprio(0); } while (0)
#define PG8_WAIT_V(n) asm volatile("s_waitcnt vmcnt(" #n ")" ::: "memory")
#define PG8_WAIT_L(n) asm volatile("s_waitcnt lgkmcnt(" #n ")" ::: "memory")
#define PG8_BAR __builtin_amdgcn_s_barrier()
#define PG8_SCHED __builtin_amdgcn_sched_barrier(0)
    Unit cur, nxt; int ui = 0;
    if (!S.next(0, cur)) return;
    f32x4 acc[2][2][4][2];
#pragma unroll
    for (int a = 0; a < 2; ++a)
#pragma unroll
        for (int b = 0; b < 2; ++b)
#pragma unroll
            for (int m = 0; m < 4; ++m)
#pragma unroll
                for (int n = 0; n < 2; ++n) acc[a][b][m][n] = (f32x4){0.f, 0.f, 0.f, 0.f};
    bf16x8 At[4][2], B0[2][2], B1[2][2];
    const char* cA = (const char*)g.A + (size_t)cur.pm * tstep; const char* cB = (const char*)g.Bt + (size_t)cur.pn * tstep;
    S.a_ready(cur);
    if constexpr (SP2) {
        PG8_STAGE(PG8_SB(0, 0), cB, voffB); PG8_STAGE(PG8_SB(0, 1), cB + hstep, voffB); PG8_STAGE(PG8_SA(0, 0), cA, voffA); PG8_STAGE(PG8_SA(0, 1), cA + hstep, voffA);
        if (wr == 1) PG8_BAR;
        PG8_WAIT_V(2); PG8_BAR;
        PG8_STAGE(PG8_SB(1, 0), cB + kstep, voffB); PG8_STAGE(PG8_SA(1, 0), cA + kstep, voffA); PG8_STAGE(PG8_SB(1, 1), cB + hstep + kstep, voffB);
        PG8_WAIT_V(6); PG8_BAR;
    } else {
        PG8_STAGE(PG8_SB(0, 0), cB, voffB); PG8_STAGE(PG8_SA(0, 0), cA, voffA); PG8_STAGE(PG8_SB(0, 1), cB + hstep, voffB); PG8_STAGE(PG8_SA(0, 1), cA + hstep, voffA);
        if (wr == 1) PG8_BAR;
        PG8_WAIT_V(4); PG8_BAR;
        PG8_STAGE(PG8_SB(1, 0), cB + kstep, voffB); PG8_STAGE(PG8_SA(1, 0), cA + kstep, voffA); PG8_STAGE(PG8_SB(1, 1), cB + hstep + kstep, voffB);
        PG8_WAIT_V(6); PG8_BAR;
    }
    for (;;) {
        const bool has_next = S.next(ui + 1, nxt);
        const char* nA = has_next ? (const char*)g.A + (size_t)nxt.pm * tstep : cA; const char* nB = has_next ? (const char*)g.Bt + (size_t)nxt.pn * tstep : cB;
        for (int t = 0; t < nt; t += 2) {
            const bool last = (t == nt - 2);
            const char* a1 = cA + (size_t)(t + 1) * kstep;
            const char* a2 = last ? nA : cA + (size_t)(t + 2) * kstep; const char* b2 = last ? nB : cB + (size_t)(t + 2) * kstep;
            const char* a3 = a2 + kstep; const char* b3 = b2 + kstep;
            if (last && has_next) S.a_ready(nxt);
            if constexpr (SP2) {
            PG8_LDB(B0, 0, 0); PG8_LDB(B1, 0, 1); PG8_SCHED; PG8_LDA(At, 0, 0); PG8_STAGE(PG8_SA(1, 1), a1 + hstep, voffA);
            PG8_WAIT_V(8); PG8_WAIT_L(0); PG8_BAR; PG8_MMA(0, 0, At, B0); PG8_MMA(0, 1, At, B1); PG8_BAR; PG8_SCHED;
            PG8_LDA(At, 0, 1); PG8_STAGE(PG8_SB(0, 0), b2, voffB); PG8_STAGE(PG8_SB(0, 1), b2 + hstep, voffB); PG8_STAGE(PG8_SA(0, 0), a2, voffA);
            PG8_WAIT_V(8); PG8_WAIT_L(0); PG8_BAR; PG8_MMA(1, 0, At, B0); PG8_MMA(1, 1, At, B1); PG8_BAR; PG8_SCHED;
            PG8_LDB(B0, 1, 0); PG8_LDB(B1, 1, 1); PG8_SCHED; PG8_LDA(At, 1, 0); PG8_STAGE(PG8_SA(0, 1), a2 + hstep, voffA);
            PG8_WAIT_V(8); PG8_WAIT_L(0); PG8_BAR; PG8_MMA(0, 0, At, B0); PG8_MMA(0, 1, At, B1); PG8_BAR; PG8_SCHED;
            PG8_LDA(At, 1, 1); PG8_STAGE(PG8_SB(1, 0), b3, voffB); PG8_STAGE(PG8_SB(1, 1), b3 + hstep, voffB); PG8_STAGE(PG8_SA(1, 0), a3, voffA);
            PG8_WAIT_V(8); PG8_WAIT_L(0); PG8_BAR; PG8_MMA(1, 0, At, B0); PG8_MMA(1, 1, At, B1); PG8_BAR; PG8_SCHED;
            } else {
            PG8_LDB(B0, 0, 0); PG8_SCHED; PG8_LDA(At, 0, 0); PG8_STAGE(PG8_SA(1, 1), a1 + hstep, voffA);
            PG8_WAIT_L(8); PG8_BAR; PG8_WAIT_L(0); PG8_MMA(0, 0, At, B0); PG8_BAR; PG8_SCHED;
            PG8_LDB(B1, 0, 1); PG8_STAGE(PG8_SB(0, 0), b2, voffB);
            PG8_BAR; PG8_WAIT_L(0); PG8_MMA(0, 1, At, B1); PG8_BAR;
            PG8_LDA(At, 0, 1); PG8_STAGE(PG8_SA(0, 0), a2, voffA);
            PG8_BAR; PG8_WAIT_L(0); PG8_MMA(1, 0, At, B0); PG8_BAR; PG8_SCHED;
            PG8_STAGE(PG8_SB(0, 1), b2 + hstep, voffB);
            PG8_WAIT_V(6); PG8_BAR; PG8_MMA(1, 1, At, B1); PG8_BAR;
            PG8_LDB(B0, 1, 0); PG8_SCHED; PG8_LDA(At, 1, 0); PG8_STAGE(PG8_SA(0, 1), a2 + hstep, voffA);
            PG8_WAIT_L(8); PG8_BAR; PG8_WAIT_L(0); PG8_MMA(0, 0, At, B0); PG8_BAR; PG8_SCHED;
            PG8_LDB(B1, 1, 1); PG8_STAGE(PG8_SB(1, 0), b3, voffB);
            PG8_BAR; PG8_WAIT_L(0); PG8_MMA(0, 1, At, B1); PG8_BAR;
            PG8_LDA(At, 1, 1); PG8_STAGE(PG8_SA(1, 0), a3, voffA);
            PG8_BAR; PG8_WAIT_L(0); PG8_MMA(1, 0, At, B0); PG8_BAR; PG8_SCHED;
            PG8_STAGE(PG8_SB(1, 1), b3 + hstep, voffB);
            PG8_WAIT_V(6); PG8_BAR; PG8_MMA(1, 1, At, B1); PG8_BAR;
            }
        }
        if constexpr (ALIGN_EPI) { if (wr == 0) PG8_BAR; }
        if constexpr (!Epi::AFTER_DRAIN) { E(acc, cur, wr, wc, fr, fq); S.done(cur); }
        if (!has_next) break;
#pragma unroll
        for (int a = 0; a < 2; ++a)
#pragma unroll
            for (int b = 0; b < 2; ++b)
#pragma unroll
                for (int m = 0; m < 4; ++m)
#pragma unroll
                    for (int n = 0; n < 2; ++n) acc[a][b][m][n] = (f32x4){0.f, 0.f, 0.f, 0.f};
        cur = nxt; cA = nA; cB = nB; ++ui;
        if constexpr (ALIGN_EPI) { if (wr == 1) PG8_BAR; }
    }
    PG8_WAIT_V(0);
    if constexpr (!ALIGN_EPI) { if (wr == 0) PG8_BAR; }
    PG8_BAR;
    if constexpr (Epi::AFTER_DRAIN) { E.fused(acc, cur, wr, wc, fr, fq, lds, wid, lane); S.done(cur); }
#undef PG8_SA
#undef PG8_SB
#undef PG8_STAGE
#undef PG8_LDA
#undef PG8_LDB
#undef PG8_MMA
#undef PG8_WAIT_V
#undef PG8_WAIT_L
#undef PG8_BAR
#undef PG8_SCHED
}
}
#include <hip/hip_bf16.h>
#include <cmath>
namespace attn_body {
using bf16=__hip_bfloat16;
using bf16x8=__attribute__((ext_vector_type(8)))short;
using s16x4=__attribute__((ext_vector_type(4)))short;
using f32x16=__attribute__((ext_vector_type(16)))float;
using u32x4=__attribute__((ext_vector_type(4)))unsigned;
constexpr int BATCH=8,NHEAD=16,SEQ=4096,D=64,DM=NHEAD*D;
constexpr int NW=8,QBLK=32,QB=QBLK*NW,KVBLK=64,NQB=SEQ/QB;
constexpr int ATTN_PITCH=DM, ATTN_UNIT_ROWS=QB;
__device__ __forceinline__ int crow(int r,int hi){return (r&3)+8*(r>>2)+4*hi;}
#define SBAR() __builtin_amdgcn_sched_barrier(0)
__device__ __forceinline__ void cmask(f32x16&p0,f32x16&p1,int jb,int qrel,int hi){
  const float NEG=-INFINITY; int kb=64*jb+4*hi;
  #pragma unroll
  for(int r=0;r<16;++r){int kv=kb+(r&3)+8*(r>>2); if(kv>qrel)p0[r]=NEG; if(kv+32>qrel)p1[r]=NEG;}
}

constexpr int NSLOT=3, SLOTB=8192;
constexpr int LDS_K=0, LDS_V=NSLOT*SLOTB, LDS_WS=2*NSLOT*SLOTB, LDS_OST=LDS_WS+NW*64*4, LDS_BYTES=LDS_OST+NW*4096;
constexpr float C2=0.125f*1.4426950408889634f;
__device__ __forceinline__ void glds16(const void*gsrc,unsigned lds_dst){unsigned keep;
  asm volatile("s_mov_b32 %0, m0\n\ts_mov_b32 m0, %2\n\ts_nop 0\n\tglobal_load_lds_dwordx4 %1, off\n\ts_mov_b32 m0, %0":"=&s"(keep):"v"(gsrc),"s"(lds_dst):"memory");}
__device__ __forceinline__ float max3f(float a,float b,float c){float r;asm("v_max3_f32 %0, %1, %2, %3":"=v"(r):"v"(a),"v"(b),"v"(c));return r;}
__device__ __forceinline__ float max2f(float a,float b){float r;asm("v_max_f32_e32 %0, %1, %2":"=v"(r):"v"(a),"v"(b));return r;}
__device__ __forceinline__ float fadd_s(float a,float b){float r;asm("v_add_f32_e32 %0, %1, %2":"=v"(r):"v"(a),"v"(b));return r;}
__device__ __forceinline__ float fsub_s(float a,float b){float r;asm("v_sub_f32_e32 %0, %1, %2":"=v"(r):"v"(a),"v"(b));return r;}
typedef float f32x2_t __attribute__((ext_vector_type(2))); typedef __bf16 bf16x2_t __attribute__((ext_vector_type(2)));
__device__ __forceinline__ unsigned cvtpk_s(float lo,float hi){f32x2_t v={lo,hi};bf16x2_t b=__builtin_convertvector(v,bf16x2_t);return __builtin_bit_cast(unsigned,b);}
#define WAIT_BAR(N) asm volatile("s_waitcnt vmcnt(" #N ") lgkmcnt(0)\n\ts_barrier":::"memory")

__device__ __forceinline__ void qkt(f32x16&p0,f32x16&p1,const char*Kslot,const bf16x8*qr,const f32x16&negm,int r32,int hi){
  const char*kb=Kslot+hi*1024+r32*16;
  #pragma unroll
  for(int d0=0;d0<4;++d0){
    const bf16x8 b0=*reinterpret_cast<const bf16x8*>(kb+d0*2048);
    const bf16x8 b1=*reinterpret_cast<const bf16x8*>(kb+d0*2048+512);
    if(d0==0){p0=__builtin_amdgcn_mfma_f32_32x32x16_bf16(b0,qr[0],negm,0,0,0);p1=__builtin_amdgcn_mfma_f32_32x32x16_bf16(b1,qr[0],negm,0,0,0);}
    else{p0=__builtin_amdgcn_mfma_f32_32x32x16_bf16(b0,qr[d0],p0,0,0,0);p1=__builtin_amdgcn_mfma_f32_32x32x16_bf16(b1,qr[d0],p1,0,0,0);}}
}
typedef __attribute__((address_space(3))) const char* lds_cptr;
typedef short v4i16_t __attribute__((ext_vector_type(4)));
__device__ __forceinline__ void kload8(bf16x8*kf,lds_cptr kp){
  kf[0]=*(const __attribute__((address_space(3))) bf16x8*)(kp);      kf[1]=*(const __attribute__((address_space(3))) bf16x8*)(kp+512);
  kf[2]=*(const __attribute__((address_space(3))) bf16x8*)(kp+2048); kf[3]=*(const __attribute__((address_space(3))) bf16x8*)(kp+2560);
  kf[4]=*(const __attribute__((address_space(3))) bf16x8*)(kp+4096); kf[5]=*(const __attribute__((address_space(3))) bf16x8*)(kp+4608);
  kf[6]=*(const __attribute__((address_space(3))) bf16x8*)(kp+6144); kf[7]=*(const __attribute__((address_space(3))) bf16x8*)(kp+6656);
}
__device__ __forceinline__ void kload2(bf16x8*kf,lds_cptr kp,int j){ kf[2*j]=*(const __attribute__((address_space(3))) bf16x8*)(kp+j*2048); kf[2*j+1]=*(const __attribute__((address_space(3))) bf16x8*)(kp+j*2048+512); }
__device__ __forceinline__ s16x4 vtr(lds_cptr p){ return __builtin_bit_cast(s16x4,__builtin_amdgcn_ds_read_tr16_b64_v4i16((__attribute__((address_space(3))) v4i16_t*)p)); }
__device__ __forceinline__ float rowmax(const f32x16&p0,const f32x16&p1){
  float a=max3f(p0[0],p0[1],p1[0]),b=max3f(p0[2],p0[3],p1[1]);a=max3f(a,p1[2],p1[3]);
  #pragma unroll
  for(int r=4;r<16;r+=4){a=max3f(a,p0[r],p0[r+1]);b=max3f(b,p0[r+2],p0[r+3]);a=max3f(a,p1[r],p1[r+1]);b=max3f(b,p1[r+2],p1[r+3]);}
  const float m=max2f(a,b);
  auto rr=__builtin_amdgcn_permlane32_swap(__float_as_uint(m),__float_as_uint(m),false,false);
  return max2f(__uint_as_float(rr[0]),__uint_as_float(rr[1]));
}
__device__ __forceinline__ void pv(f32x16*o,int vb,bf16x8 pa0,bf16x8 pa1,bf16x8 pa2,bf16x8 pa3){
  #pragma unroll
  for(int d0=0;d0<2;++d0){s16x4 lo[4],hi[4];
    #pragma unroll
    for(int ks=0;ks<4;++ks){
      asm volatile("ds_read_b64_tr_b16 %0,%1 offset:%c2":"=&v"(lo[ks]):"v"(vb),"i"(d0*4096+ks*1024):"memory");
      asm volatile("ds_read_b64_tr_b16 %0,%1 offset:%c2":"=&v"(hi[ks]):"v"(vb),"i"(d0*4096+ks*1024+512):"memory");}
    asm volatile("s_waitcnt lgkmcnt(0)":::"memory");SBAR();
    #define PK(k) (bf16x8){lo[k][0],lo[k][1],lo[k][2],lo[k][3],hi[k][0],hi[k][1],hi[k][2],hi[k][3]}
    o[d0]=__builtin_amdgcn_mfma_f32_32x32x16_bf16(pa0,PK(0),o[d0],0,0,0);
    o[d0]=__builtin_amdgcn_mfma_f32_32x32x16_bf16(pa1,PK(1),o[d0],0,0,0);
    o[d0]=__builtin_amdgcn_mfma_f32_32x32x16_bf16(pa2,PK(2),o[d0],0,0,0);
    o[d0]=__builtin_amdgcn_mfma_f32_32x32x16_bf16(pa3,PK(3),o[d0],0,0,0);
    #undef PK
  }
}

#ifndef ATTN_STORE16
#define ATTN_STORE16(p,v) (*(u32x4*)(p)=(v))
#endif
template<int THRL> __device__ __forceinline__ void attn_unit(int b,int h,int qb,const bf16*Q,const bf16*__restrict__ K,const bf16*__restrict__ V,bf16*O,char*shm,const int tid_in){
  const int tid=tid_in,lane=tid&63,r32=lane&31,hi=lane>>5; const int wid=__builtin_amdgcn_readfirstlane(tid>>6);
  const long rowbase=(long)b*SEQ; const int q0=qb*QB;
  const bf16*Qw=Q+(rowbase+q0+wid*QBLK)*DM+h*D;
  const bf16*Kh=K+rowbase*DM+h*D,*Vh=V+rowbase*DM+h*D;
  const unsigned lds0=(unsigned)(uintptr_t)shm;
  float*wsf=(float*)(shm+LDS_WS)+wid*64;
  const bf16*ksrc=Kh+(long)lane*DM+wid*8;
  const bf16*vsrc=Vh+(long)(16*(wid&3)+(lane>>2))*DM+(wid>>2)*32+(lane&3)*8;
  const unsigned kdst=lds0+LDS_K+wid*1024, vdst=lds0+LDS_V+wid*1024;
  #define DMA_K(t,slot) glds16(ksrc+(long)(t)*KVBLK*DM,(unsigned)__builtin_amdgcn_readfirstlane(kdst+(slot)))
  #define DMA_V(t,slot) glds16(vsrc+(long)(t)*KVBLK*DM,(unsigned)__builtin_amdgcn_readfirstlane(vdst+(slot)))
  const int vb0=(int)(lds0+LDS_V)+((lane>>4)&1)*32+(lane&3)*8+(4*hi+((lane&15)>>2))*64;
  const char*Kbase=shm+LDS_K; bf16x8 kf[8];
  const lds_cptr shm3=(lds_cptr)shm; const lds_cptr kp0=shm3+LDS_K+hi*1024+r32*16; const lds_cptr vp0=shm3+LDS_V+((lane>>4)&1)*32+(lane&3)*8+(4*hi+((lane&15)>>2))*64;
  const int NT=(q0+QB)/KVBLK;
  DMA_K(0,0);DMA_V(0,0);DMA_K(1,SLOTB);
  bf16x8 qr[4];
  #pragma unroll
  for(int d0=0;d0<4;++d0)qr[d0]=*reinterpret_cast<const bf16x8*>(&Qw[(long)r32*DM+d0*16+hi*8]);
  float mhat=0.f,l_reg=0.f;f32x16 o[2];o[0]=f32x16{};o[1]=f32x16{};f32x16 negm=f32x16{};asm volatile("":"+v"(negm));
  const int qrel=wid*QBLK+r32;
  #define CMASK(P0,P1,t) do{int jb_=(t)-(NT-4); if(jb_>=0)cmask(P0,P1,jb_,qrel,hi);}while(0)
  bool resc=false;
  #define START(P0,P1) do{ const float rm=rowmax(P0,P1); resc=false; \
    { const float dl=rm; mhat=fadd_s(mhat,dl); \
      _Pragma("unroll") for(int r=0;r<16;++r){P0[r]=fsub_s(P0[r],dl);P1[r]=fsub_s(P1[r],dl);} \
      _Pragma("unroll") for(int r=0;r<16;++r)negm[r]=-mhat; asm volatile("":"+v"(negm)); } \
    _Pragma("unroll") for(int r=0;r<16;++r)P0[r]=__builtin_amdgcn_exp2f(P0[r]); }while(0)
  #define RESC() do{ if(resc){ asm volatile("s_waitcnt lgkmcnt(0)":::"memory"); \
      _Pragma("unroll") for(int d_=0;d_<2;++d_) _Pragma("unroll") for(int r=0;r<16;++r)o[d_][r]*=wsf[crow(r,hi)]; } }while(0)
  f32x16 pA0,pA1,pB0,pB1;
  int sl_prev=0,sl_cur=0,sl_next=SLOTB;
  #define ROT() do{sl_prev=sl_cur;sl_cur=sl_next;sl_next=(sl_next==(NSLOT-1)*SLOTB)?0:sl_next+SLOTB;}while(0)
  DMA_K(2,2*SLOTB);
  WAIT_BAR(3);
  qkt(pA0,pA1,Kbase,qr,negm,r32,hi);asm volatile("s_nop 15\n\ts_nop 7":"+v"(pA0),"+v"(pA1));CMASK(pA0,pA1,0);
  START(pA0,pA1);
  _Pragma("unroll") for(int r=0;r<16;++r)pA1[r]=__builtin_amdgcn_exp2f(pA1[r]);
  WAIT_BAR(0);
  DMA_K(3,0);DMA_V(1,SLOTB);
  ROT();
  kload8(kf,kp0+sl_cur);
  WAIT_BAR(2);
  s16x4 vlo[8],vhi[8]; u32x4 pw0,pw1,pw2,pw3;
  #define PKW(P,B) cvtpk_s(P[B],P[B+1])
  #define PAF(k) __builtin_bit_cast(bf16x8,pw##k)
  #define VFR(i) (bf16x8){vlo[i][0],vlo[i][1],vlo[i][2],vlo[i][3],vhi[i][0],vhi[i][1],vhi[i][2],vhi[i][3]}
  #define PIN(x) asm volatile("":"+v"(x))
  #define MX3(a,b,c) __builtin_fmaxf(__builtin_fmaxf((a),(b)),(c))
  #define GAPA(MF,A0,A1,A2,A3,W0,W1,PW) do{ MF; sacc+=A0; sacc+=A1; sacc+=A2; sacc+=A3; PIN(sacc); W0; W1; PIN(PW); SBAR(); }while(0)
  #define EX(v) __builtin_amdgcn_exp2f(v)
  #define GAPB(MF,X,B) do{ MF; X[B]=EX(X[B]); X[B+1]=EX(X[B+1]); X[B+2]=EX(X[B+2]); X[B+3]=EX(X[B+3]); PIN(X); SBAR(); }while(0)
  #define VRD(i) do{ vlo[i]=vtr(vp_+(((i)>>2)*4096+((i)&3)*1024)); vhi[i]=vtr(vp_+(((i)>>2)*4096+((i)&3)*1024+512)); }while(0)
  #define KRD(G,j) do{ if(G){ kload2(kf,kp0+sl_next,j); SBAR(); } }while(0)
  #define STEP(C0,C1,P0,P1,t,GK,GV,GL) do{ SBAR(); \
    const lds_cptr vp_=vp0+sl_prev; \
    VRD(0); SBAR(); float sacc=(P0[0]+P0[1]); \
    GAPA(C0=__builtin_amdgcn_mfma_f32_32x32x16_bf16(kf[0],qr[0],negm,0,0,0), P0[2],P0[3],P0[4],P0[5],     pw0[0]=PKW(P0,0), pw0[1]=PKW(P0,2), pw0); \
    VRD(4); SBAR(); GAPA(C1=__builtin_amdgcn_mfma_f32_32x32x16_bf16(kf[1],qr[0],negm,0,0,0), P0[6],P0[7],P0[8],P0[9],     pw0[2]=PKW(P0,4), pw0[3]=PKW(P0,6), pw0); \
    VRD(1); SBAR(); GAPA(C0=__builtin_amdgcn_mfma_f32_32x32x16_bf16(kf[2],qr[1],C0,0,0,0),   P0[10],P0[11],P0[12],P0[13], pw1[0]=PKW(P0,8), pw1[1]=PKW(P0,10), pw1); \
    VRD(5); SBAR(); GAPA(C1=__builtin_amdgcn_mfma_f32_32x32x16_bf16(kf[3],qr[1],C1,0,0,0),   P0[14],P0[15],P1[0],P1[1],   pw1[2]=PKW(P0,12),pw1[3]=PKW(P0,14), pw1); \
    VRD(2); SBAR(); GAPA(C0=__builtin_amdgcn_mfma_f32_32x32x16_bf16(kf[4],qr[2],C0,0,0,0),   P1[2],P1[3],P1[4],P1[5],     pw2[0]=PKW(P1,0), pw2[1]=PKW(P1,2), pw2); \
    VRD(6); SBAR(); GAPA(C1=__builtin_amdgcn_mfma_f32_32x32x16_bf16(kf[5],qr[2],C1,0,0,0),   P1[6],P1[7],P1[8],P1[9],     pw2[2]=PKW(P1,4), pw2[3]=PKW(P1,6), pw2); \
    VRD(3); SBAR(); GAPA(C0=__builtin_amdgcn_mfma_f32_32x32x16_bf16(kf[6],qr[3],C0,0,0,0),   P1[10],P1[11],P1[12],P1[13], pw3[0]=PKW(P1,8), pw3[1]=PKW(P1,10), pw3); \
    VRD(7); SBAR(); GAPA(C1=__builtin_amdgcn_mfma_f32_32x32x16_bf16(kf[7],qr[3],C1,0,0,0),   P1[14],P1[15],0.f,0.f,       pw3[2]=PKW(P1,12),pw3[3]=PKW(P1,14), pw3); \
    l_reg+=sacc; \
    if(GK){DMA_K((t)+3,sl_cur);} if(GV){DMA_V((t)+1,sl_next);} \
    CMASK(C0,C1,t); \
    { float a=MX3(C0[0],C0[1],C1[0]),b=MX3(C0[2],C0[3],C1[1]); a=MX3(a,C1[2],C1[3]); \
      _Pragma("unroll") for(int r=4;r<16;r+=4){a=MX3(a,C0[r],C0[r+1]);b=MX3(b,C0[r+2],C0[r+3]);a=MX3(a,C1[r],C1[r+1]);b=MX3(b,C1[r+2],C1[r+3]);} \
      float rm=__builtin_fmaxf(a,b); { auto rr=__builtin_amdgcn_permlane32_swap(__float_as_uint(rm),__float_as_uint(rm),false,false); rm=__builtin_fmaxf(__uint_as_float(rr[0]),__uint_as_float(rr[1])); } \
      resc=false; \
      if(__builtin_expect(__any(rm>(float)THRL),0)){ const float dl=__builtin_fmaxf(rm,0.f); mhat+=dl; \
        _Pragma("unroll") for(int r=0;r<16;++r){C0[r]-=dl;C1[r]-=dl;} \
        _Pragma("unroll") for(int r=0;r<16;++r)negm[r]=-mhat; asm volatile("":"+v"(negm)); \
        const float f=__builtin_amdgcn_exp2f(-dl); l_reg*=f; if(hi==0)wsf[r32]=f; resc=true; } } \
    SBAR(); \
    GAPB(o[0]=__builtin_amdgcn_mfma_f32_32x32x16_bf16(PAF(0),VFR(0),o[0],0,0,0), C0,0); \
    GAPB(o[1]=__builtin_amdgcn_mfma_f32_32x32x16_bf16(PAF(0),VFR(4),o[1],0,0,0), C0,4); \
    KRD(GL,0); GAPB(o[0]=__builtin_amdgcn_mfma_f32_32x32x16_bf16(PAF(1),VFR(1),o[0],0,0,0), C0,8); \
    KRD(GL,1); GAPB(o[1]=__builtin_amdgcn_mfma_f32_32x32x16_bf16(PAF(1),VFR(5),o[1],0,0,0), C0,12); \
    KRD(GL,2); GAPB(o[0]=__builtin_amdgcn_mfma_f32_32x32x16_bf16(PAF(2),VFR(2),o[0],0,0,0), C1,0); \
    KRD(GL,3); GAPB(o[1]=__builtin_amdgcn_mfma_f32_32x32x16_bf16(PAF(2),VFR(6),o[1],0,0,0), C1,4); \
    GAPB(o[0]=__builtin_amdgcn_mfma_f32_32x32x16_bf16(PAF(3),VFR(3),o[0],0,0,0), C1,8); \
    GAPB(o[1]=__builtin_amdgcn_mfma_f32_32x32x16_bf16(PAF(3),VFR(7),o[1],0,0,0), C1,12); \
    }while(0)
  int t=1;
  #undef CMASK
  #define CMASK(P0,P1,t) do{}while(0)
  for(;t+5<NT;t+=2){
    STEP(pB0,pB1,pA0,pA1,t,true,true,true);     WAIT_BAR(2); RESC(); ROT();
    STEP(pA0,pA1,pB0,pB1,t+1,true,true,true);   WAIT_BAR(2); RESC(); ROT();
  }
  #undef CMASK
  #define CMASK(P0,P1,t) do{int jb_=(t)-(NT-4); if(jb_>=0)cmask(P0,P1,jb_,qrel,hi);}while(0)
  #define ENDW(tt) do{ if((tt)+3<NT){WAIT_BAR(2);} else if((tt)+2<NT){WAIT_BAR(1);} else {WAIT_BAR(0);} }while(0)
  for(;t+1<NT;t+=2){
    STEP(pB0,pB1,pA0,pA1,t,(t+3<NT),(t+1<NT),(t+1<NT));       ENDW(t);   RESC(); ROT();
    STEP(pA0,pA1,pB0,pB1,t+1,(t+4<NT),(t+2<NT),(t+2<NT));     ENDW(t+1); RESC(); ROT();
  }
  STEP(pB0,pB1,pA0,pA1,NT-1,false,false,false); RESC();
  { float sacc=pB0[0]+pB0[1]; _Pragma("unroll") for(int r=2;r<16;++r)sacc+=pB0[r]; _Pragma("unroll") for(int r=0;r<16;++r)sacc+=pB1[r]; l_reg+=sacc;
    pw0=(u32x4){PKW(pB0,0),PKW(pB0,2),PKW(pB0,4),PKW(pB0,6)};pw1=(u32x4){PKW(pB0,8),PKW(pB0,10),PKW(pB0,12),PKW(pB0,14)};pw2=(u32x4){PKW(pB1,0),PKW(pB1,2),PKW(pB1,4),PKW(pB1,6)};pw3=(u32x4){PKW(pB1,8),PKW(pB1,10),PKW(pB1,12),PKW(pB1,14)};
    SBAR(); pv(o,vb0+sl_cur,PAF(0),PAF(1),PAF(2),PAF(3)); }
  #undef PKW
  #undef PAF
  #undef VFR
  #undef PIN
  #undef MX3
  #undef GAPA
  #undef GAPB
  #undef EX
  #undef VRD
  #undef KRD
  #undef STEP
  #undef ENDW
  {auto rr=__builtin_amdgcn_permlane32_swap(__float_as_uint(l_reg),__float_as_uint(l_reg),false,false);l_reg=__uint_as_float(rr[0])+__uint_as_float(rr[1]);}
  if(hi==0)wsf[32+r32]=l_reg;asm volatile("s_waitcnt lgkmcnt(0)":::"memory");
  float rli[16];
  #pragma unroll
  for(int r=0;r<16;++r)rli[r]=__builtin_amdgcn_rcpf(wsf[32+crow(r,hi)]);
  bf16*Ow=O+(rowbase+q0+wid*QBLK)*DM+h*D;
  { bf16*stg=(bf16*)(shm+LDS_OST)+wid*2048;
    #pragma unroll
    for(int r=0;r<16;++r){const int orow=crow(r,hi);
      #pragma unroll
      for(int d0=0;d0<2;++d0)stg[orow*64+d0*32+r32]=__float2bfloat16(o[d0][r]*rli[r]);}
    asm volatile("s_waitcnt lgkmcnt(0)":::"memory");
    #pragma unroll
    for(int i=0;i<4;++i){const int row=i*8+(lane>>3),ch=lane&7; const u32x4 v=*(const u32x4*)(stg+row*64+ch*8); ATTN_STORE16(Ow+(long)row*DM+ch*8,v);} }
  asm volatile("s_waitcnt lgkmcnt(0)\n\ts_barrier":::"memory");
  #undef DMA_K
  #undef DMA_V
  #undef CMASK
  #undef START
  #undef RESC
  #undef ROT
}
constexpr int ATTN_LDS_BYTES=LDS_BYTES;
struct AttnTensors { const bf16* Q; const bf16* K; const bf16* V; bf16* O; };
struct AttnUnit { int bh; int qb; };
template<class Sched,int THRL=8> __device__ __forceinline__ void attn_phase(char*lds,const AttnTensors&T,const Sched&S,const int tid_in){
  AttnUnit u;
  for(int i=0;S.next(i,u);++i){ S.a_ready(u); attn_unit<THRL>(u.bh/NHEAD,u.bh%NHEAD,u.qb,T.Q,T.K,T.V,T.O,lds,tid_in); S.done(u); }
}
#undef SBAR
#undef WAIT_BAR
}
constexpr int NWAVES = 8;
constexpr int BATCH = 8, SEQ = 4096, DM = 1024, M = BATCH * SEQ;
constexpr int IN_COLS = 2560, PLE_DIM = 256, NEXP = 16384, QCOLS = 2048;
constexpr float EPS = 1e-6f;
#ifndef MK_N_LAUNCHES
#define MK_N_LAUNCHES 1
#endif
constexpr int N_PHASES = 11;
constexpr size_t MiB = 1u << 20;
constexpr size_t WS_CTL = 0, CTL_ZERO_BYTES = 1 * MiB;
constexpr size_t WS_ROPEC = 1 * MiB, WS_ROPES = 1 * MiB + 512 * 1024;
constexpr size_t WS_KEYS = 2 * MiB;
constexpr size_t WS_WPROJ = 3 * MiB;
constexpr size_t WS_WIN = 4 * MiB;
constexpr size_t WS_WOUT = 10 * MiB, WS_WQ = 12 * MiB, WS_WGATE = 16 * MiB;
constexpr size_t WS_SSQ1 = 18 * MiB;
constexpr size_t WS_PB = 24 * MiB;
constexpr size_t WS_E = 40 * MiB;
constexpr size_t WS_UT = 104 * MiB, WS_VT = 120 * MiB;
constexpr size_t WS_SU = 136 * MiB, WS_SV = 137 * MiB;
constexpr size_t WS_XN = 168 * MiB;
constexpr size_t WS_QO = 232 * MiB, WS_K = 296 * MiB, WS_V = 360 * MiB;
constexpr size_t WS_U = 424 * MiB;
constexpr size_t WS_QP = 296 * MiB;
constexpr size_t WS_XN2 = 424 * MiB;
constexpr size_t WS_SM = 138 * MiB, WS_HS = 139 * MiB, WS_SSQ2 = 140 * MiB;
constexpr size_t WS_HQ = 24 * MiB;
constexpr size_t WS_APART = 168 * MiB;
constexpr size_t WS_QM = 424 * MiB;
constexpr size_t WS_EID = 488 * MiB, WS_GATE = 496 * MiB;
constexpr size_t WS_END = 512 * MiB;
constexpr int RING_BYTES = 131072, LDS_BYTES = 147456;
constexpr int MISC_OFF = LDS_BYTES - 256;
constexpr int CW_BAR = 4096;

#define GAS __attribute__((address_space(1)))
#define LAS __attribute__((address_space(3)))
typedef unsigned short bf16;
typedef unsigned v4u __attribute__((ext_vector_type(4)));
typedef float f32x4 __attribute__((ext_vector_type(4)));
typedef float f32x16 __attribute__((ext_vector_type(16)));
typedef short bf16x8 __attribute__((ext_vector_type(8)));
typedef __bf16 bf16x2_t __attribute__((ext_vector_type(2)));
#define LDS_WAIT() asm volatile("s_waitcnt lgkmcnt(0)" ::: "memory")
#define VM_WAIT() asm volatile("s_waitcnt vmcnt(0)" ::: "memory")
__device__ __forceinline__ unsigned f2bf(float f) { unsigned u = __builtin_bit_cast(unsigned, f); return (u + 0x7fffu + ((u >> 16) & 1u)) >> 16; }
__device__ __forceinline__ unsigned pk2(float lo, float hi) { return f2bf(lo) | (f2bf(hi) << 16); }
__device__ __forceinline__ v4u pk8(const f32x4 a, const f32x4 b) { v4u w; w.x = pk2(a[0], a[1]); w.y = pk2(a[2], a[3]); w.z = pk2(b[0], b[1]); w.w = pk2(b[2], b[3]); return w; }
__device__ __forceinline__ float bflo(unsigned w) { return __uint_as_float(w << 16); }
__device__ __forceinline__ float bfhi(unsigned w) { return __uint_as_float(w & 0xffff0000u); }
__device__ __forceinline__ float dot4s_(const f32x4 a) { return (a[0] * a[0] + a[1] * a[1]) + (a[2] * a[2] + a[3] * a[3]); }
__device__ __forceinline__ float wave_sum(float v) {
#pragma unroll
    for (int o = 1; o < 64; o <<= 1) v += __shfl_xor(v, o);
    return v;
}
__device__ __forceinline__ float dot2bf(unsigned w, unsigned x, float acc) { return __builtin_amdgcn_fdot2_f32_bf16(__builtin_bit_cast(bf16x2_t, w), __builtin_bit_cast(bf16x2_t, x), acc, false); }

typedef GAS unsigned gu32;
#define RLX_AGENT __ATOMIC_RELAXED, __HIP_MEMORY_SCOPE_AGENT
#define XB_TMO      128
#define XB_XCNT(j)  (256  + 64 * (j))
#define XB_XSUB(j)  (1280 + 64 * (j))
#define XB_XGEN(j)  (2304 + 64 * (j))
#define XB_TOP      3328
#define XB_TOPGEN   3392
#define XCD_BAR_WORDS 3456
#define XB_SPIN_CAP (1u << 18)

__device__ __forceinline__ unsigned xb_ld(unsigned* p)              { return __hip_atomic_load(p, __ATOMIC_RELAXED, __HIP_MEMORY_SCOPE_AGENT); }
__device__ __forceinline__ unsigned xb_add(unsigned* p, unsigned v) { return __hip_atomic_fetch_add(p, v, __ATOMIC_RELAXED, __HIP_MEMORY_SCOPE_AGENT); }
__device__ __forceinline__ unsigned xb_xcc_id() { return (unsigned)__builtin_amdgcn_s_getreg((3 << 11) | 20) & 0xFu; }
#define XB_SPIN(cond, bar) do { unsigned _sp = 0; while (cond) { __builtin_amdgcn_s_sleep(1); \
    if ((++_sp & 255u) == 0u) { if (xb_ld(&(bar)[XB_TMO])) break; if (_sp > XB_SPIN_CAP) { atomicAdd(&(bar)[XB_TMO], 1u); break; } } } } while (0)

struct XcdBarrier {
    unsigned* bar; unsigned x;
    volatile LAS unsigned* st;
};

__device__ __forceinline__ XcdBarrier xcd_barrier_post(unsigned* bar, volatile LAS unsigned* st, const bool leader) {
    XcdBarrier b; b.bar = bar; b.x = xb_xcc_id(); b.st = st;
    if (leader) (void)xb_add(&bar[XB_XCNT(b.x)], 1u);
    return b;
}
__device__ __forceinline__ void xcd_barrier_complete(unsigned* bar, unsigned x, unsigned& nloc, unsigned& nx) {
    const unsigned G = gridDim.x * gridDim.y * gridDim.z;
    unsigned sum, cnt, mine, sp = 0u;
    for (;;) {
        sum = 0u; cnt = 0u; mine = 0u;
#pragma unroll
        for (unsigned j = 0; j < 16; ++j) { const unsigned c = xb_ld(&bar[XB_XCNT(j)]); sum += c; cnt += (c > 0u) ? 1u : 0u; mine = (j == x) ? c : mine; }
        if (sum == G) break;
        __builtin_amdgcn_s_sleep(1);
        if ((++sp & 255u) == 0u) { if (xb_ld(&bar[XB_TMO])) break; if (sp > XB_SPIN_CAP) { atomicAdd(&bar[XB_TMO], 1u); break; } }
    }
    nloc = mine > 0u ? mine : 1u; nx = cnt > 0u ? cnt : 1u;
}

__device__ __forceinline__ void xcd_barrier(const XcdBarrier& b, const bool leader  ) {
    asm volatile("s_waitcnt vmcnt(0)" ::: "memory");
    __syncthreads();
    if (leader) {
        unsigned* bar = b.bar;
        __builtin_amdgcn_s_waitcnt(0);
        unsigned nloc = b.st[0], nx = b.st[1];
        if (nloc == 0u) { xcd_barrier_complete(bar, b.x, nloc, nx); b.st[0] = nloc; b.st[1] = nx; }
        const unsigned old = xb_add(&bar[XB_XSUB(b.x)], 1u);
        const unsigned gen = old / nloc;
        if (old + 1u == (gen + 1u) * nloc) {
            __builtin_amdgcn_fence(__ATOMIC_RELEASE, "agent");
            asm volatile("s_waitcnt vmcnt(0)" ::: "memory");
            const unsigned og = xb_add(&bar[XB_TOP], 1u);
            const unsigned tg = og / nx;
            if (og + 1u == (tg + 1u) * nx) xb_add(&bar[XB_TOPGEN], 1u);
            else XB_SPIN(xb_ld(&bar[XB_TOPGEN]) == tg, bar);
            __builtin_amdgcn_fence(__ATOMIC_ACQUIRE, "agent");
            xb_add(&bar[XB_XGEN(b.x)], 1u);
            asm volatile("s_waitcnt vmcnt(0)" ::: "memory");
        } else {
            XB_SPIN(xb_ld(&bar[XB_XGEN(b.x)]) == gen, bar);
            __builtin_amdgcn_fence(__ATOMIC_ACQUIRE, "agent");
            asm volatile("s_waitcnt vmcnt(0)" ::: "memory");
        }
    }
    __syncthreads();
}

__device__ __forceinline__ int lane_id() { int l; asm volatile("v_mbcnt_lo_u32_b32 %0, -1, 0\n\tv_mbcnt_hi_u32_b32 %0, -1, %0" : "=v"(l)); return l; }
#if defined(PROBE_A)
#define STAMP(i) do { if (F.wave == 0) { const unsigned long long t_ = __builtin_amdgcn_s_memrealtime(); volatile LAS unsigned* ms_ = (volatile LAS unsigned*)(F.lds + MISC_OFF) + 16 + 2 * (i); ms_[0] = (unsigned)t_; ms_[1] = (unsigned)(t_ >> 32); } } while (0)
#else
#define STAMP(i) do {} while (0)
#endif
struct Frame {
    LAS unsigned char* lds; unsigned char* ldsg;
    int wave, vcu, G;
    float* out; unsigned char* ws;
};
template <int I> __device__ __forceinline__ const float* inptr() {
    const float* p = nullptr;
#if defined(__HIP_DEVICE_COMPILE__)
    const void* ka = (const void*)__builtin_amdgcn_kernarg_segment_ptr();
    asm volatile("s_load_dwordx2 %0, %1, %2\n\ts_waitcnt lgkmcnt(0)" : "=s"(p) : "s"(ka), "i"(I * 8) : "memory");
#endif
    return p;
}
#define INP(i) inptr<i>()

__device__ const double INVREV[32] = {0.15915494309189535, 0.11934937021124886, 0.089499401608891013, 0.067115083005227255, 0.050329212104487035, 0.037741584717419771, 0.028302195830623399, 0.02122365276477766,
    0.015915494309189534, 0.011934937021124886, 0.0089499401608891024, 0.0067115083005227253, 0.0050329212104487037, 0.0037741584717419772, 0.0028302195830623399, 0.0021223652764777662,
    0.0015915494309189536, 0.0011934937021124885, 0.00089499401608891024, 0.0006711508300522726, 0.00050329212104487033, 0.00037741584717419774, 0.00028302195830623395, 0.00021223652764777661,
    0.00015915494309189535, 0.00011934937021124886, 8.9499401608891018e-05, 6.7115083005227254e-05, 5.0329212104487035e-05, 3.7741584717419777e-05, 2.8302195830623396e-05, 2.1223652764777659e-05};
__device__ __forceinline__ int win_rowmap(int n) {
    if (n < 1024) { const int region = n >> 9, r = n & 511, tile = r >> 8, w = r & 255, blk = w >> 6, d = w & 63, bj = d >> 5, dlo = d & 31; return region * 512 + tile * 256 + bj * 128 + blk * 32 + dlo; }
    if (n < 1536) return n;
    const int cc = n - 1536, isg = cc >> 9, ch = cc & 511, j = ch >> 7, c2 = ch & 127; return 1536 + j * 256 + isg * 128 + c2;
}
template <bool MAP>
__device__ __forceinline__ void p0_transpose_item(const float* W, int K, int N, bf16* WT, const float* gk, LAS float* scr, int item, int lane) {
    const int nblk = N / 32, kb = item / nblk, nb = item % nblk, k0 = 64 * kb, n0 = 32 * nb;
    float wv[32];
#pragma unroll
    for (int i = 0; i < 32; ++i) { const int kk = 2 * i + (lane >> 5); wv[i] = W[(size_t)(k0 + kk) * N + n0 + (lane & 31)]; }
    if (gk) {
#pragma unroll
        for (int i = 0; i < 32; ++i) wv[i] *= gk[k0 + 2 * i + (lane >> 5)]; }
#pragma unroll
    for (int i = 0; i < 32; ++i) { const int kk = 2 * i + (lane >> 5); scr[kk * 33 + (lane & 31)] = wv[i]; }
    LDS_WAIT(); asm volatile("" ::: "memory");
    const int c = lane & 7; const int r0 = MAP ? win_rowmap(n0) : n0;
#pragma unroll
    for (int j = 0; j < 4; ++j) { const int n = (lane >> 3) + 8 * j; const LAS float* s = scr + (8 * c) * 33 + n;
        v4u o; o.x = pk2(s[0 * 33], s[1 * 33]); o.y = pk2(s[2 * 33], s[3 * 33]); o.z = pk2(s[4 * 33], s[5 * 33]); o.w = pk2(s[6 * 33], s[7 * 33]);
        *(GAS v4u*)(WT + (size_t)(r0 + n) * K + k0 + 8 * c) = o; }
    LDS_WAIT(); asm volatile("" ::: "memory");
}
__device__ __forceinline__ void cvt_stream(const float* src, bf16* dst, size_t n8, int gw, int NGW, int lane) {
    for (size_t c = (size_t)gw * 64 + lane; c < n8; c += (size_t)NGW * 64) { const f32x4 a = *(const GAS f32x4*)(src + c * 8), b = *(const GAS f32x4*)(src + c * 8 + 4); *(GAS v4u*)(dst + c * 8) = pk8(a, b); }
}
__device__ __forceinline__ void p0_prologue(Frame& F) {
    const int lane = lane_id();
    LAS float* scr = (LAS float*)(F.lds + F.wave * 16384);
    const int gw = F.vcu * NWAVES + F.wave, NGW = F.G * NWAVES;
    bf16* WIN = (bf16*)(F.ws + WS_WIN); bf16* WOUT = (bf16*)(F.ws + WS_WOUT); bf16* WQ = (bf16*)(F.ws + WS_WQ); bf16* WGATE = (bf16*)(F.ws + WS_WGATE); bf16* WPROJ = (bf16*)(F.ws + WS_WPROJ);
    constexpr int I_IN = (DM / 64) * (IN_COLS / 32), I_OUT = (DM / 64) * (DM / 32), I_Q = (DM / 64) * (QCOLS / 32), I_G = I_OUT, I_P = (PLE_DIM / 64) * (DM / 32);
    constexpr int NITEMS = I_IN + I_OUT + I_Q + I_G + I_P;
    for (int it = gw; it < NITEMS; it += NGW) {
        int r = it;
        if (r < I_IN) { p0_transpose_item<true>(INP(3), DM, IN_COLS, WIN, nullptr, scr, r, lane); continue; } r -= I_IN;
        if (r < I_OUT) { p0_transpose_item<false>(INP(13), DM, DM, WOUT, nullptr, scr, r, lane); continue; } r -= I_OUT;
        if (r < I_Q) { p0_transpose_item<false>(INP(15), DM, QCOLS, WQ, INP(14), scr, r, lane); continue; } r -= I_Q;
        if (r < I_G) { p0_transpose_item<false>(INP(20), DM, DM, WGATE, INP(19), scr, r, lane); continue; } r -= I_G;
        p0_transpose_item<false>(INP(21), PLE_DIM, DM, WPROJ, nullptr, scr, r, lane);
    }
    cvt_stream(INP(16), (bf16*)(F.ws + WS_KEYS), (size_t)2 * 128 * 128 / 8, gw, NGW, lane);
    { const float* ut = INP(17); const float* vt = INP(18); float* SU = (float*)(F.ws + WS_SU); float* SV = (float*)(F.ws + WS_SV);
      for (int r0 = gw; r0 < 2 * NEXP; r0 += 4 * NGW) {
          f32x4 v[4][4];
#pragma unroll
          for (int u = 0; u < 4; ++u) { const int r = r0 + u * NGW; const bool isv = r >= NEXP; const int e = isv ? r - NEXP : r; const float* src = (isv ? vt : ut) + (size_t)e * DM + 16 * lane;
#pragma unroll
              for (int i = 0; i < 4; ++i) v[u][i] = *(const GAS f32x4*)(src + 4 * i); }
#pragma unroll
          for (int u = 0; u < 4; ++u) { const int r = r0 + u * NGW; const bool isv = r >= NEXP; const int e = isv ? r - NEXP : r; float amax = 0.f;
#pragma unroll
              for (int i = 0; i < 4; ++i) amax = fmaxf(amax, fmaxf(fmaxf(__builtin_fabsf(v[u][i][0]), __builtin_fabsf(v[u][i][1])), fmaxf(__builtin_fabsf(v[u][i][2]), __builtin_fabsf(v[u][i][3]))));
#pragma unroll
              for (int o = 1; o < 64; o <<= 1) amax = fmaxf(amax, __shfl_xor(amax, o));
              const float inv = 127.f / fmaxf(amax, 1e-30f); v4u w;
#pragma unroll
              for (int i = 0; i < 4; ++i) { const int a = (int)__builtin_rintf(v[u][i][0] * inv), b = (int)__builtin_rintf(v[u][i][1] * inv), c = (int)__builtin_rintf(v[u][i][2] * inv), d = (int)__builtin_rintf(v[u][i][3] * inv);
                  w[i] = (unsigned)(a & 0xff) | ((unsigned)(b & 0xff) << 8) | ((unsigned)(c & 0xff) << 16) | ((unsigned)d << 24); }
              *(GAS v4u*)(F.ws + (isv ? WS_VT : WS_UT) + ((size_t)(lane >> 3) * NEXP + e) * 128 + 16 * (lane & 7)) = w;
              if (lane == 0) (isv ? SV : SU)[e] = amax * (1.f / 127.f); } } }
    cvt_stream(INP(1), (bf16*)(F.ws + WS_PB), (size_t)M * PLE_DIM / 8, gw, NGW, lane);
    { float* rc = (float*)(F.ws + WS_ROPEC); float* rs = (float*)(F.ws + WS_ROPES);
      for (int idx = gw * 64 + lane; idx < SEQ * 32; idx += NGW * 64) { const int pos = idx >> 5, i = idx & 31; const double rev = (double)pos * INVREV[i]; const float fr = (float)(rev - __builtin_floor(rev));
          rc[idx] = __builtin_amdgcn_cosf(fr); rs[idx] = __builtin_amdgcn_sinf(fr); } }
    { const float* x = INP(0); const float* g = INP(2); bf16* XN = (bf16*)(F.ws + WS_XN);
      f32x4 gv[4];
#pragma unroll
      for (int j = 0; j < 4; ++j) gv[j] = ((const GAS f32x4*)g)[64 * j + lane];
      for (int m0 = gw; m0 < M; m0 += 4 * NGW) {
          f32x4 v[4][4];
#pragma unroll
          for (int u = 0; u < 4; ++u) { const GAS f32x4* xr = (const GAS f32x4*)(x + (size_t)(m0 + u * NGW) * DM) + lane;
#pragma unroll
              for (int j = 0; j < 4; ++j) v[u][j] = xr[64 * j]; }
#pragma unroll
          for (int u = 0; u < 4; ++u) { float s2 = 0.f;
#pragma unroll
              for (int j = 0; j < 4; ++j) s2 += (v[u][j].x * v[u][j].x + v[u][j].y * v[u][j].y) + (v[u][j].z * v[u][j].z + v[u][j].w * v[u][j].w);
              const float rstd = rsqrtf(wave_sum(s2) * (1.f / DM) + EPS);
              GAS unsigned long long* o8 = (GAS unsigned long long*)(XN + (size_t)(m0 + u * NGW) * DM) + lane;
#pragma unroll
              for (int j = 0; j < 4; ++j) { const f32x4 w = v[u][j] * rstd * gv[j]; o8[64 * j] = (unsigned long long)pk2(w.x, w.y) | ((unsigned long long)pk2(w.z, w.w) << 32); } } } }
}

struct AttnOrder {
    int vcu;
    __device__ __forceinline__ bool next(int i, attn_body::AttnUnit& u) const { if (i >= 8) return false; const int s = vcu & 7; u.bh = (vcu >> 5) * 16 + ((vcu >> 3) & 3) * 4 + (i & 3); u.qb = (i < 4) ? 15 - s : s; return true; }
    __device__ __forceinline__ void a_ready(const attn_body::AttnUnit&) const {}
    __device__ __forceinline__ void done(const attn_body::AttnUnit&) const {}
};
__device__ __forceinline__ void p2_attention(Frame& F) {
    { const attn_body::AttnTensors AT{(const attn_body::bf16*)(F.ws + WS_QO), (const attn_body::bf16*)(F.ws + WS_K), (const attn_body::bf16*)(F.ws + WS_V), (attn_body::bf16*)(F.ws + WS_QO)};
      const AttnOrder S{F.vcu};
      attn_body::attn_phase<AttnOrder>((char*)F.ldsg, AT, S, F.wave * 64 + lane_id()); }
    VM_WAIT(); __syncthreads(); STAMP(12);
    const int lane = lane_id();
    const float s1 = wave_sum(INP(4)[lane] * INP(5)[lane]), s2 = wave_sum(INP(6)[lane] * INP(7)[lane]);
    const float lam = __expf(s1) - __expf(s2) + 0.2f;
    const float* sg = INP(8); const float g0 = sg[2 * lane] * 0.8f, g1 = sg[2 * lane + 1] * 0.8f;
    const unsigned* O32 = (const unsigned*)(F.ws + WS_QO); unsigned* A2 = (unsigned*)(F.ws + WS_XN);
    const int b = F.vcu >> 5, h = (F.vcu >> 3) & 3, s = F.vcu & 7;
    for (int i = 0; i < 2; ++i) { const int qb = (i == 0) ? 15 - s : s;
        const size_t rbase = (size_t)b * SEQ + (size_t)qb * 256 + F.wave * 32;
        for (int r = 0; r < 32; r += 4) {
            unsigned w0[4], w1[4];
#pragma unroll
            for (int u = 0; u < 4; ++u) { const size_t row = rbase + r + u; w0[u] = __builtin_nontemporal_load(O32 + row * 512 + (h * 4 + 0 + (lane >> 5)) * 32 + (lane & 31)); w1[u] = __builtin_nontemporal_load(O32 + row * 512 + (h * 4 + 2 + (lane >> 5)) * 32 + (lane & 31)); }
#pragma unroll
            for (int u = 0; u < 4; ++u) { const size_t row = rbase + r + u;
                const float d0 = bflo(w0[u]) - lam * bflo(w1[u]), d1 = bfhi(w0[u]) - lam * bfhi(w1[u]);
                const float rstd = rsqrtf(wave_sum(d0 * d0 + d1 * d1) * (1.f / 128.f) + EPS);
                A2[row * 512 + h * 64 + lane] = pk2(d0 * rstd * g0, d1 * rstd * g1); } } }
}
__device__ __forceinline__ void p2_conv(Frame& F) {
    const bf16* Ub = (const bf16*)(F.ws + WS_U); bf16* A2 = (bf16*)(F.ws + WS_XN);
    LAS float* yl = (LAS float*)F.lds;
    const int lane = lane_id(); const int c = F.wave * 64 + lane;
    float w[31];
    { const float* cw = INP(9);
#pragma unroll
      for (int j = 0; j < 31; ++j) w[j] = cw[j * 512 + c]; }
    const float bias = INP(10)[c];
    const float* lng = INP(11); const float* lnb = INP(12);
    const f32x4 lg0 = *(const f32x4*)(lng + 8 * lane), lg1 = *(const f32x4*)(lng + 8 * lane + 4), lb0 = *(const f32x4*)(lnb + 8 * lane), lb1 = *(const f32x4*)(lnb + 8 * lane + 4);
    for (int tile = F.vcu; tile < M / 32; tile += F.G) {
        const int t0 = tile * 32, pos0 = t0 & (SEQ - 1);
        float xin[62];
#pragma unroll
        for (int r = 0; r < 62; ++r) { const int p = pos0 - 30 + r; xin[r] = (p >= 0) ? __uint_as_float((unsigned)Ub[(size_t)(t0 - 30 + r) * 512 + c] << 16) : 0.f; }
#pragma unroll
        for (int t = 0; t < 32; ++t) { float y = bias;
#pragma unroll
            for (int j = 0; j < 31; ++j) y += w[j] * xin[t + j];
            yl[t * 512 + c] = y; }
        __syncthreads();
#pragma unroll
        for (int q = 0; q < 4; ++q) { const int t = F.wave * 4 + q;
            const f32x4 a = *(const LAS f32x4*)(yl + t * 512 + 8 * lane), b2 = *(const LAS f32x4*)(yl + t * 512 + 8 * lane + 4);
            const float mean = wave_sum((a[0] + a[1]) + (a[2] + a[3]) + (b2[0] + b2[1]) + (b2[2] + b2[3])) * (1.f / 512.f);
            const f32x4 da = a - mean, db = b2 - mean;
            const float var = wave_sum((da[0] * da[0] + da[1] * da[1]) + (da[2] * da[2] + da[3] * da[3]) + (db[0] * db[0] + db[1] * db[1]) + (db[2] * db[2] + db[3] * db[3])) * (1.f / 512.f);
            const float rstd = rsqrtf(var + EPS);
            f32x4 oa = da * rstd * lg0 + lb0, ob = db * rstd * lg1 + lb1;
#pragma unroll
            for (int e = 0; e < 4; ++e) { oa[e] = oa[e] * __builtin_amdgcn_rcpf(1.0f + __expf(-oa[e])); ob[e] = ob[e] * __builtin_amdgcn_rcpf(1.0f + __expf(-ob[e])); }
            *(GAS v4u*)(A2 + (size_t)(t0 + t) * 1024 + 512 + 8 * lane) = pk8(oa, ob); }
        __syncthreads();
    }
}
__device__ __forceinline__ int crow16(int r, int hi) { return (r & 3) + 8 * (r >> 2) + 4 * hi; }
__device__ __forceinline__ unsigned enc_key(float f, unsigned tag, unsigned mask) { unsigned u = __float_as_uint(f); u = (u & 0x80000000u) ? ~u : (u | 0x80000000u); return (u & ~mask) | tag; }
__device__ __forceinline__ float dec_key(unsigned k, unsigned mask) { unsigned u = k & ~mask; u = (u & 0x80000000u) ? (u & 0x7fffffffu) : ~u; return __uint_as_float(u); }
__device__ __forceinline__ void ce_desc(unsigned& a, unsigned& b) { const unsigned mx = a > b ? a : b, mn = a > b ? b : a; a = mx; b = mn; }
template <int K, int J> __device__ __forceinline__ void bitonic_stage16(unsigned (&a)[16]) {
#pragma unroll
    for (int i = 0; i < 16; ++i) { const int l = i ^ J; if (l > i) { if ((i & K) == 0) ce_desc(a[i], a[l]); else ce_desc(a[l], a[i]); } }
}
__device__ __forceinline__ void sort16_desc(unsigned (&a)[16]) {
    bitonic_stage16<2, 1>(a); bitonic_stage16<4, 2>(a); bitonic_stage16<4, 1>(a); bitonic_stage16<8, 4>(a); bitonic_stage16<8, 2>(a); bitonic_stage16<8, 1>(a);
    bitonic_stage16<16, 8>(a); bitonic_stage16<16, 4>(a); bitonic_stage16<16, 2>(a); bitonic_stage16<16, 1>(a);
}
__device__ __forceinline__ void merge16_desc(unsigned (&a)[16], const unsigned (&b)[16]) {
#pragma unroll
    for (int i = 0; i < 16; ++i) a[i] = a[i] > b[15 - i] ? a[i] : b[15 - i];
    bitonic_stage16<16, 8>(a); bitonic_stage16<16, 4>(a); bitonic_stage16<16, 2>(a); bitonic_stage16<16, 1>(a);
}
__device__ __forceinline__ void top16_of_64(unsigned (&k)[4][16]) {
    sort16_desc(k[0]); sort16_desc(k[1]); sort16_desc(k[2]); sort16_desc(k[3]);
    merge16_desc(k[0], k[1]); merge16_desc(k[2], k[3]); merge16_desc(k[0], k[2]);
}
__host__ __device__ constexpr int cand_i(int s) { int c = 0; for (int i = 0; i < 16; ++i) { const int nj = 16 / (i + 1); if (s < c + nj) return i; c += nj; } return -1; }
__host__ __device__ constexpr int cand_j(int s) { int c = 0; for (int i = 0; i < 16; ++i) { const int nj = 16 / (i + 1); if (s < c + nj) return s - c; c += nj; } return -1; }
template <int S> __device__ __forceinline__ void cand_fill(unsigned (&c)[4][16], const float (&v0)[16], const float (&v1)[16]) {
    if constexpr (S < 64) { constexpr int i = cand_i(S), j = cand_j(S);
        if constexpr (i >= 0) c[S >> 4][S & 15] = enc_key(v0[i] + v1[j], 255u - (unsigned)(i * 16 + j), 255u); else c[S >> 4][S & 15] = 0u;
        cand_fill<S + 1>(c, v0, v1); }
}
__device__ __forceinline__ float gelu_exact(float v) {
    const float av = __builtin_fabsf(v), d = av * 0.2316418882f + 1.0f, t = __builtin_amdgcn_rcpf(d);
    float q = t * 0.5307027145f + (-0.7265760135f); q = q * t + 0.7107068705f; q = q * t + (-0.142248368f); q = q * t + 0.127414796f; q = q * t;
    const float e = __builtin_amdgcn_exp2f((v * v) * (-0.72134752044f)); const float m = v * (q * e); return v < 0.f ? m : v - m;
}
typedef float f32x2 __attribute__((ext_vector_type(2)));
__device__ __forceinline__ float ub0(unsigned w) { return (float)(w & 0xffu); }
__device__ __forceinline__ float ub1(unsigned w) { return (float)((w >> 8) & 0xffu); }
__device__ __forceinline__ float ub2(unsigned w) { return (float)((w >> 16) & 0xffu); }
__device__ __forceinline__ float ub3(unsigned w) { return (float)(w >> 24); }
__device__ __forceinline__ float wave_max(float v) {
#pragma unroll
    for (int o = 1; o < 64; o <<= 1) v = fmaxf(v, __shfl_xor(v, o));
    return v;
}
__device__ __forceinline__ int reduce8(const int (&p)[8], int lane) {
    const bool b0 = lane & 1, b1 = lane & 2, b2 = lane & 4;
    int q[4], r[2];
#pragma unroll
    for (int i = 0; i < 4; ++i) { const int keep = b0 ? p[2 * i + 1] : p[2 * i], send = b0 ? p[2 * i] : p[2 * i + 1]; q[i] = keep + __builtin_amdgcn_update_dpp(0, send, 0xB1, 0xF, 0xF, true); }
#pragma unroll
    for (int i = 0; i < 2; ++i) { const int keep = b1 ? q[2 * i + 1] : q[2 * i], send = b1 ? q[2 * i] : q[2 * i + 1]; r[i] = keep + __builtin_amdgcn_update_dpp(0, send, 0x4E, 0xF, 0xF, true); }
    int s; { const int keep = b2 ? r[1] : r[0], send = b2 ? r[0] : r[1]; s = keep + __builtin_amdgcn_ds_swizzle(send, 0x101F); }
    s += __builtin_amdgcn_ds_swizzle(s, 0x201F); s += __builtin_amdgcn_ds_swizzle(s, 0x401F);
    { const auto rr = __builtin_amdgcn_permlane32_swap((unsigned)s, (unsigned)s, false, false); s = (int)rr[0] + (int)rr[1]; }
    return s;
}
constexpr int P5_TOK = 32;
constexpr int P5_KEYS = 0, P5_LS = 65536, P5_EID = 65536 + 33792, P5_GATE = 65536 + 33792 + 16384;
__device__ __forceinline__ void p5a_topk(Frame& F) {
    const bf16* QP = (const bf16*)(F.ws + WS_QP); const bf16* KEYS = (const bf16*)(F.ws + WS_KEYS);
    LAS unsigned* lsc = (LAS unsigned*)(F.lds + P5_LS) + (F.wave * 32 + (lane_id() & 31)) * 33; LAS unsigned* eidL = (LAS unsigned*)(F.lds + P5_EID); LAS float* gateL = (LAS float*)(F.lds + P5_GATE);
    const int lane = lane_id(), tid = F.wave * 64 + lane, r32 = lane & 31, hi = lane >> 5, h = F.wave;
    const float* gffn = INP(14);
#pragma unroll
    for (int i = 0; i < 8; ++i) { const int q = tid + 512 * i, row = q >> 4, ch = q & 15; *(LAS v4u*)(F.lds + P5_KEYS + row * 256 + ((ch ^ (row & 15)) << 4)) = *(const GAS v4u*)(KEYS + row * 128 + ch * 8); }
    __syncthreads();
    const LAS unsigned char* kl = F.lds + P5_KEYS + r32 * 256;
    for (int tile = F.vcu; tile < M / P5_TOK; tile += F.G) {
        const size_t t0 = (size_t)tile * P5_TOK;
        float sv[2][16];
#pragma unroll
        for (int c = 0; c < 2; ++c) {
            bf16x8 qf[8];
#pragma unroll
            for (int ks = 0; ks < 8; ++ks) qf[ks] = *(const bf16x8*)(QP + (t0 + r32) * QCOLS + h * 256 + c * 128 + ks * 16 + hi * 8);
            unsigned key[4][16];
#pragma unroll
            for (int nb = 0; nb < 4; ++nb) { f32x16 acc = {}; asm volatile("" ::: "memory");
#pragma unroll
                for (int ks = 0; ks < 8; ++ks) { const bf16x8 kf = *(const LAS bf16x8*)(kl + (c * 128 + nb * 32) * 256 + (((ks * 2 + hi) ^ (r32 & 15)) << 4)); acc = __builtin_amdgcn_mfma_f32_32x32x16_bf16(kf, qf[ks], acc, 0, 0, 0); }
#pragma unroll
                for (int r = 0; r < 16; ++r) key[nb][r] = enc_key(acc[r], 127u - (unsigned)(nb * 32 + crow16(r, hi)), 127u); }
            top16_of_64(key);
            unsigned other[16];
#pragma unroll
            for (int i = 0; i < 16; ++i) other[i] = __shfl_xor(key[0][i], 32);
            merge16_desc(key[0], other);
#pragma unroll
            for (int i = 0; i < 16; ++i) { sv[c][i] = dec_key(key[0][i], 127u); if (hi == 0) lsc[c * 16 + i] = key[0][i]; }
        }
        asm volatile("" ::: "memory");
        unsigned cand[4][16];
        cand_fill<0>(cand, sv[0], sv[1]);
        top16_of_64(cand);
        LDS_WAIT();
        { float wv[16]; float wsum = 0.f; const float mx = dec_key(cand[0][0], 255u);
#pragma unroll
          for (int k = 0; k < 16; ++k) { wv[k] = __expf(dec_key(cand[0][k], 255u) - mx); wsum += wv[k]; }
          const float rs = 1.0f / wsum;
#pragma unroll
          for (int k = 0; k < 16; ++k) { const unsigned id = 255u - (cand[0][k] & 255u); const unsigned k0 = lsc[id >> 4], k1 = lsc[16 + (id & 15u)];
              const unsigned e = (127u - (k0 & 127u)) * 128u + (127u - (k1 & 127u));
              if (hi == 0) { eidL[r32 * 128 + h * 16 + k] = e; gateL[r32 * 128 + h * 16 + k] = wv[k] * rs; } } }
        __syncthreads();
        { const int token = tid >> 4, seg = tid & 15; const LAS unsigned* es = eidL + token * 128 + seg * 8; const LAS float* gs = gateL + token * 128 + seg * 8;
          v4u w; w.x = es[0] | (es[1] << 16); w.y = es[2] | (es[3] << 16); w.z = es[4] | (es[5] << 16); w.w = es[6] | (es[7] << 16);
          *(GAS v4u*)(F.ws + WS_EID + (t0 + token) * 256 + seg * 16) = w;
          *(GAS f32x4*)(F.ws + WS_GATE + (t0 + token) * 512 + seg * 32) = *(const LAS f32x4*)gs; *(GAS f32x4*)(F.ws + WS_GATE + (t0 + token) * 512 + seg * 32 + 16) = *(const LAS f32x4*)(gs + 4); }
        { f32x4 hv[4][4];
#pragma unroll
          for (int j = 0; j < 4; ++j) { const bf16* hrow = (const bf16*)F.out + (t0 + F.wave * 4 + j) * DM + 16 * lane;
              const v4u w0 = *(const GAS v4u*)hrow, w1 = *(const GAS v4u*)(hrow + 8);
              hv[j][0] = (f32x4){bflo(w0.x), bfhi(w0.x), bflo(w0.y), bfhi(w0.y)}; hv[j][1] = (f32x4){bflo(w0.z), bfhi(w0.z), bflo(w0.w), bfhi(w0.w)};
              hv[j][2] = (f32x4){bflo(w1.x), bfhi(w1.x), bflo(w1.y), bfhi(w1.y)}; hv[j][3] = (f32x4){bflo(w1.z), bfhi(w1.z), bflo(w1.w), bfhi(w1.w)}; }
          f32x4 gv[4];
#pragma unroll
          for (int i = 0; i < 4; ++i) gv[i] = *(const f32x4*)(gffn + 16 * lane + 4 * i);
#pragma unroll
          for (int j = 0; j < 4; ++j) { const size_t tok = t0 + F.wave * 4 + j;
            const float rstd1 = rsqrtf(wave_sum(dot4s_(hv[j][0]) + dot4s_(hv[j][1]) + dot4s_(hv[j][2]) + dot4s_(hv[j][3])) * (1.f / DM) + EPS);
            f32x4 mv[4]; float amax = 0.f;
#pragma unroll
            for (int i = 0; i < 4; ++i) { mv[i] = hv[j][i] * rstd1 * gv[i];
                amax = fmaxf(amax, fmaxf(fmaxf(__builtin_fabsf(mv[i][0]), __builtin_fabsf(mv[i][1])), fmaxf(__builtin_fabsf(mv[i][2]), __builtin_fabsf(mv[i][3])))); }
            amax = wave_max(amax); const float inv = 127.f / fmaxf(amax, 1e-30f); v4u qm;
#pragma unroll
            for (int i = 0; i < 4; ++i) { const int a = (int)__builtin_rintf(mv[i][0] * inv), b = (int)__builtin_rintf(mv[i][1] * inv), c = (int)__builtin_rintf(mv[i][2] * inv), d = (int)__builtin_rintf(mv[i][3] * inv);
                qm[i] = (unsigned)(a & 0xff) | ((unsigned)(b & 0xff) << 8) | ((unsigned)(c & 0xff) << 16) | ((unsigned)d << 24); }
            *(GAS v4u*)(F.ws + WS_QM + ((size_t)(lane >> 3) * M + tok) * 128 + 16 * (lane & 7)) = qm;
            if (lane == 0) ((float*)(F.ws + WS_SM))[tok] = amax * (1.f / 127.f);
          } }
        __syncthreads();
    }
}
__device__ __forceinline__ int xl1(int v) { return __builtin_amdgcn_update_dpp(0, v, 0xB1, 0xF, 0xF, true); }
__device__ __forceinline__ int xl2(int v) { return __builtin_amdgcn_update_dpp(0, v, 0x4E, 0xF, 0xF, true); }
__device__ __forceinline__ int xl4(int v) { return __builtin_amdgcn_ds_swizzle(v, 0x101F); }
__device__ __forceinline__ int xl8(int v) { return __builtin_amdgcn_ds_swizzle(v, 0x201F); }
__device__ __forceinline__ int xl16(int v) { return __builtin_amdgcn_ds_swizzle(v, 0x401F); }
__device__ __forceinline__ int xl32(int v, bool hi) { const auto rr = __builtin_amdgcn_permlane32_swap((unsigned)v, (unsigned)v, false, false); return (int)(hi ? rr[0] : rr[1]); }
__device__ __forceinline__ float fxl8(float v) { return __int_as_float(xl8(__float_as_int(v))); }
__device__ __forceinline__ float fxl16(float v) { return __int_as_float(xl16(__float_as_int(v))); }
__device__ __forceinline__ float fxl32(float v, bool hi) { return __int_as_float(xl32(__float_as_int(v), hi)); }
#define TSTEP(dst, src, n, c, XF) _Pragma("unroll") for (int ni_ = 0; ni_ < (n) / 2; ++ni_) { const int i_ = (ni_ & 1) | ((ni_ >> 1) << 2); const auto lo_ = src[i_], hi_ = src[i_ + 2]; dst[ni_] = ((c) ? hi_ : lo_) + XF((c) ? lo_ : hi_); }

#define ASM_LD16(dst, ptr) asm volatile("global_load_dwordx4 %0, %1, off" : "+v"(dst) : "v"(ptr) : "memory")
#define ASM_LD8(dst, ptr) asm volatile("global_load_dwordx2 %0, %1, off" : "+v"(dst) : "v"(ptr) : "memory")
#define ASM_LD4(dst, ptr) asm volatile("global_load_dword %0, %1, off" : "+v"(dst) : "v"(ptr) : "memory")
#define ASM_WAIT4(N, a, b, c, d) asm volatile("s_waitcnt vmcnt(" #N ")" : "+v"(a), "+v"(b), "+v"(c), "+v"(d) :: "memory")
#define ASM_WAIT5(N, a, b, c, d, e) asm volatile("s_waitcnt vmcnt(" #N ")" : "+v"(a), "+v"(b), "+v"(c), "+v"(d), "+v"(e) :: "memory")
__device__ __forceinline__ void p5b_udot(Frame& F) {
    const int lane = lane_id(), g = lane >> 3, s = lane & 7;
    const int x = blockIdx.x & 7, rk = blockIdx.x >> 3, nrk = F.G >> 3;
    const unsigned char* UTs = F.ws + WS_UT + (size_t)x * NEXP * 128 + 16 * s; const unsigned char* QMs = F.ws + WS_QM + (size_t)x * M * 128 + 16 * s; const unsigned char* EIDs = F.ws + WS_EID + 32 * g;
    int* AP = (int*)(F.ws + WS_APART) + (size_t)x * M * 128 + 2 * lane;
    const bool c0 = s & 1, c1 = s & 2, c2 = s & 4;
    const int nT = M / nrk; LAS unsigned* qctr = (LAS unsigned*)(F.lds + MISC_OFF) + 62;
#define P5_PULL(jv, tv) do { unsigned j_ = 0; if (lane == 0) j_ = __hip_atomic_fetch_add(qctr, 1u, __ATOMIC_RELAXED, __HIP_MEMORY_SCOPE_WORKGROUP); jv = (int)__builtin_amdgcn_readfirstlane(j_); tv = rk + nrk * (jv < nT ? jv : nT - 1); } while (0)
#define P5B_E(i, E0, E1) ((((i) & 1) ? (((i) < 8 ? E0[(i) >> 1] : E1[((i) - 8) >> 1]) >> 16) : (((i) < 8 ? E0[(i) >> 1] : E1[((i) - 8) >> 1]) & 0xffffu)))
#define P5B_LDMETA(E0, E1, Q, tq_, te_) do { ASM_LD16(E0, EIDs + (size_t)(te_) * 256); ASM_LD16(E1, EIDs + (size_t)(te_) * 256 + 16); ASM_LD16(Q, QMs + (size_t)(tq_) * 128); } while (0)
#define P5B_ITER(RR, E0, E1, Q, tcur, tq, te) do { int p_[16]; \
        asm volatile("s_waitcnt vmcnt(19)" : "+v"(E0), "+v"(E1), "+v"(Q) :: "memory"); \
        _Pragma("unroll") for (int b = 0; b < 4; ++b) { \
            ASM_WAIT4(34, RR[4 * b], RR[4 * b + 1], RR[4 * b + 2], RR[4 * b + 3]); __builtin_amdgcn_sched_barrier(0); \
            _Pragma("unroll") for (int j = 0; j < 4; ++j) { const int i = 4 * b + j; p_[i] = __builtin_amdgcn_sdot4((int)RR[i].x, (int)Q.x, __builtin_amdgcn_sdot4((int)RR[i].y, (int)Q.y, __builtin_amdgcn_sdot4((int)RR[i].z, (int)Q.z, __builtin_amdgcn_sdot4((int)RR[i].w, (int)Q.w, 0, false), false), false), false); } \
            __builtin_amdgcn_sched_barrier(0); \
            _Pragma("unroll") for (int j = 0; j < 4; ++j) { const int i = 4 * b + j; ASM_LD16(RR[i], UTs + (size_t)P5B_E(i, E0, E1) * 128); } \
            __builtin_amdgcn_sched_barrier(0); } \
        int a8_[8], a4_[4], a2_[2]; TSTEP(a8_, p_, 16, c0, xl1) TSTEP(a4_, a8_, 8, c1, xl2) TSTEP(a2_, a4_, 4, c2, xl4) \
        *(GAS unsigned long long*)(AP + (size_t)(tcur) * 128) = (unsigned long long)(unsigned)a2_[0] | ((unsigned long long)(unsigned)a2_[1] << 32); \
        __builtin_amdgcn_sched_barrier(0); P5B_LDMETA(E0, E1, Q, tq, te); __builtin_amdgcn_sched_barrier(0); } while (0)
    int j0, j1, j2, j3, j4, j5, p0, p1, p2, p3, p4, p5;
    P5_PULL(j0, p0); P5_PULL(j1, p1); P5_PULL(j2, p2); P5_PULL(j3, p3);
    v4u RA[16], RB[16], eA0, eA1, qA, eB0, eB1, qB;
    { const v4u e0 = *(const GAS v4u*)(EIDs + (size_t)p0 * 256), e1 = *(const GAS v4u*)(EIDs + (size_t)p0 * 256 + 16), f0 = *(const GAS v4u*)(EIDs + (size_t)p1 * 256), f1 = *(const GAS v4u*)(EIDs + (size_t)p1 * 256 + 16);
      eA0 = e0; eA1 = e1; qA = e0; eB0 = e0; eB1 = e1; qB = e0;
#pragma unroll
      for (int i = 0; i < 16; ++i) { RA[i] = e0; RB[i] = e0; }
      asm volatile("s_waitcnt vmcnt(0)" ::: "memory");
#pragma unroll
      for (int i = 0; i < 16; ++i) ASM_LD16(RA[i], UTs + (size_t)P5B_E(i, e0, e1) * 128);
#pragma unroll
      for (int i = 0; i < 16; ++i) ASM_LD16(RB[i], UTs + (size_t)P5B_E(i, f0, f1) * 128); }
    P5B_LDMETA(eA0, eA1, qA, p0, p2); P5B_LDMETA(eB0, eB1, qB, p1, p3);
    asm volatile("s_waitcnt vmcnt(0)" ::: "memory");
#pragma unroll 1
    while (j0 < nT) {
        P5_PULL(j4, p4); P5B_ITER(RA, eA0, eA1, qA, p0, p2, p4);
        P5_PULL(j5, p5); P5B_ITER(RB, eB0, eB1, qB, p1, p3, p5);
        j0 = j2; j1 = j3; j2 = j4; j3 = j5; p0 = p2; p1 = p3; p2 = p4; p3 = p5;
    }
    asm volatile("s_waitcnt vmcnt(0)" ::: "memory");
#undef P5B_E
#undef P5B_LDMETA
#undef P5B_ITER
}
__device__ __forceinline__ void p5b2_gelu(Frame& F) {
    const int lane = lane_id(); const int gw = F.vcu * NWAVES + F.wave, NGW = F.G * NWAVES;
    const float* SU = (const float*)(F.ws + WS_SU); const float* SV = (const float*)(F.ws + WS_SV); const float* SM = (const float*)(F.ws + WS_SM);
    for (int t = gw; t < M; t += NGW) {
        int a0 = 0, a1 = 0;
#pragma unroll
        for (int xx = 0; xx < 8; ++xx) { const unsigned long long w = *(const GAS unsigned long long*)((const int*)(F.ws + WS_APART) + (size_t)xx * M * 128 + (size_t)t * 128 + 2 * lane); a0 += (int)(unsigned)w; a1 += (int)(unsigned)(w >> 32); }
        const unsigned ew = *(const GAS unsigned*)(F.ws + WS_EID + (size_t)t * 256 + 4 * lane); const unsigned e0 = ew & 0xffffu, e1 = ew >> 16;
        const f32x2 gt = *(const GAS f32x2*)(F.ws + WS_GATE + (size_t)t * 512 + 8 * lane); const float sm = SM[t];
        const float h0 = gelu_exact((float)a0 * sm * SU[e0]) * gt[0] * SV[e0], h1 = gelu_exact((float)a1 * sm * SU[e1]) * gt[1] * SV[e1];
        const float hmax = wave_max(fmaxf(__builtin_fabsf(h0), __builtin_fabsf(h1))); const float inv = 127.f / fmaxf(hmax, 1e-30f);
        const int q0 = (int)__builtin_rintf(h0 * inv), q1 = (int)__builtin_rintf(h1 * inv);
        *(GAS unsigned short*)(F.ws + WS_HQ + (size_t)t * 128 + 2 * lane) = (unsigned short)((q0 & 0xff) | ((q1 & 0xff) << 8));
        if (lane == 0) ((float*)(F.ws + WS_HS))[t] = hmax * (1.f / 127.f);
    }
}
__device__ __forceinline__ void p5c_vacc(Frame& F) {
    const int lane = lane_id(), g = lane >> 3, s = lane & 7;
    const int x = blockIdx.x & 7, rk = blockIdx.x >> 3, nrk = F.G >> 3;
    const unsigned char* VTs = F.ws + WS_VT + (size_t)x * NEXP * 128 + 16 * s; const unsigned char* EIDs = F.ws + WS_EID + 32 * g; const unsigned char* HQs = F.ws + WS_HQ + 16 * g;
    const float* SH = (const float*)(F.ws + WS_HS); float* ssq2 = (float*)(F.ws + WS_SSQ2); unsigned* H2B = (unsigned*)(F.ws + WS_XN2);
    const int dcol = 128 * x + 16 * s + 2 * g;
    const bool c3 = g & 1, c4 = g & 2, c5 = g & 4; const bool hi32 = lane >= 32;
    const int nT = M / nrk; LAS unsigned* qctr = (LAS unsigned*)(F.lds + MISC_OFF) + 63;
#define P5C_E(i, E0, E1) ((((i) & 1) ? (((i) < 8 ? E0[(i) >> 1] : E1[((i) - 8) >> 1]) >> 16) : (((i) < 8 ? E0[(i) >> 1] : E1[((i) - 8) >> 1]) & 0xffffu)))
#define P5C_LDMETA(E0, E1, HB, H1, SHv, tq_, te_) do { ASM_LD16(E0, EIDs + (size_t)(te_) * 256); ASM_LD16(E1, EIDs + (size_t)(te_) * 256 + 16); \
        ASM_LD16(HB, HQs + (size_t)(tq_) * 128); ASM_LD4(H1, (const unsigned*)F.out + (((size_t)(tq_) * DM + dcol) >> 1)); ASM_LD4(SHv, SH + (tq_)); } while (0)
#define IX32(v) xl32(v, hi32)
#define P5C_ITER(RR, E0, E1, HB, H1, SHv, tcur, vcur, tq, te) do { int yi_[16]; _Pragma("unroll") for (int i = 0; i < 16; ++i) yi_[i] = 0; \
        asm volatile("s_waitcnt vmcnt(21)" : "+v"(E0), "+v"(E1), "+v"(HB), "+v"(H1), "+v"(SHv) :: "memory"); \
        _Pragma("unroll") for (int b = 0; b < 4; ++b) { const int hb_ = (int)HB[b]; \
            ASM_WAIT4(38, RR[4 * b], RR[4 * b + 1], RR[4 * b + 2], RR[4 * b + 3]); __builtin_amdgcn_sched_barrier(0); \
            _Pragma("unroll") for (int c = 0; c < 4; ++c) { \
                const unsigned ra_ = RR[4 * b][c], rb_ = RR[4 * b + 1][c], rc_ = RR[4 * b + 2][c], rd_ = RR[4 * b + 3][c]; \
                const unsigned p_ = __builtin_amdgcn_perm(rb_, ra_, 0x05010400u), q_ = __builtin_amdgcn_perm(rb_, ra_, 0x07030602u), r_ = __builtin_amdgcn_perm(rd_, rc_, 0x05010400u), s_ = __builtin_amdgcn_perm(rd_, rc_, 0x07030602u); \
                yi_[4 * c + 0] = __builtin_amdgcn_sdot4((int)__builtin_amdgcn_perm(r_, p_, 0x05040100u), hb_, yi_[4 * c + 0], false); yi_[4 * c + 1] = __builtin_amdgcn_sdot4((int)__builtin_amdgcn_perm(r_, p_, 0x07060302u), hb_, yi_[4 * c + 1], false); \
                yi_[4 * c + 2] = __builtin_amdgcn_sdot4((int)__builtin_amdgcn_perm(s_, q_, 0x05040100u), hb_, yi_[4 * c + 2], false); yi_[4 * c + 3] = __builtin_amdgcn_sdot4((int)__builtin_amdgcn_perm(s_, q_, 0x07060302u), hb_, yi_[4 * c + 3], false); } \
            __builtin_amdgcn_sched_barrier(0); \
            _Pragma("unroll") for (int j = 0; j < 4; ++j) { const int i = 4 * b + j; ASM_LD16(RR[i], VTs + (size_t)P5C_E(i, E0, E1) * 128); } \
            __builtin_amdgcn_sched_barrier(0); } \
        int y8_[8], y4_[4], y2_[2]; TSTEP(y8_, yi_, 16, c3, xl8) TSTEP(y4_, y8_, 8, c4, xl16) TSTEP(y2_, y4_, 4, c5, IX32) \
        const f32x2 n_ = {bflo(H1) + SHv * (float)y2_[0], bfhi(H1) + SHv * (float)y2_[1]}; \
        const float ss_ = wave_sum(n_[0] * n_[0] + n_[1] * n_[1]); \
        if (vcur) { H2B[((size_t)(tcur) * DM + dcol) >> 1] = pk2(n_[0], n_[1]); if (lane == 0) ssq2[(size_t)(tcur) * 8 + x] = ss_; } \
        __builtin_amdgcn_sched_barrier(0); P5C_LDMETA(E0, E1, HB, H1, SHv, tq, te); __builtin_amdgcn_sched_barrier(0); } while (0)
    int j0, j1, j2, j3, j4, j5, p0, p1, p2, p3, p4, p5;
    P5_PULL(j0, p0); P5_PULL(j1, p1); P5_PULL(j2, p2); P5_PULL(j3, p3);
    v4u RA[16], RB[16], eA0, eA1, hbA, eB0, eB1, hbB; unsigned h1A = 0u, h1B = 0u; float shA = 0.f, shB = 0.f;
    { const v4u e0 = *(const GAS v4u*)(EIDs + (size_t)p0 * 256), e1 = *(const GAS v4u*)(EIDs + (size_t)p0 * 256 + 16), f0 = *(const GAS v4u*)(EIDs + (size_t)p1 * 256), f1 = *(const GAS v4u*)(EIDs + (size_t)p1 * 256 + 16);
      eA0 = e0; eA1 = e1; hbA = e0; eB0 = e0; eB1 = e1; hbB = e0;
#pragma unroll
      for (int i = 0; i < 16; ++i) { RA[i] = e0; RB[i] = e0; }
      asm volatile("s_waitcnt vmcnt(0)" ::: "memory");
#pragma unroll
      for (int i = 0; i < 16; ++i) ASM_LD16(RA[i], VTs + (size_t)P5C_E(i, e0, e1) * 128);
#pragma unroll
      for (int i = 0; i < 16; ++i) ASM_LD16(RB[i], VTs + (size_t)P5C_E(i, f0, f1) * 128); }
    P5C_LDMETA(eA0, eA1, hbA, h1A, shA, p0, p2); P5C_LDMETA(eB0, eB1, hbB, h1B, shB, p1, p3);
    asm volatile("s_waitcnt vmcnt(0)" ::: "memory");
#pragma unroll 1
    while (j0 < nT) {
        P5_PULL(j4, p4); P5C_ITER(RA, eA0, eA1, hbA, h1A, shA, p0, true, p2, p4);
        P5_PULL(j5, p5); P5C_ITER(RB, eB0, eB1, hbB, h1B, shB, p1, (j1 < nT), p3, p5);
        j0 = j2; j1 = j3; j2 = j4; j3 = j5; p0 = p2; p1 = p3; p2 = p4; p3 = p5;
    }
    asm volatile("s_waitcnt vmcnt(0)" ::: "memory");
#undef P5C_E
#undef P5C_LDMETA
#undef P5C_ITER
#undef IX32
}
__device__ __forceinline__ void p7_final(Frame& F) {
    const int lane = lane_id(); const int gw = F.vcu * NWAVES + F.wave, NGW = F.G * NWAVES; const float* g = INP(22);
    f32x4 gv[4];
#pragma unroll
    for (int j = 0; j < 4; ++j) gv[j] = ((const GAS f32x4*)g)[64 * j + lane];
    for (int m = gw; m < M; m += NGW) { GAS f32x4* xr = (GAS f32x4*)(F.out + (size_t)m * DM) + lane; f32x4 v[4]; float s2 = 0.f;
#pragma unroll
        for (int j = 0; j < 4; ++j) { v[j] = xr[64 * j]; s2 += (v[j].x * v[j].x + v[j].y * v[j].y) + (v[j].z * v[j].z + v[j].w * v[j].w); }
        const float rstd = rsqrtf(wave_sum(s2) * (1.f / DM) + EPS);
#pragma unroll
        for (int j = 0; j < 4; ++j) xr[64 * j] = v[j] * rstd * gv[j]; }
}
struct Args { const float* in[23]; float* out; unsigned char* ws; int ph_lo, ph_hi; };
__global__ void __launch_bounds__(NWAVES * 64, 2) hymba_fwd(Args args) {
    extern __shared__ __attribute__((aligned(16))) unsigned char lds[];
    cg::grid_group grid = cg::this_grid();
    Frame F;
    F.lds = (LAS unsigned char*)lds; F.ldsg = lds;
    F.wave = __builtin_amdgcn_readfirstlane(threadIdx.x >> 6);
    F.G = gridDim.x; { const int bx = blockIdx.x; F.vcu = (F.G % 8 == 0) ? (bx % 8) * (F.G / 8) + bx / 8 : bx; }
    F.out = args.out; F.ws = args.ws;
    const int lo = args.ph_lo, hi = args.ph_hi;
#ifdef ONLY_PH
#define IN(k) ((k) == ONLY_PH)
#else
#define IN(k) (lo <= (k) && (k) < hi)
#endif
#define BOTH(k) (IN(k) && IN((k) + 1))
    { const int l0 = lane_id(); if (F.wave == 0) ((volatile LAS unsigned*)(F.lds + MISC_OFF))[l0] = 0u; }
    __syncthreads();
    const XcdBarrier bar = xcd_barrier_post((unsigned*)(F.ws + WS_CTL) + CW_BAR, (volatile LAS unsigned*)(F.lds + MISC_OFF) + 8, F.wave == 0 && lane_id() == 0);
    if (hi > N_PHASES) grid.sync();
#if defined(PROBE_BARSUM)
#define GRID_BAR(k) do { STAMP(20); xcd_barrier(bar, F.wave == 0 && lane_id() == 0); STAMP((k) + 1); \
    if (F.wave == 0 && ((PROBE_BARSUM >> (k)) & 1)) { volatile LAS unsigned* ms_ = (volatile LAS unsigned*)(F.lds + MISC_OFF) + 16; ms_[2 * 21] += ms_[2 * ((k) + 1)] - ms_[2 * 20]; } } while (0)
#else
#define GRID_BAR(k) do { xcd_barrier(bar, F.wave == 0 && lane_id() == 0); STAMP((k) + 1); } while (0)
#endif
    STAMP(0);
    if (IN(0)) { p0_prologue(F); if (BOTH(0)) GRID_BAR(0); }
    if (IN(1)) {
        { pg8::Gemm g{(const pg8::bf16_t*)(F.ws + WS_XN), (const pg8::bf16_t*)(F.ws + WS_WIN), M, IN_COLS, DM}; pg8::StaticOrder S; S.init(M, IN_COLS, F.G, (int)blockIdx.x);
          pg8::EpiIn E{(pg8::bf16_t*)(F.ws + WS_QO), (pg8::bf16_t*)(F.ws + WS_K), (pg8::bf16_t*)(F.ws + WS_V), (pg8::bf16_t*)(F.ws + WS_U), (const float*)(F.ws + WS_ROPEC), (const float*)(F.ws + WS_ROPES), attn_body::C2};
          pg8::gemm_phase<pg8::EpiIn, pg8::StaticOrder, true, true>(F.lds, g, S, E, F.wave); }
        { pg8::Gemm g{(const pg8::bf16_t*)(F.ws + WS_PB), (const pg8::bf16_t*)(F.ws + WS_WPROJ), M, DM, PLE_DIM}; pg8::StaticOrder S; S.init(M, DM, F.G, (int)blockIdx.x);
          pg8::EpiBf16<0> E{(pg8::bf16_t*)(F.ws + WS_E), DM, nullptr, 0, 0, 1.f};
          pg8::gemm_phase<pg8::EpiBf16<0>, pg8::StaticOrder, true, true>(F.lds, g, S, E, F.wave); }
        if (BOTH(1)) GRID_BAR(1);
    }
    if (IN(2)) { p2_attention(F); STAMP(13); p2_conv(F); STAMP(14); if (BOTH(2)) GRID_BAR(2); }
    if (IN(3)) {
        pg8::Gemm g{(const pg8::bf16_t*)(F.ws + WS_XN), (const pg8::bf16_t*)(F.ws + WS_WOUT), M, DM, DM}; pg8::StaticOrder S; S.init(M, DM, F.G, (int)blockIdx.x);
        pg8::EpiOut E{INP(0), (pg8::bf16_t*)F.out  , (float*)(F.ws + WS_SSQ1)};
        pg8::gemm_phase<pg8::EpiOut, pg8::StaticOrder, true, true>(F.lds, g, S, E, F.wave);
        if (BOTH(3)) GRID_BAR(3);
    }
    if (IN(4)) {
        pg8::Gemm g{(const pg8::bf16_t*)F.out, (const pg8::bf16_t*)(F.ws + WS_WQ), M, QCOLS, DM}; pg8::StaticOrder S; S.init(M, QCOLS, F.G, (int)blockIdx.x);
        pg8::EpiQ E{(const float*)(F.ws + WS_SSQ1), (pg8::bf16_t*)(F.ws + WS_QP), EPS};
        pg8::gemm_phase<pg8::EpiQ, pg8::StaticOrder, true, true>(F.lds, g, S, E, F.wave);
        if (BOTH(4)) GRID_BAR(4);
    }
    if (IN(5)) { p5a_topk(F); if (BOTH(5)) GRID_BAR(5); }
    if (IN(6)) { p5b_udot(F); if (BOTH(6)) GRID_BAR(6); }
    if (IN(7)) { p5b2_gelu(F); if (BOTH(7)) GRID_BAR(7); }
    if (IN(8)) { p5c_vacc(F); if (BOTH(8)) GRID_BAR(8); }
    if (IN(9)) {
        pg8::Gemm g{(const pg8::bf16_t*)(F.ws + WS_XN2), (const pg8::bf16_t*)(F.ws + WS_WGATE), M, DM, DM}; pg8::StaticOrder S; S.init(M, DM, F.G, (int)blockIdx.x);
        pg8::EpiGate E{F.out, (const pg8::bf16_t*)(F.ws + WS_XN2), (const pg8::bf16_t*)(F.ws + WS_E), (const float*)(F.ws + WS_SSQ2), EPS};
        pg8::gemm_phase<pg8::EpiGate, pg8::StaticOrder, true, true>(F.lds, g, S, E, F.wave);
        if (BOTH(9)) GRID_BAR(9);
    }
    if (IN(10)) p7_final(F);
#if defined(MBENCH)
    { xcd_barrier(bar, F.wave == 0 && lane_id() == 0); STAMP(15);
      unsigned r[32]; const unsigned l0 = (unsigned)lane_id();
#pragma unroll
      for (int i = 0; i < 32; ++i) r[i] = l0 * 2654435761u + i;
      float* rf = (float*)r;
#pragma unroll 1
      for (int it = 0; it < 1024; ++it) {
#pragma unroll
          for (int i = 0; i < 32; ++i) {
#if MBENCH == 1
              asm volatile("v_dot4c_i32_i8 %0, %1, %2" : "+v"(r[i]) : "v"(r[(i + 1) & 31]), "v"(r[(i + 2) & 31]));
#elif MBENCH == 2
              asm volatile("v_perm_b32 %0, %1, %2, %3" : "=v"(r[i]) : "v"(r[(i + 1) & 31]), "v"(r[(i + 2) & 31]), "v"(r[(i + 3) & 31]));
#elif MBENCH == 3
              asm volatile("v_fma_f32 %0, %1, %2, %0" : "+v"(r[i]) : "v"(r[(i + 1) & 31]), "v"(r[(i + 2) & 31]));
#elif MBENCH == 4
              asm volatile("v_cvt_f32_ubyte1 %0, %1" : "=v"(r[i]) : "v"(r[(i + 1) & 31]));
#elif MBENCH == 5
              asm volatile("v_pk_fma_f32 %0, %1, %2, %0" : "+v"(*(unsigned long long*)&r[2 * (i & 15)]) : "v"(*(unsigned long long*)&r[2 * ((i + 1) & 15)]), "v"(*(unsigned long long*)&r[2 * ((i + 2) & 15)]));
#elif MBENCH == 6
              asm volatile("v_add_u32 %0, %1, %2" : "=v"(r[i]) : "v"(r[(i + 1) & 31]), "v"(r[(i + 2) & 31]));
#elif MBENCH == 7
              asm volatile("v_mad_i32_i24 %0, %1, %2, %0" : "+v"(r[i]) : "v"(r[(i + 1) & 31]), "v"(r[(i + 2) & 31]));
#endif
          } }
      unsigned acc = 0;
#pragma unroll
      for (int i = 0; i < 32; ++i) acc ^= r[i];
      if (acc == 0x12345678u) ((unsigned*)(F.ws + WS_CTL))[2000 + l0] = acc;
      STAMP(16); }
#endif
#if defined(PROBE_A)
    STAMP(11);
#if !defined(PROBE_BLK)
#define PROBE_BLK 0
#endif
    if (blockIdx.x == PROBE_BLK && F.wave == 0) { volatile LAS unsigned* ms_ = (volatile LAS unsigned*)(F.lds + MISC_OFF) + 16;
        const unsigned long long ta = ((unsigned long long)ms_[2 * PROBE_A + 1] << 32) | ms_[2 * PROBE_A], tb = ((unsigned long long)ms_[2 * PROBE_B + 1] << 32) | ms_[2 * PROBE_B];
#if defined(PROBE_BARSUM)
        const unsigned long long span_ = ms_[2 * 21];
#else
        const unsigned long long span_ = tb - ta;
#endif
        const unsigned long long t0_ = __builtin_amdgcn_s_memrealtime(); while (__builtin_amdgcn_s_memrealtime() - t0_ < span_) __builtin_amdgcn_s_sleep(8); }
#endif
#undef IN
#undef BOTH
}

extern "C" void kernel_launch(void* const* d_in, const int* in_sizes, int n_in, void* d_out, int out_size, void* d_ws, size_t ws_size, hipStream_t stream) {
    static int grid = 0;
    if (grid == 0) {
        if (n_in != 23 || in_sizes[0] != M * DM || out_size != M * DM || ws_size < WS_END) { fprintf(stderr, "kernel_launch: unexpected shapes (n_in %d, in0 %d, out %d, ws %zu); nothing launched\n", n_in, n_in > 0 ? in_sizes[0] : -1, out_size, ws_size); grid = -1; return; }
        int dev = 0, cus = 0, per_cu = 0;
        if (hipGetDevice(&dev) != hipSuccess || hipDeviceGetAttribute(&cus, hipDeviceAttributeMultiprocessorCount, dev) != hipSuccess) { fprintf(stderr, "kernel_launch: device query failed\n"); grid = -1; return; }
        if (hipFuncSetAttribute((const void*)hymba_fwd, hipFuncAttributeMaxDynamicSharedMemorySize, LDS_BYTES) != hipSuccess) { fprintf(stderr, "kernel_launch: hipFuncSetAttribute failed\n"); grid = -1; return; }
        if (hipOccupancyMaxActiveBlocksPerMultiprocessor(&per_cu, (const void*)hymba_fwd, NWAVES * 64, LDS_BYTES) != hipSuccess || per_cu < 1) { fprintf(stderr, "kernel_launch: occupancy query says %d blocks per CU\n", per_cu); (void)hipGetLastError(); grid = -1; return; }
        grid = cus * per_cu;
        if (grid != 256) { fprintf(stderr, "kernel_launch: this kernel's attention order needs exactly 256 resident workgroups (got %d x %d); nothing launched\n", cus, per_cu); grid = -1; return; }
    }
    if (grid < 0) return;
    if (hipMemsetAsync((char*)d_ws + WS_CTL, 0, CTL_ZERO_BYTES, stream) != hipSuccess) { fprintf(stderr, "kernel_launch: hipMemsetAsync failed\n"); return; }
    Args a{};
    for (int i = 0; i < 23; ++i) a.in[i] = (const float*)d_in[i];
    a.out = (float*)d_out; a.ws = (unsigned char*)d_ws;
#if MK_N_LAUNCHES == 1
    a.ph_lo = 0; a.ph_hi = N_PHASES;
    void* kargs[] = {&a};
    hipError_t e = hipLaunchCooperativeKernel((const void*)hymba_fwd, dim3(grid), dim3(NWAVES * 64), kargs, LDS_BYTES, stream);
    if (e != hipSuccess) fprintf(stderr, "kernel_launch: cooperative launch failed: %s (grid %d)\n", hipGetErrorString(e), grid);
#else
    for (int li = 0; li < N_PHASES; ++li) { a.ph_lo = li; a.ph_hi = li + 1;
        hipLaunchKernelGGL(hymba_fwd, dim3(grid), dim3(NWAVES * 64), LDS_BYTES, stream, a);
        const hipError_t le = hipPeekAtLastError(); if (le != hipSuccess) { fprintf(stderr, "kernel_launch: launch %d failed: %s\n", li, hipGetErrorName(le)); break; } }
#endif
}
```

```cpp
#include <hip/hip_runtime.h>
#include <hip/hip_cooperative_groups.h>
#include <cstdio>
#include <cstdint>
namespace cg = cooperative_groups;
namespace pg8 {
#define PG8_LAS __attribute__((address_space(3)))
typedef unsigned short bf16_t;
typedef short bf16x8 __attribute__((ext_vector_type(8)));
typedef float f32x4 __attribute__((ext_vector_type(4)));
typedef unsigned u32x4 __attribute__((ext_vector_type(4)));
constexpr int BM = 256, BK = 64, HALF = 128, HTB = HALF * BK * 2  , STAGE_BYTES = 8 * HTB, NXCD = 8, WGM = 8;

__host__ __device__ __forceinline__ int lds_byte(int r, int c) { const int st = (r >> 4) * 2 + (c >> 5), rr = r & 15, cc = c & 31, ob = rr * 64 + cc * 2; return st * 1024 + (ob ^ (((ob >> 9) & 1) << 5)); }
__host__ __device__ __forceinline__ void stage_rc(int b, int& R, int& C) { const int st = b / 1024, sb = b % 1024, swz = sb ^ (((sb >> 9) & 1) << 5); R = (st >> 1) * 16 + swz / 64; C = (st & 1) * 32 + (swz % 64) / 2; }
__host__ __device__ __forceinline__ int perm32(int rho) { const int n = rho >> 4, i = rho & 15; return 8 * (i >> 2) + 4 * n + (i & 3); }

struct Unit { int pm, pn; };
struct Gemm { const bf16_t* A; const bf16_t* Bt; int M, N, K; };

struct StaticOrder {
    int nM, nN, nwg, G, c;
    __host__ __device__ void init(int M, int N, int G_, int c_) { nM = M / BM; nN = N / BM; nwg = nM * nN; G = G_; c = c_; }
    __host__ __device__ bool next(int i, Unit& u) const {
        const long L = (long)i * G + c; if (L >= nwg) return false;
        int wgid = (int)L; { const int q = nwg / NXCD, r = nwg % NXCD, xcd = wgid % NXCD, off = wgid / NXCD; wgid = (xcd < r ? xcd * (q + 1) : r * (q + 1) + (xcd - r) * q) + off; }
        const int nig = WGM * nN, gid = wgid / nig, fm = gid * WGM, gsz = (nM - fm) < WGM ? (nM - fm) : WGM;
        u.pm = fm + ((wgid % nig) % gsz); u.pn = (wgid % nig) / gsz; return true;
    }
    __device__ __forceinline__ void a_ready(const Unit&) const {}
    __device__ __forceinline__ void done(const Unit&) const {}
};

__device__ __forceinline__ unsigned cvt_pk_bf16(float lo, float hi) { unsigned r; asm volatile("v_cvt_pk_bf16_f32 %0, %1, %2" : "=v"(r) : "v"(lo), "v"(hi)); return r; }
typedef float f32x2 __attribute__((ext_vector_type(2)));
__device__ __forceinline__ f32x2 gelu_pk(f32x2 v) {
    const f32x2 av = __builtin_elementwise_abs(v), d = av * 0.2316418882f + 1.0f;
    f32x2 t; t.x = __builtin_amdgcn_rcpf(d.x); t.y = __builtin_amdgcn_rcpf(d.y);
    f32x2 q = t * 0.5307027145f + (-0.7265760135f); q = q * t + 0.7107068705f; q = q * t + (-0.142248368f); q = q * t + 0.127414796f; q = q * t;
    const f32x2 s = (v * v) * (-0.72134752044f);
    f32x2 e; e.x = __builtin_amdgcn_exp2f(s.x); e.y = __builtin_amdgcn_exp2f(s.y);
    const f32x2 m = v * (q * e), r = v - m;
    f32x2 o; o.x = v.x < 0.f ? m.x : r.x; o.y = v.y < 0.f ? m.y : r.y; return o;
}

template <int ACT  > struct EpiBf16 {
    static constexpr bool PERM = true, AFTER_DRAIN = false; static_assert(ACT == 0 || ACT == 1, "EpiBf16: ACT is 0 (none) or 1 (gelu_pk)");
    bf16_t* O; int ldc; const float* bias; int split_cols; size_t split_stride; float scale0;
    __device__ __forceinline__ void operator()(const f32x4 (&acc)[2][2][4][2], const Unit& u, int wr, int wc, int fr, int fq) const {
        const int row0 = u.pm * BM + wr * 64 + fr; int colt = u.pn * BM; bf16_t* base = O;
        float sc = 1.f; if (split_cols) { const int t = colt / split_cols; base += (size_t)t * split_stride; colt -= t * split_cols; if (t == 0) sc = scale0; }
        const int col0 = colt + wc * 32 + 8 * fq, bcol0 = u.pn * BM + wc * 32 + 8 * fq;
        f32x4 bv[2][2];
#pragma unroll
        for (int bj = 0; bj < 2; ++bj)
#pragma unroll
            for (int n = 0; n < 2; ++n) bv[bj][n] = bias ? *(const f32x4*)(bias + bcol0 + bj * HALF + 4 * n) : (f32x4){0.f, 0.f, 0.f, 0.f};
#pragma unroll
        for (int ai = 0; ai < 2; ++ai)
#pragma unroll
            for (int m = 0; m < 4; ++m) { bf16_t* rowp = base + (size_t)(row0 + ai * HALF + m * 16) * ldc + col0;
#pragma unroll
                for (int bj = 0; bj < 2; ++bj) { f32x4 v0 = acc[ai][bj][m][0] + bv[bj][0], v1 = acc[ai][bj][m][1] + bv[bj][1];
                    if (ACT == 1) { f32x2 a = gelu_pk((f32x2){v0[0], v0[1]}), b = gelu_pk((f32x2){v0[2], v0[3]}), c = gelu_pk((f32x2){v1[0], v1[1]}), d = gelu_pk((f32x2){v1[2], v1[3]});
                        v0 = (f32x4){a.x, a.y, b.x, b.y}; v1 = (f32x4){c.x, c.y, d.x, d.y}; }
                    v0 = v0 * sc; v1 = v1 * sc; u32x4 w; w.x = cvt_pk_bf16(v0[0], v0[1]); w.y = cvt_pk_bf16(v0[2], v0[3]); w.z = cvt_pk_bf16(v1[0], v1[1]); w.w = cvt_pk_bf16(v1[2], v1[3]);
                    *(u32x4*)(rowp + bj * HALF) = w; } }
    }
};
__device__ __forceinline__ float sigmoid_fast(float x) { return __builtin_amdgcn_rcpf(1.0f + __expf(-x)); }
__device__ __forceinline__ f32x4 sigmoid4(f32x4 x) { f32x4 r; r[0] = sigmoid_fast(x[0]); r[1] = sigmoid_fast(x[1]); r[2] = sigmoid_fast(x[2]); r[3] = sigmoid_fast(x[3]); return r; }
__device__ __forceinline__ u32x4 pack8(const f32x4 a, const f32x4 b) { u32x4 w; w.x = cvt_pk_bf16(a[0], a[1]); w.y = cvt_pk_bf16(a[2], a[3]); w.z = cvt_pk_bf16(b[0], b[1]); w.w = cvt_pk_bf16(b[2], b[3]); return w; }
__device__ __forceinline__ float dot4s(const f32x4 a) { return (a[0] * a[0] + a[1] * a[1]) + (a[2] * a[2] + a[3] * a[3]); }

struct EpiIn {
    static constexpr bool PERM = true, AFTER_DRAIN = false;
    bf16_t *Q, *Kk, *V, *U; const float* ropec; const float* ropes; float qscale;
    __device__ __forceinline__ void operator()(const f32x4 (&acc)[2][2][4][2], const Unit& u, int wr, int wc, int fr, int fq) const {
        const int row0 = u.pm * BM + wr * 64 + fr; const int pn = u.pn;
        if (pn < 4) {
            bf16_t* dst = (pn < 2) ? Q : Kk; const float sc = (pn < 2) ? qscale : 1.0f; const int colb = ((pn & 1) * 4 + wc) * 128 + 8 * fq;
#pragma unroll
            for (int ai = 0; ai < 2; ++ai)
#pragma unroll
                for (int m = 0; m < 4; ++m) { const int row = row0 + ai * HALF + m * 16; const int pos = row & 4095;
                    const f32x4 c0 = *(const f32x4*)(ropec + pos * 32 + 8 * fq), c1 = *(const f32x4*)(ropec + pos * 32 + 8 * fq + 4);
                    const f32x4 s0 = *(const f32x4*)(ropes + pos * 32 + 8 * fq), s1 = *(const f32x4*)(ropes + pos * 32 + 8 * fq + 4);
                    const f32x4 x10 = acc[ai][0][m][0], x11 = acc[ai][0][m][1], x20 = acc[ai][1][m][0], x21 = acc[ai][1][m][1];
                    const f32x4 o10 = (x10 * c0 - x20 * s0) * sc, o11 = (x11 * c1 - x21 * s1) * sc, o20 = (x20 * c0 + x10 * s0) * sc, o21 = (x21 * c1 + x11 * s1) * sc;
                    bf16_t* rp = dst + (size_t)row * 1024 + colb; const u32x4 w1 = pack8(o10, o11), w2 = pack8(o20, o21);
                    *(u32x4*)rp = w1; *(u32x4*)(rp + 32) = w2; *(u32x4*)(rp + 64) = w1; *(u32x4*)(rp + 96) = w2; }
        } else if (pn < 6) {
#pragma unroll
            for (int ai = 0; ai < 2; ++ai)
#pragma unroll
                for (int m = 0; m < 4; ++m) { const int row = row0 + ai * HALF + m * 16;
#pragma unroll
                    for (int bj = 0; bj < 2; ++bj) { const int hh = (pn - 4) * 2 + bj, vh = wc >> 1, d = (wc & 1) * 32 + 8 * fq;
                        const u32x4 w = pack8(acc[ai][bj][m][0], acc[ai][bj][m][1]); bf16_t* rp = V + (size_t)row * 1024 + (hh * 4 + vh) * 64 + d; *(u32x4*)rp = w; *(u32x4*)(rp + 128) = w; } }
        } else {
#pragma unroll
            for (int ai = 0; ai < 2; ++ai)
#pragma unroll
                for (int m = 0; m < 4; ++m) { const int row = row0 + ai * HALF + m * 16;
                    const f32x4 u0 = acc[ai][0][m][0] * sigmoid4(acc[ai][1][m][0]), u1 = acc[ai][0][m][1] * sigmoid4(acc[ai][1][m][1]);
                    *(u32x4*)(U + (size_t)row * 512 + (pn - 6) * 128 + wc * 32 + 8 * fq) = pack8(u0, u1); }
        }
    }
};
struct EpiOut {
    static constexpr bool PERM = true, AFTER_DRAIN = false;
    const float* x; bf16_t* hb; float* ssq;
    __device__ __forceinline__ void operator()(const f32x4 (&acc)[2][2][4][2], const Unit& u, int wr, int wc, int fr, int fq) const {
        const int row0 = u.pm * BM + wr * 64 + fr;
#pragma unroll
        for (int ai = 0; ai < 2; ++ai)
#pragma unroll
            for (int m = 0; m < 4; ++m) { const int row = row0 + ai * HALF + m * 16; float ss = 0.f;
#pragma unroll
                for (int bj = 0; bj < 2; ++bj) { const size_t off = (size_t)row * 1024 + u.pn * BM + bj * HALF + wc * 32 + 8 * fq;
                    const f32x4 h0 = acc[ai][bj][m][0] + *(const f32x4*)(x + off), h1 = acc[ai][bj][m][1] + *(const f32x4*)(x + off + 4);
                    *(u32x4*)(hb + off) = pack8(h0, h1); ss += dot4s(h0) + dot4s(h1); }
                ss += __shfl_xor(ss, 16); ss += __shfl_xor(ss, 32);
                if (fq == 0) ssq[(size_t)row * 16 + u.pn * 4 + wc] = ss; }
    }
};
struct EpiQ {
    static constexpr bool PERM = true, AFTER_DRAIN = false;
    const float* ssq; bf16_t* qp; float eps;
    __device__ __forceinline__ void operator()(const f32x4 (&acc)[2][2][4][2], const Unit& u, int wr, int wc, int fr, int fq) const {
        const int row0 = u.pm * BM + wr * 64 + fr;
#pragma unroll
        for (int ai = 0; ai < 2; ++ai)
#pragma unroll
            for (int m = 0; m < 4; ++m) { const int row = row0 + ai * HALF + m * 16; const f32x4* sp = (const f32x4*)(ssq + (size_t)row * 16);
                const f32x4 a = sp[0], b = sp[1], c = sp[2], d = sp[3]; const f32x4 t = (a + b) + (c + d);
                const float rstd = rsqrtf(((t[0] + t[1]) + (t[2] + t[3])) * (1.0f / 1024.0f) + eps);
#pragma unroll
                for (int bj = 0; bj < 2; ++bj) *(u32x4*)(qp + (size_t)row * 2048 + u.pn * BM + bj * HALF + wc * 32 + 8 * fq) = pack8(acc[ai][bj][m][0] * rstd, acc[ai][bj][m][1] * rstd); }
    }
};
__device__ __forceinline__ f32x4 bf_lo4(unsigned a, unsigned b) { f32x4 r; r[0] = __uint_as_float(a << 16); r[1] = __uint_as_float(a & 0xffff0000u); r[2] = __uint_as_float(b << 16); r[3] = __uint_as_float(b & 0xffff0000u); return r; }
struct EpiGate {
    static constexpr bool PERM = true, AFTER_DRAIN = false;
    bf16_t* h3b; const bf16_t* h2b; const bf16_t* e; const float* ssq; float eps;
    __device__ __forceinline__ void operator()(const f32x4 (&acc)[2][2][4][2], const Unit& u, int wr, int wc, int fr, int fq) const {
        const int row0 = u.pm * BM + wr * 64 + fr;
#pragma unroll
        for (int ai = 0; ai < 2; ++ai)
#pragma unroll
            for (int m = 0; m < 4; ++m) { const int row = row0 + ai * HALF + m * 16; const f32x4* sp = (const f32x4*)(ssq + (size_t)row * 8); const f32x4 t = sp[0] + sp[1];
                const float rstd = rsqrtf(((t[0] + t[1]) + (t[2] + t[3])) * (1.0f / 1024.0f) + eps);
#pragma unroll
                for (int bj = 0; bj < 2; ++bj) { const size_t off = (size_t)row * 1024 + u.pn * BM + bj * HALF + wc * 32 + 8 * fq;
                    const u32x4 ev = *(const u32x4*)(e + off), hv = *(const u32x4*)(h2b + off);
                    const f32x4 h0 = bf_lo4(hv.x, hv.y) + bf_lo4(ev.x, ev.y) * sigmoid4(acc[ai][bj][m][0] * rstd), h1 = bf_lo4(hv.z, hv.w) + bf_lo4(ev.z, ev.w) * sigmoid4(acc[ai][bj][m][1] * rstd);
                    *(u32x4*)(h3b + off) = pack8(h0, h1); } }
    }
};
template <class Epi, class Sched, bool ALIGN_EPI = false, bool SP2 = false>
__device__ __forceinline__ void gemm_phase(PG8_LAS unsigned char* lds, const Gemm g, const Sched& S, const Epi& E, const int wid  ) {
    int lane; asm volatile("v_mbcnt_lo_u32_b32 %0, -1, 0\n\tv_mbcnt_hi_u32_b32 %0, -1, %0" : "=v"(lane));
    const int tid = wid * 64 + lane, wr = wid >> 2, wc = wid & 3, fr = lane & 15, fq = lane >> 4;
    const int K = g.K, nt = K / BK;
    unsigned voffA[2], voffB[2];
#pragma unroll
    for (int i = 0; i < 2; ++i) { int R, C; stage_rc(tid * 16 + i * 8192, R, C); const int Rb = Epi::PERM ? ((R & ~31) + perm32(R & 31)) : R;
        voffA[i] = (unsigned)(R * K + C) * 2u; voffB[i] = (unsigned)(Rb * K + C) * 2u; }
    const size_t kstep = (size_t)(BK * 2);
    const size_t hstep = (size_t)HALF * K * 2;
    const size_t tstep = 2 * hstep;
    const unsigned ldsw = (unsigned)wid * 1024u;
    const int aoff = lds_byte(wr * 64 + fr, fq * 8), boff = lds_byte(wc * 32 + fr, fq * 8);
#define PG8_SA(b, h) (((b) * 2 + (h)) * HTB)
#define PG8_SB(b, h) ((4 + (b) * 2 + (h)) * HTB)
#define PG8_STAGE(bufoff, gbase, voff) do { _Pragma("unroll") for (int _i = 0; _i < 2; ++_i) \
        __builtin_amdgcn_global_load_lds((const unsigned*)((const char*)(gbase) + (voff)[_i]), (PG8_LAS unsigned*)(lds + (bufoff) + ldsw + _i * 8192), 16, 0, 0); } while (0)
#define PG8_LDA(dst, b, h) do { _Pragma("unroll") for (int m = 0; m < 4; ++m) _Pragma("unroll") for (int k = 0; k < 2; ++k) dst[m][k] = *(const PG8_LAS bf16x8*)(lds + PG8_SA(b, h) + aoff + m * 2048 + k * 1024); } while (0)
#define PG8_LDB(dst, b, h) do { _Pragma("unroll") for (int n = 0; n < 2; ++n) _Pragma("unroll") for (int k = 0; k < 2; ++k) dst[n][k] = *(const PG8_LAS bf16x8*)(lds + PG8_SB(b, h) + boff + n * 2048 + k * 1024); } while (0)
#define PG8_MMA(ai, bj, At, Bt) do { __builtin_amdgcn_s_setprio(1); _Pragma("unroll") for (int m = 0; m < 4; ++m) _Pragma("unroll") for (int n = 0; n < 2; ++n) _Pragma("unroll") for (int k = 0; k < 2; ++k) \
        acc[ai][bj][m][n] = __builtin_amdgcn_mfma_f32_16x16x32_bf16(Bt[n][k], At[m][k], acc[ai][bj][m][n], 0, 0, 0); __builtin_amdgcn_s_setprio(0); } while (0)
#define PG8_WAIT_V(n) asm volatile("s_waitcnt vmcnt(" #n ")" ::: "memory")
#define PG8_WAIT_L(n) asm volatile("s_waitcnt lgkmcnt(" #n ")" ::: "memory")
#define PG8_BAR __builtin_amdgcn_s_barrier()
#define PG8_SCHED __builtin_amdgcn_sched_barrier(0)
    Unit cur, nxt; int ui = 0;
    if (!S.next(0, cur)) return;
    f32x4 acc[2][2][4][2];
#pragma unroll
    for (int a = 0; a < 2; ++a)
#pragma unroll
        for (int b = 0; b < 2; ++b)
#pragma unroll
            for (int m = 0; m < 4; ++m)
#pragma unroll
                for (int n = 0; n < 2; ++n) acc[a][b][m][n] = (f32x4){0.f, 0.f, 0.f, 0.f};
    bf16x8 At[4][2], B0[2][2], B1[2][2];
    const char* cA = (const char*)g.A + (size_t)cur.pm * tstep; const char* cB = (const char*)g.Bt + (size_t)cur.pn * tstep;
    S.a_ready(cur);
    if constexpr (SP2) {
        PG8_STAGE(PG8_SB(0, 0), cB, voffB); PG8_STAGE(PG8_SB(0, 1), cB + hstep, voffB); PG8_STAGE(PG8_SA(0, 0), cA, voffA); PG8_STAGE(PG8_SA(0, 1), cA + hstep, voffA);
        if (wr == 1) PG8_BAR;
        PG8_WAIT_V(2); PG8_BAR;
        PG8_STAGE(PG8_SB(1, 0), cB + kstep, voffB); PG8_STAGE(PG8_SA(1, 0), cA + kstep, voffA); PG8_STAGE(PG8_SB(1, 1), cB + hstep + kstep, voffB);
        PG8_WAIT_V(6); PG8_BAR;
    } else {
        PG8_STAGE(PG8_SB(0, 0), cB, voffB); PG8_STAGE(PG8_SA(0, 0), cA, voffA); PG8_STAGE(PG8_SB(0, 1), cB + hstep, voffB); PG8_STAGE(PG8_SA(0, 1), cA + hstep, voffA);
        if (wr == 1) PG8_BAR;
        PG8_WAIT_V(4); PG8_BAR;
        PG8_STAGE(PG8_SB(1, 0), cB + kstep, voffB); PG8_STAGE(PG8_SA(1, 0), cA + kstep, voffA); PG8_STAGE(PG8_SB(1, 1), cB + hstep + kstep, voffB);
        PG8_WAIT_V(6); PG8_BAR;
    }
    for (;;) {
        const bool has_next = S.next(ui + 1, nxt);
        const char* nA = has_next ? (const char*)g.A + (size_t)nxt.pm * tstep : cA; const char* nB = has_next ? (const char*)g.Bt + (size_t)nxt.pn * tstep : cB;
        for (int t = 0; t < nt; t += 2) {
            const bool last = (t == nt - 2);
            const char* a1 = cA + (size_t)(t + 1) * kstep;
            const char* a2 = last ? nA : cA + (size_t)(t + 2) * kstep; const char* b2 = last ? nB : cB + (size_t)(t + 2) * kstep;
            const char* a3 = a2 + kstep; const char* b3 = b2 + kstep;
            if (last && has_next) S.a_ready(nxt);
            if constexpr (SP2) {
            PG8_LDB(B0, 0, 0); PG8_LDB(B1, 0, 1); PG8_SCHED; PG8_LDA(At, 0, 0); PG8_STAGE(PG8_SA(1, 1), a1 + hstep, voffA);
            PG8_WAIT_V(8); PG8_WAIT_L(0); PG8_BAR; PG8_MMA(0, 0, At, B0); PG8_MMA(0, 1, At, B1); PG8_BAR; PG8_SCHED;
            PG8_LDA(At, 0, 1); PG8_STAGE(PG8_SB(0, 0), b2, voffB); PG8_STAGE(PG8_SB(0, 1), b2 + hstep, voffB); PG8_STAGE(PG8_SA(0, 0), a2, voffA);
            PG8_WAIT_V(8); PG8_WAIT_L(0); PG8_BAR; PG8_MMA(1, 0, At, B0); PG8_MMA(1, 1, At, B1); PG8_BAR; PG8_SCHED;
            PG8_LDB(B0, 1, 0); PG8_LDB(B1, 1, 1); PG8_SCHED; PG8_LDA(At, 1, 0); PG8_STAGE(PG8_SA(0, 1), a2 + hstep, voffA);
            PG8_WAIT_V(8); PG8_WAIT_L(0); PG8_BAR; PG8_MMA(0, 0, At, B0); PG8_MMA(0, 1, At, B1); PG8_BAR; PG8_SCHED;
            PG8_LDA(At, 1, 1); PG8_STAGE(PG8_SB(1, 0), b3, voffB); PG8_STAGE(PG8_SB(1, 1), b3 + hstep, voffB); PG8_STAGE(PG8_SA(1, 0), a3, voffA);
            PG8_WAIT_V(8); PG8_WAIT_L(0); PG8_BAR; PG8_MMA(1, 0, At, B0); PG8_MMA(1, 1, At, B1); PG8_BAR; PG8_SCHED;
            } else {
            PG8_LDB(B0, 0, 0); PG8_SCHED; PG8_LDA(At, 0, 0); PG8_STAGE(PG8_SA(1, 1), a1 + hstep, voffA);
            PG8_WAIT_L(8); PG8_BAR; PG8_WAIT_L(0); PG8_MMA(0, 0, At, B0); PG8_BAR; PG8_SCHED;
            PG8_LDB(B1, 0, 1); PG8_STAGE(PG8_SB(0, 0), b2, voffB);
            PG8_BAR; PG8_WAIT_L(0); PG8_MMA(0, 1, At, B1); PG8_BAR;
            PG8_LDA(At, 0, 1); PG8_STAGE(PG8_SA(0, 0), a2, voffA);
            PG8_BAR; PG8_WAIT_L(0); PG8_MMA(1, 0, At, B0); PG8_BAR; PG8_SCHED;
            PG8_STAGE(PG8_SB(0, 1), b2 + hstep, voffB);
            PG8_WAIT_V(6); PG8_BAR; PG8_MMA(1, 1, At, B1); PG8_BAR;
            PG8_LDB(B0, 1, 0); PG8_SCHED; PG8_LDA(At, 1, 0); PG8_STAGE(PG8_SA(0, 1), a2 + hstep, voffA);
            PG8_WAIT_L(8); PG8_BAR; PG8_WAIT_L(0); PG8_MMA(0, 0, At, B0); PG8_BAR; PG8_SCHED;
            PG8_LDB(B1, 1, 1); PG8_STAGE(PG8_SB(1, 0), b3, voffB);
            PG8_BAR; PG8_WAIT_L(0); PG8_MMA(0, 1, At, B1); PG8_BAR;
            PG8_LDA(At, 1, 1); PG8_STAGE(PG8_SA(1, 0), a3, voffA);
            PG8_BAR; PG8_WAIT_L(0); PG8_MMA(1, 0, At, B0); PG8_BAR; PG8_SCHED;
            PG8_STAGE(PG8_SB(1, 1), b3 + hstep, voffB);
            PG8_WAIT_V(6); PG8_BAR; PG8_MMA(1, 1, At, B1); PG8_BAR;
            }
        }
        if constexpr (ALIGN_EPI) { if (wr == 0) PG8_BAR; }
        if constexpr (!Epi::AFTER_DRAIN) { E(acc, cur, wr, wc, fr, fq); S.done(cur); }
        if (!has_next) break;
#pragma unroll
        for (int a = 0; a < 2; ++a)
#pragma unroll
            for (int b = 0; b < 2; ++b)
#pragma unroll
                for (int m = 0; m < 4; ++m)
#pragma unroll
                    for (int n = 0; n < 2; ++n) acc[a][b][m][n] = (f32x4){0.f, 0.f, 0.f, 0.f};
        cur = nxt; cA = nA; cB = nB; ++ui;
        if constexpr (ALIGN_EPI) { if (wr == 1) PG8_BAR; }
    }
    PG8_WAIT_V(0);
    if constexpr (!ALIGN_EPI) { if (wr == 0) PG8_BAR; }
    PG8_BAR;
    if constexpr (Epi::AFTER_DRAIN) { E.fused(acc, cur, wr, wc, fr, fq, lds, wid, lane); S.done(cur); }
#undef PG8_SA
#undef PG8_SB
#undef PG8_STAGE
#undef PG8_LDA
#undef PG8_LDB
#undef PG8_MMA
#undef PG8_WAIT_V
#undef PG8_WAIT_L
#undef PG8_BAR
#undef PG8_SCHED
}
}
#include <hip/hip_bf16.h>
#include <cmath>
namespace attn_body {
using bf16=__hip_bfloat16;
using bf16x8=__attribute__((ext_vector_type(8)))short;
using s16x4=__attribute__((ext_vector_type(4)))short;
using f32x16=__attribute__((ext_vector_type(16)))float;
using u32x4=__attribute__((ext_vector_type(4)))unsigned;
constexpr int BATCH=8,NHEAD=16,SEQ=4096,D=64,DM=NHEAD*D;
constexpr int NW=8,QBLK=32,QB=QBLK*NW,KVBLK=64,NQB=SEQ/QB;
constexpr int ATTN_PITCH=DM, ATTN_UNIT_ROWS=QB;
__device__ __forceinline__ int crow(int r,int hi){return (r&3)+8*(r>>2)+4*hi;}
#define SBAR() __builtin_amdgcn_sched_barrier(0)
__device__ __forceinline__ void cmask(f32x16&p0,f32x16&p1,int jb,int qrel,int hi){
  const float NEG=-INFINITY; int kb=64*jb+4*hi;
  #pragma unroll
  for(int r=0;r<16;++r){int kv=kb+(r&3)+8*(r>>2); if(kv>qrel)p0[r]=NEG; if(kv+32>qrel)p1[r]=NEG;}
}

constexpr int NSLOT=3, SLOTB=8192;
constexpr int LDS_K=0, LDS_V=NSLOT*SLOTB, LDS_WS=2*NSLOT*SLOTB, LDS_OST=LDS_WS+NW*64*4, LDS_BYTES=LDS_OST+NW*4096;
constexpr float C2=0.125f*1.4426950408889634f;
__device__ __forceinline__ void glds16(const void*gsrc,unsigned lds_dst){unsigned keep;
  asm volatile("s_mov_b32 %0, m0\n\ts_mov_b32 m0, %2\n\ts_nop 0\n\tglobal_load_lds_dwordx4 %1, off\n\ts_mov_b32 m0, %0":"=&s"(keep):"v"(gsrc),"s"(lds_dst):"memory");}
__device__ __forceinline__ float max3f(float a,float b,float c){float r;asm("v_max3_f32 %0, %1, %2, %3":"=v"(r):"v"(a),"v"(b),"v"(c));return r;}
__device__ __forceinline__ float max2f(float a,float b){float r;asm("v_max_f32_e32 %0, %1, %2":"=v"(r):"v"(a),"v"(b));return r;}
__device__ __forceinline__ float fadd_s(float a,float b){float r;asm("v_add_f32_e32 %0, %1, %2":"=v"(r):"v"(a),"v"(b));return r;}
__device__ __forceinline__ float fsub_s(float a,float b){float r;asm("v_sub_f32_e32 %0, %1, %2":"=v"(r):"v"(a),"v"(b));return r;}
typedef float f32x2_t __attribute__((ext_vector_type(2))); typedef __bf16 bf16x2_t __attribute__((ext_vector_type(2)));
__device__ __forceinline__ unsigned cvtpk_s(float lo,float hi){f32x2_t v={lo,hi};bf16x2_t b=__builtin_convertvector(v,bf16x2_t);return __builtin_bit_cast(unsigned,b);}
#define WAIT_BAR(N) asm volatile("s_waitcnt vmcnt(" #N ") lgkmcnt(0)\n\ts_barrier":::"memory")

__device__ __forceinline__ void qkt(f32x16&p0,f32x16&p1,const char*Kslot,const bf16x8*qr,const f32x16&negm,int r32,int hi){
  const char*kb=Kslot+hi*1024+r32*16;
  #pragma unroll
  for(int d0=0;d0<4;++d0){
    const bf16x8 b0=*reinterpret_cast<const bf16x8*>(kb+d0*2048);
    const bf16x8 b1=*reinterpret_cast<const bf16x8*>(kb+d0*2048+512);
    if(d0==0){p0=__builtin_amdgcn_mfma_f32_32x32x16_bf16(b0,qr[0],negm,0,0,0);p1=__builtin_amdgcn_mfma_f32_32x32x16_bf16(b1,qr[0],negm,0,0,0);}
    else{p0=__builtin_amdgcn_mfma_f32_32x32x16_bf16(b0,qr[d0],p0,0,0,0);p1=__builtin_amdgcn_mfma_f32_32x32x16_bf16(b1,qr[d0],p1,0,0,0);}}
}
typedef __attribute__((address_space(3))) const char* lds_cptr;
typedef short v4i16_t __attribute__((ext_vector_type(4)));
__device__ __forceinline__ void kload8(bf16x8*kf,lds_cptr kp){
  kf[0]=*(const __attribute__((address_space(3))) bf16x8*)(kp);      kf[1]=*(const __attribute__((address_space(3))) bf16x8*)(kp+512);
  kf[2]=*(const __attribute__((address_space(3))) bf16x8*)(kp+2048); kf[3]=*(const __attribute__((address_space(3))) bf16x8*)(kp+2560);
  kf[4]=*(const __attribute__((address_space(3))) bf16x8*)(kp+4096); kf[5]=*(const __attribute__((address_space(3))) bf16x8*)(kp+4608);
  kf[6]=*(const __attribute__((address_space(3))) bf16x8*)(kp+6144); kf[7]=*(const __attribute__((address_space(3))) bf16x8*)(kp+6656);
}
__device__ __forceinline__ void kload2(bf16x8*kf,lds_cptr kp,int j){ kf[2*j]=*(const __attribute__((address_space(3))) bf16x8*)(kp+j*2048); kf[2*j+1]=*(const __attribute__((address_space(3))) bf16x8*)(kp+j*2048+512); }
__device__ __forceinline__ s16x4 vtr(lds_cptr p){ return __builtin_bit_cast(s16x4,__builtin_amdgcn_ds_read_tr16_b64_v4i16((__attribute__((address_space(3))) v4i16_t*)p)); }
__device__ __forceinline__ float rowmax(const f32x16&p0,const f32x16&p1){
  float a=max3f(p0[0],p0[1],p1[0]),b=max3f(p0[2],p0[3],p1[1]);a=max3f(a,p1[2],p1[3]);
  #pragma unroll
  for(int r=4;r<16;r+=4){a=max3f(a,p0[r],p0[r+1]);b=max3f(b,p0[r+2],p0[r+3]);a=max3f(a,p1[r],p1[r+1]);b=max3f(b,p1[r+2],p1[r+3]);}
  const float m=max2f(a,b);
  auto rr=__builtin_amdgcn_permlane32_swap(__float_as_uint(m),__float_as_uint(m),false,false);
  return max2f(__uint_as_float(rr[0]),__uint_as_float(rr[1]));
}
__device__ __forceinline__ void pv(f32x16*o,int vb,bf16x8 pa0,bf16x8 pa1,bf16x8 pa2,bf16x8 pa3){
  #pragma unroll
  for(int d0=0;d0<2;++d0){s16x4 lo[4],hi[4];
    #pragma unroll
    for(int ks=0;ks<4;++ks){
      asm volatile("ds_read_b64_tr_b16 %0,%1 offset:%c2":"=&v"(lo[ks]):"v"(vb),"i"(d0*4096+ks*1024):"memory");
      asm volatile("ds_read_b64_tr_b16 %0,%1 offset:%c2":"=&v"(hi[ks]):"v"(vb),"i"(d0*4096+ks*1024+512):"memory");}
    asm volatile("s_waitcnt lgkmcnt(0)":::"memory");SBAR();
    #define PK(k) (bf16x8){lo[k][0],lo[k][1],lo[k][2],lo[k][3],hi[k][0],hi[k][1],hi[k][2],hi[k][3]}
    o[d0]=__builtin_amdgcn_mfma_f32_32x32x16_bf16(pa0,PK(0),o[d0],0,0,0);
    o[d0]=__builtin_amdgcn_mfma_f32_32x32x16_bf16(pa1,PK(1),o[d0],0,0,0);
    o[d0]=__builtin_amdgcn_mfma_f32_32x32x16_bf16(pa2,PK(2),o[d0],0,0,0);
    o[d0]=__builtin_amdgcn_mfma_f32_32x32x16_bf16(pa3,PK(3),o[d0],0,0,0);
    #undef PK
  }
}

#ifndef ATTN_STORE16
#define ATTN_STORE16(p,v) (*(u32x4*)(p)=(v))
#endif
template<int THRL> __device__ __forceinline__ void attn_unit(int b,int h,int qb,const bf16*Q,const bf16*__restrict__ K,const bf16*__restrict__ V,bf16*O,char*shm,const int tid_in){
  const int tid=tid_in,lane=tid&63,r32=lane&31,hi=lane>>5; const int wid=__builtin_amdgcn_readfirstlane(tid>>6);
  const long rowbase=(long)b*SEQ; const int q0=qb*QB;
  const bf16*Qw=Q+(rowbase+q0+wid*QBLK)*DM+h*D;
  const bf16*Kh=K+rowbase*DM+h*D,*Vh=V+rowbase*DM+h*D;
  const unsigned lds0=(unsigned)(uintptr_t)shm;
  float*wsf=(float*)(shm+LDS_WS)+wid*64;
  const bf16*ksrc=Kh+(long)lane*DM+wid*8;
  const bf16*vsrc=Vh+(long)(16*(wid&3)+(lane>>2))*DM+(wid>>2)*32+(lane&3)*8;
  const unsigned kdst=lds0+LDS_K+wid*1024, vdst=lds0+LDS_V+wid*1024;
  #define DMA_K(t,slot) glds16(ksrc+(long)(t)*KVBLK*DM,(unsigned)__builtin_amdgcn_readfirstlane(kdst+(slot)))
  #define DMA_V(t,slot) glds16(vsrc+(long)(t)*KVBLK*DM,(unsigned)__builtin_amdgcn_readfirstlane(vdst+(slot)))
  const int vb0=(int)(lds0+LDS_V)+((lane>>4)&1)*32+(lane&3)*8+(4*hi+((lane&15)>>2))*64;
  const char*Kbase=shm+LDS_K; bf16x8 kf[8];
  const lds_cptr shm3=(lds_cptr)shm; const lds_cptr kp0=shm3+LDS_K+hi*1024+r32*16; const lds_cptr vp0=shm3+LDS_V+((lane>>4)&1)*32+(lane&3)*8+(4*hi+((lane&15)>>2))*64;
  const int NT=(q0+QB)/KVBLK;
  DMA_K(0,0);DMA_V(0,0);DMA_K(1,SLOTB);
  bf16x8 qr[4];
  #pragma unroll
  for(int d0=0;d0<4;++d0)qr[d0]=*reinterpret_cast<const bf16x8*>(&Qw[(long)r32*DM+d0*16+hi*8]);
  float mhat=0.f,l_reg=0.f;f32x16 o[2];o[0]=f32x16{};o[1]=f32x16{};f32x16 negm=f32x16{};asm volatile("":"+v"(negm));
  const int qrel=wid*QBLK+r32;
  #define CMASK(P0,P1,t) do{int jb_=(t)-(NT-4); if(jb_>=0)cmask(P0,P1,jb_,qrel,hi);}while(0)
  bool resc=false;
  #define START(P0,P1) do{ const float rm=rowmax(P0,P1); resc=false; \
    { const float dl=rm; mhat=fadd_s(mhat,dl); \
      _Pragma("unroll") for(int r=0;r<16;++r){P0[r]=fsub_s(P0[r],dl);P1[r]=fsub_s(P1[r],dl);} \
      _Pragma("unroll") for(int r=0;r<16;++r)negm[r]=-mhat; asm volatile("":"+v"(negm)); } \
    _Pragma("unroll") for(int r=0;r<16;++r)P0[r]=__builtin_amdgcn_exp2f(P0[r]); }while(0)
  #define RESC() do{ if(resc){ asm volatile("s_waitcnt lgkmcnt(0)":::"memory"); \
      _Pragma("unroll") for(int d_=0;d_<2;++d_) _Pragma("unroll") for(int r=0;r<16;++r)o[d_][r]*=wsf[crow(r,hi)]; } }while(0)
  f32x16 pA0,pA1,pB0,pB1;
  int sl_prev=0,sl_cur=0,sl_next=SLOTB;
  #define ROT() do{sl_prev=sl_cur;sl_cur=sl_next;sl_next=(sl_next==(NSLOT-1)*SLOTB)?0:sl_next+SLOTB;}while(0)
  DMA_K(2,2*SLOTB);
  WAIT_BAR(3);
  qkt(pA0,pA1,Kbase,qr,negm,r32,hi);asm volatile("s_nop 15\n\ts_nop 7":"+v"(pA0),"+v"(pA1));CMASK(pA0,pA1,0);
  START(pA0,pA1);
  _Pragma("unroll") for(int r=0;r<16;++r)pA1[r]=__builtin_amdgcn_exp2f(pA1[r]);
  WAIT_BAR(0);
  DMA_K(3,0);DMA_V(1,SLOTB);
  ROT();
  kload8(kf,kp0+sl_cur);
  WAIT_BAR(2);
  s16x4 vlo[8],vhi[8]; u32x4 pw0,pw1,pw2,pw3;
  #define PKW(P,B) cvtpk_s(P[B],P[B+1])
  #define PAF(k) __builtin_bit_cast(bf16x8,pw##k)
  #define VFR(i) (bf16x8){vlo[i][0],vlo[i][1],vlo[i][2],vlo[i][3],vhi[i][0],vhi[i][1],vhi[i][2],vhi[i][3]}
  #define PIN(x) asm volatile("":"+v"(x))
  #define MX3(a,b,c) __builtin_fmaxf(__builtin_fmaxf((a),(b)),(c))
  #define GAPA(MF,A0,A1,A2,A3,W0,W1,PW) do{ MF; sacc+=A0; sacc+=A1; sacc+=A2; sacc+=A3; PIN(sacc); W0; W1; PIN(PW); SBAR(); }while(0)
  #define EX(v) __builtin_amdgcn_exp2f(v)
  #define GAPB(MF,X,B) do{ MF; X[B]=EX(X[B]); X[B+1]=EX(X[B+1]); X[B+2]=EX(X[B+2]); X[B+3]=EX(X[B+3]); PIN(X); SBAR(); }while(0)
  #define VRD(i) do{ vlo[i]=vtr(vp_+(((i)>>2)*4096+((i)&3)*1024)); vhi[i]=vtr(vp_+(((i)>>2)*4096+((i)&3)*1024+512)); }while(0)
  #define KRD(G,j) do{ if(G){ kload2(kf,kp0+sl_next,j); SBAR(); } }while(0)
  #define STEP(C0,C1,P0,P1,t,GK,GV,GL) do{ SBAR(); \
    const lds_cptr vp_=vp0+sl_prev; \
    VRD(0); SBAR(); float sacc=(P0[0]+P0[1]); \
    GAPA(C0=__builtin_amdgcn_mfma_f32_32x32x16_bf16(kf[0],qr[0],negm,0,0,0), P0[2],P0[3],P0[4],P0[5],     pw0[0]=PKW(P0,0), pw0[1]=PKW(P0,2), pw0); \
    VRD(4); SBAR(); GAPA(C1=__builtin_amdgcn_mfma_f32_32x32x16_bf16(kf[1],qr[0],negm,0,0,0), P0[6],P0[7],P0[8],P0[9],     pw0[2]=PKW(P0,4), pw0[3]=PKW(P0,6), pw0); \
    VRD(1); SBAR(); GAPA(C0=__builtin_amdgcn_mfma_f32_32x32x16_bf16(kf[2],qr[1],C0,0,0,0),   P0[10],P0[11],P0[12],P0[13], pw1[0]=PKW(P0,8), pw1[1]=PKW(P0,10), pw1); \
    VRD(5); SBAR(); GAPA(C1=__builtin_amdgcn_mfma_f32_32x32x16_bf16(kf[3],qr[1],C1,0,0,0),   P0[14],P0[15],P1[0],P1[1],   pw1[2]=PKW(P0,12),pw1[3]=PKW(P0,14), pw1); \
    VRD(2); SBAR(); GAPA(C0=__builtin_amdgcn_mfma_f32_32x32x16_bf16(kf[4],qr[2],C0,0,0,0),   P1[2],P1[3],P1[4],P1[5],     pw2[0]=PKW(P1,0), pw2[1]=PKW(P1,2), pw2); \
    VRD(6); SBAR(); GAPA(C1=__builtin_amdgcn_mfma_f32_32x32x16_bf16(kf[5],qr[2],C1,0,0,0),   P1[6],P1[7],P1[8],P1[9],     pw2[2]=PKW(P1,4), pw2[3]=PKW(P1,6), pw2); \
    VRD(3); SBAR(); GAPA(C0=__builtin_amdgcn_mfma_f32_32x32x16_bf16(kf[6],qr[3],C0,0,0,0),   P1[10],P1[11],P1[12],P1[13], pw3[0]=PKW(P1,8), pw3[1]=PKW(P1,10), pw3); \
    VRD(7); SBAR(); GAPA(C1=__builtin_amdgcn_mfma_f32_32x32x16_bf16(kf[7],qr[3],C1,0,0,0),   P1[14],P1[15],0.f,0.f,       pw3[2]=PKW(P1,12),pw3[3]=PKW(P1,14), pw3); \
    l_reg+=sacc; \
    if(GK){DMA_K((t)+3,sl_cur);} if(GV){DMA_V((t)+1,sl_next);} \
    CMASK(C0,C1,t); \
    { float a=MX3(C0[0],C0[1],C1[0]),b=MX3(C0[2],C0[3],C1[1]); a=MX3(a,C1[2],C1[3]); \
      _Pragma("unroll") for(int r=4;r<16;r+=4){a=MX3(a,C0[r],C0[r+1]);b=MX3(b,C0[r+2],C0[r+3]);a=MX3(a,C1[r],C1[r+1]);b=MX3(b,C1[r+2],C1[r+3]);} \
      float rm=__builtin_fmaxf(a,b); { auto rr=__builtin_amdgcn_permlane32_swap(__float_as_uint(rm),__float_as_uint(rm),false,false); rm=__builtin_fmaxf(__uint_as_float(rr[0]),__uint_as_float(rr[1])); } \
      resc=false; \
      if(__builtin_expect(__any(rm>(float)THRL),0)){ const float dl=__builtin_fmaxf(rm,0.f); mhat+=dl; \
        _Pragma("unroll") for(int r=0;r<16;++r){C0[r]-=dl;C1[r]-=dl;} \
        _Pragma("unroll") for(int r=0;r<16;++r)negm[r]=-mhat; asm volatile("":"+v"(negm)); \
        const float f=__builtin_amdgcn_exp2f(-dl); l_reg*=f; if(hi==0)wsf[r32]=f; resc=true; } } \
    SBAR(); \
    GAPB(o[0]=__builtin_amdgcn_mfma_f32_32x32x16_bf16(PAF(0),VFR(0),o[0],0,0,0), C0,0); \
    GAPB(o[1]=__builtin_amdgcn_mfma_f32_32x32x16_bf16(PAF(0),VFR(4),o[1],0,0,0), C0,4); \
    KRD(GL,0); GAPB(o[0]=__builtin_amdgcn_mfma_f32_32x32x16_bf16(PAF(1),VFR(1),o[0],0,0,0), C0,8); \
    KRD(GL,1); GAPB(o[1]=__builtin_amdgcn_mfma_f32_32x32x16_bf16(PAF(1),VFR(5),o[1],0,0,0), C0,12); \
    KRD(GL,2); GAPB(o[0]=__builtin_amdgcn_mfma_f32_32x32x16_bf16(PAF(2),VFR(2),o[0],0,0,0), C1,0); \
    KRD(GL,3); GAPB(o[1]=__builtin_amdgcn_mfma_f32_32x32x16_bf16(PAF(2),VFR(6),o[1],0,0,0), C1,4); \
    GAPB(o[0]=__builtin_amdgcn_mfma_f32_32x32x16_bf16(PAF(3),VFR(3),o[0],0,0,0), C1,8); \
    GAPB(o[1]=__builtin_amdgcn_mfma_f32_32x32x16_bf16(PAF(3),VFR(7),o[1],0,0,0), C1,12); \
    }while(0)
  int t=1;
  #undef CMASK
  #define CMASK(P0,P1,t) do{}while(0)
  for(;t+5<NT;t+=2){
    STEP(pB0,pB1,pA0,pA1,t,true,true,true);     WAIT_BAR(2); RESC(); ROT();
    STEP(pA0,pA1,pB0,pB1,t+1,true,true,true);   WAIT_BAR(2); RESC(); ROT();
  }
  #undef CMASK
  #define CMASK(P0,P1,t) do{int jb_=(t)-(NT-4); if(jb_>=0)cmask(P0,P1,jb_,qrel,hi);}while(0)
  #define ENDW(tt) do{ if((tt)+3<NT){WAIT_BAR(2);} else if((tt)+2<NT){WAIT_BAR(1);} else {WAIT_BAR(0);} }while(0)
  for(;t+1<NT;t+=2){
    STEP(pB0,pB1,pA0,pA1,t,(t+3<NT),(t+1<NT),(t+1<NT));       ENDW(t);   RESC(); ROT();
    STEP(pA0,pA1,pB0,pB1,t+1,(t+4<NT),(t+2<NT),(t+2<NT));     ENDW(t+1); RESC(); ROT();
  }
  STEP(pB0,pB1,pA0,pA1,NT-1,false,false,false); RESC();
  { float sacc=pB0[0]+pB0[1]; _Pragma("unroll") for(int r=2;r<16;++r)sacc+=pB0[r]; _Pragma("unroll") for(int r=0;r<16;++r)sacc+=pB1[r]; l_reg+=sacc;
    pw0=(u32x4){PKW(pB0,0),PKW(pB0,2),PKW(pB0,4),PKW(pB0,6)};pw1=(u32x4){PKW(pB0,8),PKW(pB0,10),PKW(pB0,12),PKW(pB0,14)};pw2=(u32x4){PKW(pB1,0),PKW(pB1,2),PKW(pB1,4),PKW(pB1,6)};pw3=(u32x4){PKW(pB1,8),PKW(pB1,10),PKW(pB1,12),PKW(pB1,14)};
    SBAR(); pv(o,vb0+sl_cur,PAF(0),PAF(1),PAF(2),PAF(3)); }
  #undef PKW
  #undef PAF
  #undef VFR
  #undef PIN
  #undef MX3
  #undef GAPA
  #undef GAPB
  #undef EX
  #undef VRD
  #undef KRD
  #undef STEP
  #undef ENDW
  {auto rr=__builtin_amdgcn_permlane32_swap(__float_as_uint(l_reg),__float_as_uint(l_reg),false,false);l_reg=__uint_as_float(rr[0])+__uint_as_float(rr[1]);}
  if(hi==0)wsf[32+r32]=l_reg;asm volatile("s_waitcnt lgkmcnt(0)":::"memory");
  float rli[16];
  #pragma unroll
  for(int r=0;r<16;++r)rli[r]=__builtin_amdgcn_rcpf(wsf[32+crow(r,hi)]);
  bf16*Ow=O+(rowbase+q0+wid*QBLK)*DM+h*D;
  { bf16*stg=(bf16*)(shm+LDS_OST)+wid*2048;
    #pragma unroll
    for(int r=0;r<16;++r){const int orow=crow(r,hi);
      #pragma unroll
      for(int d0=0;d0<2;++d0)stg[orow*64+d0*32+r32]=__float2bfloat16(o[d0][r]*rli[r]);}
    asm volatile("s_waitcnt lgkmcnt(0)":::"memory");
    #pragma unroll
    for(int i=0;i<4;++i){const int row=i*8+(lane>>3),ch=lane&7; const u32x4 v=*(const u32x4*)(stg+row*64+ch*8); ATTN_STORE16(Ow+(long)row*DM+ch*8,v);} }
  asm volatile("s_waitcnt lgkmcnt(0)\n\ts_barrier":::"memory");
  #undef DMA_K
  #undef DMA_V
  #undef CMASK
  #undef START
  #undef RESC
  #undef ROT
}
constexpr int ATTN_LDS_BYTES=LDS_BYTES;
struct AttnTensors { const bf16* Q; const bf16* K; const bf16* V; bf16* O; };
struct AttnUnit { int bh; int qb; };
template<class Sched,int THRL=8> __device__ __forceinline__ void attn_phase(char*lds,const AttnTensors&T,const Sched&S,const int tid_in){
  AttnUnit u;
  for(int i=0;S.next(i,u);++i){ S.a_ready(u); attn_unit<THRL>(u.bh/NHEAD,u.bh%NHEAD,u.qb,T.Q,T.K,T.V,T.O,lds,tid_in); S.done(u); }
}
#undef SBAR
#undef WAIT_BAR
}
constexpr int NWAVES = 8;
constexpr int BATCH = 8, SEQ = 4096, DM = 1024, M = BATCH * SEQ;
constexpr int IN_COLS = 2560, PLE_DIM = 256, NEXP = 16384, QCOLS = 2048;
constexpr float EPS = 1e-6f;
#ifndef MK_N_LAUNCHES
#define MK_N_LAUNCHES 1
#endif
constexpr int N_PHASES = 11;
constexpr size_t MiB = 1u << 20;
constexpr size_t WS_CTL = 0, CTL_ZERO_BYTES = 1 * MiB;
constexpr size_t WS_ROPEC = 1 * MiB, WS_ROPES = 1 * MiB + 512 * 1024;
constexpr size_t WS_KEYS = 2 * MiB;
constexpr size_t WS_WPROJ = 3 * MiB;
constexpr size_t WS_WIN = 4 * MiB;
constexpr size_t WS_WOUT = 10 * MiB, WS_WQ = 12 * MiB, WS_WGATE = 16 * MiB;
constexpr size_t WS_SSQ1 = 18 * MiB;
constexpr size_t WS_PB = 24 * MiB;
constexpr size_t WS_E = 40 * MiB;
constexpr size_t WS_UT = 104 * MiB, WS_VT = 120 * MiB;
constexpr size_t WS_SU = 136 * MiB, WS_SV = 137 * MiB;
constexpr size_t WS_XN = 168 * MiB;
constexpr size_t WS_QO = 232 * MiB, WS_K = 296 * MiB, WS_V = 360 * MiB;
constexpr size_t WS_U = 424 * MiB;
constexpr size_t WS_QP = 296 * MiB;
constexpr size_t WS_XN2 = 424 * MiB;
constexpr size_t WS_SM = 138 * MiB, WS_HS = 139 * MiB, WS_SSQ2 = 140 * MiB;
constexpr size_t WS_HQ = 24 * MiB;
constexpr size_t WS_APART = 168 * MiB;
constexpr size_t WS_QM = 424 * MiB;
constexpr size_t WS_EID = 488 * MiB, WS_GATE = 496 * MiB;
constexpr size_t WS_END = 512 * MiB;
constexpr int RING_BYTES = 131072, LDS_BYTES = 147456;
constexpr int MISC_OFF = LDS_BYTES - 256;
constexpr int CW_BAR = 4096;

#define GAS __attribute__((address_space(1)))
#define LAS __attribute__((address_space(3)))
typedef unsigned short bf16;
typedef unsigned v4u __attribute__((ext_vector_type(4)));
typedef float f32x4 __attribute__((ext_vector_type(4)));
typedef float f32x16 __attribute__((ext_vector_type(16)));
typedef short bf16x8 __attribute__((ext_vector_type(8)));
typedef __bf16 bf16x2_t __attribute__((ext_vector_type(2)));
#define LDS_WAIT() asm volatile("s_waitcnt lgkmcnt(0)" ::: "memory")
#define VM_WAIT() asm volatile("s_waitcnt vmcnt(0)" ::: "memory")
__device__ __forceinline__ unsigned f2bf(float f) { unsigned u = __builtin_bit_cast(unsigned, f); return (u + 0x7fffu + ((u >> 16) & 1u)) >> 16; }
__device__ __forceinline__ unsigned pk2(float lo, float hi) { return f2bf(lo) | (f2bf(hi) << 16); }
__device__ __forceinline__ v4u pk8(const f32x4 a, const f32x4 b) { v4u w; w.x = pk2(a[0], a[1]); w.y = pk2(a[2], a[3]); w.z = pk2(b[0], b[1]); w.w = pk2(b[2], b[3]); return w; }
__device__ __forceinline__ float bflo(unsigned w) { return __uint_as_float(w << 16); }
__device__ __forceinline__ float bfhi(unsigned w) { return __uint_as_float(w & 0xffff0000u); }
__device__ __forceinline__ float dot4s_(const f32x4 a) { return (a[0] * a[0] + a[1] * a[1]) + (a[2] * a[2] + a[3] * a[3]); }
__device__ __forceinline__ float wave_sum(float v) {
#pragma unroll
    for (int o = 1; o < 64; o <<= 1) v += __shfl_xor(v, o);
    return v;
}
__device__ __forceinline__ float dot2bf(unsigned w, unsigned x, float acc) { return __builtin_amdgcn_fdot2_f32_bf16(__builtin_bit_cast(bf16x2_t, w), __builtin_bit_cast(bf16x2_t, x), acc, false); }

typedef GAS unsigned gu32;
#define RLX_AGENT __ATOMIC_RELAXED, __HIP_MEMORY_SCOPE_AGENT
#define XB_TMO      128
#define XB_XCNT(j)  (256  + 64 * (j))
#define XB_XSUB(j)  (1280 + 64 * (j))
#define XB_XGEN(j)  (2304 + 64 * (j))
#define XB_TOP      3328
#define XB_TOPGEN   3392
#define XCD_BAR_WORDS 3456
#define XB_SPIN_CAP (1u << 18)

__device__ __forceinline__ unsigned xb_ld(unsigned* p)              { return __hip_atomic_load(p, __ATOMIC_RELAXED, __HIP_MEMORY_SCOPE_AGENT); }
__device__ __forceinline__ unsigned xb_add(unsigned* p, unsigned v) { return __hip_atomic_fetch_add(p, v, __ATOMIC_RELAXED, __HIP_MEMORY_SCOPE_AGENT); }
__device__ __forceinline__ unsigned xb_xcc_id() { return (unsigned)__builtin_amdgcn_s_getreg((3 << 11) | 20) & 0xFu; }
#define XB_SPIN(cond, bar) do { unsigned _sp = 0; while (cond) { __builtin_amdgcn_s_sleep(1); \
    if ((++_sp & 255u) == 0u) { if (xb_ld(&(bar)[XB_TMO])) break; if (_sp > XB_SPIN_CAP) { atomicAdd(&(bar)[XB_TMO], 1u); break; } } } } while (0)

struct XcdBarrier {
    unsigned* bar; unsigned x;
    volatile LAS unsigned* st;
};

__device__ __forceinline__ XcdBarrier xcd_barrier_post(unsigned* bar, volatile LAS unsigned* st, const bool leader) {
    XcdBarrier b; b.bar = bar; b.x = xb_xcc_id(); b.st = st;
    if (leader) (void)xb_add(&bar[XB_XCNT(b.x)], 1u);
    return b;
}
__device__ __forceinline__ void xcd_barrier_complete(unsigned* bar, unsigned x, unsigned& nloc, unsigned& nx) {
    const unsigned G = gridDim.x * gridDim.y * gridDim.z;
    unsigned sum, cnt, mine, sp = 0u;
    for (;;) {
        sum = 0u; cnt = 0u; mine = 0u;
#pragma unroll
        for (unsigned j = 0; j < 16; ++j) { const unsigned c = xb_ld(&bar[XB_XCNT(j)]); sum += c; cnt += (c > 0u) ? 1u : 0u; mine = (j == x) ? c : mine; }
        if (sum == G) break;
        __builtin_amdgcn_s_sleep(1);
        if ((++sp & 255u) == 0u) { if (xb_ld(&bar[XB_TMO])) break; if (sp > XB_SPIN_CAP) { atomicAdd(&bar[XB_TMO], 1u); break; } }
    }
    nloc = mine > 0u ? mine : 1u; nx = cnt > 0u ? cnt : 1u;
}

__device__ __forceinline__ void xcd_barrier(const XcdBarrier& b, const bool leader  ) {
    asm volatile("s_waitcnt vmcnt(0)" ::: "memory");
    __syncthreads();
    if (leader) {
        unsigned* bar = b.bar;
        __builtin_amdgcn_s_waitcnt(0);
        unsigned nloc = b.st[0], nx = b.st[1];
        if (nloc == 0u) { xcd_barrier_complete(bar, b.x, nloc, nx); b.st[0] = nloc; b.st[1] = nx; }
        const unsigned old = xb_add(&bar[XB_XSUB(b.x)], 1u);
        const unsigned gen = old / nloc;
        if (old + 1u == (gen + 1u) * nloc) {
            __builtin_amdgcn_fence(__ATOMIC_RELEASE, "agent");
            asm volatile("s_waitcnt vmcnt(0)" ::: "memory");
            const unsigned og = xb_add(&bar[XB_TOP], 1u);
            const unsigned tg = og / nx;
            if (og + 1u == (tg + 1u) * nx) xb_add(&bar[XB_TOPGEN], 1u);
            else XB_SPIN(xb_ld(&bar[XB_TOPGEN]) == tg, bar);
            __builtin_amdgcn_fence(__ATOMIC_ACQUIRE, "agent");
            xb_add(&bar[XB_XGEN(b.x)], 1u);
            asm volatile("s_waitcnt vmcnt(0)" ::: "memory");
        } else {
            XB_SPIN(xb_ld(&bar[XB_XGEN(b.x)]) == gen, bar);
            __builtin_amdgcn_fence(__ATOMIC_ACQUIRE, "agent");
            asm volatile("s_waitcnt vmcnt(0)" ::: "memory");
        }
    }
    __syncthreads();
}

__device__ __forceinline__ int lane_id() { int l; asm volatile("v_mbcnt_lo_u32_b32 %0, -1, 0\n\tv_mbcnt_hi_u32_b32 %0, -1, %0" : "=v"(l)); return l; }
#if defined(PROBE_A)
#define STAMP(i) do { if (F.wave == 0) { const unsigned long long t_ = __builtin_amdgcn_s_memrealtime(); volatile LAS unsigned* ms_ = (volatile LAS unsigned*)(F.lds + MISC_OFF) + 16 + 2 * (i); ms_[0] = (unsigned)t_; ms_[1] = (unsigned)(t_ >> 32); } } while (0)
#else
#define STAMP(i) do {} while (0)
#endif
struct Frame {
    LAS unsigned char* lds; unsigned char* ldsg;
    int wave, vcu, G;
    float* out; unsigned char* ws;
};
template <int I> __device__ __forceinline__ const float* inptr() {
    const float* p = nullptr;
#if defined(__HIP_DEVICE_COMPILE__)
    const void* ka = (const void*)__builtin_amdgcn_kernarg_segment_ptr();
    asm volatile("s_load_dwordx2 %0, %1, %2\n\ts_waitcnt lgkmcnt(0)" : "=s"(p) : "s"(ka), "i"(I * 8) : "memory");
#endif
    return p;
}
#define INP(i) inptr<i>()

__device__ const double INVREV[32] = {0.15915494309189535, 0.11934937021124886, 0.089499401608891013, 0.067115083005227255, 0.050329212104487035, 0.037741584717419771, 0.028302195830623399, 0.02122365276477766,
    0.015915494309189534, 0.011934937021124886, 0.0089499401608891024, 0.0067115083005227253, 0.0050329212104487037, 0.0037741584717419772, 0.0028302195830623399, 0.0021223652764777662,
    0.0015915494309189536, 0.0011934937021124885, 0.00089499401608891024, 0.0006711508300522726, 0.00050329212104487033, 0.00037741584717419774, 0.00028302195830623395, 0.00021223652764777661,
    0.00015915494309189535, 0.00011934937021124886, 8.9499401608891018e-05, 6.7115083005227254e-05, 5.0329212104487035e-05, 3.7741584717419777e-05, 2.8302195830623396e-05, 2.1223652764777659e-05};
__device__ __forceinline__ int win_rowmap(int n) {
    if (n < 1024) { const int region = n >> 9, r = n & 511, tile = r >> 8, w = r & 255, blk = w >> 6, d = w & 63, bj = d >> 5, dlo = d & 31; return region * 512 + tile * 256 + bj * 128 + blk * 32 + dlo; }
    if (n < 1536) return n;
    const int cc = n - 1536, isg = cc >> 9, ch = cc & 511, j = ch >> 7, c2 = ch & 127; return 1536 + j * 256 + isg * 128 + c2;
}
template <bool MAP>
__device__ __forceinline__ void p0_transpose_item(const float* W, int K, int N, bf16* WT, const float* gk, LAS float* scr, int item, int lane) {
    const int nblk = N / 32, kb = item / nblk, nb = item % nblk, k0 = 64 * kb, n0 = 32 * nb;
    float wv[32];
#pragma unroll
    for (int i = 0; i < 32; ++i) { const int kk = 2 * i + (lane >> 5); wv[i] = W[(size_t)(k0 + kk) * N + n0 + (lane & 31)]; }
    if (gk) {
#pragma unroll
        for (int i = 0; i < 32; ++i) wv[i] *= gk[k0 + 2 * i + (lane >> 5)]; }
#pragma unroll
    for (int i = 0; i < 32; ++i) { const int kk = 2 * i + (lane >> 5); scr[kk * 33 + (lane & 31)] = wv[i]; }
    LDS_WAIT(); asm volatile("" ::: "memory");
    const int c = lane & 7; const int r0 = MAP ? win_rowmap(n0) : n0;
#pragma unroll
    for (int j = 0; j < 4; ++j) { const int n = (lane >> 3) + 8 * j; const LAS float* s = scr + (8 * c) * 33 + n;
        v4u o; o.x = pk2(s[0 * 33], s[1 * 33]); o.y = pk2(s[2 * 33], s[3 * 33]); o.z = pk2(s[4 * 33], s[5 * 33]); o.w = pk2(s[6 * 33], s[7 * 33]);
        *(GAS v4u*)(WT + (size_t)(r0 + n) * K + k0 + 8 * c) = o; }
    LDS_WAIT(); asm volatile("" ::: "memory");
}
__device__ __forceinline__ void cvt_stream(const float* src, bf16* dst, size_t n8, int gw, int NGW, int lane) {
    for (size_t c = (size_t)gw * 64 + lane; c < n8; c += (size_t)NGW * 64) { const f32x4 a = *(const GAS f32x4*)(src + c * 8), b = *(const GAS f32x4*)(src + c * 8 + 4); *(GAS v4u*)(dst + c * 8) = pk8(a, b); }
}
__device__ __forceinline__ void p0_prologue(Frame& F) {
    const int lane = lane_id();
    LAS float* scr = (LAS float*)(F.lds + F.wave * 16384);
    const int gw = F.vcu * NWAVES + F.wave, NGW = F.G * NWAVES;
    bf16* WIN = (bf16*)(F.ws + WS_WIN); bf16* WOUT = (bf16*)(F.ws + WS_WOUT); bf16* WQ = (bf16*)(F.ws + WS_WQ); bf16* WGATE = (bf16*)(F.ws + WS_WGATE); bf16* WPROJ = (bf16*)(F.ws + WS_WPROJ);
    constexpr int I_IN = (DM / 64) * (IN_COLS / 32), I_OUT = (DM / 64) * (DM / 32), I_Q = (DM / 64) * (QCOLS / 32), I_G = I_OUT, I_P = (PLE_DIM / 64) * (DM / 32);
    constexpr int NITEMS = I_IN + I_OUT + I_Q + I_G + I_P;
    for (int it = gw; it < NITEMS; it += NGW) {
        int r = it;
        if (r < I_IN) { p0_transpose_item<true>(INP(3), DM, IN_COLS, WIN, nullptr, scr, r, lane); continue; } r -= I_IN;
        if (r < I_OUT) { p0_transpose_item<false>(INP(13), DM, DM, WOUT, nullptr, scr, r, lane); continue; } r -= I_OUT;
        if (r < I_Q) { p0_transpose_item<false>(INP(15), DM, QCOLS, WQ, INP(14), scr, r, lane); continue; } r -= I_Q;
        if (r < I_G) { p0_transpose_item<false>(INP(20), DM, DM, WGATE, INP(19), scr, r, lane); continue; } r -= I_G;
        p0_transpose_item<false>(INP(21), PLE_DIM, DM, WPROJ, nullptr, scr, r, lane);
    }
    cvt_stream(INP(16), (bf16*)(F.ws + WS_KEYS), (size_t)2 * 128 * 128 / 8, gw, NGW, lane);
    { const float* ut = INP(17); const float* vt = INP(18); float* SU = (float*)(F.ws + WS_SU); float* SV = (float*)(F.ws + WS_SV);
      for (int r0 = gw; r0 < 2 * NEXP; r0 += 4 * NGW) {
          f32x4 v[4][4];
#pragma unroll
          for (int u = 0; u < 4; ++u) { const int r = r0 + u * NGW; const bool isv = r >= NEXP; const int e = isv ? r - NEXP : r; const float* src = (isv ? vt : ut) + (size_t)e * DM + 16 * lane;
#pragma unroll
              for (int i = 0; i < 4; ++i) v[u][i] = *(const GAS f32x4*)(src + 4 * i); }
#pragma unroll
          for (int u = 0; u < 4; ++u) { const int r = r0 + u * NGW; const bool isv = r >= NEXP; const int e = isv ? r - NEXP : r; float amax = 0.f;
#pragma unroll
              for (int i = 0; i < 4; ++i) amax = fmaxf(amax, fmaxf(fmaxf(__builtin_fabsf(v[u][i][0]), __builtin_fabsf(v[u][i][1])), fmaxf(__builtin_fabsf(v[u][i][2]), __builtin_fabsf(v[u][i][3]))));
#pragma unroll
              for (int o = 1; o < 64; o <<= 1) amax = fmaxf(amax, __shfl_xor(amax, o));
              const float inv = 127.f / fmaxf(amax, 1e-30f); v4u w;
#pragma unroll
              for (int i = 0; i < 4; ++i) { const int a = (int)__builtin_rintf(v[u][i][0] * inv), b = (int)__builtin_rintf(v[u][i][1] * inv), c = (int)__builtin_rintf(v[u][i][2] * inv), d = (int)__builtin_rintf(v[u][i][3] * inv);
                  w[i] = (unsigned)(a & 0xff) | ((unsigned)(b & 0xff) << 8) | ((unsigned)(c & 0xff) << 16) | ((unsigned)d << 24); }
              *(GAS v4u*)(F.ws + (isv ? WS_VT : WS_UT) + ((size_t)(lane >> 3) * NEXP + e) * 128 + 16 * (lane & 7)) = w;
              if (lane == 0) (isv ? SV : SU)[e] = amax * (1.f / 127.f); } } }
    cvt_stream(INP(1), (bf16*)(F.ws + WS_PB), (size_t)M * PLE_DIM / 8, gw, NGW, lane);
    { float* rc = (float*)(F.ws + WS_ROPEC); float* rs = (float*)(F.ws + WS_ROPES);
      for (int idx = gw * 64 + lane; idx < SEQ * 32; idx += NGW * 64) { const int pos = idx >> 5, i = idx & 31; const double rev = (double)pos * INVREV[i]; const float fr = (float)(rev - __builtin_floor(rev));
          rc[idx] = __builtin_amdgcn_cosf(fr); rs[idx] = __builtin_amdgcn_sinf(fr); } }
    { const float* x = INP(0); const float* g = INP(2); bf16* XN = (bf16*)(F.ws + WS_XN);
      f32x4 gv[4];
#pragma unroll
      for (int j = 0; j < 4; ++j) gv[j] = ((const GAS f32x4*)g)[64 * j + lane];
      for (int m0 = gw; m0 < M; m0 += 4 * NGW) {
          f32x4 v[4][4];
#pragma unroll
          for (int u = 0; u < 4; ++u) { const GAS f32x4* xr = (const GAS f32x4*)(x + (size_t)(m0 + u * NGW) * DM) + lane;
#pragma unroll
              for (int j = 0; j < 4; ++j) v[u][j] = xr[64 * j]; }
#pragma unroll
          for (int u = 0; u < 4; ++u) { float s2 = 0.f;
#pragma unroll
              for (int j = 0; j < 4; ++j) s2 += (v[u][j].x * v[u][j].x + v[u][j].y * v[u][j].y) + (v[u][j].z * v[u][j].z + v[u][j].w * v[u][j].w);
              const float rstd = rsqrtf(wave_sum(s2) * (1.f / DM) + EPS);
              GAS unsigned long long* o8 = (GAS unsigned long long*)(XN + (size_t)(m0 + u * NGW) * DM) + lane;
#pragma unroll
              for (int j = 0; j < 4; ++j) { const f32x4 w = v[u][j] * rstd * gv[j]; o8[64 * j] = (unsigned long long)pk2(w.x, w.y) | ((unsigned long long)pk2(w.z, w.w) << 32); } } } }
}

struct AttnOrder {
    int vcu;
    __device__ __forceinline__ bool next(int i, attn_body::AttnUnit& u) const { if (i >= 8) return false; const int s = vcu & 7; u.bh = (vcu >> 5) * 16 + ((vcu >> 3) & 3) * 4 + (i & 3); u.qb = (i < 4) ? 15 - s : s; return true; }
    __device__ __forceinline__ void a_ready(const attn_body::AttnUnit&) const {}
    __device__ __forceinline__ void done(const attn_body::AttnUnit&) const {}
};
__device__ __forceinline__ void p2_attention(Frame& F) {
    { const attn_body::AttnTensors AT{(const attn_body::bf16*)(F.ws + WS_QO), (const attn_body::bf16*)(F.ws + WS_K), (const attn_body::bf16*)(F.ws + WS_V), (attn_body::bf16*)(F.ws + WS_QO)};
      const AttnOrder S{F.vcu};
      attn_body::attn_phase<AttnOrder>((char*)F.ldsg, AT, S, F.wave * 64 + lane_id()); }
    VM_WAIT(); __syncthreads(); STAMP(12);
    const int lane = lane_id();
    const float s1 = wave_sum(INP(4)[lane] * INP(5)[lane]), s2 = wave_sum(INP(6)[lane] * INP(7)[lane]);
    const float lam = __expf(s1) - __expf(s2) + 0.2f;
    const float* sg = INP(8); const float g0 = sg[2 * lane] * 0.8f, g1 = sg[2 * lane + 1] * 0.8f;
    const unsigned* O32 = (const unsigned*)(F.ws + WS_QO); unsigned* A2 = (unsigned*)(F.ws + WS_XN);
    const int b = F.vcu >> 5, h = (F.vcu >> 3) & 3, s = F.vcu & 7;
    for (int i = 0; i < 2; ++i) { const int qb = (i == 0) ? 15 - s : s;
        const size_t rbase = (size_t)b * SEQ + (size_t)qb * 256 + F.wave * 32;
        for (int r = 0; r < 32; r += 4) {
            unsigned w0[4], w1[4];
#pragma unroll
            for (int u = 0; u < 4; ++u) { const size_t row = rbase + r + u; w0[u] = __builtin_nontemporal_load(O32 + row * 512 + (h * 4 + 0 + (lane >> 5)) * 32 + (lane & 31)); w1[u] = __builtin_nontemporal_load(O32 + row * 512 + (h * 4 + 2 + (lane >> 5)) * 32 + (lane & 31)); }
#pragma unroll
            for (int u = 0; u < 4; ++u) { const size_t row = rbase + r + u;
                const float d0 = bflo(w0[u]) - lam * bflo(w1[u]), d1 = bfhi(w0[u]) - lam * bfhi(w1[u]);
                const float rstd = rsqrtf(wave_sum(d0 * d0 + d1 * d1) * (1.f / 128.f) + EPS);
                A2[row * 512 + h * 64 + lane] = pk2(d0 * rstd * g0, d1 * rstd * g1); } } }
}
__device__ __forceinline__ void p2_conv(Frame& F) {
    const bf16* Ub = (const bf16*)(F.ws + WS_U); bf16* A2 = (bf16*)(F.ws + WS_XN);
    LAS float* yl = (LAS float*)F.lds;
    const int lane = lane_id(); const int c = F.wave * 64 + lane;
    float w[31];
    { const float* cw = INP(9);
#pragma unroll
      for (int j = 0; j < 31; ++j) w[j] = cw[j * 512 + c]; }
    const float bias = INP(10)[c];
    const float* lng = INP(11); const float* lnb = INP(12);
    const f32x4 lg0 = *(const f32x4*)(lng + 8 * lane), lg1 = *(const f32x4*)(lng + 8 * lane + 4), lb0 = *(const f32x4*)(lnb + 8 * lane), lb1 = *(const f32x4*)(lnb + 8 * lane + 4);
    for (int tile = F.vcu; tile < M / 32; tile += F.G) {
        const int t0 = tile * 32, pos0 = t0 & (SEQ - 1);
        float xin[62];
#pragma unroll
        for (int r = 0; r < 62; ++r) { const int p = pos0 - 30 + r; xin[r] = (p >= 0) ? __uint_as_float((unsigned)Ub[(size_t)(t0 - 30 + r) * 512 + c] << 16) : 0.f; }
#pragma unroll
        for (int t = 0; t < 32; ++t) { float y = bias;
#pragma unroll
            for (int j = 0; j < 31; ++j) y += w[j] * xin[t + j];
            yl[t * 512 + c] = y; }
        __syncthreads();
#pragma unroll
        for (int q = 0; q < 4; ++q) { const int t = F.wave * 4 + q;
            const f32x4 a = *(const LAS f32x4*)(yl + t * 512 + 8 * lane), b2 = *(const LAS f32x4*)(yl + t * 512 + 8 * lane + 4);
            const float mean = wave_sum((a[0] + a[1]) + (a[2] + a[3]) + (b2[0] + b2[1]) + (b2[2] + b2[3])) * (1.f / 512.f);
            const f32x4 da = a - mean, db = b2 - mean;
            const float var = wave_sum((da[0] * da[0] + da[1] * da[1]) + (da[2] * da[2] + da[3] * da[3]) + (db[0] * db[0] + db[1] * db[1]) + (db[2] * db[2] + db[3] * db[3])) * (1.f / 512.f);
            const float rstd = rsqrtf(var + EPS);
            f32x4 oa = da * rstd * lg0 + lb0, ob = db * rstd * lg1 + lb1;
#pragma unroll
            for (int e = 0; e < 4; ++e) { oa[e] = oa[e] * __builtin_amdgcn_rcpf(1.0f + __expf(-oa[e])); ob[e] = ob[e] * __builtin_amdgcn_rcpf(1.0f + __expf(-ob[e])); }
            *(GAS v4u*)(A2 + (size_t)(t0 + t) * 1024 + 512 + 8 * lane) = pk8(oa, ob); }
        __syncthreads();
    }
}
__device__ __forceinline__ int crow16(int r, int hi) { return (r & 3) + 8 * (r >> 2) + 4 * hi; }
__device__ __forceinline__ unsigned enc_key(float f, unsigned tag, unsigned mask) { unsigned u = __float_as_uint(f); u = (u & 0x80000000u) ? ~u : (u | 0x80000000u); return (u & ~mask) | tag; }
__device__ __forceinline__ float dec_key(unsigned k, unsigned mask) { unsigned u = k & ~mask; u = (u & 0x80000000u) ? (u & 0x7fffffffu) : ~u; return __uint_as_float(u); }
__device__ __forceinline__ void ce_desc(unsigned& a, unsigned& b) { const unsigned mx = a > b ? a : b, mn = a > b ? b : a; a = mx; b = mn; }
template <int K, int J> __device__ __forceinline__ void bitonic_stage16(unsigned (&a)[16]) {
#pragma unroll
    for (int i = 0; i < 16; ++i) { const int l = i ^ J; if (l > i) { if ((i & K) == 0) ce_desc(a[i], a[l]); else ce_desc(a[l], a[i]); } }
}
__device__ __forceinline__ void sort16_desc(unsigned (&a)[16]) {
    bitonic_stage16<2, 1>(a); bitonic_stage16<4, 2>(a); bitonic_stage16<4, 1>(a); bitonic_stage16<8, 4>(a); bitonic_stage16<8, 2>(a); bitonic_stage16<8, 1>(a);
    bitonic_stage16<16, 8>(a); bitonic_stage16<16, 4>(a); bitonic_stage16<16, 2>(a); bitonic_stage16<16, 1>(a);
}
__device__ __forceinline__ void merge16_desc(unsigned (&a)[16], const unsigned (&b)[16]) {
#pragma unroll
    for (int i = 0; i < 16; ++i) a[i] = a[i] > b[15 - i] ? a[i] : b[15 - i];
    bitonic_stage16<16, 8>(a); bitonic_stage16<16, 4>(a); bitonic_stage16<16, 2>(a); bitonic_stage16<16, 1>(a);
}
__device__ __forceinline__ void top16_of_64(unsigned (&k)[4][16]) {
    sort16_desc(k[0]); sort16_desc(k[1]); sort16_desc(k[2]); sort16_desc(k[3]);
    merge16_desc(k[0], k[1]); merge16_desc(k[2], k[3]); merge16_desc(k[0], k[2]);
}
__host__ __device__ constexpr int cand_i(int s) { int c = 0; for (int i = 0; i < 16; ++i) { const int nj = 16 / (i + 1); if (s < c + nj) return i; c += nj; } return -1; }
__host__ __device__ constexpr int cand_j(int s) { int c = 0; for (int i = 0; i < 16; ++i) { const int nj = 16 / (i + 1); if (s < c + nj) return s - c; c += nj; } return -1; }
template <int S> __device__ __forceinline__ void cand_fill(unsigned (&c)[4][16], const float (&v0)[16], const float (&v1)[16]) {
    if constexpr (S < 64) { constexpr int i = cand_i(S), j = cand_j(S);
        if constexpr (i >= 0) c[S >> 4][S & 15] = enc_key(v0[i] + v1[j], 255u - (unsigned)(i * 16 + j), 255u); else c[S >> 4][S & 15] = 0u;
        cand_fill<S + 1>(c, v0, v1); }
}
__device__ __forceinline__ float gelu_exact(float v) {
    const float av = __builtin_fabsf(v), d = av * 0.2316418882f + 1.0f, t = __builtin_amdgcn_rcpf(d);
    float q = t * 0.5307027145f + (-0.7265760135f); q = q * t + 0.7107068705f; q = q * t + (-0.142248368f); q = q * t + 0.127414796f; q = q * t;
    const float e = __builtin_amdgcn_exp2f((v * v) * (-0.72134752044f)); const float m = v * (q * e); return v < 0.f ? m : v - m;
}
typedef float f32x2 __attribute__((ext_vector_type(2)));
__device__ __forceinline__ float ub0(unsigned w) { return (float)(w & 0xffu); }
__device__ __forceinline__ float ub1(unsigned w) { return (float)((w >> 8) & 0xffu); }
__device__ __forceinline__ float ub2(unsigned w) { return (float)((w >> 16) & 0xffu); }
__device__ __forceinline__ float ub3(unsigned w) { return (float)(w >> 24); }
__device__ __forceinline__ float wave_max(float v) {
#pragma unroll
    for (int o = 1; o < 64; o <<= 1) v = fmaxf(v, __shfl_xor(v, o));
    return v;
}
__device__ __forceinline__ int reduce8(const int (&p)[8], int lane) {
    const bool b0 = lane & 1, b1 = lane & 2, b2 = lane & 4;
    int q[4], r[2];
#pragma unroll
    for (int i = 0; i < 4; ++i) { const int keep = b0 ? p[2 * i + 1] : p[2 * i], send = b0 ? p[2 * i] : p[2 * i + 1]; q[i] = keep + __builtin_amdgcn_update_dpp(0, send, 0xB1, 0xF, 0xF, true); }
#pragma unroll
    for (int i = 0; i < 2; ++i) { const int keep = b1 ? q[2 * i + 1] : q[2 * i], send = b1 ? q[2 * i] : q[2 * i + 1]; r[i] = keep + __builtin_amdgcn_update_dpp(0, send, 0x4E, 0xF, 0xF, true); }
    int s; { const int keep = b2 ? r[1] : r[0], send = b2 ? r[0] : r[1]; s = keep + __builtin_amdgcn_ds_swizzle(send, 0x101F); }
    s += __builtin_amdgcn_ds_swizzle(s, 0x201F); s += __builtin_amdgcn_ds_swizzle(s, 0x401F);
    { const auto rr = __builtin_amdgcn_permlane32_swap((unsigned)s, (unsigned)s, false, false); s = (int)rr[0] + (int)rr[1]; }
    return s;
}
constexpr int P5_TOK = 32;
constexpr int P5_KEYS = 0, P5_LS = 65536, P5_EID = 65536 + 33792, P5_GATE = 65536 + 33792 + 16384;
__device__ __forceinline__ void p5a_topk(Frame& F) {
    const bf16* QP = (const bf16*)(F.ws + WS_QP); const bf16* KEYS = (const bf16*)(F.ws + WS_KEYS);
    LAS unsigned* lsc = (LAS unsigned*)(F.lds + P5_LS) + (F.wave * 32 + (lane_id() & 31)) * 33; LAS unsigned* eidL = (LAS unsigned*)(F.lds + P5_EID); LAS float* gateL = (LAS float*)(F.lds + P5_GATE);
    const int lane = lane_id(), tid = F.wave * 64 + lane, r32 = lane & 31, hi = lane >> 5, h = F.wave;
    const float* gffn = INP(14);
#pragma unroll
    for (int i = 0; i < 8; ++i) { const int q = tid + 512 * i, row = q >> 4, ch = q & 15; *(LAS v4u*)(F.lds + P5_KEYS + row * 256 + ((ch ^ (row & 15)) << 4)) = *(const GAS v4u*)(KEYS + row * 128 + ch * 8); }
    __syncthreads();
    const LAS unsigned char* kl = F.lds + P5_KEYS + r32 * 256;
    for (int tile = F.vcu; tile < M / P5_TOK; tile += F.G) {
        const size_t t0 = (size_t)tile * P5_TOK;
        float sv[2][16];
#pragma unroll
        for (int c = 0; c < 2; ++c) {
            bf16x8 qf[8];
#pragma unroll
            for (int ks = 0; ks < 8; ++ks) qf[ks] = *(const bf16x8*)(QP + (t0 + r32) * QCOLS + h * 256 + c * 128 + ks * 16 + hi * 8);
            unsigned key[4][16];
#pragma unroll
            for (int nb = 0; nb < 4; ++nb) { f32x16 acc = {}; asm volatile("" ::: "memory");
#pragma unroll
                for (int ks = 0; ks < 8; ++ks) { const bf16x8 kf = *(const LAS bf16x8*)(kl + (c * 128 + nb * 32) * 256 + (((ks * 2 + hi) ^ (r32 & 15)) << 4)); acc = __builtin_amdgcn_mfma_f32_32x32x16_bf16(kf, qf[ks], acc, 0, 0, 0); }
#pragma unroll
                for (int r = 0; r < 16; ++r) key[nb][r] = enc_key(acc[r], 127u - (unsigned)(nb * 32 + crow16(r, hi)), 127u); }
            top16_of_64(key);
            unsigned other[16];
#pragma unroll
            for (int i = 0; i < 16; ++i) other[i] = __shfl_xor(key[0][i], 32);
            merge16_desc(key[0], other);
#pragma unroll
            for (int i = 0; i < 16; ++i) { sv[c][i] = dec_key(key[0][i], 127u); if (hi == 0) lsc[c * 16 + i] = key[0][i]; }
        }
        asm volatile("" ::: "memory");
        unsigned cand[4][16];
        cand_fill<0>(cand, sv[0], sv[1]);
        top16_of_64(cand);
        LDS_WAIT();
        { float wv[16]; float wsum = 0.f; const float mx = dec_key(cand[0][0], 255u);
#pragma unroll
          for (int k = 0; k < 16; ++k) { wv[k] = __expf(dec_key(cand[0][k], 255u) - mx); wsum += wv[k]; }
          const float rs = 1.0f / wsum;
#pragma unroll
          for (int k = 0; k < 16; ++k) { const unsigned id = 255u - (cand[0][k] & 255u); const unsigned k0 = lsc[id >> 4], k1 = lsc[16 + (id & 15u)];
              const unsigned e = (127u - (k0 & 127u)) * 128u + (127u - (k1 & 127u));
              if (hi == 0) { eidL[r32 * 128 + h * 16 + k] = e; gateL[r32 * 128 + h * 16 + k] = wv[k] * rs; } } }
        __syncthreads();
        { const int token = tid >> 4, seg = tid & 15; const LAS unsigned* es = eidL + token * 128 + seg * 8; const LAS float* gs = gateL + token * 128 + seg * 8;
          v4u w; w.x = es[0] | (es[1] << 16); w.y = es[2] | (es[3] << 16); w.z = es[4] | (es[5] << 16); w.w = es[6] | (es[7] << 16);
          *(GAS v4u*)(F.ws + WS_EID + (t0 + token) * 256 + seg * 16) = w;
          *(GAS f32x4*)(F.ws + WS_GATE + (t0 + token) * 512 + seg * 32) = *(const LAS f32x4*)gs; *(GAS f32x4*)(F.ws + WS_GATE + (t0 + token) * 512 + seg * 32 + 16) = *(const LAS f32x4*)(gs + 4); }
        { f32x4 hv[4][4];
#pragma unroll
          for (int j = 0; j < 4; ++j) { const bf16* hrow = (const bf16*)F.out + (t0 + F.wave * 4 + j) * DM + 16 * lane;
              const v4u w0 = *(const GAS v4u*)hrow, w1 = *(const GAS v4u*)(hrow + 8);
              hv[j][0] = (f32x4){bflo(w0.x), bfhi(w0.x), bflo(w0.y), bfhi(w0.y)}; hv[j][1] = (f32x4){bflo(w0.z), bfhi(w0.z), bflo(w0.w), bfhi(w0.w)};
              hv[j][2] = (f32x4){bflo(w1.x), bfhi(w1.x), bflo(w1.y), bfhi(w1.y)}; hv[j][3] = (f32x4){bflo(w1.z), bfhi(w1.z), bflo(w1.w), bfhi(w1.w)}; }
          f32x4 gv[4];
#pragma unroll
          for (int i = 0; i < 4; ++i) gv[i] = *(const f32x4*)(gffn + 16 * lane + 4 * i);
#pragma unroll
          for (int j = 0; j < 4; ++j) { const size_t tok = t0 + F.wave * 4 + j;
            const float rstd1 = rsqrtf(wave_sum(dot4s_(hv[j][0]) + dot4s_(hv[j][1]) + dot4s_(hv[j][2]) + dot4s_(hv[j][3])) * (1.f / DM) + EPS);
            f32x4 mv[4]; float amax = 0.f;
#pragma unroll
            for (int i = 0; i < 4; ++i) { mv[i] = hv[j][i] * rstd1 * gv[i];
                amax = fmaxf(amax, fmaxf(fmaxf(__builtin_fabsf(mv[i][0]), __builtin_fabsf(mv[i][1])), fmaxf(__builtin_fabsf(mv[i][2]), __builtin_fabsf(mv[i][3])))); }
            amax = wave_max(amax); const float inv = 127.f / fmaxf(amax, 1e-30f); v4u qm;
#pragma unroll
            for (int i = 0; i < 4; ++i) { const int a = (int)__builtin_rintf(mv[i][0] * inv), b = (int)__builtin_rintf(mv[i][1] * inv), c = (int)__builtin_rintf(mv[i][2] * inv), d = (int)__builtin_rintf(mv[i][3] * inv);
                qm[i] = (unsigned)(a & 0xff) | ((unsigned)(b & 0xff) << 8) | ((unsigned)(c & 0xff) << 16) | ((unsigned)d << 24); }
            *(GAS v4u*)(F.ws + WS_QM + ((size_t)(lane >> 3) * M + tok) * 128 + 16 * (lane & 7)) = qm;
            if (lane == 0) ((float*)(F.ws + WS_SM))[tok] = amax * (1.f / 127.f);
          } }
        __syncthreads();
    }
}
__device__ __forceinline__ int xl1(int v) { return __builtin_amdgcn_update_dpp(0, v, 0xB1, 0xF, 0xF, true); }
__device__ __forceinline__ int xl2(int v) { return __builtin_amdgcn_update_dpp(0, v, 0x4E, 0xF, 0xF, true); }
__device__ __forceinline__ int xl4(int v) { return __builtin_amdgcn_ds_swizzle(v, 0x101F); }
__device__ __forceinline__ int xl8(int v) { return __builtin_amdgcn_ds_swizzle(v, 0x201F); }
__device__ __forceinline__ int xl16(int v) { return __builtin_amdgcn_ds_swizzle(v, 0x401F); }
__device__ __forceinline__ int xl32(int v, bool hi) { const auto rr = __builtin_amdgcn_permlane32_swap((unsigned)v, (unsigned)v, false, false); return (int)(hi ? rr[0] : rr[1]); }
__device__ __forceinline__ float fxl8(float v) { return __int_as_float(xl8(__float_as_int(v))); }
__device__ __forceinline__ float fxl16(float v) { return __int_as_float(xl16(__float_as_int(v))); }
__device__ __forceinline__ float fxl32(float v, bool hi) { return __int_as_float(xl32(__float_as_int(v), hi)); }
#define TSTEP(dst, src, n, c, XF) _Pragma("unroll") for (int ni_ = 0; ni_ < (n) / 2; ++ni_) { const int i_ = (ni_ & 1) | ((ni_ >> 1) << 2); const auto lo_ = src[i_], hi_ = src[i_ + 2]; dst[ni_] = ((c) ? hi_ : lo_) + XF((c) ? lo_ : hi_); }

#define ASM_LD16(dst, ptr) asm volatile("global_load_dwordx4 %0, %1, off" : "+v"(dst) : "v"(ptr) : "memory")
#define ASM_LD8(dst, ptr) asm volatile("global_load_dwordx2 %0, %1, off" : "+v"(dst) : "v"(ptr) : "memory")
#define ASM_LD4(dst, ptr) asm volatile("global_load_dword %0, %1, off" : "+v"(dst) : "v"(ptr) : "memory")
#define ASM_WAIT4(N, a, b, c, d) asm volatile("s_waitcnt vmcnt(" #N ")" : "+v"(a), "+v"(b), "+v"(c), "+v"(d) :: "memory")
#define ASM_WAIT5(N, a, b, c, d, e) asm volatile("s_waitcnt vmcnt(" #N ")" : "+v"(a), "+v"(b), "+v"(c), "+v"(d), "+v"(e) :: "memory")
__device__ __forceinline__ void p5b_udot(Frame& F) {
    const int lane = lane_id(), g = lane >> 3, s = lane & 7;
    const int x = blockIdx.x & 7, rk = blockIdx.x >> 3, nrk = F.G >> 3;
    const unsigned char* UTs = F.ws + WS_UT + (size_t)x * NEXP * 128 + 16 * s; const unsigned char* QMs = F.ws + WS_QM + (size_t)x * M * 128 + 16 * s; const unsigned char* EIDs = F.ws + WS_EID + 32 * g;
    int* AP = (int*)(F.ws + WS_APART) + (size_t)x * M * 128 + 2 * lane;
    const bool c0 = s & 1, c1 = s & 2, c2 = s & 4;
    const int nT = M / nrk; LAS unsigned* qctr = (LAS unsigned*)(F.lds + MISC_OFF) + 62;
#define P5_PULL(jv, tv) do { unsigned j_ = 0; if (lane == 0) j_ = __hip_atomic_fetch_add(qctr, 1u, __ATOMIC_RELAXED, __HIP_MEMORY_SCOPE_WORKGROUP); jv = (int)__builtin_amdgcn_readfirstlane(j_); tv = rk + nrk * (jv < nT ? jv : nT - 1); } while (0)
#define P5B_E(i, E0, E1) ((((i) & 1) ? (((i) < 8 ? E0[(i) >> 1] : E1[((i) - 8) >> 1]) >> 16) : (((i) < 8 ? E0[(i) >> 1] : E1[((i) - 8) >> 1]) & 0xffffu)))
#define P5B_LDMETA(E0, E1, Q, tq_, te_) do { ASM_LD16(E0, EIDs + (size_t)(te_) * 256); ASM_LD16(E1, EIDs + (size_t)(te_) * 256 + 16); ASM_LD16(Q, QMs + (size_t)(tq_) * 128); } while (0)
#define P5B_ITER(RR, E0, E1, Q, tcur, tq, te) do { int p_[16]; \
        asm volatile("s_waitcnt vmcnt(19)" : "+v"(E0), "+v"(E1), "+v"(Q) :: "memory"); \
        _Pragma("unroll") for (int b = 0; b < 4; ++b) { \
            ASM_WAIT4(34, RR[4 * b], RR[4 * b + 1], RR[4 * b + 2], RR[4 * b + 3]); __builtin_amdgcn_sched_barrier(0); \
            _Pragma("unroll") for (int j = 0; j < 4; ++j) { const int i = 4 * b + j; p_[i] = __builtin_amdgcn_sdot4((int)RR[i].x, (int)Q.x, __builtin_amdgcn_sdot4((int)RR[i].y, (int)Q.y, __builtin_amdgcn_sdot4((int)RR[i].z, (int)Q.z, __builtin_amdgcn_sdot4((int)RR[i].w, (int)Q.w, 0, false), false), false), false); } \
            __builtin_amdgcn_sched_barrier(0); \
            _Pragma("unroll") for (int j = 0; j < 4; ++j) { const int i = 4 * b + j; ASM_LD16(RR[i], UTs + (size_t)P5B_E(i, E0, E1) * 128); } \
            __builtin_amdgcn_sched_barrier(0); } \
        int a8_[8], a4_[4], a2_[2]; TSTEP(a8_, p_, 16, c0, xl1) TSTEP(a4_, a8_, 8, c1, xl2) TSTEP(a2_, a4_, 4, c2, xl4) \
        *(GAS unsigned long long*)(AP + (size_t)(tcur) * 128) = (unsigned long long)(unsigned)a2_[0] | ((unsigned long long)(unsigned)a2_[1] << 32); \
        __builtin_amdgcn_sched_barrier(0); P5B_LDMETA(E0, E1, Q, tq, te); __builtin_amdgcn_sched_barrier(0); } while (0)
    int j0, j1, j2, j3, j4, j5, p0, p1, p2, p3, p4, p5;
    P5_PULL(j0, p0); P5_PULL(j1, p1); P5_PULL(j2, p2); P5_PULL(j3, p3);
    v4u RA[16], RB[16], eA0, eA1, qA, eB0, eB1, qB;
    { const v4u e0 = *(const GAS v4u*)(EIDs + (size_t)p0 * 256), e1 = *(const GAS v4u*)(EIDs + (size_t)p0 * 256 + 16), f0 = *(const GAS v4u*)(EIDs + (size_t)p1 * 256), f1 = *(const GAS v4u*)(EIDs + (size_t)p1 * 256 + 16);
      eA0 = e0; eA1 = e1; qA = e0; eB0 = e0; eB1 = e1; qB = e0;
#pragma unroll
      for (int i = 0; i < 16; ++i) { RA[i] = e0; RB[i] = e0; }
      asm volatile("s_waitcnt vmcnt(0)" ::: "memory");
#pragma unroll
      for (int i = 0; i < 16; ++i) ASM_LD16(RA[i], UTs + (size_t)P5B_E(i, e0, e1) * 128);
#pragma unroll
      for (int i = 0; i < 16; ++i) ASM_LD16(RB[i], UTs + (size_t)P5B_E(i, f0, f1) * 128); }
    P5B_LDMETA(eA0, eA1, qA, p0, p2); P5B_LDMETA(eB0, eB1, qB, p1, p3);
    asm volatile("s_waitcnt vmcnt(0)" ::: "memory");
#pragma unroll 1
    while (j0 < nT) {
        P5_PULL(j4, p4); P5B_ITER(RA, eA0, eA1, qA, p0, p2, p4);
        P5_PULL(j5, p5); P5B_ITER(RB, eB0, eB1, qB, p1, p3, p5);
        j0 = j2; j1 = j3; j2 = j4; j3 = j5; p0 = p2; p1 = p3; p2 = p4; p3 = p5;
    }
    asm volatile("s_waitcnt vmcnt(0)" ::: "memory");
#undef P5B_E
#undef P5B_LDMETA
#undef P5B_ITER
}
__device__ __forceinline__ void p5b2_gelu(Frame& F) {
    const int lane = lane_id(); const int gw = F.vcu * NWAVES + F.wave, NGW = F.G * NWAVES;
    const float* SU = (const float*)(F.ws + WS_SU); const float* SV = (const float*)(F.ws + WS_SV); const float* SM = (const float*)(F.ws + WS_SM);
    for (int t = gw; t < M; t += NGW) {
        int a0 = 0, a1 = 0;
#pragma unroll
        for (int xx = 0; xx < 8; ++xx) { const unsigned long long w = *(const GAS unsigned long long*)((const int*)(F.ws + WS_APART) + (size_t)xx * M * 128 + (size_t)t * 128 + 2 * lane); a0 += (int)(unsigned)w; a1 += (int)(unsigned)(w >> 32); }
        const unsigned ew = *(const GAS unsigned*)(F.ws + WS_EID + (size_t)t * 256 + 4 * lane); const unsigned e0 = ew & 0xffffu, e1 = ew >> 16;
        const f32x2 gt = *(const GAS f32x2*)(F.ws + WS_GATE + (size_t)t * 512 + 8 * lane); const float sm = SM[t];
        const float h0 = gelu_exact((float)a0 * sm * SU[e0]) * gt[0] * SV[e0], h1 = gelu_exact((float)a1 * sm * SU[e1]) * gt[1] * SV[e1];
        const float hmax = wave_max(fmaxf(__builtin_fabsf(h0), __builtin_fabsf(h1))); const float inv = 127.f / fmaxf(hmax, 1e-30f);
        const int q0 = (int)__builtin_rintf(h0 * inv), q1 = (int)__builtin_rintf(h1 * inv);
        *(GAS unsigned short*)(F.ws + WS_HQ + (size_t)t * 128 + 2 * lane) = (unsigned short)((q0 & 0xff) | ((q1 & 0xff) << 8));
        if (lane == 0) ((float*)(F.ws + WS_HS))[t] = hmax * (1.f / 127.f);
    }
}
__device__ __forceinline__ void p5c_vacc(Frame& F) {
    const int lane = lane_id(), g = lane >> 3, s = lane & 7;
    const int x = blockIdx.x & 7, rk = blockIdx.x >> 3, nrk = F.G >> 3;
    const unsigned char* VTs = F.ws + WS_VT + (size_t)x * NEXP * 128 + 16 * s; const unsigned char* EIDs = F.ws + WS_EID + 32 * g; const unsigned char* HQs = F.ws + WS_HQ + 16 * g;
    const float* SH = (const float*)(F.ws + WS_HS); float* ssq2 = (float*)(F.ws + WS_SSQ2); unsigned* H2B = (unsigned*)(F.ws + WS_XN2);
    const int dcol = 128 * x + 16 * s + 2 * g;
    const bool c3 = g & 1, c4 = g & 2, c5 = g & 4; const bool hi32 = lane >= 32;
    const int nT = M / nrk; LAS unsigned* qctr = (LAS unsigned*)(F.lds + MISC_OFF) + 63;
#define P5C_E(i, E0, E1) ((((i) & 1) ? (((i) < 8 ? E0[(i) >> 1] : E1[((i) - 8) >> 1]) >> 16) : (((i) < 8 ? E0[(i) >> 1] : E1[((i) - 8) >> 1]) & 0xffffu)))
#define P5C_LDMETA(E0, E1, HB, H1, SHv, tq_, te_) do { ASM_LD16(E0, EIDs + (size_t)(te_) * 256); ASM_LD16(E1, EIDs + (size_t)(te_) * 256 + 16); \
        ASM_LD16(HB, HQs + (size_t)(tq_) * 128); ASM_LD4(H1, (const unsigned*)F.out + (((size_t)(tq_) * DM + dcol) >> 1)); ASM_LD4(SHv, SH + (tq_)); } while (0)
#define IX32(v) xl32(v, hi32)
#define P5C_ITER(RR, E0, E1, HB, H1, SHv, tcur, vcur, tq, te) do { int yi_[16]; _Pragma("unroll") for (int i = 0; i < 16; ++i) yi_[i] = 0; \
        asm volatile("s_waitcnt vmcnt(21)" : "+v"(E0), "+v"(E1), "+v"(HB), "+v"(H1), "+v"(SHv) :: "memory"); \
        _Pragma("unroll") for (int b = 0; b < 4; ++b) { const int hb_ = (int)HB[b]; \
            ASM_WAIT4(38, RR[4 * b], RR[4 * b + 1], RR[4 * b + 2], RR[4 * b + 3]); __builtin_amdgcn_sched_barrier(0); \
            _Pragma("unroll") for (int c = 0; c < 4; ++c) { \
                const unsigned ra_ = RR[4 * b][c], rb_ = RR[4 * b + 1][c], rc_ = RR[4 * b + 2][c], rd_ = RR[4 * b + 3][c]; \
                const unsigned p_ = __builtin_amdgcn_perm(rb_, ra_, 0x05010400u), q_ = __builtin_amdgcn_perm(rb_, ra_, 0x07030602u), r_ = __builtin_amdgcn_perm(rd_, rc_, 0x05010400u), s_ = __builtin_amdgcn_perm(rd_, rc_, 0x07030602u); \
                yi_[4 * c + 0] = __builtin_amdgcn_sdot4((int)__builtin_amdgcn_perm(r_, p_, 0x05040100u), hb_, yi_[4 * c + 0], false); yi_[4 * c + 1] = __builtin_amdgcn_sdot4((int)__builtin_amdgcn_perm(r_, p_, 0x07060302u), hb_, yi_[4 * c + 1], false); \
                yi_[4 * c + 2] = __builtin_amdgcn_sdot4((int)__builtin_amdgcn_perm(s_, q_, 0x05040100u), hb_, yi_[4 * c + 2], false); yi_[4 * c + 3] = __builtin_amdgcn_sdot4((int)__builtin_amdgcn_perm(s_, q_, 0x07060302u), hb_, yi_[4 * c + 3], false); } \
            __builtin_amdgcn_sched_barrier(0); \
            _Pragma("unroll") for (int j = 0; j < 4; ++j) { const int i = 4 * b + j; ASM_LD16(RR[i], VTs + (size_t)P5C_E(i, E0, E1) * 128); } \
            __builtin_amdgcn_sched_barrier(0); } \
        int y8_[8], y4_[4], y2_[2]; TSTEP(y8_, yi_, 16, c3, xl8) TSTEP(y4_, y8_, 8, c4, xl16) TSTEP(y2_, y4_, 4, c5, IX32) \
        const f32x2 n_ = {bflo(H1) + SHv * (float)y2_[0], bfhi(H1) + SHv * (float)y2_[1]}; \
        const float ss_ = wave_sum(n_[0] * n_[0] + n_[1] * n_[1]); \
        if (vcur) { H2B[((size_t)(tcur) * DM + dcol) >> 1] = pk2(n_[0], n_[1]); if (lane == 0) ssq2[(size_t)(tcur) * 8 + x] = ss_; } \
        __builtin_amdgcn_sched_barrier(0); P5C_LDMETA(E0, E1, HB, H1, SHv, tq, te); __builtin_amdgcn_sched_barrier(0); } while (0)
    int j0, j1, j2, j3, j4, j5, p0, p1, p2, p3, p4, p5;
    P5_PULL(j0, p0); P5_PULL(j1, p1); P5_PULL(j2, p2); P5_PULL(j3, p3);
    v4u RA[16], RB[16], eA0, eA1, hbA, eB0, eB1, hbB; unsigned h1A = 0u, h1B = 0u; float shA = 0.f, shB = 0.f;
    { const v4u e0 = *(const GAS v4u*)(EIDs + (size_t)p0 * 256), e1 = *(const GAS v4u*)(EIDs + (size_t)p0 * 256 + 16), f0 = *(const GAS v4u*)(EIDs + (size_t)p1 * 256), f1 = *(const GAS v4u*)(EIDs + (size_t)p1 * 256 + 16);
      eA0 = e0; eA1 = e1; hbA = e0; eB0 = e0; eB1 = e1; hbB = e0;
#pragma unroll
      for (int i = 0; i < 16; ++i) { RA[i] = e0; RB[i] = e0; }
      asm volatile("s_waitcnt vmcnt(0)" ::: "memory");
#pragma unroll
      for (int i = 0; i < 16; ++i) ASM_LD16(RA[i], VTs + (size_t)P5C_E(i, e0, e1) * 128);
#pragma unroll
      for (int i = 0; i < 16; ++i) ASM_LD16(RB[i], VTs + (size_t)P5C_E(i, f0, f1) * 128); }
    P5C_LDMETA(eA0, eA1, hbA, h1A, shA, p0, p2); P5C_LDMETA(eB0, eB1, hbB, h1B, shB, p1, p3);
    asm volatile("s_waitcnt vmcnt(0)" ::: "memory");
#pragma unroll 1
    while (j0 < nT) {
        P5_PULL(j4, p4); P5C_ITER(RA, eA0, eA1, hbA, h1A, shA, p0, true, p2, p4);
        P5_PULL(j5, p5); P5C_ITER(RB, eB0, eB1, hbB, h1B, shB, p1, (j1 < nT), p3, p5);
        j0 = j2; j1 = j3; j2 = j4; j3 = j5; p0 = p2; p1 = p3; p2 = p4; p3 = p5;
    }
    asm volatile("s_waitcnt vmcnt(0)" ::: "memory");
#undef P5C_E
#undef P5C_LDMETA
#undef P5C_ITER
#undef IX32
}
__device__ __forceinline__ void p7_final(Frame& F) {
    const int lane = lane_id(); const int gw = F.vcu * NWAVES + F.wave, NGW = F.G * NWAVES; const float* g = INP(22);
    const bf16* H3B = (const bf16*)(F.ws + WS_E);
    f32x4 gq[4];
#pragma unroll
    for (int j = 0; j < 2; ++j) { gq[2 * j] = *(const GAS f32x4*)(g + 512 * j + 8 * lane); gq[2 * j + 1] = *(const GAS f32x4*)(g + 512 * j + 8 * lane + 4); }
    for (int m0 = gw; m0 < M; m0 += 4 * NGW) {
        v4u w[4][2];
#pragma unroll
        for (int u = 0; u < 4; ++u) { const bf16* hr = H3B + (size_t)(m0 + u * NGW) * DM + 8 * lane; w[u][0] = *(const GAS v4u*)hr; w[u][1] = *(const GAS v4u*)(hr + 512); }
#pragma unroll
        for (int u = 0; u < 4; ++u) { f32x4 v[4]; float s2 = 0.f;
#pragma unroll
            for (int j = 0; j < 2; ++j) { v[2 * j] = (f32x4){bflo(w[u][j].x), bfhi(w[u][j].x), bflo(w[u][j].y), bfhi(w[u][j].y)}; v[2 * j + 1] = (f32x4){bflo(w[u][j].z), bfhi(w[u][j].z), bflo(w[u][j].w), bfhi(w[u][j].w)}; }
#pragma unroll
            for (int j = 0; j < 4; ++j) s2 += dot4s_(v[j]);
            const float rstd = rsqrtf(wave_sum(s2) * (1.f / DM) + EPS); float* orow = F.out + (size_t)(m0 + u * NGW) * DM + 8 * lane;
#pragma unroll
            for (int j = 0; j < 2; ++j) { *(GAS f32x4*)(orow + 512 * j) = v[2 * j] * rstd * gq[2 * j]; *(GAS f32x4*)(orow + 512 * j + 4) = v[2 * j + 1] * rstd * gq[2 * j + 1]; } } }
}
struct Args { const float* in[23]; float* out; unsigned char* ws; int ph_lo, ph_hi; };
__global__ void __launch_bounds__(NWAVES * 64, 2) hymba_fwd(Args args) {
    extern __shared__ __attribute__((aligned(16))) unsigned char lds[];
    cg::grid_group grid = cg::this_grid();
    Frame F;
    F.lds = (LAS unsigned char*)lds; F.ldsg = lds;
    F.wave = __builtin_amdgcn_readfirstlane(threadIdx.x >> 6);
    F.G = gridDim.x; { const int bx = blockIdx.x; F.vcu = (F.G % 8 == 0) ? (bx % 8) * (F.G / 8) + bx / 8 : bx; }
    F.out = args.out; F.ws = args.ws;
    const int lo = args.ph_lo, hi = args.ph_hi;
#ifdef ONLY_PH
#define IN(k) ((k) == ONLY_PH)
#else
#define IN(k) (lo <= (k) && (k) < hi)
#endif
#define BOTH(k) (IN(k) && IN((k) + 1))
    { const int l0 = lane_id(); if (F.wave == 0) ((volatile LAS unsigned*)(F.lds + MISC_OFF))[l0] = 0u; }
    __syncthreads();
    const XcdBarrier bar = xcd_barrier_post((unsigned*)(F.ws + WS_CTL) + CW_BAR, (volatile LAS unsigned*)(F.lds + MISC_OFF) + 8, F.wave == 0 && lane_id() == 0);
    if (hi > N_PHASES) grid.sync();
#if defined(PROBE_BARSUM)
#define GRID_BAR(k) do { STAMP(20); xcd_barrier(bar, F.wave == 0 && lane_id() == 0); STAMP((k) + 1); \
    if (F.wave == 0 && ((PROBE_BARSUM >> (k)) & 1)) { volatile LAS unsigned* ms_ = (volatile LAS unsigned*)(F.lds + MISC_OFF) + 16; ms_[2 * 21] += ms_[2 * ((k) + 1)] - ms_[2 * 20]; } } while (0)
#else
#define GRID_BAR(k) do { xcd_barrier(bar, F.wave == 0 && lane_id() == 0); STAMP((k) + 1); } while (0)
#endif
    STAMP(0);
    if (IN(0)) { p0_prologue(F); if (BOTH(0)) GRID_BAR(0); }
    if (IN(1)) {
        { pg8::Gemm g{(const pg8::bf16_t*)(F.ws + WS_XN), (const pg8::bf16_t*)(F.ws + WS_WIN), M, IN_COLS, DM}; pg8::StaticOrder S; S.init(M, IN_COLS, F.G, (int)blockIdx.x);
          pg8::EpiIn E{(pg8::bf16_t*)(F.ws + WS_QO), (pg8::bf16_t*)(F.ws + WS_K), (pg8::bf16_t*)(F.ws + WS_V), (pg8::bf16_t*)(F.ws + WS_U), (const float*)(F.ws + WS_ROPEC), (const float*)(F.ws + WS_ROPES), attn_body::C2};
          pg8::gemm_phase<pg8::EpiIn, pg8::StaticOrder, true, true>(F.lds, g, S, E, F.wave); }
        { pg8::Gemm g{(const pg8::bf16_t*)(F.ws + WS_PB), (const pg8::bf16_t*)(F.ws + WS_WPROJ), M, DM, PLE_DIM}; pg8::StaticOrder S; S.init(M, DM, F.G, (int)blockIdx.x);
          pg8::EpiBf16<0> E{(pg8::bf16_t*)(F.ws + WS_E), DM, nullptr, 0, 0, 1.f};
          pg8::gemm_phase<pg8::EpiBf16<0>, pg8::StaticOrder, true, true>(F.lds, g, S, E, F.wave); }
        if (BOTH(1)) GRID_BAR(1);
    }
    if (IN(2)) { p2_attention(F); STAMP(13); p2_conv(F); STAMP(14); if (BOTH(2)) GRID_BAR(2); }
    if (IN(3)) {
        pg8::Gemm g{(const pg8::bf16_t*)(F.ws + WS_XN), (const pg8::bf16_t*)(F.ws + WS_WOUT), M, DM, DM}; pg8::StaticOrder S; S.init(M, DM, F.G, (int)blockIdx.x);
        pg8::EpiOut E{INP(0), (pg8::bf16_t*)F.out  , (float*)(F.ws + WS_SSQ1)};
        pg8::gemm_phase<pg8::EpiOut, pg8::StaticOrder, true, true>(F.lds, g, S, E, F.wave);
        if (BOTH(3)) GRID_BAR(3);
    }
    if (IN(4)) {
        pg8::Gemm g{(const pg8::bf16_t*)F.out, (const pg8::bf16_t*)(F.ws + WS_WQ), M, QCOLS, DM}; pg8::StaticOrder S; S.init(M, QCOLS, F.G, (int)blockIdx.x);
        pg8::EpiQ E{(const float*)(F.ws + WS_SSQ1), (pg8::bf16_t*)(F.ws + WS_QP), EPS};
        pg8::gemm_phase<pg8::EpiQ, pg8::StaticOrder, true, true>(F.lds, g, S, E, F.wave);
        if (BOTH(4)) GRID_BAR(4);
    }
    if (IN(5)) { p5a_topk(F); if (BOTH(5)) GRID_BAR(5); }
    if (IN(6)) { p5b_udot(F); if (BOTH(6)) GRID_BAR(6); }
    if (IN(7)) { p5b2_gelu(F); if (BOTH(7)) GRID_BAR(7); }
    if (IN(8)) { p5c_vacc(F); if (BOTH(8)) GRID_BAR(8); }
    if (IN(9)) {
        pg8::Gemm g{(const pg8::bf16_t*)(F.ws + WS_XN2), (const pg8::bf16_t*)(F.ws + WS_WGATE), M, DM, DM}; pg8::StaticOrder S; S.init(M, DM, F.G, (int)blockIdx.x);
        pg8::EpiGate E{(pg8::bf16_t*)(F.ws + WS_E), (const pg8::bf16_t*)(F.ws + WS_XN2), (const pg8::bf16_t*)(F.ws + WS_E), (const float*)(F.ws + WS_SSQ2), EPS};
        pg8::gemm_phase<pg8::EpiGate, pg8::StaticOrder, true, true>(F.lds, g, S, E, F.wave);
        if (BOTH(9)) GRID_BAR(9);
    }
    if (IN(10)) p7_final(F);
#if defined(MBENCH)
    { xcd_barrier(bar, F.wave == 0 && lane_id() == 0); STAMP(15);
      unsigned r[32]; const unsigned l0 = (unsigned)lane_id();
#pragma unroll
      for (int i = 0; i < 32; ++i) r[i] = l0 * 2654435761u + i;
      float* rf = (float*)r;
#pragma unroll 1
      for (int it = 0; it < 1024; ++it) {
#pragma unroll
          for (int i = 0; i < 32; ++i) {
#if MBENCH == 1
              asm volatile("v_dot4c_i32_i8 %0, %1, %2" : "+v"(r[i]) : "v"(r[(i + 1) & 31]), "v"(r[(i + 2) & 31]));
#elif MBENCH == 2
              asm volatile("v_perm_b32 %0, %1, %2, %3" : "=v"(r[i]) : "v"(r[(i + 1) & 31]), "v"(r[(i + 2) & 31]), "v"(r[(i + 3) & 31]));
#elif MBENCH == 3
              asm volatile("v_fma_f32 %0, %1, %2, %0" : "+v"(r[i]) : "v"(r[(i + 1) & 31]), "v"(r[(i + 2) & 31]));
#elif MBENCH == 4
              asm volatile("v_cvt_f32_ubyte1 %0, %1" : "=v"(r[i]) : "v"(r[(i + 1) & 31]));
#elif MBENCH == 5
              asm volatile("v_pk_fma_f32 %0, %1, %2, %0" : "+v"(*(unsigned long long*)&r[2 * (i & 15)]) : "v"(*(unsigned long long*)&r[2 * ((i + 1) & 15)]), "v"(*(unsigned long long*)&r[2 * ((i + 2) & 15)]));
#elif MBENCH == 6
              asm volatile("v_add_u32 %0, %1, %2" : "=v"(r[i]) : "v"(r[(i + 1) & 31]), "v"(r[(i + 2) & 31]));
#elif MBENCH == 7
              asm volatile("v_mad_i32_i24 %0, %1, %2, %0" : "+v"(r[i]) : "v"(r[(i + 1) & 31]), "v"(r[(i + 2) & 31]));
#endif
          } }
      unsigned acc = 0;
#pragma unroll
      for (int i = 0; i < 32; ++i) acc ^= r[i];
      if (acc == 0x12345678u) ((unsigned*)(F.ws + WS_CTL))[2000 + l0] = acc;
      STAMP(16); }
#endif
#if defined(PROBE_A)
    STAMP(11);
#if !defined(PROBE_BLK)
#define PROBE_BLK 0
#endif
    if (blockIdx.x == PROBE_BLK && F.wave == 0) { volatile LAS unsigned* ms_ = (volatile LAS unsigned*)(F.lds + MISC_OFF) + 16;
        const unsigned long long ta = ((unsigned long long)ms_[2 * PROBE_A + 1] << 32) | ms_[2 * PROBE_A], tb = ((unsigned long long)ms_[2 * PROBE_B + 1] << 32) | ms_[2 * PROBE_B];
#if defined(PROBE_BARSUM)
        const unsigned long long span_ = ms_[2 * 21];
#else
        const unsigned long long span_ = tb - ta;
#endif
        const unsigned long long t0_ = __builtin_amdgcn_s_memrealtime(); while (__builtin_amdgcn_s_memrealtime() - t0_ < span_) __builtin_amdgcn_s_sleep(8); }
#endif
#undef IN
#undef BOTH
}

extern "C" void kernel_launch(void* const* d_in, const int* in_sizes, int n_in, void* d_out, int out_size, void* d_ws, size_t ws_size, hipStream_t stream) {
    static int grid = 0;
    if (grid == 0) {
        if (n_in != 23 || in_sizes[0] != M * DM || out_size != M * DM || ws_size < WS_END) { fprintf(stderr, "kernel_launch: unexpected shapes (n_in %d, in0 %d, out %d, ws %zu); nothing launched\n", n_in, n_in > 0 ? in_sizes[0] : -1, out_size, ws_size); grid = -1; return; }
        int dev = 0, cus = 0, per_cu = 0;
        if (hipGetDevice(&dev) != hipSuccess || hipDeviceGetAttribute(&cus, hipDeviceAttributeMultiprocessorCount, dev) != hipSuccess) { fprintf(stderr, "kernel_launch: device query failed\n"); grid = -1; return; }
        if (hipFuncSetAttribute((const void*)hymba_fwd, hipFuncAttributeMaxDynamicSharedMemorySize, LDS_BYTES) != hipSuccess) { fprintf(stderr, "kernel_launch: hipFuncSetAttribute failed\n"); grid = -1; return; }
        if (hipOccupancyMaxActiveBlocksPerMultiprocessor(&per_cu, (const void*)hymba_fwd, NWAVES * 64, LDS_BYTES) != hipSuccess || per_cu < 1) { fprintf(stderr, "kernel_launch: occupancy query says %d blocks per CU\n", per_cu); (void)hipGetLastError(); grid = -1; return; }
        grid = cus * per_cu;
        if (grid != 256) { fprintf(stderr, "kernel_launch: this kernel's attention order needs exactly 256 resident workgroups (got %d x %d); nothing launched\n", cus, per_cu); grid = -1; return; }
    }
    if (grid < 0) return;
    if (hipMemsetAsync((char*)d_ws + WS_CTL, 0, CTL_ZERO_BYTES, stream) != hipSuccess) { fprintf(stderr, "kernel_launch: hipMemsetAsync failed\n"); return; }
    Args a{};
    for (int i = 0; i < 23; ++i) a.in[i] = (const float*)d_in[i];
    a.out = (float*)d_out; a.ws = (unsigned char*)d_ws;
#if MK_N_LAUNCHES == 1
    a.ph_lo = 0; a.ph_hi = N_PHASES;
    void* kargs[] = {&a};
    hipError_t e = hipLaunchCooperativeKernel((const void*)hymba_fwd, dim3(grid), dim3(NWAVES * 64), kargs, LDS_BYTES, stream);
    if (e != hipSuccess) fprintf(stderr, "kernel_launch: cooperative launch failed: %s (grid %d)\n", hipGetErrorString(e), grid);
#else
    for (int li = 0; li < N_PHASES; ++li) { a.ph_lo = li; a.ph_hi = li + 1;
        hipLaunchKernelGGL(hymba_fwd, dim3(grid), dim3(NWAVES * 64), LDS_BYTES, stream, a);
        const hipError_t le = hipPeekAtLastError(); if (le != hipSuccess) { fprintf(stderr, "kernel_launch: launch %d failed: %s\n", li, hipGetErrorName(le)); break; } }
#endif
}
```

```cpp
#include <hip/hip_runtime.h>
#include <hip/hip_cooperative_groups.h>
#include <cstdio>
#include <cstdint>
namespace cg = cooperative_groups;
namespace pg8 {
#define PG8_LAS __attribute__((address_space(3)))
typedef unsigned short bf16_t;
typedef short bf16x8 __attribute__((ext_vector_type(8)));
typedef float f32x4 __attribute__((ext_vector_type(4)));
typedef unsigned u32x4 __attribute__((ext_vector_type(4)));
constexpr int BM = 256, BK = 64, HALF = 128, HTB = HALF * BK * 2  , STAGE_BYTES = 8 * HTB, NXCD = 8, WGM = 8;

__host__ __device__ __forceinline__ int lds_byte(int r, int c) { const int st = (r >> 4) * 2 + (c >> 5), rr = r & 15, cc = c & 31, ob = rr * 64 + cc * 2; return st * 1024 + (ob ^ (((ob >> 9) & 1) << 5)); }
__host__ __device__ __forceinline__ void stage_rc(int b, int& R, int& C) { const int st = b / 1024, sb = b % 1024, swz = sb ^ (((sb >> 9) & 1) << 5); R = (st >> 1) * 16 + swz / 64; C = (st & 1) * 32 + (swz % 64) / 2; }
__host__ __device__ __forceinline__ int perm32(int rho) { const int n = rho >> 4, i = rho & 15; return 8 * (i >> 2) + 4 * n + (i & 3); }

struct Unit { int pm, pn; };
struct Gemm { const bf16_t* A; const bf16_t* Bt; int M, N, K; };

struct StaticOrder {
    int nM, nN, nwg, G, c;
    __host__ __device__ void init(int M, int N, int G_, int c_) { nM = M / BM; nN = N / BM; nwg = nM * nN; G = G_; c = c_; }
    __host__ __device__ bool next(int i, Unit& u) const {
        const long L = (long)i * G + c; if (L >= nwg) return false;
        int wgid = (int)L; { const int q = nwg / NXCD, r = nwg % NXCD, xcd = wgid % NXCD, off = wgid / NXCD; wgid = (xcd < r ? xcd * (q + 1) : r * (q + 1) + (xcd - r) * q) + off; }
        const int nig = WGM * nN, gid = wgid / nig, fm = gid * WGM, gsz = (nM - fm) < WGM ? (nM - fm) : WGM;
        u.pm = fm + ((wgid % nig) % gsz); u.pn = (wgid % nig) / gsz; return true;
    }
    __device__ __forceinline__ void a_ready(const Unit&) const {}
    __device__ __forceinline__ void done(const Unit&) const {}
};

__device__ __forceinline__ unsigned cvt_pk_bf16(float lo, float hi) { unsigned r; asm volatile("v_cvt_pk_bf16_f32 %0, %1, %2" : "=v"(r) : "v"(lo), "v"(hi)); return r; }
typedef float f32x2 __attribute__((ext_vector_type(2)));
__device__ __forceinline__ f32x2 gelu_pk(f32x2 v) {
    const f32x2 av = __builtin_elementwise_abs(v), d = av * 0.2316418882f + 1.0f;
    f32x2 t; t.x = __builtin_amdgcn_rcpf(d.x); t.y = __builtin_amdgcn_rcpf(d.y);
    f32x2 q = t * 0.5307027145f + (-0.7265760135f); q = q * t + 0.7107068705f; q = q * t + (-0.142248368f); q = q * t + 0.127414796f; q = q * t;
    const f32x2 s = (v * v) * (-0.72134752044f);
    f32x2 e; e.x = __builtin_amdgcn_exp2f(s.x); e.y = __builtin_amdgcn_exp2f(s.y);
    const f32x2 m = v * (q * e), r = v - m;
    f32x2 o; o.x = v.x < 0.f ? m.x : r.x; o.y = v.y < 0.f ? m.y : r.y; return o;
}

template <int ACT  > struct EpiBf16 {
    static constexpr bool PERM = true, AFTER_DRAIN = false; static_assert(ACT == 0 || ACT == 1, "EpiBf16: ACT is 0 (none) or 1 (gelu_pk)");
    bf16_t* O; int ldc; const float* bias; int split_cols; size_t split_stride; float scale0;
    __device__ __forceinline__ void operator()(const f32x4 (&acc)[2][2][4][2], const Unit& u, int wr, int wc, int fr, int fq) const {
        const int row0 = u.pm * BM + wr * 64 + fr; int colt = u.pn * BM; bf16_t* base = O;
        float sc = 1.f; if (split_cols) { const int t = colt / split_cols; base += (size_t)t * split_stride; colt -= t * split_cols; if (t == 0) sc = scale0; }
        const int col0 = colt + wc * 32 + 8 * fq, bcol0 = u.pn * BM + wc * 32 + 8 * fq;
        f32x4 bv[2][2];
#pragma unroll
        for (int bj = 0; bj < 2; ++bj)
#pragma unroll
            for (int n = 0; n < 2; ++n) bv[bj][n] = bias ? *(const f32x4*)(bias + bcol0 + bj * HALF + 4 * n) : (f32x4){0.f, 0.f, 0.f, 0.f};
#pragma unroll
        for (int ai = 0; ai < 2; ++ai)
#pragma unroll
            for (int m = 0; m < 4; ++m) { bf16_t* rowp = base + (size_t)(row0 + ai * HALF + m * 16) * ldc + col0;
#pragma unroll
                for (int bj = 0; bj < 2; ++bj) { f32x4 v0 = acc[ai][bj][m][0] + bv[bj][0], v1 = acc[ai][bj][m][1] + bv[bj][1];
                    if (ACT == 1) { f32x2 a = gelu_pk((f32x2){v0[0], v0[1]}), b = gelu_pk((f32x2){v0[2], v0[3]}), c = gelu_pk((f32x2){v1[0], v1[1]}), d = gelu_pk((f32x2){v1[2], v1[3]});
                        v0 = (f32x4){a.x, a.y, b.x, b.y}; v1 = (f32x4){c.x, c.y, d.x, d.y}; }
                    v0 = v0 * sc; v1 = v1 * sc; u32x4 w; w.x = cvt_pk_bf16(v0[0], v0[1]); w.y = cvt_pk_bf16(v0[2], v0[3]); w.z = cvt_pk_bf16(v1[0], v1[1]); w.w = cvt_pk_bf16(v1[2], v1[3]);
                    *(u32x4*)(rowp + bj * HALF) = w; } }
    }
};
__device__ __forceinline__ float sigmoid_fast(float x) { return __builtin_amdgcn_rcpf(1.0f + __expf(-x)); }
__device__ __forceinline__ f32x4 sigmoid4(f32x4 x) { f32x4 r; r[0] = sigmoid_fast(x[0]); r[1] = sigmoid_fast(x[1]); r[2] = sigmoid_fast(x[2]); r[3] = sigmoid_fast(x[3]); return r; }
__device__ __forceinline__ u32x4 pack8(const f32x4 a, const f32x4 b) { u32x4 w; w.x = cvt_pk_bf16(a[0], a[1]); w.y = cvt_pk_bf16(a[2], a[3]); w.z = cvt_pk_bf16(b[0], b[1]); w.w = cvt_pk_bf16(b[2], b[3]); return w; }
__device__ __forceinline__ float dot4s(const f32x4 a) { return (a[0] * a[0] + a[1] * a[1]) + (a[2] * a[2] + a[3] * a[3]); }

struct EpiIn {
    static constexpr bool PERM = true, AFTER_DRAIN = false;
    bf16_t *Q, *Kk, *V, *U; const float* ropec; const float* ropes; float qscale;
    __device__ __forceinline__ void operator()(const f32x4 (&acc)[2][2][4][2], const Unit& u, int wr, int wc, int fr, int fq) const {
        const int row0 = u.pm * BM + wr * 64 + fr; const int pn = u.pn;
        if (pn < 4) {
            bf16_t* dst = (pn < 2) ? Q : Kk; const float sc = (pn < 2) ? qscale : 1.0f; const int colb = ((pn & 1) * 4 + wc) * 128 + 8 * fq;
#pragma unroll
            for (int ai = 0; ai < 2; ++ai)
#pragma unroll
                for (int m = 0; m < 4; ++m) { const int row = row0 + ai * HALF + m * 16; const int pos = row & 4095;
                    const f32x4 c0 = *(const f32x4*)(ropec + pos * 32 + 8 * fq), c1 = *(const f32x4*)(ropec + pos * 32 + 8 * fq + 4);
                    const f32x4 s0 = *(const f32x4*)(ropes + pos * 32 + 8 * fq), s1 = *(const f32x4*)(ropes + pos * 32 + 8 * fq + 4);
                    const f32x4 x10 = acc[ai][0][m][0], x11 = acc[ai][0][m][1], x20 = acc[ai][1][m][0], x21 = acc[ai][1][m][1];
                    const f32x4 o10 = (x10 * c0 - x20 * s0) * sc, o11 = (x11 * c1 - x21 * s1) * sc, o20 = (x20 * c0 + x10 * s0) * sc, o21 = (x21 * c1 + x11 * s1) * sc;
                    bf16_t* rp = dst + (size_t)row * 1024 + colb; const u32x4 w1 = pack8(o10, o11), w2 = pack8(o20, o21);
                    *(u32x4*)rp = w1; *(u32x4*)(rp + 32) = w2; *(u32x4*)(rp + 64) = w1; *(u32x4*)(rp + 96) = w2; }
        } else if (pn < 6) {
#pragma unroll
            for (int ai = 0; ai < 2; ++ai)
#pragma unroll
                for (int m = 0; m < 4; ++m) { const int row = row0 + ai * HALF + m * 16;
#pragma unroll
                    for (int bj = 0; bj < 2; ++bj) { const int hh = (pn - 4) * 2 + bj, vh = wc >> 1, d = (wc & 1) * 32 + 8 * fq;
                        const u32x4 w = pack8(acc[ai][bj][m][0], acc[ai][bj][m][1]); bf16_t* rp = V + (size_t)row * 1024 + (hh * 4 + vh) * 64 + d; *(u32x4*)rp = w; *(u32x4*)(rp + 128) = w; } }
        } else {
#pragma unroll
            for (int ai = 0; ai < 2; ++ai)
#pragma unroll
                for (int m = 0; m < 4; ++m) { const int row = row0 + ai * HALF + m * 16;
                    const f32x4 u0 = acc[ai][0][m][0] * sigmoid4(acc[ai][1][m][0]), u1 = acc[ai][0][m][1] * sigmoid4(acc[ai][1][m][1]);
                    *(u32x4*)(U + (size_t)row * 512 + (pn - 6) * 128 + wc * 32 + 8 * fq) = pack8(u0, u1); }
        }
    }
};
struct EpiOut {
    static constexpr bool PERM = true, AFTER_DRAIN = false;
    const float* x; bf16_t* hb; float* ssq;
    __device__ __forceinline__ void operator()(const f32x4 (&acc)[2][2][4][2], const Unit& u, int wr, int wc, int fr, int fq) const {
        const int row0 = u.pm * BM + wr * 64 + fr;
#pragma unroll
        for (int ai = 0; ai < 2; ++ai)
#pragma unroll
            for (int m = 0; m < 4; ++m) { const int row = row0 + ai * HALF + m * 16; float ss = 0.f;
#pragma unroll
                for (int bj = 0; bj < 2; ++bj) { const size_t off = (size_t)row * 1024 + u.pn * BM + bj * HALF + wc * 32 + 8 * fq;
                    const f32x4 h0 = acc[ai][bj][m][0] + *(const f32x4*)(x + off), h1 = acc[ai][bj][m][1] + *(const f32x4*)(x + off + 4);
                    *(u32x4*)(hb + off) = pack8(h0, h1); ss += dot4s(h0) + dot4s(h1); }
                ss += __shfl_xor(ss, 16); ss += __shfl_xor(ss, 32);
                if (fq == 0) ssq[(size_t)row * 16 + u.pn * 4 + wc] = ss; }
    }
};
struct EpiQ {
    static constexpr bool PERM = true, AFTER_DRAIN = false;
    const float* ssq; bf16_t* qp; float eps;
    __device__ __forceinline__ void operator()(const f32x4 (&acc)[2][2][4][2], const Unit& u, int wr, int wc, int fr, int fq) const {
        const int row0 = u.pm * BM + wr * 64 + fr;
#pragma unroll
        for (int ai = 0; ai < 2; ++ai)
#pragma unroll
            for (int m = 0; m < 4; ++m) { const int row = row0 + ai * HALF + m * 16; const f32x4* sp = (const f32x4*)(ssq + (size_t)row * 16);
                const f32x4 a = sp[0], b = sp[1], c = sp[2], d = sp[3]; const f32x4 t = (a + b) + (c + d);
                const float rstd = rsqrtf(((t[0] + t[1]) + (t[2] + t[3])) * (1.0f / 1024.0f) + eps);
#pragma unroll
                for (int bj = 0; bj < 2; ++bj) *(u32x4*)(qp + (size_t)row * 2048 + u.pn * BM + bj * HALF + wc * 32 + 8 * fq) = pack8(acc[ai][bj][m][0] * rstd, acc[ai][bj][m][1] * rstd); }
    }
};
__device__ __forceinline__ f32x4 bf_lo4(unsigned a, unsigned b) { f32x4 r; r[0] = __uint_as_float(a << 16); r[1] = __uint_as_float(a & 0xffff0000u); r[2] = __uint_as_float(b << 16); r[3] = __uint_as_float(b & 0xffff0000u); return r; }
struct EpiGate {
    static constexpr bool PERM = true, AFTER_DRAIN = false;
    bf16_t* h3b; const bf16_t* h2b; const bf16_t* e; const float* ssq; float eps;
    __device__ __forceinline__ void operator()(const f32x4 (&acc)[2][2][4][2], const Unit& u, int wr, int wc, int fr, int fq) const {
        const int row0 = u.pm * BM + wr * 64 + fr;
#pragma unroll
        for (int ai = 0; ai < 2; ++ai)
#pragma unroll
            for (int m = 0; m < 4; ++m) { const int row = row0 + ai * HALF + m * 16; const f32x4* sp = (const f32x4*)(ssq + (size_t)row * 8); const f32x4 t = sp[0] + sp[1];
                const float rstd = rsqrtf(((t[0] + t[1]) + (t[2] + t[3])) * (1.0f / 1024.0f) + eps);
#pragma unroll
                for (int bj = 0; bj < 2; ++bj) { const size_t off = (size_t)row * 1024 + u.pn * BM + bj * HALF + wc * 32 + 8 * fq;
                    const u32x4 ev = *(const u32x4*)(e + off), hv = *(const u32x4*)(h2b + off);
                    const f32x4 h0 = bf_lo4(hv.x, hv.y) + bf_lo4(ev.x, ev.y) * sigmoid4(acc[ai][bj][m][0] * rstd), h1 = bf_lo4(hv.z, hv.w) + bf_lo4(ev.z, ev.w) * sigmoid4(acc[ai][bj][m][1] * rstd);
                    *(u32x4*)(h3b + off) = pack8(h0, h1); } }
    }
};
template <class Epi, class Sched, bool ALIGN_EPI = false, bool SP2 = false>
__device__ __forceinline__ void gemm_phase(PG8_LAS unsigned char* lds, const Gemm g, const Sched& S, const Epi& E, const int wid  ) {
    int lane; asm volatile("v_mbcnt_lo_u32_b32 %0, -1, 0\n\tv_mbcnt_hi_u32_b32 %0, -1, %0" : "=v"(lane));
    const int tid = wid * 64 + lane, wr = wid >> 2, wc = wid & 3, fr = lane & 15, fq = lane >> 4;
    const int K = g.K, nt = K / BK;
    unsigned voffA[2], voffB[2];
#pragma unroll
    for (int i = 0; i < 2; ++i) { int R, C; stage_rc(tid * 16 + i * 8192, R, C); const int Rb = Epi::PERM ? ((R & ~31) + perm32(R & 31)) : R;
        voffA[i] = (unsigned)(R * K + C) * 2u; voffB[i] = (unsigned)(Rb * K + C) * 2u; }
    const size_t kstep = (size_t)(BK * 2);
    const size_t hstep = (size_t)HALF * K * 2;
    const size_t tstep = 2 * hstep;
    const unsigned ldsw = (unsigned)wid * 1024u;
    const int aoff = lds_byte(wr * 64 + fr, fq * 8), boff = lds_byte(wc * 32 + fr, fq * 8);
#define PG8_SA(b, h) (((b) * 2 + (h)) * HTB)
#define PG8_SB(b, h) ((4 + (b) * 2 + (h)) * HTB)
#define PG8_STAGE(bufoff, gbase, voff) do { _Pragma("unroll") for (int _i = 0; _i < 2; ++_i) \
        __builtin_amdgcn_global_load_lds((const unsigned*)((const char*)(gbase) + (voff)[_i]), (PG8_LAS unsigned*)(lds + (bufoff) + ldsw + _i * 8192), 16, 0, 0); } while (0)
#define PG8_LDA(dst, b, h) do { _Pragma("unroll") for (int m = 0; m < 4; ++m) _Pragma("unroll") for (int k = 0; k < 2; ++k) dst[m][k] = *(const PG8_LAS bf16x8*)(lds + PG8_SA(b, h) + aoff + m * 2048 + k * 1024); } while (0)
#define PG8_LDB(dst, b, h) do { _Pragma("unroll") for (int n = 0; n < 2; ++n) _Pragma("unroll") for (int k = 0; k < 2; ++k) dst[n][k] = *(const PG8_LAS bf16x8*)(lds + PG8_SB(b, h) + boff + n * 2048 + k * 1024); } while (0)
#define PG8_MMA(ai, bj, At, Bt) do { __builtin_amdgcn_s_setprio(1); _Pragma("unroll") for (int m = 0; m < 4; ++m) _Pragma("unroll") for (int n = 0; n < 2; ++n) _Pragma("unroll") for (int k = 0; k < 2; ++k) \
        acc[ai][bj][m][n] = __builtin_amdgcn_mfma_f32_16x16x32_bf16(Bt[n][k], At[m][k], acc[ai][bj][m][n], 0, 0, 0); __builtin_amdgcn_s_setprio(0); } while (0)
#define PG8_WAIT_V(n) asm volatile("s_waitcnt vmcnt(" #n ")" ::: "memory")
#define PG8_WAIT_L(n) asm volatile("s_waitcnt lgkmcnt(" #n ")" ::: "memory")
#define PG8_BAR __builtin_amdgcn_s_barrier()
#define PG8_SCHED __builtin_amdgcn_sched_barrier(0)
    Unit cur, nxt; int ui = 0;
    if (!S.next(0, cur)) return;
    f32x4 acc[2][2][4][2];
#pragma unroll
    for (int a = 0; a < 2; ++a)
#pragma unroll
        for (int b = 0; b < 2; ++b)
#pragma unroll
            for (int m = 0; m < 4; ++m)
#pragma unroll
                for (int n = 0; n < 2; ++n) acc[a][b][m][n] = (f32x4){0.f, 0.f, 0.f, 0.f};
    bf16x8 At[4][2], B0[2][2], B1[2][2];
    const char* cA = (const char*)g.A + (size_t)cur.pm * tstep; const char* cB = (const char*)g.Bt + (size_t)cur.pn * tstep;
    S.a_ready(cur);
    if constexpr (SP2) {
        PG8_STAGE(PG8_SB(0, 0), cB, voffB); PG8_STAGE(PG8_SB(0, 1), cB + hstep, voffB); PG8_STAGE(PG8_SA(0, 0), cA, voffA); PG8_STAGE(PG8_SA(0, 1), cA + hstep, voffA);
        if (wr == 1) PG8_BAR;
        PG8_WAIT_V(2); PG8_BAR;
        PG8_STAGE(PG8_SB(1, 0), cB + kstep, voffB); PG8_STAGE(PG8_SA(1, 0), cA + kstep, voffA); PG8_STAGE(PG8_SB(1, 1), cB + hstep + kstep, voffB);
        PG8_WAIT_V(6); PG8_BAR;
    } else {
        PG8_STAGE(PG8_SB(0, 0), cB, voffB); PG8_STAGE(PG8_SA(0, 0), cA, voffA); PG8_STAGE(PG8_SB(0, 1), cB + hstep, voffB); PG8_STAGE(PG8_SA(0, 1), cA + hstep, voffA);
        if (wr == 1) PG8_BAR;
        PG8_WAIT_V(4); PG8_BAR;
        PG8_STAGE(PG8_SB(1, 0), cB + kstep, voffB); PG8_STAGE(PG8_SA(1, 0), cA + kstep, voffA); PG8_STAGE(PG8_SB(1, 1), cB + hstep + kstep, voffB);
        PG8_WAIT_V(6); PG8_BAR;
    }
    for (;;) {
        const bool has_next = S.next(ui + 1, nxt);
        const char* nA = has_next ? (const char*)g.A + (size_t)nxt.pm * tstep : cA; const char* nB = has_next ? (const char*)g.Bt + (size_t)nxt.pn * tstep : cB;
        for (int t = 0; t < nt; t += 2) {
            const bool last = (t == nt - 2);
            const char* a1 = cA + (size_t)(t + 1) * kstep;
            const char* a2 = last ? nA : cA + (size_t)(t + 2) * kstep; const char* b2 = last ? nB : cB + (size_t)(t + 2) * kstep;
            const char* a3 = a2 + kstep; const char* b3 = b2 + kstep;
            if (last && has_next) S.a_ready(nxt);
            if constexpr (SP2) {
            PG8_LDB(B0, 0, 0); PG8_LDB(B1, 0, 1); PG8_SCHED; PG8_LDA(At, 0, 0); PG8_STAGE(PG8_SA(1, 1), a1 + hstep, voffA);
            PG8_WAIT_V(8); PG8_WAIT_L(0); PG8_BAR; PG8_MMA(0, 0, At, B0); PG8_MMA(0, 1, At, B1); PG8_BAR; PG8_SCHED;
            PG8_LDA(At, 0, 1); PG8_STAGE(PG8_SB(0, 0), b2, voffB); PG8_STAGE(PG8_SB(0, 1), b2 + hstep, voffB); PG8_STAGE(PG8_SA(0, 0), a2, voffA);
            PG8_WAIT_V(8); PG8_WAIT_L(0); PG8_BAR; PG8_MMA(1, 0, At, B0); PG8_MMA(1, 1, At, B1); PG8_BAR; PG8_SCHED;
            PG8_LDB(B0, 1, 0); PG8_LDB(B1, 1, 1); PG8_SCHED; PG8_LDA(At, 1, 0); PG8_STAGE(PG8_SA(0, 1), a2 + hstep, voffA);
            PG8_WAIT_V(8); PG8_WAIT_L(0); PG8_BAR; PG8_MMA(0, 0, At, B0); PG8_MMA(0, 1, At, B1); PG8_BAR; PG8_SCHED;
            PG8_LDA(At, 1, 1); PG8_STAGE(PG8_SB(1, 0), b3, voffB); PG8_STAGE(PG8_SB(1, 1), b3 + hstep, voffB); PG8_STAGE(PG8_SA(1, 0), a3, voffA);
            PG8_WAIT_V(8); PG8_WAIT_L(0); PG8_BAR; PG8_MMA(1, 0, At, B0); PG8_MMA(1, 1, At, B1); PG8_BAR; PG8_SCHED;
            } else {
            PG8_LDB(B0, 0, 0); PG8_SCHED; PG8_LDA(At, 0, 0); PG8_STAGE(PG8_SA(1, 1), a1 + hstep, voffA);
            PG8_WAIT_L(8); PG8_BAR; PG8_WAIT_L(0); PG8_MMA(0, 0, At, B0); PG8_BAR; PG8_SCHED;
            PG8_LDB(B1, 0, 1); PG8_STAGE(PG8_SB(0, 0), b2, voffB);
            PG8_BAR; PG8_WAIT_L(0); PG8_MMA(0, 1, At, B1); PG8_BAR;
            PG8_LDA(At, 0, 1); PG8_STAGE(PG8_SA(0, 0), a2, voffA);
            PG8_BAR; PG8_WAIT_L(0); PG8_MMA(1, 0, At, B0); PG8_BAR; PG8_SCHED;
            PG8_STAGE(PG8_SB(0, 1), b2 + hstep, voffB);
            PG8_WAIT_V(6); PG8_BAR; PG8_MMA(1, 1, At, B1); PG8_BAR;
            PG8_LDB(B0, 1, 0); PG8_SCHED; PG8_LDA(At, 1, 0); PG8_STAGE(PG8_SA(0, 1), a2 + hstep, voffA);
            PG8_WAIT_L(8); PG8_BAR; PG8_WAIT_L(0); PG8_MMA(0, 0, At, B0); PG8_BAR; PG8_SCHED;
            PG8_LDB(B1, 1, 1); PG8_STAGE(PG8_SB(1, 0), b3, voffB);
            PG8_BAR; PG8_WAIT_L(0); PG8_MMA(0, 1, At, B1); PG8_BAR;
            PG8_LDA(At, 1, 1); PG8_STAGE(PG8_SA(1, 0), a3, voffA);
            PG8_BAR; PG8_WAIT_L(0); PG8_MMA(1, 0, At, B0); PG8_BAR; PG8_SCHED;
            PG8_STAGE(PG8_SB(1, 1), b3 + hstep, voffB);
            PG8_WAIT_V(6); PG8_BAR; PG8_MMA(1, 1, At, B1); PG8_BAR;
            }
        }
        if constexpr (ALIGN_EPI) { if (wr == 0) PG8_BAR; }
        if constexpr (!Epi::AFTER_DRAIN) { E(acc, cur, wr, wc, fr, fq); S.done(cur); }
        if (!has_next) break;
#pragma unroll
        for (int a = 0; a < 2; ++a)
#pragma unroll
            for (int b = 0; b < 2; ++b)
#pragma unroll
                for (int m = 0; m < 4; ++m)
#pragma unroll
                    for (int n = 0; n < 2; ++n) acc[a][b][m][n] = (f32x4){0.f, 0.f, 0.f, 0.f};
        cur = nxt; cA = nA; cB = nB; ++ui;
        if constexpr (ALIGN_EPI) { if (wr == 1) PG8_BAR; }
    }
    PG8_WAIT_V(0);
    if constexpr (!ALIGN_EPI) { if (wr == 0) PG8_BAR; }
    PG8_BAR;
    if constexpr (Epi::AFTER_DRAIN) { E.fused(acc, cur, wr, wc, fr, fq, lds, wid, lane); S.done(cur); }
#undef PG8_SA
#undef PG8_SB
#undef PG8_STAGE
#undef PG8_LDA
#undef PG8_LDB
#undef PG8_MMA
#undef PG8_WAIT_V
#undef PG8_WAIT_L
#undef PG8_BAR
#undef PG8_SCHED
}
}
#include <hip/hip_bf16.h>
#include <cmath>
namespace attn_body {
using bf16=__hip_bfloat16;
using bf16x8=__attribute__((ext_vector_type(8)))short;
using s16x4=__attribute__((ext_vector_type(4)))short;
using f32x16=__attribute__((ext_vector_type(16)))float;
using u32x4=__attribute__((ext_vector_type(4)))unsigned;
constexpr int BATCH=8,NHEAD=16,SEQ=4096,D=64,DM=NHEAD*D;
constexpr int NW=8,QBLK=32,QB=QBLK*NW,KVBLK=64,NQB=SEQ/QB;
constexpr int ATTN_PITCH=DM, ATTN_UNIT_ROWS=QB;
__device__ __forceinline__ int crow(int r,int hi){return (r&3)+8*(r>>2)+4*hi;}
#define SBAR() __builtin_amdgcn_sched_barrier(0)
__device__ __forceinline__ void cmask(f32x16&p0,f32x16&p1,int jb,int qrel,int hi){
  const float NEG=-INFINITY; int kb=64*jb+4*hi;
  #pragma unroll
  for(int r=0;r<16;++r){int kv=kb+(r&3)+8*(r>>2); if(kv>qrel)p0[r]=NEG; if(kv+32>qrel)p1[r]=NEG;}
}

constexpr int NSLOT=3, SLOTB=8192;
constexpr int LDS_K=0, LDS_V=NSLOT*SLOTB, LDS_WS=2*NSLOT*SLOTB, LDS_OST=LDS_WS+NW*64*4, LDS_BYTES=LDS_OST+NW*4096;
constexpr float C2=0.125f*1.4426950408889634f;
__device__ __forceinline__ void glds16(const void*gsrc,unsigned lds_dst){unsigned keep;
  asm volatile("s_mov_b32 %0, m0\n\ts_mov_b32 m0, %2\n\ts_nop 0\n\tglobal_load_lds_dwordx4 %1, off\n\ts_mov_b32 m0, %0":"=&s"(keep):"v"(gsrc),"s"(lds_dst):"memory");}
__device__ __forceinline__ float max3f(float a,float b,float c){float r;asm("v_max3_f32 %0, %1, %2, %3":"=v"(r):"v"(a),"v"(b),"v"(c));return r;}
__device__ __forceinline__ float max2f(float a,float b){float r;asm("v_max_f32_e32 %0, %1, %2":"=v"(r):"v"(a),"v"(b));return r;}
__device__ __forceinline__ float fadd_s(float a,float b){float r;asm("v_add_f32_e32 %0, %1, %2":"=v"(r):"v"(a),"v"(b));return r;}
__device__ __forceinline__ float fsub_s(float a,float b){float r;asm("v_sub_f32_e32 %0, %1, %2":"=v"(r):"v"(a),"v"(b));return r;}
typedef float f32x2_t __attribute__((ext_vector_type(2))); typedef __bf16 bf16x2_t __attribute__((ext_vector_type(2)));
__device__ __forceinline__ unsigned cvtpk_s(float lo,float hi){f32x2_t v={lo,hi};bf16x2_t b=__builtin_convertvector(v,bf16x2_t);return __builtin_bit_cast(unsigned,b);}
#define WAIT_BAR(N) asm volatile("s_waitcnt vmcnt(" #N ") lgkmcnt(0)\n\ts_barrier":::"memory")

__device__ __forceinline__ void qkt(f32x16&p0,f32x16&p1,const char*Kslot,const bf16x8*qr,const f32x16&negm,int r32,int hi){
  const char*kb=Kslot+hi*1024+r32*16;
  #pragma unroll
  for(int d0=0;d0<4;++d0){
    const bf16x8 b0=*reinterpret_cast<const bf16x8*>(kb+d0*2048);
    const bf16x8 b1=*reinterpret_cast<const bf16x8*>(kb+d0*2048+512);
    if(d0==0){p0=__builtin_amdgcn_mfma_f32_32x32x16_bf16(b0,qr[0],negm,0,0,0);p1=__builtin_amdgcn_mfma_f32_32x32x16_bf16(b1,qr[0],negm,0,0,0);}
    else{p0=__builtin_amdgcn_mfma_f32_32x32x16_bf16(b0,qr[d0],p0,0,0,0);p1=__builtin_amdgcn_mfma_f32_32x32x16_bf16(b1,qr[d0],p1,0,0,0);}}
}
typedef __attribute__((address_space(3))) const char* lds_cptr;
typedef short v4i16_t __attribute__((ext_vector_type(4)));
__device__ __forceinline__ void kload8(bf16x8*kf,lds_cptr kp){
  kf[0]=*(const __attribute__((address_space(3))) bf16x8*)(kp);      kf[1]=*(const __attribute__((address_space(3))) bf16x8*)(kp+512);
  kf[2]=*(const __attribute__((address_space(3))) bf16x8*)(kp+2048); kf[3]=*(const __attribute__((address_space(3))) bf16x8*)(kp+2560);
  kf[4]=*(const __attribute__((address_space(3))) bf16x8*)(kp+4096); kf[5]=*(const __attribute__((address_space(3))) bf16x8*)(kp+4608);
  kf[6]=*(const __attribute__((address_space(3))) bf16x8*)(kp+6144); kf[7]=*(const __attribute__((address_space(3))) bf16x8*)(kp+6656);
}
__device__ __forceinline__ void kload2(bf16x8*kf,lds_cptr kp,int j){ kf[2*j]=*(const __attribute__((address_space(3))) bf16x8*)(kp+j*2048); kf[2*j+1]=*(const __attribute__((address_space(3))) bf16x8*)(kp+j*2048+512); }
__device__ __forceinline__ s16x4 vtr(lds_cptr p){ return __builtin_bit_cast(s16x4,__builtin_amdgcn_ds_read_tr16_b64_v4i16((__attribute__((address_space(3))) v4i16_t*)p)); }
__device__ __forceinline__ float rowmax(const f32x16&p0,const f32x16&p1){
  float a=max3f(p0[0],p0[1],p1[0]),b=max3f(p0[2],p0[3],p1[1]);a=max3f(a,p1[2],p1[3]);
  #pragma unroll
  for(int r=4;r<16;r+=4){a=max3f(a,p0[r],p0[r+1]);b=max3f(b,p0[r+2],p0[r+3]);a=max3f(a,p1[r],p1[r+1]);b=max3f(b,p1[r+2],p1[r+3]);}
  const float m=max2f(a,b);
  auto rr=__builtin_amdgcn_permlane32_swap(__float_as_uint(m),__float_as_uint(m),false,false);
  return max2f(__uint_as_float(rr[0]),__uint_as_float(rr[1]));
}
__device__ __forceinline__ void pv(f32x16*o,int vb,bf16x8 pa0,bf16x8 pa1,bf16x8 pa2,bf16x8 pa3){
  #pragma unroll
  for(int d0=0;d0<2;++d0){s16x4 lo[4],hi[4];
    #pragma unroll
    for(int ks=0;ks<4;++ks){
      asm volatile("ds_read_b64_tr_b16 %0,%1 offset:%c2":"=&v"(lo[ks]):"v"(vb),"i"(d0*4096+ks*1024):"memory");
      asm volatile("ds_read_b64_tr_b16 %0,%1 offset:%c2":"=&v"(hi[ks]):"v"(vb),"i"(d0*4096+ks*1024+512):"memory");}
    asm volatile("s_waitcnt lgkmcnt(0)":::"memory");SBAR();
    #define PK(k) (bf16x8){lo[k][0],lo[k][1],lo[k][2],lo[k][3],hi[k][0],hi[k][1],hi[k][2],hi[k][3]}
    o[d0]=__builtin_amdgcn_mfma_f32_32x32x16_bf16(pa0,PK(0),o[d0],0,0,0);
    o[d0]=__builtin_amdgcn_mfma_f32_32x32x16_bf16(pa1,PK(1),o[d0],0,0,0);
    o[d0]=__builtin_amdgcn_mfma_f32_32x32x16_bf16(pa2,PK(2),o[d0],0,0,0);
    o[d0]=__builtin_amdgcn_mfma_f32_32x32x16_bf16(pa3,PK(3),o[d0],0,0,0);
    #undef PK
  }
}

#ifndef ATTN_STORE16
#define ATTN_STORE16(p,v) (*(u32x4*)(p)=(v))
#endif
template<int THRL> __device__ __forceinline__ void attn_unit(int b,int h,int qb,const bf16*Q,const bf16*__restrict__ K,const bf16*__restrict__ V,bf16*O,char*shm,const int tid_in){
  const int tid=tid_in,lane=tid&63,r32=lane&31,hi=lane>>5; const int wid=__builtin_amdgcn_readfirstlane(tid>>6);
  const long rowbase=(long)b*SEQ; const int q0=qb*QB;
  const bf16*Qw=Q+(rowbase+q0+wid*QBLK)*DM+h*D;
  const bf16*Kh=K+rowbase*DM+h*D,*Vh=V+rowbase*DM+h*D;
  const unsigned lds0=(unsigned)(uintptr_t)shm;
  float*wsf=(float*)(shm+LDS_WS)+wid*64;
  const bf16*ksrc=Kh+(long)lane*DM+wid*8;
  const bf16*vsrc=Vh+(long)(16*(wid&3)+(lane>>2))*DM+(wid>>2)*32+(lane&3)*8;
  const unsigned kdst=lds0+LDS_K+wid*1024, vdst=lds0+LDS_V+wid*1024;
  #define DMA_K(t,slot) glds16(ksrc+(long)(t)*KVBLK*DM,(unsigned)__builtin_amdgcn_readfirstlane(kdst+(slot)))
  #define DMA_V(t,slot) glds16(vsrc+(long)(t)*KVBLK*DM,(unsigned)__builtin_amdgcn_readfirstlane(vdst+(slot)))
  const int vb0=(int)(lds0+LDS_V)+((lane>>4)&1)*32+(lane&3)*8+(4*hi+((lane&15)>>2))*64;
  const char*Kbase=shm+LDS_K; bf16x8 kf[8];
  const lds_cptr shm3=(lds_cptr)shm; const lds_cptr kp0=shm3+LDS_K+hi*1024+r32*16; const lds_cptr vp0=shm3+LDS_V+((lane>>4)&1)*32+(lane&3)*8+(4*hi+((lane&15)>>2))*64;
  const int NT=(q0+QB)/KVBLK;
  DMA_K(0,0);DMA_V(0,0);DMA_K(1,SLOTB);
  bf16x8 qr[4];
  #pragma unroll
  for(int d0=0;d0<4;++d0)qr[d0]=*reinterpret_cast<const bf16x8*>(&Qw[(long)r32*DM+d0*16+hi*8]);
  float mhat=0.f,l_reg=0.f;f32x16 o[2];o[0]=f32x16{};o[1]=f32x16{};f32x16 negm=f32x16{};asm volatile("":"+v"(negm));
  const int qrel=wid*QBLK+r32;
  #define CMASK(P0,P1,t) do{int jb_=(t)-(NT-4); if(jb_>=0)cmask(P0,P1,jb_,qrel,hi);}while(0)
  bool resc=false;
  #define START(P0,P1) do{ const float rm=rowmax(P0,P1); resc=false; \
    { const float dl=rm; mhat=fadd_s(mhat,dl); \
      _Pragma("unroll") for(int r=0;r<16;++r){P0[r]=fsub_s(P0[r],dl);P1[r]=fsub_s(P1[r],dl);} \
      _Pragma("unroll") for(int r=0;r<16;++r)negm[r]=-mhat; asm volatile("":"+v"(negm)); } \
    _Pragma("unroll") for(int r=0;r<16;++r)P0[r]=__builtin_amdgcn_exp2f(P0[r]); }while(0)
  #define RESC() do{ if(resc){ asm volatile("s_waitcnt lgkmcnt(0)":::"memory"); \
      _Pragma("unroll") for(int d_=0;d_<2;++d_) _Pragma("unroll") for(int r=0;r<16;++r)o[d_][r]*=wsf[crow(r,hi)]; } }while(0)
  f32x16 pA0,pA1,pB0,pB1;
  int sl_prev=0,sl_cur=0,sl_next=SLOTB;
  #define ROT() do{sl_prev=sl_cur;sl_cur=sl_next;sl_next=(sl_next==(NSLOT-1)*SLOTB)?0:sl_next+SLOTB;}while(0)
  DMA_K(2,2*SLOTB);
  WAIT_BAR(3);
  qkt(pA0,pA1,Kbase,qr,negm,r32,hi);asm volatile("s_nop 15\n\ts_nop 7":"+v"(pA0),"+v"(pA1));CMASK(pA0,pA1,0);
  START(pA0,pA1);
  _Pragma("unroll") for(int r=0;r<16;++r)pA1[r]=__builtin_amdgcn_exp2f(pA1[r]);
  WAIT_BAR(0);
  DMA_K(3,0);DMA_V(1,SLOTB);
  ROT();
  kload8(kf,kp0+sl_cur);
  WAIT_BAR(2);
  s16x4 vlo[8],vhi[8]; u32x4 pw0,pw1,pw2,pw3;
  #define PKW(P,B) cvtpk_s(P[B],P[B+1])
  #define PAF(k) __builtin_bit_cast(bf16x8,pw##k)
  #define VFR(i) (bf16x8){vlo[i][0],vlo[i][1],vlo[i][2],vlo[i][3],vhi[i][0],vhi[i][1],vhi[i][2],vhi[i][3]}
  #define PIN(x) asm volatile("":"+v"(x))
  #define MX3(a,b,c) __builtin_fmaxf(__builtin_fmaxf((a),(b)),(c))
  #define GAPA(MF,A0,A1,A2,A3,W0,W1,PW) do{ MF; sacc+=A0; sacc+=A1; sacc+=A2; sacc+=A3; PIN(sacc); W0; W1; PIN(PW); SBAR(); }while(0)
  #define EX(v) __builtin_amdgcn_exp2f(v)
  #define GAPB(MF,X,B) do{ MF; X[B]=EX(X[B]); X[B+1]=EX(X[B+1]); X[B+2]=EX(X[B+2]); X[B+3]=EX(X[B+3]); PIN(X); SBAR(); }while(0)
  #define VRD(i) do{ vlo[i]=vtr(vp_+(((i)>>2)*4096+((i)&3)*1024)); vhi[i]=vtr(vp_+(((i)>>2)*4096+((i)&3)*1024+512)); }while(0)
  #define KRD(G,j) do{ if(G){ kload2(kf,kp0+sl_next,j); SBAR(); } }while(0)
  #define STEP(C0,C1,P0,P1,t,GK,GV,GL) do{ SBAR(); \
    const lds_cptr vp_=vp0+sl_prev; \
    VRD(0); SBAR(); float sacc=(P0[0]+P0[1]); \
    GAPA(C0=__builtin_amdgcn_mfma_f32_32x32x16_bf16(kf[0],qr[0],negm,0,0,0), P0[2],P0[3],P0[4],P0[5],     pw0[0]=PKW(P0,0), pw0[1]=PKW(P0,2), pw0); \
    VRD(4); SBAR(); GAPA(C1=__builtin_amdgcn_mfma_f32_32x32x16_bf16(kf[1],qr[0],negm,0,0,0), P0[6],P0[7],P0[8],P0[9],     pw0[2]=PKW(P0,4), pw0[3]=PKW(P0,6), pw0); \
    VRD(1); SBAR(); GAPA(C0=__builtin_amdgcn_mfma_f32_32x32x16_bf16(kf[2],qr[1],C0,0,0,0),   P0[10],P0[11],P0[12],P0[13], pw1[0]=PKW(P0,8), pw1[1]=PKW(P0,10), pw1); \
    VRD(5); SBAR(); GAPA(C1=__builtin_amdgcn_mfma_f32_32x32x16_bf16(kf[3],qr[1],C1,0,0,0),   P0[14],P0[15],P1[0],P1[1],   pw1[2]=PKW(P0,12),pw1[3]=PKW(P0,14), pw1); \
    VRD(2); SBAR(); GAPA(C0=__builtin_amdgcn_mfma_f32_32x32x16_bf16(kf[4],qr[2],C0,0,0,0),   P1[2],P1[3],P1[4],P1[5],     pw2[0]=PKW(P1,0), pw2[1]=PKW(P1,2), pw2); \
    VRD(6); SBAR(); GAPA(C1=__builtin_amdgcn_mfma_f32_32x32x16_bf16(kf[5],qr[2],C1,0,0,0),   P1[6],P1[7],P1[8],P1[9],     pw2[2]=PKW(P1,4), pw2[3]=PKW(P1,6), pw2); \
    VRD(3); SBAR(); GAPA(C0=__builtin_amdgcn_mfma_f32_32x32x16_bf16(kf[6],qr[3],C0,0,0,0),   P1[10],P1[11],P1[12],P1[13], pw3[0]=PKW(P1,8), pw3[1]=PKW(P1,10), pw3); \
    VRD(7); SBAR(); GAPA(C1=__builtin_amdgcn_mfma_f32_32x32x16_bf16(kf[7],qr[3],C1,0,0,0),   P1[14],P1[15],0.f,0.f,       pw3[2]=PKW(P1,12),pw3[3]=PKW(P1,14), pw3); \
    l_reg+=sacc; \
    if(GK){DMA_K((t)+3,sl_cur);} if(GV){DMA_V((t)+1,sl_next);} \
    CMASK(C0,C1,t); \
    { float a=MX3(C0[0],C0[1],C1[0]),b=MX3(C0[2],C0[3],C1[1]); a=MX3(a,C1[2],C1[3]); \
      _Pragma("unroll") for(int r=4;r<16;r+=4){a=MX3(a,C0[r],C0[r+1]);b=MX3(b,C0[r+2],C0[r+3]);a=MX3(a,C1[r],C1[r+1]);b=MX3(b,C1[r+2],C1[r+3]);} \
      float rm=__builtin_fmaxf(a,b); { auto rr=__builtin_amdgcn_permlane32_swap(__float_as_uint(rm),__float_as_uint(rm),false,false); rm=__builtin_fmaxf(__uint_as_float(rr[0]),__uint_as_float(rr[1])); } \
      resc=false; \
      if(__builtin_expect(__any(rm>(float)THRL),0)){ const float dl=__builtin_fmaxf(rm,0.f); mhat+=dl; \
        _Pragma("unroll") for(int r=0;r<16;++r){C0[r]-=dl;C1[r]-=dl;} \
        _Pragma("unroll") for(int r=0;r<16;++r)negm[r]=-mhat; asm volatile("":"+v"(negm)); \
        const float f=__builtin_amdgcn_exp2f(-dl); l_reg*=f; if(hi==0)wsf[r32]=f; resc=true; } } \
    SBAR(); \
    GAPB(o[0]=__builtin_amdgcn_mfma_f32_32x32x16_bf16(PAF(0),VFR(0),o[0],0,0,0), C0,0); \
    GAPB(o[1]=__builtin_amdgcn_mfma_f32_32x32x16_bf16(PAF(0),VFR(4),o[1],0,0,0), C0,4); \
    KRD(GL,0); GAPB(o[0]=__builtin_amdgcn_mfma_f32_32x32x16_bf16(PAF(1),VFR(1),o[0],0,0,0), C0,8); \
    KRD(GL,1); GAPB(o[1]=__builtin_amdgcn_mfma_f32_32x32x16_bf16(PAF(1),VFR(5),o[1],0,0,0), C0,12); \
    KRD(GL,2); GAPB(o[0]=__builtin_amdgcn_mfma_f32_32x32x16_bf16(PAF(2),VFR(2),o[0],0,0,0), C1,0); \
    KRD(GL,3); GAPB(o[1]=__builtin_amdgcn_mfma_f32_32x32x16_bf16(PAF(2),VFR(6),o[1],0,0,0), C1,4); \
    GAPB(o[0]=__builtin_amdgcn_mfma_f32_32x32x16_bf16(PAF(3),VFR(3),o[0],0,0,0), C1,8); \
    GAPB(o[1]=__builtin_amdgcn_mfma_f32_32x32x16_bf16(PAF(3),VFR(7),o[1],0,0,0), C1,12); \
    }while(0)
  int t=1;
  #undef CMASK
  #define CMASK(P0,P1,t) do{}while(0)
  for(;t+5<NT;t+=2){
    STEP(pB0,pB1,pA0,pA1,t,true,true,true);     WAIT_BAR(2); RESC(); ROT();
    STEP(pA0,pA1,pB0,pB1,t+1,true,true,true);   WAIT_BAR(2); RESC(); ROT();
  }
  #undef CMASK
  #define CMASK(P0,P1,t) do{int jb_=(t)-(NT-4); if(jb_>=0)cmask(P0,P1,jb_,qrel,hi);}while(0)
  #define ENDW(tt) do{ if((tt)+3<NT){WAIT_BAR(2);} else if((tt)+2<NT){WAIT_BAR(1);} else {WAIT_BAR(0);} }while(0)
  for(;t+1<NT;t+=2){
    STEP(pB0,pB1,pA0,pA1,t,(t+3<NT),(t+1<NT),(t+1<NT));       ENDW(t);   RESC(); ROT();
    STEP(pA0,pA1,pB0,pB1,t+1,(t+4<NT),(t+2<NT),(t+2<NT));     ENDW(t+1); RESC(); ROT();
  }
  STEP(pB0,pB1,pA0,pA1,NT-1,false,false,false); RESC();
  { float sacc=pB0[0]+pB0[1]; _Pragma("unroll") for(int r=2;r<16;++r)sacc+=pB0[r]; _Pragma("unroll") for(int r=0;r<16;++r)sacc+=pB1[r]; l_reg+=sacc;
    pw0=(u32x4){PKW(pB0,0),PKW(pB0,2),PKW(pB0,4),PKW(pB0,6)};pw1=(u32x4){PKW(pB0,8),PKW(pB0,10),PKW(pB0,12),PKW(pB0,14)};pw2=(u32x4){PKW(pB1,0),PKW(pB1,2),PKW(pB1,4),PKW(pB1,6)};pw3=(u32x4){PKW(pB1,8),PKW(pB1,10),PKW(pB1,12),PKW(pB1,14)};
    SBAR(); pv(o,vb0+sl_cur,PAF(0),PAF(1),PAF(2),PAF(3)); }
  #undef PKW
  #undef PAF
  #undef VFR
  #undef PIN
  #undef MX3
  #undef GAPA
  #undef GAPB
  #undef EX
  #undef VRD
  #undef KRD
  #undef STEP
  #undef ENDW
  {auto rr=__builtin_amdgcn_permlane32_swap(__float_as_uint(l_reg),__float_as_uint(l_reg),false,false);l_reg=__uint_as_float(rr[0])+__uint_as_float(rr[1]);}
  if(hi==0)wsf[32+r32]=l_reg;asm volatile("s_waitcnt lgkmcnt(0)":::"memory");
  float rli[16];
  #pragma unroll
  for(int r=0;r<16;++r)rli[r]=__builtin_amdgcn_rcpf(wsf[32+crow(r,hi)]);
  bf16*Ow=O+(rowbase+q0+wid*QBLK)*DM+h*D;
  { bf16*stg=(bf16*)(shm+LDS_OST)+wid*2048;
    #pragma unroll
    for(int r=0;r<16;++r){const int orow=crow(r,hi);
      #pragma unroll
      for(int d0=0;d0<2;++d0)stg[orow*64+d0*32+r32]=__float2bfloat16(o[d0][r]*rli[r]);}
    asm volatile("s_waitcnt lgkmcnt(0)":::"memory");
    #pragma unroll
    for(int i=0;i<4;++i){const int row=i*8+(lane>>3),ch=lane&7; const u32x4 v=*(const u32x4*)(stg+row*64+ch*8); ATTN_STORE16(Ow+(long)row*DM+ch*8,v);} }
  asm volatile("s_waitcnt lgkmcnt(0)\n\ts_barrier":::"memory");
  #undef DMA_K
  #undef DMA_V
  #undef CMASK
  #undef START
  #undef RESC
  #undef ROT
}
constexpr int ATTN_LDS_BYTES=LDS_BYTES;
struct AttnTensors { const bf16* Q; const bf16* K; const bf16* V; bf16* O; };
struct AttnUnit { int bh; int qb; };
template<class Sched,int THRL=8> __device__ __forceinline__ void attn_phase(char*lds,const AttnTensors&T,const Sched&S,const int tid_in){
  AttnUnit u;
  for(int i=0;S.next(i,u);++i){ S.a_ready(u); attn_unit<THRL>(u.bh/NHEAD,u.bh%NHEAD,u.qb,T.Q,T.K,T.V,T.O,lds,tid_in); S.done(u); }
}
#undef SBAR
#undef WAIT_BAR
}
constexpr int NWAVES = 8;
constexpr int BATCH = 8, SEQ = 4096, DM = 1024, M = BATCH * SEQ;
constexpr int IN_COLS = 2560, PLE_DIM = 256, NEXP = 16384, QCOLS = 2048;
constexpr float EPS = 1e-6f;
#ifndef MK_N_LAUNCHES
#define MK_N_LAUNCHES 1
#endif
constexpr int N_PHASES = 11;
constexpr size_t MiB = 1u << 20;
constexpr size_t WS_CTL = 0, CTL_ZERO_BYTES = 32 * 1024;
constexpr size_t WS_ROPEC = 1 * MiB, WS_ROPES = 1 * MiB + 512 * 1024;
constexpr size_t WS_KEYS = 2 * MiB;
constexpr size_t WS_WPROJ = 3 * MiB;
constexpr size_t WS_WIN = 4 * MiB;
constexpr size_t WS_WOUT = 10 * MiB, WS_WQ = 12 * MiB, WS_WGATE = 16 * MiB;
constexpr size_t WS_SSQ1 = 18 * MiB;
constexpr size_t WS_PB = 24 * MiB;
constexpr size_t WS_E = 40 * MiB;
constexpr size_t WS_UT = 104 * MiB, WS_VT = 120 * MiB;
constexpr size_t WS_SU = 136 * MiB, WS_SV = 137 * MiB;
constexpr size_t WS_XN = 168 * MiB;
constexpr size_t WS_QO = 232 * MiB, WS_K = 296 * MiB, WS_V = 360 * MiB;
constexpr size_t WS_U = 424 * MiB;
constexpr size_t WS_QP = 296 * MiB;
constexpr size_t WS_XN2 = 424 * MiB;
constexpr size_t WS_SM = 138 * MiB, WS_HS = 139 * MiB, WS_SSQ2 = 140 * MiB;
constexpr size_t WS_HQ = 24 * MiB;
constexpr size_t WS_APART = 168 * MiB;
constexpr size_t WS_QM = 424 * MiB;
constexpr size_t WS_EID = 488 * MiB, WS_GATE = 496 * MiB;
constexpr size_t WS_END = 512 * MiB;
constexpr int RING_BYTES = 131072, LDS_BYTES = 147456;
constexpr int MISC_OFF = LDS_BYTES - 256;
constexpr int CW_BAR = 4096;

#define GAS __attribute__((address_space(1)))
#define LAS __attribute__((address_space(3)))
typedef unsigned short bf16;
typedef unsigned v4u __attribute__((ext_vector_type(4)));
typedef float f32x4 __attribute__((ext_vector_type(4)));
typedef float f32x16 __attribute__((ext_vector_type(16)));
typedef short bf16x8 __attribute__((ext_vector_type(8)));
typedef __bf16 bf16x2_t __attribute__((ext_vector_type(2)));
#define LDS_WAIT() asm volatile("s_waitcnt lgkmcnt(0)" ::: "memory")
#define VM_WAIT() asm volatile("s_waitcnt vmcnt(0)" ::: "memory")
__device__ __forceinline__ unsigned f2bf(float f) { unsigned u = __builtin_bit_cast(unsigned, f); return (u + 0x7fffu + ((u >> 16) & 1u)) >> 16; }
__device__ __forceinline__ unsigned pk2(float lo, float hi) { return f2bf(lo) | (f2bf(hi) << 16); }
__device__ __forceinline__ v4u pk8(const f32x4 a, const f32x4 b) { v4u w; w.x = pk2(a[0], a[1]); w.y = pk2(a[2], a[3]); w.z = pk2(b[0], b[1]); w.w = pk2(b[2], b[3]); return w; }
__device__ __forceinline__ float bflo(unsigned w) { return __uint_as_float(w << 16); }
__device__ __forceinline__ float bfhi(unsigned w) { return __uint_as_float(w & 0xffff0000u); }
__device__ __forceinline__ float dot4s_(const f32x4 a) { return (a[0] * a[0] + a[1] * a[1]) + (a[2] * a[2] + a[3] * a[3]); }
__device__ __forceinline__ float wave_sum(float v) {
#pragma unroll
    for (int o = 1; o < 64; o <<= 1) v += __shfl_xor(v, o);
    return v;
}
__device__ __forceinline__ float dot2bf(unsigned w, unsigned x, float acc) { return __builtin_amdgcn_fdot2_f32_bf16(__builtin_bit_cast(bf16x2_t, w), __builtin_bit_cast(bf16x2_t, x), acc, false); }

typedef GAS unsigned gu32;
#define RLX_AGENT __ATOMIC_RELAXED, __HIP_MEMORY_SCOPE_AGENT
#define XB_TMO      128
#define XB_XCNT(j)  (256  + 64 * (j))
#define XB_XSUB(j)  (1280 + 64 * (j))
#define XB_XGEN(j)  (2304 + 64 * (j))
#define XB_TOP      3328
#define XB_TOPGEN   3392
#define XCD_BAR_WORDS 3456
#define XB_SPIN_CAP (1u << 18)

__device__ __forceinline__ unsigned xb_ld(unsigned* p)              { return __hip_atomic_load(p, __ATOMIC_RELAXED, __HIP_MEMORY_SCOPE_AGENT); }
__device__ __forceinline__ unsigned xb_add(unsigned* p, unsigned v) { return __hip_atomic_fetch_add(p, v, __ATOMIC_RELAXED, __HIP_MEMORY_SCOPE_AGENT); }
__device__ __forceinline__ unsigned xb_xcc_id() { return (unsigned)__builtin_amdgcn_s_getreg((3 << 11) | 20) & 0xFu; }
#define XB_SPIN(cond, bar) do { unsigned _sp = 0; while (cond) { __builtin_amdgcn_s_sleep(1); \
    if ((++_sp & 255u) == 0u) { if (xb_ld(&(bar)[XB_TMO])) break; if (_sp > XB_SPIN_CAP) { atomicAdd(&(bar)[XB_TMO], 1u); break; } } } } while (0)

struct XcdBarrier {
    unsigned* bar; unsigned x;
    volatile LAS unsigned* st;
};

__device__ __forceinline__ XcdBarrier xcd_barrier_post(unsigned* bar, volatile LAS unsigned* st, const bool leader) {
    XcdBarrier b; b.bar = bar; b.x = xb_xcc_id(); b.st = st;
    if (leader) (void)xb_add(&bar[XB_XCNT(b.x)], 1u);
    return b;
}
__device__ __forceinline__ void xcd_barrier_complete(unsigned* bar, unsigned x, unsigned& nloc, unsigned& nx) {
    const unsigned G = gridDim.x * gridDim.y * gridDim.z;
    unsigned sum, cnt, mine, sp = 0u;
    for (;;) {
        sum = 0u; cnt = 0u; mine = 0u;
#pragma unroll
        for (unsigned j = 0; j < 16; ++j) { const unsigned c = xb_ld(&bar[XB_XCNT(j)]); sum += c; cnt += (c > 0u) ? 1u : 0u; mine = (j == x) ? c : mine; }
        if (sum == G) break;
        __builtin_amdgcn_s_sleep(1);
        if ((++sp & 255u) == 0u) { if (xb_ld(&bar[XB_TMO])) break; if (sp > XB_SPIN_CAP) { atomicAdd(&bar[XB_TMO], 1u); break; } }
    }
    nloc = mine > 0u ? mine : 1u; nx = cnt > 0u ? cnt : 1u;
}

__device__ __forceinline__ void xcd_barrier(const XcdBarrier& b, const bool leader  ) {
    asm volatile("s_waitcnt vmcnt(0)" ::: "memory");
    __syncthreads();
    if (leader) {
        unsigned* bar = b.bar;
        __builtin_amdgcn_s_waitcnt(0);
        unsigned nloc = b.st[0], nx = b.st[1];
        if (nloc == 0u) { xcd_barrier_complete(bar, b.x, nloc, nx); b.st[0] = nloc; b.st[1] = nx; }
        const unsigned old = xb_add(&bar[XB_XSUB(b.x)], 1u);
        const unsigned gen = old / nloc;
        if (old + 1u == (gen + 1u) * nloc) {
            __builtin_amdgcn_fence(__ATOMIC_RELEASE, "agent");
            asm volatile("s_waitcnt vmcnt(0)" ::: "memory");
            const unsigned og = xb_add(&bar[XB_TOP], 1u);
            const unsigned tg = og / nx;
            if (og + 1u == (tg + 1u) * nx) xb_add(&bar[XB_TOPGEN], 1u);
            else XB_SPIN(xb_ld(&bar[XB_TOPGEN]) == tg, bar);
            __builtin_amdgcn_fence(__ATOMIC_ACQUIRE, "agent");
            xb_add(&bar[XB_XGEN(b.x)], 1u);
            asm volatile("s_waitcnt vmcnt(0)" ::: "memory");
        } else {
            XB_SPIN(xb_ld(&bar[XB_XGEN(b.x)]) == gen, bar);
            __builtin_amdgcn_fence(__ATOMIC_ACQUIRE, "agent");
            asm volatile("s_waitcnt vmcnt(0)" ::: "memory");
        }
    }
    __syncthreads();
}

__device__ __forceinline__ int lane_id() { int l; asm volatile("v_mbcnt_lo_u32_b32 %0, -1, 0\n\tv_mbcnt_hi_u32_b32 %0, -1, %0" : "=v"(l)); return l; }
#if defined(PROBE_A)
#define STAMP(i) do { if (F.wave == 0) { const unsigned long long t_ = __builtin_amdgcn_s_memrealtime(); volatile LAS unsigned* ms_ = (volatile LAS unsigned*)(F.lds + MISC_OFF) + 16 + 2 * (i); ms_[0] = (unsigned)t_; ms_[1] = (unsigned)(t_ >> 32); } } while (0)
#else
#define STAMP(i) do {} while (0)
#endif
struct Frame {
    LAS unsigned char* lds; unsigned char* ldsg;
    int wave, vcu, G;
    float* out; unsigned char* ws;
};
template <int I> __device__ __forceinline__ const float* inptr() {
    const float* p = nullptr;
#if defined(__HIP_DEVICE_COMPILE__)
    const void* ka = (const void*)__builtin_amdgcn_kernarg_segment_ptr();
    asm volatile("s_load_dwordx2 %0, %1, %2\n\ts_waitcnt lgkmcnt(0)" : "=s"(p) : "s"(ka), "i"(I * 8) : "memory");
#endif
    return p;
}
#define INP(i) inptr<i>()

__device__ const double INVREV[32] = {0.15915494309189535, 0.11934937021124886, 0.089499401608891013, 0.067115083005227255, 0.050329212104487035, 0.037741584717419771, 0.028302195830623399, 0.02122365276477766,
    0.015915494309189534, 0.011934937021124886, 0.0089499401608891024, 0.0067115083005227253, 0.0050329212104487037, 0.0037741584717419772, 0.0028302195830623399, 0.0021223652764777662,
    0.0015915494309189536, 0.0011934937021124885, 0.00089499401608891024, 0.0006711508300522726, 0.00050329212104487033, 0.00037741584717419774, 0.00028302195830623395, 0.00021223652764777661,
    0.00015915494309189535, 0.00011934937021124886, 8.9499401608891018e-05, 6.7115083005227254e-05, 5.0329212104487035e-05, 3.7741584717419777e-05, 2.8302195830623396e-05, 2.1223652764777659e-05};
__device__ __forceinline__ int win_rowmap(int n) {
    if (n < 1024) { const int region = n >> 9, r = n & 511, tile = r >> 8, w = r & 255, blk = w >> 6, d = w & 63, bj = d >> 5, dlo = d & 31; return region * 512 + tile * 256 + bj * 128 + blk * 32 + dlo; }
    if (n < 1536) return n;
    const int cc = n - 1536, isg = cc >> 9, ch = cc & 511, j = ch >> 7, c2 = ch & 127; return 1536 + j * 256 + isg * 128 + c2;
}
template <bool MAP>
__device__ __forceinline__ void p0_transpose_item(const float* W, int K, int N, bf16* WT, const float* gk, LAS float* scr, int item, int lane) {
    const int nblk = N / 32, kb = item / nblk, nb = item % nblk, k0 = 64 * kb, n0 = 32 * nb;
    float wv[32];
#pragma unroll
    for (int i = 0; i < 32; ++i) { const int kk = 2 * i + (lane >> 5); wv[i] = W[(size_t)(k0 + kk) * N + n0 + (lane & 31)]; }
    if (gk) {
#pragma unroll
        for (int i = 0; i < 32; ++i) wv[i] *= gk[k0 + 2 * i + (lane >> 5)]; }
#pragma unroll
    for (int i = 0; i < 32; ++i) { const int kk = 2 * i + (lane >> 5); scr[kk * 33 + (lane & 31)] = wv[i]; }
    LDS_WAIT(); asm volatile("" ::: "memory");
    const int c = lane & 7; const int r0 = MAP ? win_rowmap(n0) : n0;
#pragma unroll
    for (int j = 0; j < 4; ++j) { const int n = (lane >> 3) + 8 * j; const LAS float* s = scr + (8 * c) * 33 + n;
        v4u o; o.x = pk2(s[0 * 33], s[1 * 33]); o.y = pk2(s[2 * 33], s[3 * 33]); o.z = pk2(s[4 * 33], s[5 * 33]); o.w = pk2(s[6 * 33], s[7 * 33]);
        *(GAS v4u*)(WT + (size_t)(r0 + n) * K + k0 + 8 * c) = o; }
    LDS_WAIT(); asm volatile("" ::: "memory");
}
__device__ __forceinline__ void cvt_stream(const float* src, bf16* dst, size_t n8, int gw, int NGW, int lane) {
    for (size_t c = (size_t)gw * 64 + lane; c < n8; c += (size_t)NGW * 64) { const f32x4 a = *(const GAS f32x4*)(src + c * 8), b = *(const GAS f32x4*)(src + c * 8 + 4); *(GAS v4u*)(dst + c * 8) = pk8(a, b); }
}
__device__ __forceinline__ void p0_prologue(Frame& F) {
    const int lane = lane_id();
    LAS float* scr = (LAS float*)(F.lds + F.wave * 16384);
    const int gw = F.vcu * NWAVES + F.wave, NGW = F.G * NWAVES;
    bf16* WIN = (bf16*)(F.ws + WS_WIN); bf16* WOUT = (bf16*)(F.ws + WS_WOUT); bf16* WQ = (bf16*)(F.ws + WS_WQ); bf16* WGATE = (bf16*)(F.ws + WS_WGATE); bf16* WPROJ = (bf16*)(F.ws + WS_WPROJ);
    constexpr int I_IN = (DM / 64) * (IN_COLS / 32), I_OUT = (DM / 64) * (DM / 32), I_Q = (DM / 64) * (QCOLS / 32), I_G = I_OUT, I_P = (PLE_DIM / 64) * (DM / 32);
    constexpr int NITEMS = I_IN + I_OUT + I_Q + I_G + I_P;
    for (int it = gw; it < NITEMS; it += NGW) {
        int r = it;
        if (r < I_IN) { p0_transpose_item<true>(INP(3), DM, IN_COLS, WIN, nullptr, scr, r, lane); continue; } r -= I_IN;
        if (r < I_OUT) { p0_transpose_item<false>(INP(13), DM, DM, WOUT, nullptr, scr, r, lane); continue; } r -= I_OUT;
        if (r < I_Q) { p0_transpose_item<false>(INP(15), DM, QCOLS, WQ, INP(14), scr, r, lane); continue; } r -= I_Q;
        if (r < I_G) { p0_transpose_item<false>(INP(20), DM, DM, WGATE, INP(19), scr, r, lane); continue; } r -= I_G;
        p0_transpose_item<false>(INP(21), PLE_DIM, DM, WPROJ, nullptr, scr, r, lane);
    }
    cvt_stream(INP(16), (bf16*)(F.ws + WS_KEYS), (size_t)2 * 128 * 128 / 8, gw, NGW, lane);
    { const float* ut = INP(17); const float* vt = INP(18); float* SU = (float*)(F.ws + WS_SU); float* SV = (float*)(F.ws + WS_SV);
      for (int r0 = gw; r0 < 2 * NEXP; r0 += 4 * NGW) {
          f32x4 v[4][4];
#pragma unroll
          for (int u = 0; u < 4; ++u) { const int r = r0 + u * NGW; const bool isv = r >= NEXP; const int e = isv ? r - NEXP : r; const float* src = (isv ? vt : ut) + (size_t)e * DM + 16 * lane;
#pragma unroll
              for (int i = 0; i < 4; ++i) v[u][i] = *(const GAS f32x4*)(src + 4 * i); }
#pragma unroll
          for (int u = 0; u < 4; ++u) { const int r = r0 + u * NGW; const bool isv = r >= NEXP; const int e = isv ? r - NEXP : r; float amax = 0.f;
#pragma unroll
              for (int i = 0; i < 4; ++i) amax = fmaxf(amax, fmaxf(fmaxf(__builtin_fabsf(v[u][i][0]), __builtin_fabsf(v[u][i][1])), fmaxf(__builtin_fabsf(v[u][i][2]), __builtin_fabsf(v[u][i][3]))));
#pragma unroll
              for (int o = 1; o < 64; o <<= 1) amax = fmaxf(amax, __shfl_xor(amax, o));
              const float inv = 127.f / fmaxf(amax, 1e-30f); v4u w;
#pragma unroll
              for (int i = 0; i < 4; ++i) { const int a = (int)__builtin_rintf(v[u][i][0] * inv), b = (int)__builtin_rintf(v[u][i][1] * inv), c = (int)__builtin_rintf(v[u][i][2] * inv), d = (int)__builtin_rintf(v[u][i][3] * inv);
                  w[i] = (unsigned)(a & 0xff) | ((unsigned)(b & 0xff) << 8) | ((unsigned)(c & 0xff) << 16) | ((unsigned)d << 24); }
              *(GAS v4u*)(F.ws + (isv ? WS_VT : WS_UT) + ((size_t)(lane >> 3) * NEXP + e) * 128 + 16 * (lane & 7)) = w;
              if (lane == 0) (isv ? SV : SU)[e] = amax * (1.f / 127.f); } } }
    cvt_stream(INP(1), (bf16*)(F.ws + WS_PB), (size_t)M * PLE_DIM / 8, gw, NGW, lane);
    { float* rc = (float*)(F.ws + WS_ROPEC); float* rs = (float*)(F.ws + WS_ROPES);
      for (int idx = gw * 64 + lane; idx < SEQ * 32; idx += NGW * 64) { const int pos = idx >> 5, i = idx & 31; const double rev = (double)pos * INVREV[i]; const float fr = (float)(rev - __builtin_floor(rev));
          rc[idx] = __builtin_amdgcn_cosf(fr); rs[idx] = __builtin_amdgcn_sinf(fr); } }
    { const float* x = INP(0); const float* g = INP(2); bf16* XN = (bf16*)(F.ws + WS_XN);
      f32x4 gv[4];
#pragma unroll
      for (int j = 0; j < 4; ++j) gv[j] = ((const GAS f32x4*)g)[64 * j + lane];
      for (int m0 = gw; m0 < M; m0 += 4 * NGW) {
          f32x4 v[4][4];
#pragma unroll
          for (int u = 0; u < 4; ++u) { const GAS f32x4* xr = (const GAS f32x4*)(x + (size_t)(m0 + u * NGW) * DM) + lane;
#pragma unroll
              for (int j = 0; j < 4; ++j) v[u][j] = xr[64 * j]; }
#pragma unroll
          for (int u = 0; u < 4; ++u) { float s2 = 0.f;
#pragma unroll
              for (int j = 0; j < 4; ++j) s2 += (v[u][j].x * v[u][j].x + v[u][j].y * v[u][j].y) + (v[u][j].z * v[u][j].z + v[u][j].w * v[u][j].w);
              const float rstd = rsqrtf(wave_sum(s2) * (1.f / DM) + EPS);
              GAS unsigned long long* o8 = (GAS unsigned long long*)(XN + (size_t)(m0 + u * NGW) * DM) + lane;
#pragma unroll
              for (int j = 0; j < 4; ++j) { const f32x4 w = v[u][j] * rstd * gv[j]; o8[64 * j] = (unsigned long long)pk2(w.x, w.y) | ((unsigned long long)pk2(w.z, w.w) << 32); } } } }
}

struct AttnOrder {
    int vcu;
    __device__ __forceinline__ bool next(int i, attn_body::AttnUnit& u) const { if (i >= 8) return false; const int s = vcu & 7; u.bh = (vcu >> 5) * 16 + ((vcu >> 3) & 3) * 4 + (i & 3); u.qb = (i < 4) ? 15 - s : s; return true; }
    __device__ __forceinline__ void a_ready(const attn_body::AttnUnit&) const {}
    __device__ __forceinline__ void done(const attn_body::AttnUnit&) const {}
};
__device__ __forceinline__ void p2_attention(Frame& F) {
    { const attn_body::AttnTensors AT{(const attn_body::bf16*)(F.ws + WS_QO), (const attn_body::bf16*)(F.ws + WS_K), (const attn_body::bf16*)(F.ws + WS_V), (attn_body::bf16*)(F.ws + WS_QO)};
      const AttnOrder S{F.vcu};
      attn_body::attn_phase<AttnOrder>((char*)F.ldsg, AT, S, F.wave * 64 + lane_id()); }
    VM_WAIT(); __syncthreads(); STAMP(12);
    const int lane = lane_id();
    const float s1 = wave_sum(INP(4)[lane] * INP(5)[lane]), s2 = wave_sum(INP(6)[lane] * INP(7)[lane]);
    const float lam = __expf(s1) - __expf(s2) + 0.2f;
    const float* sg = INP(8); const float g0 = sg[2 * lane] * 0.8f, g1 = sg[2 * lane + 1] * 0.8f;
    const unsigned* O32 = (const unsigned*)(F.ws + WS_QO); unsigned* A2 = (unsigned*)(F.ws + WS_XN);
    const int b = F.vcu >> 5, h = (F.vcu >> 3) & 3, s = F.vcu & 7;
    for (int i = 0; i < 2; ++i) { const int qb = (i == 0) ? 15 - s : s;
        const size_t rbase = (size_t)b * SEQ + (size_t)qb * 256 + F.wave * 32;
        for (int r = 0; r < 32; r += 8) {
            unsigned w0[8], w1[8];
#pragma unroll
            for (int u = 0; u < 8; ++u) { const size_t row = rbase + r + u; w0[u] = __builtin_nontemporal_load(O32 + row * 512 + (h * 4 + 0 + (lane >> 5)) * 32 + (lane & 31)); w1[u] = __builtin_nontemporal_load(O32 + row * 512 + (h * 4 + 2 + (lane >> 5)) * 32 + (lane & 31)); }
#pragma unroll
            for (int u = 0; u < 8; ++u) { const size_t row = rbase + r + u;
                const float d0 = bflo(w0[u]) - lam * bflo(w1[u]), d1 = bfhi(w0[u]) - lam * bfhi(w1[u]);
                const float rstd = rsqrtf(wave_sum(d0 * d0 + d1 * d1) * (1.f / 128.f) + EPS);
                A2[row * 512 + h * 64 + lane] = pk2(d0 * rstd * g0, d1 * rstd * g1); } } }
}
__device__ __forceinline__ void p2_conv(Frame& F) {
    const bf16* Ub = (const bf16*)(F.ws + WS_U); bf16* A2 = (bf16*)(F.ws + WS_XN);
    LAS float* yl = (LAS float*)F.lds;
    const int lane = lane_id(); const int c = F.wave * 64 + lane;
    float w[31];
    { const float* cw = INP(9);
#pragma unroll
      for (int j = 0; j < 31; ++j) w[j] = cw[j * 512 + c]; }
    const float bias = INP(10)[c];
    const float* lng = INP(11); const float* lnb = INP(12);
    const f32x4 lg0 = *(const f32x4*)(lng + 8 * lane), lg1 = *(const f32x4*)(lng + 8 * lane + 4), lb0 = *(const f32x4*)(lnb + 8 * lane), lb1 = *(const f32x4*)(lnb + 8 * lane + 4);
    for (int tile = F.vcu; tile < M / 32; tile += F.G) {
        const int t0 = tile * 32, pos0 = t0 & (SEQ - 1);
        LAS bf16* ul = (LAS bf16*)(F.lds + 65536);
#pragma unroll
        for (int q = 0; q < 8; ++q) { const int ci = c + 512 * q; if (ci < 62 * 64) { const int r = ci >> 6, ch = ci & 63; const int p = pos0 - 30 + r;
            v4u w = {0u, 0u, 0u, 0u}; if (p >= 0) w = *(const GAS v4u*)(Ub + (size_t)(t0 - 30 + r) * 512 + ch * 8);
            *(LAS v4u*)(ul + r * 512 + ch * 8) = w; } }
        __syncthreads();
        float xin[62];
#pragma unroll
        for (int r = 0; r < 62; ++r) xin[r] = __uint_as_float((unsigned)ul[r * 512 + c] << 16);
#pragma unroll
        for (int t = 0; t < 32; ++t) { float y = bias;
#pragma unroll
            for (int j = 0; j < 31; ++j) y += w[j] * xin[t + j];
            yl[t * 512 + c] = y; }
        __syncthreads();
#pragma unroll
        for (int q = 0; q < 4; ++q) { const int t = F.wave * 4 + q;
            const f32x4 a = *(const LAS f32x4*)(yl + t * 512 + 8 * lane), b2 = *(const LAS f32x4*)(yl + t * 512 + 8 * lane + 4);
            const float mean = wave_sum((a[0] + a[1]) + (a[2] + a[3]) + (b2[0] + b2[1]) + (b2[2] + b2[3])) * (1.f / 512.f);
            const f32x4 da = a - mean, db = b2 - mean;
            const float var = wave_sum((da[0] * da[0] + da[1] * da[1]) + (da[2] * da[2] + da[3] * da[3]) + (db[0] * db[0] + db[1] * db[1]) + (db[2] * db[2] + db[3] * db[3])) * (1.f / 512.f);
            const float rstd = rsqrtf(var + EPS);
            f32x4 oa = da * rstd * lg0 + lb0, ob = db * rstd * lg1 + lb1;
#pragma unroll
            for (int e = 0; e < 4; ++e) { oa[e] = oa[e] * __builtin_amdgcn_rcpf(1.0f + __expf(-oa[e])); ob[e] = ob[e] * __builtin_amdgcn_rcpf(1.0f + __expf(-ob[e])); }
            *(GAS v4u*)(A2 + (size_t)(t0 + t) * 1024 + 512 + 8 * lane) = pk8(oa, ob); }
        __syncthreads();
    }
}
__device__ __forceinline__ int crow16(int r, int hi) { return (r & 3) + 8 * (r >> 2) + 4 * hi; }
__device__ __forceinline__ unsigned enc_key(float f, unsigned tag, unsigned mask) { unsigned u = __float_as_uint(f); u = (u & 0x80000000u) ? ~u : (u | 0x80000000u); return (u & ~mask) | tag; }
__device__ __forceinline__ float dec_key(unsigned k, unsigned mask) { unsigned u = k & ~mask; u = (u & 0x80000000u) ? (u & 0x7fffffffu) : ~u; return __uint_as_float(u); }
__device__ __forceinline__ void ce_desc(unsigned& a, unsigned& b) { const unsigned mx = a > b ? a : b, mn = a > b ? b : a; a = mx; b = mn; }
template <int K, int J> __device__ __forceinline__ void bitonic_stage16(unsigned (&a)[16]) {
#pragma unroll
    for (int i = 0; i < 16; ++i) { const int l = i ^ J; if (l > i) { if ((i & K) == 0) ce_desc(a[i], a[l]); else ce_desc(a[l], a[i]); } }
}
__device__ __forceinline__ void sort16_desc(unsigned (&a)[16]) {
    bitonic_stage16<2, 1>(a); bitonic_stage16<4, 2>(a); bitonic_stage16<4, 1>(a); bitonic_stage16<8, 4>(a); bitonic_stage16<8, 2>(a); bitonic_stage16<8, 1>(a);
    bitonic_stage16<16, 8>(a); bitonic_stage16<16, 4>(a); bitonic_stage16<16, 2>(a); bitonic_stage16<16, 1>(a);
}
__device__ __forceinline__ void merge16_desc(unsigned (&a)[16], const unsigned (&b)[16]) {
#pragma unroll
    for (int i = 0; i < 16; ++i) a[i] = a[i] > b[15 - i] ? a[i] : b[15 - i];
    bitonic_stage16<16, 8>(a); bitonic_stage16<16, 4>(a); bitonic_stage16<16, 2>(a); bitonic_stage16<16, 1>(a);
}
__device__ __forceinline__ void top16_of_64(unsigned (&k)[4][16]) {
    sort16_desc(k[0]); sort16_desc(k[1]); sort16_desc(k[2]); sort16_desc(k[3]);
    merge16_desc(k[0], k[1]); merge16_desc(k[2], k[3]); merge16_desc(k[0], k[2]);
}
__host__ __device__ constexpr int cand_i(int s) { int c = 0; for (int i = 0; i < 16; ++i) { const int nj = 16 / (i + 1); if (s < c + nj) return i; c += nj; } return -1; }
__host__ __device__ constexpr int cand_j(int s) { int c = 0; for (int i = 0; i < 16; ++i) { const int nj = 16 / (i + 1); if (s < c + nj) return s - c; c += nj; } return -1; }
template <int S> __device__ __forceinline__ void cand_fill(unsigned (&c)[4][16], const float (&v0)[16], const float (&v1)[16]) {
    if constexpr (S < 64) { constexpr int i = cand_i(S), j = cand_j(S);
        if constexpr (i >= 0) c[S >> 4][S & 15] = enc_key(v0[i] + v1[j], 255u - (unsigned)(i * 16 + j), 255u); else c[S >> 4][S & 15] = 0u;
        cand_fill<S + 1>(c, v0, v1); }
}
__device__ __forceinline__ float gelu_exact(float v) {
    const float av = __builtin_fabsf(v), d = av * 0.2316418882f + 1.0f, t = __builtin_amdgcn_rcpf(d);
    float q = t * 0.5307027145f + (-0.7265760135f); q = q * t + 0.7107068705f; q = q * t + (-0.142248368f); q = q * t + 0.127414796f; q = q * t;
    const float e = __builtin_amdgcn_exp2f((v * v) * (-0.72134752044f)); const float m = v * (q * e); return v < 0.f ? m : v - m;
}
typedef float f32x2 __attribute__((ext_vector_type(2)));
__device__ __forceinline__ float ub0(unsigned w) { return (float)(w & 0xffu); }
__device__ __forceinline__ float ub1(unsigned w) { return (float)((w >> 8) & 0xffu); }
__device__ __forceinline__ float ub2(unsigned w) { return (float)((w >> 16) & 0xffu); }
__device__ __forceinline__ float ub3(unsigned w) { return (float)(w >> 24); }
__device__ __forceinline__ float wave_max(float v) {
#pragma unroll
    for (int o = 1; o < 64; o <<= 1) v = fmaxf(v, __shfl_xor(v, o));
    return v;
}
__device__ __forceinline__ int reduce8(const int (&p)[8], int lane) {
    const bool b0 = lane & 1, b1 = lane & 2, b2 = lane & 4;
    int q[4], r[2];
#pragma unroll
    for (int i = 0; i < 4; ++i) { const int keep = b0 ? p[2 * i + 1] : p[2 * i], send = b0 ? p[2 * i] : p[2 * i + 1]; q[i] = keep + __builtin_amdgcn_update_dpp(0, send, 0xB1, 0xF, 0xF, true); }
#pragma unroll
    for (int i = 0; i < 2; ++i) { const int keep = b1 ? q[2 * i + 1] : q[2 * i], send = b1 ? q[2 * i] : q[2 * i + 1]; r[i] = keep + __builtin_amdgcn_update_dpp(0, send, 0x4E, 0xF, 0xF, true); }
    int s; { const int keep = b2 ? r[1] : r[0], send = b2 ? r[0] : r[1]; s = keep + __builtin_amdgcn_ds_swizzle(send, 0x101F); }
    s += __builtin_amdgcn_ds_swizzle(s, 0x201F); s += __builtin_amdgcn_ds_swizzle(s, 0x401F);
    { const auto rr = __builtin_amdgcn_permlane32_swap((unsigned)s, (unsigned)s, false, false); s = (int)rr[0] + (int)rr[1]; }
    return s;
}
constexpr int P5_TOK = 32;
constexpr int P5_KEYS = 0, P5_LS = 65536, P5_EID = 65536 + 33792, P5_GATE = 65536 + 33792 + 16384;
__device__ __forceinline__ void p5a_topk(Frame& F) {
    const bf16* QP = (const bf16*)(F.ws + WS_QP); const bf16* KEYS = (const bf16*)(F.ws + WS_KEYS);
    LAS unsigned* lsc = (LAS unsigned*)(F.lds + P5_LS) + (F.wave * 32 + (lane_id() & 31)) * 33; LAS unsigned* eidL = (LAS unsigned*)(F.lds + P5_EID); LAS float* gateL = (LAS float*)(F.lds + P5_GATE);
    const int lane = lane_id(), tid = F.wave * 64 + lane, r32 = lane & 31, hi = lane >> 5, h = F.wave;
    const float* gffn = INP(14);
#pragma unroll
    for (int i = 0; i < 8; ++i) { const int q = tid + 512 * i, row = q >> 4, ch = q & 15; *(LAS v4u*)(F.lds + P5_KEYS + row * 256 + ((ch ^ (row & 15)) << 4)) = *(const GAS v4u*)(KEYS + row * 128 + ch * 8); }
    __syncthreads();
    const LAS unsigned char* kl = F.lds + P5_KEYS + r32 * 256;
    for (int tile = F.vcu; tile < M / P5_TOK; tile += F.G) {
        const size_t t0 = (size_t)tile * P5_TOK;
        float sv[2][16];
#pragma unroll
        for (int c = 0; c < 2; ++c) {
            bf16x8 qf[8];
#pragma unroll
            for (int ks = 0; ks < 8; ++ks) qf[ks] = *(const bf16x8*)(QP + (t0 + r32) * QCOLS + h * 256 + c * 128 + ks * 16 + hi * 8);
            unsigned key[4][16];
#pragma unroll
            for (int nb = 0; nb < 4; ++nb) { f32x16 acc = {}; asm volatile("" ::: "memory");
#pragma unroll
                for (int ks = 0; ks < 8; ++ks) { const bf16x8 kf = *(const LAS bf16x8*)(kl + (c * 128 + nb * 32) * 256 + (((ks * 2 + hi) ^ (r32 & 15)) << 4)); acc = __builtin_amdgcn_mfma_f32_32x32x16_bf16(kf, qf[ks], acc, 0, 0, 0); }
#pragma unroll
                for (int r = 0; r < 16; ++r) key[nb][r] = enc_key(acc[r], 127u - (unsigned)(nb * 32 + crow16(r, hi)), 127u); }
            top16_of_64(key);
            unsigned other[16];
#pragma unroll
            for (int i = 0; i < 16; ++i) other[i] = __shfl_xor(key[0][i], 32);
            merge16_desc(key[0], other);
#pragma unroll
            for (int i = 0; i < 16; ++i) { sv[c][i] = dec_key(key[0][i], 127u); if (hi == 0) lsc[c * 16 + i] = key[0][i]; }
        }
        asm volatile("" ::: "memory");
        unsigned cand[4][16];
        cand_fill<0>(cand, sv[0], sv[1]);
        top16_of_64(cand);
        LDS_WAIT();
        { float wv[16]; float wsum = 0.f; const float mx = dec_key(cand[0][0], 255u);
#pragma unroll
          for (int k = 0; k < 16; ++k) { wv[k] = __expf(dec_key(cand[0][k], 255u) - mx); wsum += wv[k]; }
          const float rs = 1.0f / wsum;
#pragma unroll
          for (int k = 0; k < 16; ++k) { const unsigned id = 255u - (cand[0][k] & 255u); const unsigned k0 = lsc[id >> 4], k1 = lsc[16 + (id & 15u)];
              const unsigned e = (127u - (k0 & 127u)) * 128u + (127u - (k1 & 127u));
              if (hi == 0) { eidL[r32 * 128 + h * 16 + k] = e; gateL[r32 * 128 + h * 16 + k] = wv[k] * rs; } } }
        __syncthreads();
        { const int token = tid >> 4, seg = tid & 15; const LAS unsigned* es = eidL + token * 128 + seg * 8; const LAS float* gs = gateL + token * 128 + seg * 8;
          v4u w; w.x = es[0] | (es[1] << 16); w.y = es[2] | (es[3] << 16); w.z = es[4] | (es[5] << 16); w.w = es[6] | (es[7] << 16);
          *(GAS v4u*)(F.ws + WS_EID + (t0 + token) * 256 + seg * 16) = w;
          *(GAS f32x4*)(F.ws + WS_GATE + (t0 + token) * 512 + seg * 32) = *(const LAS f32x4*)gs; *(GAS f32x4*)(F.ws + WS_GATE + (t0 + token) * 512 + seg * 32 + 16) = *(const LAS f32x4*)(gs + 4); }
        { f32x4 hv[4][4];
#pragma unroll
          for (int j = 0; j < 4; ++j) { const bf16* hrow = (const bf16*)F.out + (t0 + F.wave * 4 + j) * DM + 16 * lane;
              const v4u w0 = *(const GAS v4u*)hrow, w1 = *(const GAS v4u*)(hrow + 8);
              hv[j][0] = (f32x4){bflo(w0.x), bfhi(w0.x), bflo(w0.y), bfhi(w0.y)}; hv[j][1] = (f32x4){bflo(w0.z), bfhi(w0.z), bflo(w0.w), bfhi(w0.w)};
              hv[j][2] = (f32x4){bflo(w1.x), bfhi(w1.x), bflo(w1.y), bfhi(w1.y)}; hv[j][3] = (f32x4){bflo(w1.z), bfhi(w1.z), bflo(w1.w), bfhi(w1.w)}; }
          f32x4 gv[4];
#pragma unroll
          for (int i = 0; i < 4; ++i) gv[i] = *(const f32x4*)(gffn + 16 * lane + 4 * i);
#pragma unroll
          for (int j = 0; j < 4; ++j) { const size_t tok = t0 + F.wave * 4 + j;
            const float rstd1 = rsqrtf(wave_sum(dot4s_(hv[j][0]) + dot4s_(hv[j][1]) + dot4s_(hv[j][2]) + dot4s_(hv[j][3])) * (1.f / DM) + EPS);
            f32x4 mv[4]; float amax = 0.f;
#pragma unroll
            for (int i = 0; i < 4; ++i) { mv[i] = hv[j][i] * rstd1 * gv[i];
                amax = fmaxf(amax, fmaxf(fmaxf(__builtin_fabsf(mv[i][0]), __builtin_fabsf(mv[i][1])), fmaxf(__builtin_fabsf(mv[i][2]), __builtin_fabsf(mv[i][3])))); }
            amax = wave_max(amax); const float inv = 127.f / fmaxf(amax, 1e-30f); v4u qm;
#pragma unroll
            for (int i = 0; i < 4; ++i) { const int a = (int)__builtin_rintf(mv[i][0] * inv), b = (int)__builtin_rintf(mv[i][1] * inv), c = (int)__builtin_rintf(mv[i][2] * inv), d = (int)__builtin_rintf(mv[i][3] * inv);
                qm[i] = (unsigned)(a & 0xff) | ((unsigned)(b & 0xff) << 8) | ((unsigned)(c & 0xff) << 16) | ((unsigned)d << 24); }
            *(GAS v4u*)(F.ws + WS_QM + ((size_t)(lane >> 3) * M + tok) * 128 + 16 * (lane & 7)) = qm;
            if (lane == 0) ((float*)(F.ws + WS_SM))[tok] = amax * (1.f / 127.f);
          } }
        __syncthreads();
    }
}
__device__ __forceinline__ int xl1(int v) { return __builtin_amdgcn_update_dpp(0, v, 0xB1, 0xF, 0xF, true); }
__device__ __forceinline__ int xl2(int v) { return __builtin_amdgcn_update_dpp(0, v, 0x4E, 0xF, 0xF, true); }
__device__ __forceinline__ int xl4(int v) { return __builtin_amdgcn_ds_swizzle(v, 0x101F); }
__device__ __forceinline__ int xl8(int v) { return __builtin_amdgcn_ds_swizzle(v, 0x201F); }
__device__ __forceinline__ int xl16(int v) { return __builtin_amdgcn_ds_swizzle(v, 0x401F); }
__device__ __forceinline__ int xl32(int v, bool hi) { const auto rr = __builtin_amdgcn_permlane32_swap((unsigned)v, (unsigned)v, false, false); return (int)(hi ? rr[0] : rr[1]); }
__device__ __forceinline__ float fxl8(float v) { return __int_as_float(xl8(__float_as_int(v))); }
__device__ __forceinline__ float fxl16(float v) { return __int_as_float(xl16(__float_as_int(v))); }
__device__ __forceinline__ float fxl32(float v, bool hi) { return __int_as_float(xl32(__float_as_int(v), hi)); }
#define TSTEP(dst, src, n, c, XF) _Pragma("unroll") for (int ni_ = 0; ni_ < (n) / 2; ++ni_) { const int i_ = (ni_ & 1) | ((ni_ >> 1) << 2); const auto lo_ = src[i_], hi_ = src[i_ + 2]; dst[ni_] = ((c) ? hi_ : lo_) + XF((c) ? lo_ : hi_); }

#define ASM_LD16(dst, ptr) asm volatile("global_load_dwordx4 %0, %1, off" : "+v"(dst) : "v"(ptr) : "memory")
#define ASM_LD8(dst, ptr) asm volatile("global_load_dwordx2 %0, %1, off" : "+v"(dst) : "v"(ptr) : "memory")
#define ASM_LD4(dst, ptr) asm volatile("global_load_dword %0, %1, off" : "+v"(dst) : "v"(ptr) : "memory")
#define ASM_WAIT4(N, a, b, c, d) asm volatile("s_waitcnt vmcnt(" #N ")" : "+v"(a), "+v"(b), "+v"(c), "+v"(d) :: "memory")
#define ASM_WAIT5(N, a, b, c, d, e) asm volatile("s_waitcnt vmcnt(" #N ")" : "+v"(a), "+v"(b), "+v"(c), "+v"(d), "+v"(e) :: "memory")
__device__ __forceinline__ void p5b_udot(Frame& F) {
    const int lane = lane_id(), g = lane >> 3, s = lane & 7;
    const int x = blockIdx.x & 7, rk = blockIdx.x >> 3, nrk = F.G >> 3;
    const unsigned char* UTs = F.ws + WS_UT + (size_t)x * NEXP * 128 + 16 * s; const unsigned char* QMs = F.ws + WS_QM + (size_t)x * M * 128 + 16 * s; const unsigned char* EIDs = F.ws + WS_EID + 32 * g;
    int* AP = (int*)(F.ws + WS_APART) + (size_t)x * M * 128 + 2 * lane;
    const bool c0 = s & 1, c1 = s & 2, c2 = s & 4;
    const int nT = M / nrk; LAS unsigned* qctr = (LAS unsigned*)(F.lds + MISC_OFF) + 62;
#define P5_PULL(jv, tv) do { unsigned j_ = 0; if (lane == 0) j_ = __hip_atomic_fetch_add(qctr, 1u, __ATOMIC_RELAXED, __HIP_MEMORY_SCOPE_WORKGROUP); jv = (int)__builtin_amdgcn_readfirstlane(j_); tv = rk + nrk * (jv < nT ? jv : nT - 1); } while (0)
#define P5B_E(i, E0, E1) ((((i) & 1) ? (((i) < 8 ? E0[(i) >> 1] : E1[((i) - 8) >> 1]) >> 16) : (((i) < 8 ? E0[(i) >> 1] : E1[((i) - 8) >> 1]) & 0xffffu)))
#define P5B_LDMETA(E0, E1, Q, tq_, te_) do { ASM_LD16(E0, EIDs + (size_t)(te_) * 256); ASM_LD16(E1, EIDs + (size_t)(te_) * 256 + 16); ASM_LD16(Q, QMs + (size_t)(tq_) * 128); } while (0)
#define P5B_ITER(RR, E0, E1, Q, tcur, tq, te) do { int p_[16]; \
        asm volatile("s_waitcnt vmcnt(19)" : "+v"(E0), "+v"(E1), "+v"(Q) :: "memory"); \
        _Pragma("unroll") for (int b = 0; b < 4; ++b) { \
            ASM_WAIT4(34, RR[4 * b], RR[4 * b + 1], RR[4 * b + 2], RR[4 * b + 3]); __builtin_amdgcn_sched_barrier(0); \
            _Pragma("unroll") for (int j = 0; j < 4; ++j) { const int i = 4 * b + j; p_[i] = __builtin_amdgcn_sdot4((int)RR[i].x, (int)Q.x, __builtin_amdgcn_sdot4((int)RR[i].y, (int)Q.y, __builtin_amdgcn_sdot4((int)RR[i].z, (int)Q.z, __builtin_amdgcn_sdot4((int)RR[i].w, (int)Q.w, 0, false), false), false), false); } \
            __builtin_amdgcn_sched_barrier(0); \
            _Pragma("unroll") for (int j = 0; j < 4; ++j) { const int i = 4 * b + j; ASM_LD16(RR[i], UTs + (size_t)P5B_E(i, E0, E1) * 128); } \
            __builtin_amdgcn_sched_barrier(0); } \
        int a8_[8], a4_[4], a2_[2]; TSTEP(a8_, p_, 16, c0, xl1) TSTEP(a4_, a8_, 8, c1, xl2) TSTEP(a2_, a4_, 4, c2, xl4) \
        *(GAS unsigned long long*)(AP + (size_t)(tcur) * 128) = (unsigned long long)(unsigned)a2_[0] | ((unsigned long long)(unsigned)a2_[1] << 32); \
        __builtin_amdgcn_sched_barrier(0); P5B_LDMETA(E0, E1, Q, tq, te); __builtin_amdgcn_sched_barrier(0); } while (0)
    int j0, j1, j2, j3, j4, j5, p0, p1, p2, p3, p4, p5;
    P5_PULL(j0, p0); P5_PULL(j1, p1); P5_PULL(j2, p2); P5_PULL(j3, p3);
    v4u RA[16], RB[16], eA0, eA1, qA, eB0, eB1, qB;
    { const v4u e0 = *(const GAS v4u*)(EIDs + (size_t)p0 * 256), e1 = *(const GAS v4u*)(EIDs + (size_t)p0 * 256 + 16), f0 = *(const GAS v4u*)(EIDs + (size_t)p1 * 256), f1 = *(const GAS v4u*)(EIDs + (size_t)p1 * 256 + 16);
      eA0 = e0; eA1 = e1; qA = e0; eB0 = e0; eB1 = e1; qB = e0;
#pragma unroll
      for (int i = 0; i < 16; ++i) { RA[i] = e0; RB[i] = e0; }
      asm volatile("s_waitcnt vmcnt(0)" ::: "memory");
#pragma unroll
      for (int i = 0; i < 16; ++i) ASM_LD16(RA[i], UTs + (size_t)P5B_E(i, e0, e1) * 128);
#pragma unroll
      for (int i = 0; i < 16; ++i) ASM_LD16(RB[i], UTs + (size_t)P5B_E(i, f0, f1) * 128); }
    P5B_LDMETA(eA0, eA1, qA, p0, p2); P5B_LDMETA(eB0, eB1, qB, p1, p3);
    asm volatile("s_waitcnt vmcnt(0)" ::: "memory");
#pragma unroll 1
    while (j0 < nT) {
        P5_PULL(j4, p4); P5B_ITER(RA, eA0, eA1, qA, p0, p2, p4);
        P5_PULL(j5, p5); P5B_ITER(RB, eB0, eB1, qB, p1, p3, p5);
        j0 = j2; j1 = j3; j2 = j4; j3 = j5; p0 = p2; p1 = p3; p2 = p4; p3 = p5;
    }
    asm volatile("s_waitcnt vmcnt(0)" ::: "memory");
#undef P5B_E
#undef P5B_LDMETA
#undef P5B_ITER
}
__device__ __forceinline__ void p5b2_gelu(Frame& F) {
    const int lane = lane_id(); const int gw = F.vcu * NWAVES + F.wave, NGW = F.G * NWAVES;
    const float* SU = (const float*)(F.ws + WS_SU); const float* SV = (const float*)(F.ws + WS_SV); const float* SM = (const float*)(F.ws + WS_SM);
    for (int t = gw; t < M; t += NGW) {
        int a0 = 0, a1 = 0;
#pragma unroll
        for (int xx = 0; xx < 8; ++xx) { const unsigned long long w = *(const GAS unsigned long long*)((const int*)(F.ws + WS_APART) + (size_t)xx * M * 128 + (size_t)t * 128 + 2 * lane); a0 += (int)(unsigned)w; a1 += (int)(unsigned)(w >> 32); }
        const unsigned ew = *(const GAS unsigned*)(F.ws + WS_EID + (size_t)t * 256 + 4 * lane); const unsigned e0 = ew & 0xffffu, e1 = ew >> 16;
        const f32x2 gt = *(const GAS f32x2*)(F.ws + WS_GATE + (size_t)t * 512 + 8 * lane); const float sm = SM[t];
        const float h0 = gelu_exact((float)a0 * sm * SU[e0]) * gt[0] * SV[e0], h1 = gelu_exact((float)a1 * sm * SU[e1]) * gt[1] * SV[e1];
        const float hmax = wave_max(fmaxf(__builtin_fabsf(h0), __builtin_fabsf(h1))); const float inv = 127.f / fmaxf(hmax, 1e-30f);
        const int q0 = (int)__builtin_rintf(h0 * inv), q1 = (int)__builtin_rintf(h1 * inv);
        *(GAS unsigned short*)(F.ws + WS_HQ + (size_t)t * 128 + 2 * lane) = (unsigned short)((q0 & 0xff) | ((q1 & 0xff) << 8));
        if (lane == 0) ((float*)(F.ws + WS_HS))[t] = hmax * (1.f / 127.f);
    }
}
__device__ __forceinline__ void p5c_vacc(Frame& F) {
    const int lane = lane_id(), g = lane >> 3, s = lane & 7;
    const int x = blockIdx.x & 7, rk = blockIdx.x >> 3, nrk = F.G >> 3;
    const unsigned char* VTs = F.ws + WS_VT + (size_t)x * NEXP * 128 + 16 * s; const unsigned char* EIDs = F.ws + WS_EID + 32 * g; const unsigned char* HQs = F.ws + WS_HQ + 16 * g;
    const float* SH = (const float*)(F.ws + WS_HS); float* ssq2 = (float*)(F.ws + WS_SSQ2); unsigned* H2B = (unsigned*)(F.ws + WS_XN2);
    const int dcol = 128 * x + 16 * s + 2 * g;
    const bool c3 = g & 1, c4 = g & 2, c5 = g & 4; const bool hi32 = lane >= 32;
    const int nT = M / nrk; LAS unsigned* qctr = (LAS unsigned*)(F.lds + MISC_OFF) + 63;
#define P5C_E(i, E0, E1) ((((i) & 1) ? (((i) < 8 ? E0[(i) >> 1] : E1[((i) - 8) >> 1]) >> 16) : (((i) < 8 ? E0[(i) >> 1] : E1[((i) - 8) >> 1]) & 0xffffu)))
#define P5C_LDMETA(E0, E1, HB, H1, SHv, tq_, te_) do { ASM_LD16(E0, EIDs + (size_t)(te_) * 256); ASM_LD16(E1, EIDs + (size_t)(te_) * 256 + 16); \
        ASM_LD16(HB, HQs + (size_t)(tq_) * 128); ASM_LD4(H1, (const unsigned*)F.out + (((size_t)(tq_) * DM + dcol) >> 1)); ASM_LD4(SHv, SH + (tq_)); } while (0)
#define IX32(v) xl32(v, hi32)
#define P5C_ITER(RR, E0, E1, HB, H1, SHv, tcur, vcur, tq, te) do { int yi_[16]; _Pragma("unroll") for (int i = 0; i < 16; ++i) yi_[i] = 0; \
        asm volatile("s_waitcnt vmcnt(21)" : "+v"(E0), "+v"(E1), "+v"(HB), "+v"(H1), "+v"(SHv) :: "memory"); \
        _Pragma("unroll") for (int b = 0; b < 4; ++b) { const int hb_ = (int)HB[b]; \
            ASM_WAIT4(38, RR[4 * b], RR[4 * b + 1], RR[4 * b + 2], RR[4 * b + 3]); __builtin_amdgcn_sched_barrier(0); \
            _Pragma("unroll") for (int c = 0; c < 4; ++c) { \
                const unsigned ra_ = RR[4 * b][c], rb_ = RR[4 * b + 1][c], rc_ = RR[4 * b + 2][c], rd_ = RR[4 * b + 3][c]; \
                const unsigned p_ = __builtin_amdgcn_perm(rb_, ra_, 0x05010400u), q_ = __builtin_amdgcn_perm(rb_, ra_, 0x07030602u), r_ = __builtin_amdgcn_perm(rd_, rc_, 0x05010400u), s_ = __builtin_amdgcn_perm(rd_, rc_, 0x07030602u); \
                yi_[4 * c + 0] = __builtin_amdgcn_sdot4((int)__builtin_amdgcn_perm(r_, p_, 0x05040100u), hb_, yi_[4 * c + 0], false); yi_[4 * c + 1] = __builtin_amdgcn_sdot4((int)__builtin_amdgcn_perm(r_, p_, 0x07060302u), hb_, yi_[4 * c + 1], false); \
                yi_[4 * c + 2] = __builtin_amdgcn_sdot4((int)__builtin_amdgcn_perm(s_, q_, 0x05040100u), hb_, yi_[4 * c + 2], false); yi_[4 * c + 3] = __builtin_amdgcn_sdot4((int)__builtin_amdgcn_perm(s_, q_, 0x07060302u), hb_, yi_[4 * c + 3], false); } \
            __builtin_amdgcn_sched_barrier(0); \
            _Pragma("unroll") for (int j = 0; j < 4; ++j) { const int i = 4 * b + j; ASM_LD16(RR[i], VTs + (size_t)P5C_E(i, E0, E1) * 128); } \
            __builtin_amdgcn_sched_barrier(0); } \
        int y8_[8], y4_[4], y2_[2]; TSTEP(y8_, yi_, 16, c3, xl8) TSTEP(y4_, y8_, 8, c4, xl16) TSTEP(y2_, y4_, 4, c5, IX32) \
        const f32x2 n_ = {bflo(H1) + SHv * (float)y2_[0], bfhi(H1) + SHv * (float)y2_[1]}; \
        const float ss_ = wave_sum(n_[0] * n_[0] + n_[1] * n_[1]); \
        if (vcur) { H2B[((size_t)(tcur) * DM + dcol) >> 1] = pk2(n_[0], n_[1]); if (lane == 0) ssq2[(size_t)(tcur) * 8 + x] = ss_; } \
        __builtin_amdgcn_sched_barrier(0); P5C_LDMETA(E0, E1, HB, H1, SHv, tq, te); __builtin_amdgcn_sched_barrier(0); } while (0)
    int j0, j1, j2, j3, j4, j5, p0, p1, p2, p3, p4, p5;
    P5_PULL(j0, p0); P5_PULL(j1, p1); P5_PULL(j2, p2); P5_PULL(j3, p3);
    v4u RA[16], RB[16], eA0, eA1, hbA, eB0, eB1, hbB; unsigned h1A = 0u, h1B = 0u; float shA = 0.f, shB = 0.f;
    { const v4u e0 = *(const GAS v4u*)(EIDs + (size_t)p0 * 256), e1 = *(const GAS v4u*)(EIDs + (size_t)p0 * 256 + 16), f0 = *(const GAS v4u*)(EIDs + (size_t)p1 * 256), f1 = *(const GAS v4u*)(EIDs + (size_t)p1 * 256 + 16);
      eA0 = e0; eA1 = e1; hbA = e0; eB0 = e0; eB1 = e1; hbB = e0;
#pragma unroll
      for (int i = 0; i < 16; ++i) { RA[i] = e0; RB[i] = e0; }
      asm volatile("s_waitcnt vmcnt(0)" ::: "memory");
#pragma unroll
      for (int i = 0; i < 16; ++i) ASM_LD16(RA[i], VTs + (size_t)P5C_E(i, e0, e1) * 128);
#pragma unroll
      for (int i = 0; i < 16; ++i) ASM_LD16(RB[i], VTs + (size_t)P5C_E(i, f0, f1) * 128); }
    P5C_LDMETA(eA0, eA1, hbA, h1A, shA, p0, p2); P5C_LDMETA(eB0, eB1, hbB, h1B, shB, p1, p3);
    asm volatile("s_waitcnt vmcnt(0)" ::: "memory");
#pragma unroll 1
    while (j0 < nT) {
        P5_PULL(j4, p4); P5C_ITER(RA, eA0, eA1, hbA, h1A, shA, p0, true, p2, p4);
        P5_PULL(j5, p5); P5C_ITER(RB, eB0, eB1, hbB, h1B, shB, p1, (j1 < nT), p3, p5);
        j0 = j2; j1 = j3; j2 = j4; j3 = j5; p0 = p2; p1 = p3; p2 = p4; p3 = p5;
    }
    asm volatile("s_waitcnt vmcnt(0)" ::: "memory");
#undef P5C_E
#undef P5C_LDMETA
#undef P5C_ITER
#undef IX32
}
__device__ __forceinline__ void p7_final(Frame& F) {
    const int lane = lane_id(); const int gw = F.vcu * NWAVES + F.wave, NGW = F.G * NWAVES; const float* g = INP(22);
    const bf16* H3B = (const bf16*)(F.ws + WS_E);
    f32x4 gq[4];
#pragma unroll
    for (int j = 0; j < 2; ++j) { gq[2 * j] = *(const GAS f32x4*)(g + 512 * j + 8 * lane); gq[2 * j + 1] = *(const GAS f32x4*)(g + 512 * j + 8 * lane + 4); }
    for (int m0 = gw; m0 < M; m0 += 4 * NGW) {
        v4u w[4][2];
#pragma unroll
        for (int u = 0; u < 4; ++u) { const bf16* hr = H3B + (size_t)(m0 + u * NGW) * DM + 8 * lane; w[u][0] = *(const GAS v4u*)hr; w[u][1] = *(const GAS v4u*)(hr + 512); }
#pragma unroll
        for (int u = 0; u < 4; ++u) { f32x4 v[4]; float s2 = 0.f;
#pragma unroll
            for (int j = 0; j < 2; ++j) { v[2 * j] = (f32x4){bflo(w[u][j].x), bfhi(w[u][j].x), bflo(w[u][j].y), bfhi(w[u][j].y)}; v[2 * j + 1] = (f32x4){bflo(w[u][j].z), bfhi(w[u][j].z), bflo(w[u][j].w), bfhi(w[u][j].w)}; }
#pragma unroll
            for (int j = 0; j < 4; ++j) s2 += dot4s_(v[j]);
            const float rstd = rsqrtf(wave_sum(s2) * (1.f / DM) + EPS); float* orow = F.out + (size_t)(m0 + u * NGW) * DM + 8 * lane;
#pragma unroll
            for (int j = 0; j < 2; ++j) { *(GAS f32x4*)(orow + 512 * j) = v[2 * j] * rstd * gq[2 * j]; *(GAS f32x4*)(orow + 512 * j + 4) = v[2 * j + 1] * rstd * gq[2 * j + 1]; } } }
}
struct Args { const float* in[23]; float* out; unsigned char* ws; int ph_lo, ph_hi; };
__global__ void __launch_bounds__(NWAVES * 64, 2) hymba_fwd(Args args) {
    extern __shared__ __attribute__((aligned(16))) unsigned char lds[];
    cg::grid_group grid = cg::this_grid();
    Frame F;
    F.lds = (LAS unsigned char*)lds; F.ldsg = lds;
    F.wave = __builtin_amdgcn_readfirstlane(threadIdx.x >> 6);
    F.G = gridDim.x; { const int bx = blockIdx.x; F.vcu = (F.G % 8 == 0) ? (bx % 8) * (F.G / 8) + bx / 8 : bx; }
    F.out = args.out; F.ws = args.ws;
    const int lo = args.ph_lo, hi = args.ph_hi;
#ifdef ONLY_PH
#define IN(k) ((k) == ONLY_PH)
#else
#define IN(k) (lo <= (k) && (k) < hi)
#endif
#define BOTH(k) (IN(k) && IN((k) + 1))
    { const int l0 = lane_id(); if (F.wave == 0) ((volatile LAS unsigned*)(F.lds + MISC_OFF))[l0] = 0u; }
    __syncthreads();
    const XcdBarrier bar = xcd_barrier_post((unsigned*)(F.ws + WS_CTL) + CW_BAR, (volatile LAS unsigned*)(F.lds + MISC_OFF) + 8, F.wave == 0 && lane_id() == 0);
    if (hi > N_PHASES) grid.sync();
#if defined(PROBE_BARSUM)
#define GRID_BAR(k) do { STAMP(20); xcd_barrier(bar, F.wave == 0 && lane_id() == 0); STAMP((k) + 1); \
    if (F.wave == 0 && ((PROBE_BARSUM >> (k)) & 1)) { volatile LAS unsigned* ms_ = (volatile LAS unsigned*)(F.lds + MISC_OFF) + 16; ms_[2 * 21] += ms_[2 * ((k) + 1)] - ms_[2 * 20]; } } while (0)
#else
#define GRID_BAR(k) do { xcd_barrier(bar, F.wave == 0 && lane_id() == 0); STAMP((k) + 1); } while (0)
#endif
    STAMP(0);
    if (IN(0)) { p0_prologue(F); if (BOTH(0)) GRID_BAR(0); }
    if (IN(1)) {
        { pg8::Gemm g{(const pg8::bf16_t*)(F.ws + WS_XN), (const pg8::bf16_t*)(F.ws + WS_WIN), M, IN_COLS, DM}; pg8::StaticOrder S; S.init(M, IN_COLS, F.G, (int)blockIdx.x);
          pg8::EpiIn E{(pg8::bf16_t*)(F.ws + WS_QO), (pg8::bf16_t*)(F.ws + WS_K), (pg8::bf16_t*)(F.ws + WS_V), (pg8::bf16_t*)(F.ws + WS_U), (const float*)(F.ws + WS_ROPEC), (const float*)(F.ws + WS_ROPES), attn_body::C2};
          pg8::gemm_phase<pg8::EpiIn, pg8::StaticOrder, true, true>(F.lds, g, S, E, F.wave); }
        { pg8::Gemm g{(const pg8::bf16_t*)(F.ws + WS_PB), (const pg8::bf16_t*)(F.ws + WS_WPROJ), M, DM, PLE_DIM}; pg8::StaticOrder S; S.init(M, DM, F.G, (int)blockIdx.x);
          pg8::EpiBf16<0> E{(pg8::bf16_t*)(F.ws + WS_E), DM, nullptr, 0, 0, 1.f};
          pg8::gemm_phase<pg8::EpiBf16<0>, pg8::StaticOrder, true, true>(F.lds, g, S, E, F.wave); }
        if (BOTH(1)) GRID_BAR(1);
    }
    if (IN(2)) { p2_attention(F); STAMP(13); p2_conv(F); STAMP(14); if (BOTH(2)) GRID_BAR(2); }
    if (IN(3)) {
        pg8::Gemm g{(const pg8::bf16_t*)(F.ws + WS_XN), (const pg8::bf16_t*)(F.ws + WS_WOUT), M, DM, DM}; pg8::StaticOrder S; S.init(M, DM, F.G, (int)blockIdx.x);
        pg8::EpiOut E{INP(0), (pg8::bf16_t*)F.out  , (float*)(F.ws + WS_SSQ1)};
        pg8::gemm_phase<pg8::EpiOut, pg8::StaticOrder, true, true>(F.lds, g, S, E, F.wave);
        if (BOTH(3)) GRID_BAR(3);
    }
    if (IN(4)) {
        pg8::Gemm g{(const pg8::bf16_t*)F.out, (const pg8::bf16_t*)(F.ws + WS_WQ), M, QCOLS, DM}; pg8::StaticOrder S; S.init(M, QCOLS, F.G, (int)blockIdx.x);
        pg8::EpiQ E{(const float*)(F.ws + WS_SSQ1), (pg8::bf16_t*)(F.ws + WS_QP), EPS};
        pg8::gemm_phase<pg8::EpiQ, pg8::StaticOrder, true, true>(F.lds, g, S, E, F.wave);
        if (BOTH(4)) GRID_BAR(4);
    }
    if (IN(5)) { p5a_topk(F); if (BOTH(5)) GRID_BAR(5); }
    if (IN(6)) { p5b_udot(F); if (BOTH(6)) GRID_BAR(6); }
    if (IN(7)) { p5b2_gelu(F); if (BOTH(7)) GRID_BAR(7); }
    if (IN(8)) { p5c_vacc(F); if (BOTH(8)) GRID_BAR(8); }
    if (IN(9)) {
        pg8::Gemm g{(const pg8::bf16_t*)(F.ws + WS_XN2), (const pg8::bf16_t*)(F.ws + WS_WGATE), M, DM, DM}; pg8::StaticOrder S; S.init(M, DM, F.G, (int)blockIdx.x);
        pg8::EpiGate E{(pg8::bf16_t*)(F.ws + WS_E), (const pg8::bf16_t*)(F.ws + WS_XN2), (const pg8::bf16_t*)(F.ws + WS_E), (const float*)(F.ws + WS_SSQ2), EPS};
        pg8::gemm_phase<pg8::EpiGate, pg8::StaticOrder, true, true>(F.lds, g, S, E, F.wave);
        if (BOTH(9)) GRID_BAR(9);
    }
    if (IN(10)) p7_final(F);
#if defined(MBENCH)
    { xcd_barrier(bar, F.wave == 0 && lane_id() == 0); STAMP(15);
      unsigned r[32]; const unsigned l0 = (unsigned)lane_id();
#pragma unroll
      for (int i = 0; i < 32; ++i) r[i] = l0 * 2654435761u + i;
      float* rf = (float*)r;
#pragma unroll 1
      for (int it = 0; it < 1024; ++it) {
#pragma unroll
          for (int i = 0; i < 32; ++i) {
#if MBENCH == 1
              asm volatile("v_dot4c_i32_i8 %0, %1, %2" : "+v"(r[i]) : "v"(r[(i + 1) & 31]), "v"(r[(i + 2) & 31]));
#elif MBENCH == 2
              asm volatile("v_perm_b32 %0, %1, %2, %3" : "=v"(r[i]) : "v"(r[(i + 1) & 31]), "v"(r[(i + 2) & 31]), "v"(r[(i + 3) & 31]));
#elif MBENCH == 3
              asm volatile("v_fma_f32 %0, %1, %2, %0" : "+v"(r[i]) : "v"(r[(i + 1) & 31]), "v"(r[(i + 2) & 31]));
#elif MBENCH == 4
              asm volatile("v_cvt_f32_ubyte1 %0, %1" : "=v"(r[i]) : "v"(r[(i + 1) & 31]));
#elif MBENCH == 5
              asm volatile("v_pk_fma_f32 %0, %1, %2, %0" : "+v"(*(unsigned long long*)&r[2 * (i & 15)]) : "v"(*(unsigned long long*)&r[2 * ((i + 1) & 15)]), "v"(*(unsigned long long*)&r[2 * ((i + 2) & 15)]));
#elif MBENCH == 6
              asm volatile("v_add_u32 %0, %1, %2" : "=v"(r[i]) : "v"(r[(i + 1) & 31]), "v"(r[(i + 2) & 31]));
#elif MBENCH == 7
              asm volatile("v_mad_i32_i24 %0, %1, %2, %0" : "+v"(r[i]) : "v"(r[(i + 1) & 31]), "v"(r[(i + 2) & 31]));
#endif
          } }
      unsigned acc = 0;
#pragma unroll
      for (int i = 0; i < 32; ++i) acc ^= r[i];
      if (acc == 0x12345678u) ((unsigned*)(F.ws + WS_CTL))[2000 + l0] = acc;
      STAMP(16); }
#endif
#if defined(PROBE_A)
    STAMP(11);
#if !defined(PROBE_BLK)
#define PROBE_BLK 0
#endif
    if (blockIdx.x == PROBE_BLK && F.wave == 0) { volatile LAS unsigned* ms_ = (volatile LAS unsigned*)(F.lds + MISC_OFF) + 16;
        const unsigned long long ta = ((unsigned long long)ms_[2 * PROBE_A + 1] << 32) | ms_[2 * PROBE_A], tb = ((unsigned long long)ms_[2 * PROBE_B + 1] << 32) | ms_[2 * PROBE_B];
#if defined(PROBE_BARSUM)
        const unsigned long long span_ = ms_[2 * 21];
#else
        const unsigned long long span_ = tb - ta;
#endif
        const unsigned long long t0_ = __builtin_amdgcn_s_memrealtime(); while (__builtin_amdgcn_s_memrealtime() - t0_ < span_) __builtin_amdgcn_s_sleep(8); }
#endif
#undef IN
#undef BOTH
}

extern "C" void kernel_launch(void* const* d_in, const int* in_sizes, int n_in, void* d_out, int out_size, void* d_ws, size_t ws_size, hipStream_t stream) {
    static int grid = 0;
    if (grid == 0) {
        if (n_in != 23 || in_sizes[0] != M * DM || out_size != M * DM || ws_size < WS_END) { fprintf(stderr, "kernel_launch: unexpected shapes (n_in %d, in0 %d, out %d, ws %zu); nothing launched\n", n_in, n_in > 0 ? in_sizes[0] : -1, out_size, ws_size); grid = -1; return; }
        int dev = 0, cus = 0, per_cu = 0;
        if (hipGetDevice(&dev) != hipSuccess || hipDeviceGetAttribute(&cus, hipDeviceAttributeMultiprocessorCount, dev) != hipSuccess) { fprintf(stderr, "kernel_launch: device query failed\n"); grid = -1; return; }
        if (hipFuncSetAttribute((const void*)hymba_fwd, hipFuncAttributeMaxDynamicSharedMemorySize, LDS_BYTES) != hipSuccess) { fprintf(stderr, "kernel_launch: hipFuncSetAttribute failed\n"); grid = -1; return; }
        if (hipOccupancyMaxActiveBlocksPerMultiprocessor(&per_cu, (const void*)hymba_fwd, NWAVES * 64, LDS_BYTES) != hipSuccess || per_cu < 1) { fprintf(stderr, "kernel_launch: occupancy query says %d blocks per CU\n", per_cu); (void)hipGetLastError(); grid = -1; return; }
        grid = cus * per_cu;
        if (grid != 256) { fprintf(stderr, "kernel_launch: this kernel's attention order needs exactly 256 resident workgroups (got %d x %d); nothing launched\n", cus, per_cu); grid = -1; return; }
    }
    if (grid < 0) return;
    if (hipMemsetAsync((char*)d_ws + WS_CTL, 0, CTL_ZERO_BYTES, stream) != hipSuccess) { fprintf(stderr, "kernel_launch: hipMemsetAsync failed\n"); return; }
    Args a{};
    for (int i = 0; i < 23; ++i) a.in[i] = (const float*)d_in[i];
    a.out = (float*)d_out; a.ws = (unsigned char*)d_ws;
#if MK_N_LAUNCHES == 1
    a.ph_lo = 0; a.ph_hi = N_PHASES;
    void* kargs[] = {&a};
    hipError_t e = hipLaunchCooperativeKernel((const void*)hymba_fwd, dim3(grid), dim3(NWAVES * 64), kargs, LDS_BYTES, stream);
    if (e != hipSuccess) fprintf(stderr, "kernel_launch: cooperative launch failed: %s (grid %d)\n", hipGetErrorString(e), grid);
#else
    for (int li = 0; li < N_PHASES; ++li) { a.ph_lo = li; a.ph_hi = li + 1;
        hipLaunchKernelGGL(hymba_fwd, dim3(grid), dim3(NWAVES * 64), LDS_BYTES, stream, a);
        const hipError_t le = hipPeekAtLastError(); if (le != hipSuccess) { fprintf(stderr, "kernel_launch: launch %d failed: %s\n", li, hipGetErrorName(le)); break; } }
#endif
}
```

```cpp
#include <hip/hip_runtime.h>
#include <hip/hip_cooperative_groups.h>
#include <cstdio>
#include <cstdint>
namespace cg = cooperative_groups;
namespace pg8 {
#define PG8_LAS __attribute__((address_space(3)))
typedef unsigned short bf16_t;
typedef short bf16x8 __attribute__((ext_vector_type(8)));
typedef float f32x4 __attribute__((ext_vector_type(4)));
typedef int i32x4 __attribute__((ext_vector_type(4)));
typedef unsigned u32x4 __attribute__((ext_vector_type(4)));
constexpr int BM = 256, BK = 64, HALF = 128, HTB = HALF * BK * 2  , STAGE_BYTES = 8 * HTB, NXCD = 8, WGM = 8;

__host__ __device__ __forceinline__ int lds_byte(int r, int c) { const int st = (r >> 4) * 2 + (c >> 5), rr = r & 15, cc = c & 31, ob = rr * 64 + cc * 2; return st * 1024 + (ob ^ (((ob >> 9) & 1) << 5)); }
__host__ __device__ __forceinline__ void stage_rc(int b, int& R, int& C) { const int st = b / 1024, sb = b % 1024, swz = sb ^ (((sb >> 9) & 1) << 5); R = (st >> 1) * 16 + swz / 64; C = (st & 1) * 32 + (swz % 64) / 2; }
__host__ __device__ __forceinline__ int perm32(int rho) { const int n = rho >> 4, i = rho & 15; return 8 * (i >> 2) + 4 * n + (i & 3); }

struct Unit { int pm, pn; };
struct Gemm { const bf16_t* A; const bf16_t* Bt; int M, N, K;
    const float* sA = nullptr; float sAc = 1.f; const float* sB = nullptr; };

struct StaticOrder {
    int nM, nN, nwg, G, c;
    __host__ __device__ void init(int M, int N, int G_, int c_) { nM = M / BM; nN = N / BM; nwg = nM * nN; G = G_; c = c_; }
    __host__ __device__ bool next(int i, Unit& u) const {
        const long L = (long)i * G + c; if (L >= nwg) return false;
        int wgid = (int)L; { const int q = nwg / NXCD, r = nwg % NXCD, xcd = wgid % NXCD, off = wgid / NXCD; wgid = (xcd < r ? xcd * (q + 1) : r * (q + 1) + (xcd - r) * q) + off; }
        const int nig = WGM * nN, gid = wgid / nig, fm = gid * WGM, gsz = (nM - fm) < WGM ? (nM - fm) : WGM;
        u.pm = fm + ((wgid % nig) % gsz); u.pn = (wgid % nig) / gsz; return true;
    }
    __device__ __forceinline__ void a_ready(const Unit&) const {}
    __device__ __forceinline__ void done(const Unit&) const {}
};

__device__ __forceinline__ unsigned cvt_pk_bf16(float lo, float hi) { unsigned r; asm volatile("v_cvt_pk_bf16_f32 %0, %1, %2" : "=v"(r) : "v"(lo), "v"(hi)); return r; }
typedef float f32x2 __attribute__((ext_vector_type(2)));
__device__ __forceinline__ f32x2 gelu_pk(f32x2 v) {
    const f32x2 av = __builtin_elementwise_abs(v), d = av * 0.2316418882f + 1.0f;
    f32x2 t; t.x = __builtin_amdgcn_rcpf(d.x); t.y = __builtin_amdgcn_rcpf(d.y);
    f32x2 q = t * 0.5307027145f + (-0.7265760135f); q = q * t + 0.7107068705f; q = q * t + (-0.142248368f); q = q * t + 0.127414796f; q = q * t;
    const f32x2 s = (v * v) * (-0.72134752044f);
    f32x2 e; e.x = __builtin_amdgcn_exp2f(s.x); e.y = __builtin_amdgcn_exp2f(s.y);
    const f32x2 m = v * (q * e), r = v - m;
    f32x2 o; o.x = v.x < 0.f ? m.x : r.x; o.y = v.y < 0.f ? m.y : r.y; return o;
}

template <int ACT  > struct EpiBf16 {
    static constexpr bool PERM = true, AFTER_DRAIN = false; static_assert(ACT == 0 || ACT == 1, "EpiBf16: ACT is 0 (none) or 1 (gelu_pk)");
    bf16_t* O; int ldc; const float* bias; int split_cols; size_t split_stride; float scale0;
    __device__ __forceinline__ void operator()(const f32x4 (&acc)[2][2][4][2], const Unit& u, int wr, int wc, int fr, int fq) const {
        const int row0 = u.pm * BM + wr * 64 + fr; int colt = u.pn * BM; bf16_t* base = O;
        float sc = 1.f; if (split_cols) { const int t = colt / split_cols; base += (size_t)t * split_stride; colt -= t * split_cols; if (t == 0) sc = scale0; }
        const int col0 = colt + wc * 32 + 8 * fq, bcol0 = u.pn * BM + wc * 32 + 8 * fq;
        f32x4 bv[2][2];
#pragma unroll
        for (int bj = 0; bj < 2; ++bj)
#pragma unroll
            for (int n = 0; n < 2; ++n) bv[bj][n] = bias ? *(const f32x4*)(bias + bcol0 + bj * HALF + 4 * n) : (f32x4){0.f, 0.f, 0.f, 0.f};
#pragma unroll
        for (int ai = 0; ai < 2; ++ai)
#pragma unroll
            for (int m = 0; m < 4; ++m) { bf16_t* rowp = base + (size_t)(row0 + ai * HALF + m * 16) * ldc + col0;
#pragma unroll
                for (int bj = 0; bj < 2; ++bj) { f32x4 v0 = acc[ai][bj][m][0] + bv[bj][0], v1 = acc[ai][bj][m][1] + bv[bj][1];
                    if (ACT == 1) { f32x2 a = gelu_pk((f32x2){v0[0], v0[1]}), b = gelu_pk((f32x2){v0[2], v0[3]}), c = gelu_pk((f32x2){v1[0], v1[1]}), d = gelu_pk((f32x2){v1[2], v1[3]});
                        v0 = (f32x4){a.x, a.y, b.x, b.y}; v1 = (f32x4){c.x, c.y, d.x, d.y}; }
                    v0 = v0 * sc; v1 = v1 * sc; u32x4 w; w.x = cvt_pk_bf16(v0[0], v0[1]); w.y = cvt_pk_bf16(v0[2], v0[3]); w.z = cvt_pk_bf16(v1[0], v1[1]); w.w = cvt_pk_bf16(v1[2], v1[3]);
                    *(u32x4*)(rowp + bj * HALF) = w; } }
    }
};
__device__ __forceinline__ float sigmoid_fast(float x) { return __builtin_amdgcn_rcpf(1.0f + __expf(-x)); }
__device__ __forceinline__ f32x4 sigmoid4(f32x4 x) { f32x4 r; r[0] = sigmoid_fast(x[0]); r[1] = sigmoid_fast(x[1]); r[2] = sigmoid_fast(x[2]); r[3] = sigmoid_fast(x[3]); return r; }
__device__ __forceinline__ u32x4 pack8(const f32x4 a, const f32x4 b) { u32x4 w; w.x = cvt_pk_bf16(a[0], a[1]); w.y = cvt_pk_bf16(a[2], a[3]); w.z = cvt_pk_bf16(b[0], b[1]); w.w = cvt_pk_bf16(b[2], b[3]); return w; }
__device__ __forceinline__ float sum_x16_x32(float v) {
    { const auto rr = __builtin_amdgcn_permlane16_swap(__float_as_uint(v), __float_as_uint(v), false, false); v = __uint_as_float(rr[0]) + __uint_as_float(rr[1]); }
    { const auto rr = __builtin_amdgcn_permlane32_swap(__float_as_uint(v), __float_as_uint(v), false, false); v = __uint_as_float(rr[0]) + __uint_as_float(rr[1]); }
    return v;
}
__device__ __forceinline__ float max_x16_x32(float v) {
    { const auto rr = __builtin_amdgcn_permlane16_swap(__float_as_uint(v), __float_as_uint(v), false, false); v = fmaxf(__uint_as_float(rr[0]), __uint_as_float(rr[1])); }
    { const auto rr = __builtin_amdgcn_permlane32_swap(__float_as_uint(v), __float_as_uint(v), false, false); v = fmaxf(__uint_as_float(rr[0]), __uint_as_float(rr[1])); }
    return v;
}
__device__ __forceinline__ float dot4s(const f32x4 a) { return (a[0] * a[0] + a[1] * a[1]) + (a[2] * a[2] + a[3] * a[3]); }

struct EpiIn {
    static constexpr bool PERM = true, AFTER_DRAIN = false;
    bf16_t *Q, *Kk, *V, *U; const float* ropec; const float* ropes; float qscale;
    __device__ __forceinline__ void operator()(const f32x4 (&acc)[2][2][4][2], const Unit& u, int wr, int wc, int fr, int fq) const {
        const int row0 = u.pm * BM + wr * 64 + fr; const int pn = u.pn;
        if (pn < 4) {
            bf16_t* dst = (pn < 2) ? Q : Kk; const float sc = (pn < 2) ? qscale : 1.0f; const int colb = ((pn & 1) * 4 + wc) * 128 + 8 * fq;
#pragma unroll
            for (int ai = 0; ai < 2; ++ai)
#pragma unroll
                for (int m = 0; m < 4; ++m) { const int row = row0 + ai * HALF + m * 16; const int pos = row & 4095;
                    const f32x4 c0 = *(const f32x4*)(ropec + pos * 32 + 8 * fq), c1 = *(const f32x4*)(ropec + pos * 32 + 8 * fq + 4);
                    const f32x4 s0 = *(const f32x4*)(ropes + pos * 32 + 8 * fq), s1 = *(const f32x4*)(ropes + pos * 32 + 8 * fq + 4);
                    const f32x4 x10 = acc[ai][0][m][0], x11 = acc[ai][0][m][1], x20 = acc[ai][1][m][0], x21 = acc[ai][1][m][1];
                    const f32x4 o10 = (x10 * c0 - x20 * s0) * sc, o11 = (x11 * c1 - x21 * s1) * sc, o20 = (x20 * c0 + x10 * s0) * sc, o21 = (x21 * c1 + x11 * s1) * sc;
                    bf16_t* rp = dst + (size_t)row * 1024 + colb; const u32x4 w1 = pack8(o10, o11), w2 = pack8(o20, o21);
                    *(u32x4*)rp = w1; *(u32x4*)(rp + 32) = w2; }
        } else if (pn < 6) {
#pragma unroll
            for (int ai = 0; ai < 2; ++ai)
#pragma unroll
                for (int m = 0; m < 4; ++m) { const int row = row0 + ai * HALF + m * 16;
#pragma unroll
                    for (int bj = 0; bj < 2; ++bj) { const int hh = (pn - 4) * 2 + bj, vh = wc >> 1, d = (wc & 1) * 32 + 8 * fq;
                        const u32x4 w = pack8(acc[ai][bj][m][0], acc[ai][bj][m][1]); bf16_t* rp = V + (size_t)row * 1024 + (hh * 4 + vh) * 64 + d; *(u32x4*)rp = w; } }
        } else {
#pragma unroll
            for (int ai = 0; ai < 2; ++ai)
#pragma unroll
                for (int m = 0; m < 4; ++m) { const int row = row0 + ai * HALF + m * 16;
                    const f32x4 u0 = acc[ai][0][m][0] * sigmoid4(acc[ai][1][m][0]), u1 = acc[ai][0][m][1] * sigmoid4(acc[ai][1][m][1]);
                    *(u32x4*)(U + (size_t)row * 512 + (pn - 6) * 128 + wc * 32 + 8 * fq) = pack8(u0, u1); }
        }
    }
};
struct EpiOut {
    static constexpr bool PERM = true, AFTER_DRAIN = false;
    const float* x; bf16_t* hb; float* ssq;
    __device__ __forceinline__ void operator()(const f32x4 (&acc)[2][2][4][2], const Unit& u, int wr, int wc, int fr, int fq) const {
        const int row0 = u.pm * BM + wr * 64 + fr;
#pragma unroll
        for (int ai = 0; ai < 2; ++ai)
#pragma unroll
            for (int m = 0; m < 4; ++m) { const int row = row0 + ai * HALF + m * 16; float ss = 0.f;
#pragma unroll
                for (int bj = 0; bj < 2; ++bj) { const size_t off = (size_t)row * 1024 + u.pn * BM + bj * HALF + wc * 32 + 8 * fq;
                    const f32x4 h0 = acc[ai][bj][m][0] + *(const f32x4*)(x + off), h1 = acc[ai][bj][m][1] + *(const f32x4*)(x + off + 4);
                    *(u32x4*)(hb + off) = pack8(h0, h1); ss += dot4s(h0) + dot4s(h1); }
                ss = sum_x16_x32(ss);
                if (fq == 0) ssq[(size_t)row * 16 + u.pn * 4 + wc] = ss; }
    }
};
struct EpiOutQ {
    static constexpr bool PERM = true, AFTER_DRAIN = false;
    const float* x; bf16_t* hb; float* ssq; float* amx; unsigned char* hq; float* shq; unsigned* cnt; bool spread; float eps;
    __device__ __forceinline__ void operator()(f32x4 (&acc)[2][2][4][2], const Unit& u, int wr, int wc, int fr, int fq) const {
        const int row0 = u.pm * BM + wr * 64 + fr;
#pragma unroll
        for (int ai = 0; ai < 2; ++ai)
#pragma unroll
            for (int m = 0; m < 4; ++m) { const int row = row0 + ai * HALF + m * 16; float ss = 0.f, am = 0.f;
#pragma unroll
                for (int bj = 0; bj < 2; ++bj) { const size_t off = (size_t)row * 1024 + u.pn * BM + bj * HALF + wc * 32 + 8 * fq;
                    const f32x4 h0 = acc[ai][bj][m][0] + *(const f32x4*)(x + off), h1 = acc[ai][bj][m][1] + *(const f32x4*)(x + off + 4);
                    acc[ai][bj][m][0] = h0; acc[ai][bj][m][1] = h1;
                    *(u32x4*)(hb + off) = pack8(h0, h1); ss += dot4s(h0) + dot4s(h1);
                    am = fmaxf(am, fmaxf(fmaxf(fmaxf(__builtin_fabsf(h0[0]), __builtin_fabsf(h0[1])), fmaxf(__builtin_fabsf(h0[2]), __builtin_fabsf(h0[3]))), fmaxf(fmaxf(__builtin_fabsf(h1[0]), __builtin_fabsf(h1[1])), fmaxf(__builtin_fabsf(h1[2]), __builtin_fabsf(h1[3]))))); }
                ss = sum_x16_x32(ss); am = max_x16_x32(am);
                if (fq == 0) { ssq[(size_t)row * 16 + u.pn * 4 + wc] = ss; amx[(size_t)row * 16 + u.pn * 4 + wc] = am; } }
        asm volatile("s_waitcnt vmcnt(0)" ::: "memory");
        __syncthreads();
        if (wr == 0 && wc == 0 && fr == 0 && fq == 0) {
            if (spread) { __builtin_amdgcn_fence(__ATOMIC_RELEASE, "agent"); asm volatile("s_waitcnt vmcnt(0)" ::: "memory"); }
            unsigned* c = cnt + u.pm;
            (void)__hip_atomic_fetch_add(c, 1u, __ATOMIC_RELAXED, __HIP_MEMORY_SCOPE_AGENT);
            unsigned sp_ = 0;
            while (__hip_atomic_load(c, __ATOMIC_RELAXED, __HIP_MEMORY_SCOPE_AGENT) < 4u) { __builtin_amdgcn_s_sleep(1); if (++sp_ > (1u << 22)) break; }
            __builtin_amdgcn_fence(__ATOMIC_ACQUIRE, "agent");
            asm volatile("s_waitcnt vmcnt(0)" ::: "memory");
        }
        __syncthreads();
#pragma unroll
        for (int ai = 0; ai < 2; ++ai)
#pragma unroll
            for (int m = 0; m < 4; ++m) { const int row = row0 + ai * HALF + m * 16; const f32x4* mp = (const f32x4*)(amx + (size_t)row * 16);
                const f32x4 a = mp[0], b = mp[1], c = mp[2], d = mp[3];
                const f32x4 t = (f32x4){fmaxf(fmaxf(a[0], b[0]), fmaxf(c[0], d[0])), fmaxf(fmaxf(a[1], b[1]), fmaxf(c[1], d[1])), fmaxf(fmaxf(a[2], b[2]), fmaxf(c[2], d[2])), fmaxf(fmaxf(a[3], b[3]), fmaxf(c[3], d[3]))};
                const float rmax = fmaxf(fmaxf(t[0], t[1]), fmaxf(t[2], t[3])); const float inv = 127.f / fmaxf(rmax, 1e-30f);
#pragma unroll
                for (int bj = 0; bj < 2; ++bj) { const f32x4 h0 = acc[ai][bj][m][0] * inv, h1 = acc[ai][bj][m][1] * inv;
                    const unsigned lo = (unsigned)((int)__builtin_rintf(h0[0]) & 0xff) | ((unsigned)((int)__builtin_rintf(h0[1]) & 0xff) << 8) | ((unsigned)((int)__builtin_rintf(h0[2]) & 0xff) << 16) | ((unsigned)(int)__builtin_rintf(h0[3]) << 24);
                    const unsigned hi = (unsigned)((int)__builtin_rintf(h1[0]) & 0xff) | ((unsigned)((int)__builtin_rintf(h1[1]) & 0xff) << 8) | ((unsigned)((int)__builtin_rintf(h1[2]) & 0xff) << 16) | ((unsigned)(int)__builtin_rintf(h1[3]) << 24);
                    *(unsigned long long*)(hq + (size_t)row * 1024 + u.pn * BM + bj * HALF + wc * 32 + 8 * fq) = (unsigned long long)lo | ((unsigned long long)hi << 32); }
                if (u.pn == 0 && wc == 0 && fq == 0) { const f32x4* sp = (const f32x4*)(ssq + (size_t)row * 16); const f32x4 s4 = (sp[0] + sp[1]) + (sp[2] + sp[3]);
                    shq[row] = rmax * (1.f / 127.f) * rsqrtf(((s4[0] + s4[1]) + (s4[2] + s4[3])) * (1.0f / 1024.0f) + eps); } }
    }
};
struct EpiQ {
    static constexpr bool PERM = true, AFTER_DRAIN = false;
    const float* ssq; bf16_t* qp; float eps;
    __device__ __forceinline__ void operator()(const f32x4 (&acc)[2][2][4][2], const Unit& u, int wr, int wc, int fr, int fq) const {
        const int row0 = u.pm * BM + wr * 64 + fr;
#pragma unroll
        for (int ai = 0; ai < 2; ++ai)
#pragma unroll
            for (int m = 0; m < 4; ++m) { const int row = row0 + ai * HALF + m * 16; const f32x4* sp = (const f32x4*)(ssq + (size_t)row * 16);
                const f32x4 a = sp[0], b = sp[1], c = sp[2], d = sp[3]; const f32x4 t = (a + b) + (c + d);
                const float rstd = rsqrtf(((t[0] + t[1]) + (t[2] + t[3])) * (1.0f / 1024.0f) + eps);
#pragma unroll
                for (int bj = 0; bj < 2; ++bj) *(u32x4*)(qp + (size_t)(u.pn >> 2) * ((size_t)32768 * 1024) + (size_t)row * 1024 + (u.pn & 3) * BM + bj * HALF + wc * 32 + 8 * fq) = pack8(acc[ai][bj][m][0] * rstd, acc[ai][bj][m][1] * rstd); }
    }
};
struct EpiQS {
    static constexpr bool PERM = true, AFTER_DRAIN = false;
    bf16_t* qp;
    __device__ __forceinline__ void operator()(const f32x4 (&acc)[2][2][4][2], const Unit& u, int wr, int wc, int fr, int fq) const {
        const int row0 = u.pm * BM + wr * 64 + fr;
#pragma unroll
        for (int ai = 0; ai < 2; ++ai)
#pragma unroll
            for (int m = 0; m < 4; ++m) { const int row = row0 + ai * HALF + m * 16;
#pragma unroll
                for (int bj = 0; bj < 2; ++bj) *(u32x4*)(qp + (size_t)(u.pn >> 2) * ((size_t)32768 * 1024) + (size_t)row * 1024 + (u.pn & 3) * BM + bj * HALF + wc * 32 + 8 * fq) = pack8(acc[ai][bj][m][0], acc[ai][bj][m][1]); }
    }
};
__device__ __forceinline__ f32x4 bf_lo4(unsigned a, unsigned b) { f32x4 r; r[0] = __uint_as_float(a << 16); r[1] = __uint_as_float(a & 0xffff0000u); r[2] = __uint_as_float(b << 16); r[3] = __uint_as_float(b & 0xffff0000u); return r; }
struct EpiGate {
    static constexpr bool PERM = true, AFTER_DRAIN = false;
    bf16_t* h3b; const bf16_t* h2b; const bf16_t* e; const float* ssq; float eps;
    __device__ __forceinline__ void operator()(const f32x4 (&acc)[2][2][4][2], const Unit& u, int wr, int wc, int fr, int fq) const {
        const int row0 = u.pm * BM + wr * 64 + fr;
#pragma unroll
        for (int ai = 0; ai < 2; ++ai)
#pragma unroll
            for (int m = 0; m < 4; ++m) { const int row = row0 + ai * HALF + m * 16; const f32x4* sp = (const f32x4*)(ssq + (size_t)row * 8); const f32x4 t = sp[0] + sp[1];
                const float rstd = rsqrtf(((t[0] + t[1]) + (t[2] + t[3])) * (1.0f / 1024.0f) + eps);
#pragma unroll
                for (int bj = 0; bj < 2; ++bj) { const size_t off = (size_t)row * 1024 + u.pn * BM + bj * HALF + wc * 32 + 8 * fq;
                    const u32x4 ev = *(const u32x4*)(e + off), hv = *(const u32x4*)(h2b + off);
                    const f32x4 h0 = bf_lo4(hv.x, hv.y) + bf_lo4(ev.x, ev.y) * sigmoid4(acc[ai][bj][m][0] * rstd), h1 = bf_lo4(hv.z, hv.w) + bf_lo4(ev.z, ev.w) * sigmoid4(acc[ai][bj][m][1] * rstd);
                    *(u32x4*)(h3b + off) = pack8(h0, h1); } }
    }
};

struct EpiGateNorm {
    static constexpr bool PERM = true, AFTER_DRAIN = false;
    const bf16_t* h2b; const bf16_t* e; const float* ssq2; float eps; float* ssq3; unsigned* cnt; const float* gfin; float* out; bool spread;
    __device__ __forceinline__ void operator()(f32x4 (&acc)[2][2][4][2], const Unit& u, int wr, int wc, int fr, int fq) const {
        const int row0 = u.pm * BM + wr * 64 + fr;
#pragma unroll
        for (int ai = 0; ai < 2; ++ai)
#pragma unroll
            for (int m = 0; m < 4; ++m) { const int row = row0 + ai * HALF + m * 16; const f32x4* sp = (const f32x4*)(ssq2 + (size_t)row * 8); const f32x4 t = sp[0] + sp[1];
                const float rstd = rsqrtf(((t[0] + t[1]) + (t[2] + t[3])) * (1.0f / 1024.0f) + eps); float ss = 0.f;
#pragma unroll
                for (int bj = 0; bj < 2; ++bj) { const size_t off = (size_t)row * 1024 + u.pn * BM + bj * HALF + wc * 32 + 8 * fq;
                    const u32x4 ev = *(const u32x4*)(e + off), hv = *(const u32x4*)(h2b + off);
                    const f32x4 h0 = bf_lo4(hv.x, hv.y) + bf_lo4(ev.x, ev.y) * sigmoid4(acc[ai][bj][m][0] * rstd), h1 = bf_lo4(hv.z, hv.w) + bf_lo4(ev.z, ev.w) * sigmoid4(acc[ai][bj][m][1] * rstd);
                    acc[ai][bj][m][0] = h0; acc[ai][bj][m][1] = h1; ss += dot4s(h0) + dot4s(h1); }
                ss = sum_x16_x32(ss);
                if (fq == 0) ssq3[(size_t)row * 16 + u.pn * 4 + wc] = ss; }
        asm volatile("s_waitcnt vmcnt(0)" ::: "memory");
        __syncthreads();
        if (wr == 0 && wc == 0 && fr == 0 && fq == 0) {
            if (spread) { __builtin_amdgcn_fence(__ATOMIC_RELEASE, "agent"); asm volatile("s_waitcnt vmcnt(0)" ::: "memory"); }
            unsigned* c = cnt + u.pm;
            (void)__hip_atomic_fetch_add(c, 1u, __ATOMIC_RELAXED, __HIP_MEMORY_SCOPE_AGENT);
            unsigned sp_ = 0;
            while (__hip_atomic_load(c, __ATOMIC_RELAXED, __HIP_MEMORY_SCOPE_AGENT) < 4u) { __builtin_amdgcn_s_sleep(1); if (++sp_ > (1u << 22)) break; }
            __builtin_amdgcn_fence(__ATOMIC_ACQUIRE, "agent");
            asm volatile("s_waitcnt vmcnt(0)" ::: "memory");
        }
        __syncthreads();
        f32x4 gf[2][2];
#pragma unroll
        for (int bj = 0; bj < 2; ++bj)
#pragma unroll
            for (int n = 0; n < 2; ++n) gf[bj][n] = *(const f32x4*)(gfin + u.pn * BM + bj * HALF + wc * 32 + 8 * fq + 4 * n);
#pragma unroll
        for (int ai = 0; ai < 2; ++ai)
#pragma unroll
            for (int m = 0; m < 4; ++m) { const int row = row0 + ai * HALF + m * 16; const f32x4* sp = (const f32x4*)(ssq3 + (size_t)row * 16); const f32x4 t = (sp[0] + sp[1]) + (sp[2] + sp[3]);
                const float rstd = rsqrtf(((t[0] + t[1]) + (t[2] + t[3])) * (1.0f / 1024.0f) + eps);
#pragma unroll
                for (int bj = 0; bj < 2; ++bj) { float* op = out + (size_t)row * 1024 + u.pn * BM + bj * HALF + wc * 32 + 8 * fq;
                    *(f32x4*)op = acc[ai][bj][m][0] * rstd * gf[bj][0]; *(f32x4*)(op + 4) = acc[ai][bj][m][1] * rstd * gf[bj][1]; } }
    }
};
template <class Epi, class Sched, bool ALIGN_EPI = false, bool SP2 = false, bool I8 = false>
__device__ __forceinline__ void gemm_phase(PG8_LAS unsigned char* lds, const Gemm g, const Sched& S, const Epi& E, const int wid  ) {
    int lane; asm volatile("v_mbcnt_lo_u32_b32 %0, -1, 0\n\tv_mbcnt_hi_u32_b32 %0, -1, %0" : "=v"(lane));
    const int tid = wid * 64 + lane, wr = wid >> 2, wc = wid & 3, fr = lane & 15, fq = lane >> 4;
    const int K = g.K, nt = K / BK;
    unsigned voffA[2], voffB[2];
#pragma unroll
    for (int i = 0; i < 2; ++i) { int R, C; stage_rc(tid * 16 + i * 8192, R, C); const int Rb = Epi::PERM ? ((R & ~31) + perm32(R & 31)) : R;
        voffA[i] = (unsigned)(R * K + C) * 2u; voffB[i] = (unsigned)(Rb * K + C) * 2u; }
    const size_t kstep = (size_t)(BK * 2);
    const size_t hstep = (size_t)HALF * K * 2;
    const size_t tstep = 2 * hstep;
    const unsigned ldsw = (unsigned)wid * 1024u;
    const int aoff = lds_byte(wr * 64 + fr, fq * 8), boff = lds_byte(wc * 32 + fr, fq * 8);
#define PG8_SA(b, h) (((b) * 2 + (h)) * HTB)
#define PG8_SB(b, h) ((4 + (b) * 2 + (h)) * HTB)
#define PG8_STAGE(bufoff, gbase, voff) do { _Pragma("unroll") for (int _i = 0; _i < 2; ++_i) \
        __builtin_amdgcn_global_load_lds((const unsigned*)((const char*)(gbase) + (voff)[_i]), (PG8_LAS unsigned*)(lds + (bufoff) + ldsw + _i * 8192), 16, 0, 0); } while (0)
#define PG8_LDA(dst, b, h) do { _Pragma("unroll") for (int m = 0; m < 4; ++m) _Pragma("unroll") for (int k = 0; k < 2; ++k) dst[m][k] = *(const PG8_LAS bf16x8*)(lds + PG8_SA(b, h) + aoff + m * 2048 + k * 1024); } while (0)
#define PG8_LDB(dst, b, h) do { _Pragma("unroll") for (int n = 0; n < 2; ++n) _Pragma("unroll") for (int k = 0; k < 2; ++k) dst[n][k] = *(const PG8_LAS bf16x8*)(lds + PG8_SB(b, h) + boff + n * 2048 + k * 1024); } while (0)
#define PG8_MMA(ai, bj, At, Bt) do { __builtin_amdgcn_s_setprio(1); _Pragma("unroll") for (int m = 0; m < 4; ++m) _Pragma("unroll") for (int n = 0; n < 2; ++n) _Pragma("unroll") for (int k = 0; k < 2; ++k) \
        { if constexpr (I8) acc[ai][bj][m][n] = __builtin_bit_cast(f32x4, __builtin_amdgcn_mfma_i32_16x16x64_i8(__builtin_bit_cast(i32x4, Bt[n][k]), __builtin_bit_cast(i32x4, At[m][k]), __builtin_bit_cast(i32x4, acc[ai][bj][m][n]), 0, 0, 0)); \
          else acc[ai][bj][m][n] = __builtin_amdgcn_mfma_f32_16x16x32_bf16(Bt[n][k], At[m][k], acc[ai][bj][m][n], 0, 0, 0); } __builtin_amdgcn_s_setprio(0); } while (0)
#define PG8_WAIT_V(n) asm volatile("s_waitcnt vmcnt(" #n ")" ::: "memory")
#define PG8_WAIT_L(n) asm volatile("s_waitcnt lgkmcnt(" #n ")" ::: "memory")
#define PG8_BAR __builtin_amdgcn_s_barrier()
#define PG8_SCHED __builtin_amdgcn_sched_barrier(0)
    Unit cur, nxt; int ui = 0;
    if (!S.next(0, cur)) return;
    f32x4 acc[2][2][4][2];
#pragma unroll
    for (int a = 0; a < 2; ++a)
#pragma unroll
        for (int b = 0; b < 2; ++b)
#pragma unroll
            for (int m = 0; m < 4; ++m)
#pragma unroll
                for (int n = 0; n < 2; ++n) acc[a][b][m][n] = (f32x4){0.f, 0.f, 0.f, 0.f};
    bf16x8 At[4][2], B0[2][2], B1[2][2];
    const char* cA = (const char*)g.A + (size_t)cur.pm * tstep; const char* cB = (const char*)g.Bt + (size_t)cur.pn * tstep;
    S.a_ready(cur);
    if constexpr (SP2) {
        PG8_STAGE(PG8_SB(0, 0), cB, voffB); PG8_STAGE(PG8_SB(0, 1), cB + hstep, voffB); PG8_STAGE(PG8_SA(0, 0), cA, voffA); PG8_STAGE(PG8_SA(0, 1), cA + hstep, voffA);
        if (wr == 1) PG8_BAR;
        PG8_WAIT_V(2); PG8_BAR;
        PG8_STAGE(PG8_SB(1, 0), cB + kstep, voffB); PG8_STAGE(PG8_SA(1, 0), cA + kstep, voffA); PG8_STAGE(PG8_SB(1, 1), cB + hstep + kstep, voffB);
        PG8_WAIT_V(6); PG8_BAR;
    } else {
        PG8_STAGE(PG8_SB(0, 0), cB, voffB); PG8_STAGE(PG8_SA(0, 0), cA, voffA); PG8_STAGE(PG8_SB(0, 1), cB + hstep, voffB); PG8_STAGE(PG8_SA(0, 1), cA + hstep, voffA);
        if (wr == 1) PG8_BAR;
        PG8_WAIT_V(4); PG8_BAR;
        PG8_STAGE(PG8_SB(1, 0), cB + kstep, voffB); PG8_STAGE(PG8_SA(1, 0), cA + kstep, voffA); PG8_STAGE(PG8_SB(1, 1), cB + hstep + kstep, voffB);
        PG8_WAIT_V(6); PG8_BAR;
    }
    for (;;) {
        const bool has_next = S.next(ui + 1, nxt);
        const char* nA = has_next ? (const char*)g.A + (size_t)nxt.pm * tstep : cA; const char* nB = has_next ? (const char*)g.Bt + (size_t)nxt.pn * tstep : cB;
        for (int t = 0; t < nt; t += 2) {
            const bool last = (t == nt - 2);
            const char* a1 = cA + (size_t)(t + 1) * kstep;
            const char* a2 = last ? nA : cA + (size_t)(t + 2) * kstep; const char* b2 = last ? nB : cB + (size_t)(t + 2) * kstep;
            const char* a3 = a2 + kstep; const char* b3 = b2 + kstep;
            if (last && has_next) S.a_ready(nxt);
            if constexpr (SP2) {
            PG8_LDB(B0, 0, 0); PG8_LDB(B1, 0, 1); PG8_SCHED; PG8_LDA(At, 0, 0); PG8_STAGE(PG8_SA(1, 1), a1 + hstep, voffA);
            PG8_WAIT_V(8); PG8_WAIT_L(0); PG8_BAR; PG8_MMA(0, 0, At, B0); PG8_MMA(0, 1, At, B1); PG8_BAR; PG8_SCHED;
            PG8_LDA(At, 0, 1); PG8_STAGE(PG8_SB(0, 0), b2, voffB); PG8_STAGE(PG8_SB(0, 1), b2 + hstep, voffB); PG8_STAGE(PG8_SA(0, 0), a2, voffA);
            PG8_WAIT_V(8); PG8_WAIT_L(0); PG8_BAR; PG8_MMA(1, 0, At, B0); PG8_MMA(1, 1, At, B1); PG8_BAR; PG8_SCHED;
            PG8_LDB(B0, 1, 0); PG8_LDB(B1, 1, 1); PG8_SCHED; PG8_LDA(At, 1, 0); PG8_STAGE(PG8_SA(0, 1), a2 + hstep, voffA);
            PG8_WAIT_V(8); PG8_WAIT_L(0); PG8_BAR; PG8_MMA(0, 0, At, B0); PG8_MMA(0, 1, At, B1); PG8_BAR; PG8_SCHED;
            PG8_LDA(At, 1, 1); PG8_STAGE(PG8_SB(1, 0), b3, voffB); PG8_STAGE(PG8_SB(1, 1), b3 + hstep, voffB); PG8_STAGE(PG8_SA(1, 0), a3, voffA);
            PG8_WAIT_V(8); PG8_WAIT_L(0); PG8_BAR; PG8_MMA(1, 0, At, B0); PG8_MMA(1, 1, At, B1); PG8_BAR; PG8_SCHED;
            } else {
            PG8_LDB(B0, 0, 0); PG8_SCHED; PG8_LDA(At, 0, 0); PG8_STAGE(PG8_SA(1, 1), a1 + hstep, voffA);
            PG8_WAIT_L(8); PG8_BAR; PG8_WAIT_L(0); PG8_MMA(0, 0, At, B0); PG8_BAR; PG8_SCHED;
            PG8_LDB(B1, 0, 1); PG8_STAGE(PG8_SB(0, 0), b2, voffB);
            PG8_BAR; PG8_WAIT_L(0); PG8_MMA(0, 1, At, B1); PG8_BAR;
            PG8_LDA(At, 0, 1); PG8_STAGE(PG8_SA(0, 0), a2, voffA);
            PG8_BAR; PG8_WAIT_L(0); PG8_MMA(1, 0, At, B0); PG8_BAR; PG8_SCHED;
            PG8_STAGE(PG8_SB(0, 1), b2 + hstep, voffB);
            PG8_WAIT_V(6); PG8_BAR; PG8_MMA(1, 1, At, B1); PG8_BAR;
            PG8_LDB(B0, 1, 0); PG8_SCHED; PG8_LDA(At, 1, 0); PG8_STAGE(PG8_SA(0, 1), a2 + hstep, voffA);
            PG8_WAIT_L(8); PG8_BAR; PG8_WAIT_L(0); PG8_MMA(0, 0, At, B0); PG8_BAR; PG8_SCHED;
            PG8_LDB(B1, 1, 1); PG8_STAGE(PG8_SB(1, 0), b3, voffB);
            PG8_BAR; PG8_WAIT_L(0); PG8_MMA(0, 1, At, B1); PG8_BAR;
            PG8_LDA(At, 1, 1); PG8_STAGE(PG8_SA(1, 0), a3, voffA);
            PG8_BAR; PG8_WAIT_L(0); PG8_MMA(1, 0, At, B0); PG8_BAR; PG8_SCHED;
            PG8_STAGE(PG8_SB(1, 1), b3 + hstep, voffB);
            PG8_WAIT_V(6); PG8_BAR; PG8_MMA(1, 1, At, B1); PG8_BAR;
            }
        }
        if constexpr (ALIGN_EPI) { if (wr == 0) PG8_BAR; }
        if constexpr (I8) {
            static_assert(Epi::PERM && !Epi::AFTER_DRAIN, "int8 mode: PERM epilogues only");
            f32x4 sb_[2][2];
#pragma unroll
            for (int bj = 0; bj < 2; ++bj)
#pragma unroll
                for (int n = 0; n < 2; ++n) sb_[bj][n] = *(const f32x4*)(g.sB + cur.pn * BM + bj * HALF + wc * 32 + 8 * fq + 4 * n);
#pragma unroll
            for (int ai = 0; ai < 2; ++ai)
#pragma unroll
                for (int m = 0; m < 4; ++m) { const float sa_ = g.sA ? g.sA[cur.pm * BM + ai * HALF + wr * 64 + m * 16 + fr] : g.sAc;
#pragma unroll
                    for (int bj = 0; bj < 2; ++bj)
#pragma unroll
                        for (int n = 0; n < 2; ++n) { const i32x4 ci_ = __builtin_bit_cast(i32x4, acc[ai][bj][m][n]);
                            acc[ai][bj][m][n] = (f32x4){(float)ci_[0], (float)ci_[1], (float)ci_[2], (float)ci_[3]} * sa_ * sb_[bj][n]; } }
        }
        if constexpr (!Epi::AFTER_DRAIN) { E(acc, cur, wr, wc, fr, fq); S.done(cur); }
        if (!has_next) break;
#pragma unroll
        for (int a = 0; a < 2; ++a)
#pragma unroll
            for (int b = 0; b < 2; ++b)
#pragma unroll
                for (int m = 0; m < 4; ++m)
#pragma unroll
                    for (int n = 0; n < 2; ++n) acc[a][b][m][n] = (f32x4){0.f, 0.f, 0.f, 0.f};
        cur = nxt; cA = nA; cB = nB; ++ui;
        if constexpr (ALIGN_EPI) { if (wr == 1) PG8_BAR; }
    }
    PG8_WAIT_V(0);
    if constexpr (!ALIGN_EPI) { if (wr == 0) PG8_BAR; }
    PG8_BAR;
    if constexpr (Epi::AFTER_DRAIN) { E.fused(acc, cur, wr, wc, fr, fq, lds, wid, lane); S.done(cur); }
#undef PG8_SA
#undef PG8_SB
#undef PG8_STAGE
#undef PG8_LDA
#undef PG8_LDB
#undef PG8_MMA
#undef PG8_WAIT_V
#undef PG8_WAIT_L
#undef PG8_BAR
#undef PG8_SCHED
}
}
#include <hip/hip_bf16.h>
#include <cmath>
namespace attn_body {
using bf16=__hip_bfloat16;
using bf16x8=__attribute__((ext_vector_type(8)))short;
using s16x4=__attribute__((ext_vector_type(4)))short;
using f32x16=__attribute__((ext_vector_type(16)))float;
using u32x4=__attribute__((ext_vector_type(4)))unsigned;
constexpr int BATCH=8,NHEAD=16,SEQ=4096,D=64,DM=NHEAD*D;
constexpr int NW=8,QBLK=32,QB=QBLK*NW,KVBLK=64,NQB=SEQ/QB;
constexpr int ATTN_PITCH=DM, ATTN_UNIT_ROWS=QB;
__device__ __forceinline__ int crow(int r,int hi){return (r&3)+8*(r>>2)+4*hi;}
#define SBAR() __builtin_amdgcn_sched_barrier(0)
__device__ __forceinline__ void cmask(f32x16&p0,f32x16&p1,int jb,int qrel,int hi){
  const float NEG=-INFINITY; int kb=64*jb+4*hi;
  #pragma unroll
  for(int r=0;r<16;++r){int kv=kb+(r&3)+8*(r>>2); if(kv>qrel)p0[r]=NEG; if(kv+32>qrel)p1[r]=NEG;}
}

constexpr int NSLOT=3, SLOTB=8192, VSLOTB=2*SLOTB;
constexpr int LDS_K=0, LDS_V=NSLOT*SLOTB, LDS_WS=LDS_V+NSLOT*VSLOTB, LDS_OST=LDS_WS+NW*64*4, LDS_BYTES=LDS_OST+NW*4096;
constexpr float C2=0.125f*1.4426950408889634f;
__device__ __forceinline__ void glds16(const void*gsrc,unsigned lds_dst){unsigned keep;
  asm volatile("s_mov_b32 %0, m0\n\ts_mov_b32 m0, %2\n\ts_nop 0\n\tglobal_load_lds_dwordx4 %1, off\n\ts_mov_b32 m0, %0":"=&s"(keep):"v"(gsrc),"s"(lds_dst):"memory");}
__device__ __forceinline__ float max3f(float a,float b,float c){float r;asm("v_max3_f32 %0, %1, %2, %3":"=v"(r):"v"(a),"v"(b),"v"(c));return r;}
__device__ __forceinline__ float max2f(float a,float b){float r;asm("v_max_f32_e32 %0, %1, %2":"=v"(r):"v"(a),"v"(b));return r;}
__device__ __forceinline__ float fadd_s(float a,float b){float r;asm("v_add_f32_e32 %0, %1, %2":"=v"(r):"v"(a),"v"(b));return r;}
__device__ __forceinline__ float fsub_s(float a,float b){float r;asm("v_sub_f32_e32 %0, %1, %2":"=v"(r):"v"(a),"v"(b));return r;}
typedef float f32x2_t __attribute__((ext_vector_type(2))); typedef __bf16 bf16x2_t __attribute__((ext_vector_type(2)));
__device__ __forceinline__ unsigned cvtpk_s(float lo,float hi){f32x2_t v={lo,hi};bf16x2_t b=__builtin_convertvector(v,bf16x2_t);return __builtin_bit_cast(unsigned,b);}
#define WAIT_BAR(N) asm volatile("s_waitcnt vmcnt(" #N ") lgkmcnt(0)\n\ts_barrier":::"memory")

__device__ __forceinline__ void qkt(f32x16&p0,f32x16&p1,const char*Kslot,const bf16x8*qr,const f32x16&negm,int r32,int hi){
  const char*kb=Kslot+hi*1024+r32*16;
  #pragma unroll
  for(int d0=0;d0<4;++d0){
    const bf16x8 b0=*reinterpret_cast<const bf16x8*>(kb+d0*2048);
    const bf16x8 b1=*reinterpret_cast<const bf16x8*>(kb+d0*2048+512);
    if(d0==0){p0=__builtin_amdgcn_mfma_f32_32x32x16_bf16(b0,qr[0],negm,0,0,0);p1=__builtin_amdgcn_mfma_f32_32x32x16_bf16(b1,qr[0],negm,0,0,0);}
    else{p0=__builtin_amdgcn_mfma_f32_32x32x16_bf16(b0,qr[d0],p0,0,0,0);p1=__builtin_amdgcn_mfma_f32_32x32x16_bf16(b1,qr[d0],p1,0,0,0);}}
}
typedef __attribute__((address_space(3))) const char* lds_cptr;
typedef short v4i16_t __attribute__((ext_vector_type(4)));
__device__ __forceinline__ void kload8(bf16x8*kf,lds_cptr kp){
  kf[0]=*(const __attribute__((address_space(3))) bf16x8*)(kp);      kf[1]=*(const __attribute__((address_space(3))) bf16x8*)(kp+512);
  kf[2]=*(const __attribute__((address_space(3))) bf16x8*)(kp+2048); kf[3]=*(const __attribute__((address_space(3))) bf16x8*)(kp+2560);
  kf[4]=*(const __attribute__((address_space(3))) bf16x8*)(kp+4096); kf[5]=*(const __attribute__((address_space(3))) bf16x8*)(kp+4608);
  kf[6]=*(const __attribute__((address_space(3))) bf16x8*)(kp+6144); kf[7]=*(const __attribute__((address_space(3))) bf16x8*)(kp+6656);
}
__device__ __forceinline__ void kload2(bf16x8*kf,lds_cptr kp,int j){ kf[2*j]=*(const __attribute__((address_space(3))) bf16x8*)(kp+j*2048); kf[2*j+1]=*(const __attribute__((address_space(3))) bf16x8*)(kp+j*2048+512); }
__device__ __forceinline__ s16x4 vtr(lds_cptr p){ return __builtin_bit_cast(s16x4,__builtin_amdgcn_ds_read_tr16_b64_v4i16((__attribute__((address_space(3))) v4i16_t*)p)); }
__device__ __forceinline__ float rowmax(const f32x16&p0,const f32x16&p1){
  float a=max3f(p0[0],p0[1],p1[0]),b=max3f(p0[2],p0[3],p1[1]);a=max3f(a,p1[2],p1[3]);
  #pragma unroll
  for(int r=4;r<16;r+=4){a=max3f(a,p0[r],p0[r+1]);b=max3f(b,p0[r+2],p0[r+3]);a=max3f(a,p1[r],p1[r+1]);b=max3f(b,p1[r+2],p1[r+3]);}
  const float m=max2f(a,b);
  auto rr=__builtin_amdgcn_permlane32_swap(__float_as_uint(m),__float_as_uint(m),false,false);
  return max2f(__uint_as_float(rr[0]),__uint_as_float(rr[1]));
}
__device__ __forceinline__ void pv(f32x16*o,int vb,bf16x8 pa0,bf16x8 pa1,bf16x8 pa2,bf16x8 pa3){
  #pragma unroll
  for(int d0=0;d0<4;++d0){s16x4 lo[4],hi[4];
    #pragma unroll
    for(int ks=0;ks<4;++ks){
      asm volatile("ds_read_b64_tr_b16 %0,%1 offset:%c2":"=&v"(lo[ks]):"v"(vb),"i"(d0*4096+ks*1024):"memory");
      asm volatile("ds_read_b64_tr_b16 %0,%1 offset:%c2":"=&v"(hi[ks]):"v"(vb),"i"(d0*4096+ks*1024+512):"memory");}
    asm volatile("s_waitcnt lgkmcnt(0)":::"memory");SBAR();
    #define PK(k) (bf16x8){lo[k][0],lo[k][1],lo[k][2],lo[k][3],hi[k][0],hi[k][1],hi[k][2],hi[k][3]}
    o[d0]=__builtin_amdgcn_mfma_f32_32x32x16_bf16(pa0,PK(0),o[d0],0,0,0);
    o[d0]=__builtin_amdgcn_mfma_f32_32x32x16_bf16(pa1,PK(1),o[d0],0,0,0);
    o[d0]=__builtin_amdgcn_mfma_f32_32x32x16_bf16(pa2,PK(2),o[d0],0,0,0);
    o[d0]=__builtin_amdgcn_mfma_f32_32x32x16_bf16(pa3,PK(3),o[d0],0,0,0);
    #undef PK
  }
}

#ifndef ATTN_STORE16
#define ATTN_STORE16(p,v) (*(u32x4*)(p)=(v))
#endif
template<int THRL> __device__ __forceinline__ void attn_unit(int b,int hc,int qb,const bf16*Q,const bf16*__restrict__ K,const bf16*__restrict__ V,bf16*O,char*shm,const int tid_in){
  const int tid=tid_in,lane=tid&63,r32=lane&31,hi=lane>>5; const int wid=__builtin_amdgcn_readfirstlane(tid>>6);
  const long rowbase=(long)b*SEQ; const int q0=qb*QB;
  const bf16*Qw=Q+(rowbase+q0+wid*QBLK)*DM+hc*128;
  const bf16*Kh=K+rowbase*DM+hc*128,*Vh=V+rowbase*DM+(hc>>1)*256;
  const unsigned lds0=(unsigned)(uintptr_t)shm;
  float*wsf=(float*)(shm+LDS_WS)+wid*64;
  const bf16*ksrc=Kh+(long)lane*DM+wid*8;
  const bf16*vsrc=Vh+(long)(16*(wid&3)+(lane>>2))*DM+(wid>>2)*32+(lane&3)*8;
  const unsigned kdst=lds0+LDS_K+wid*1024, vdst=lds0+LDS_V+wid*1024;
  #define DMA_K(t,slot) glds16(ksrc+(long)(t)*KVBLK*DM,(unsigned)__builtin_amdgcn_readfirstlane(kdst+(slot)))
  #define DMA_V(t,slot) do{ glds16(vsrc+(long)(t)*KVBLK*DM,(unsigned)__builtin_amdgcn_readfirstlane(vdst+2*(slot))); glds16(vsrc+64+(long)(t)*KVBLK*DM,(unsigned)__builtin_amdgcn_readfirstlane(vdst+2*(slot)+8192)); }while(0)
  const int vb0=(int)(lds0+LDS_V)+((lane>>4)&1)*32+(lane&3)*8+(4*hi+((lane&15)>>2))*64;
  const char*Kbase=shm+LDS_K; bf16x8 kf[8];
  const lds_cptr shm3=(lds_cptr)shm; const lds_cptr kp0=shm3+LDS_K+hi*1024+r32*16; const lds_cptr vp0=shm3+LDS_V+((lane>>4)&1)*32+(lane&3)*8+(4*hi+((lane&15)>>2))*64;
  const int NT=(q0+QB)/KVBLK;
  DMA_K(0,0);DMA_V(0,0);DMA_K(1,SLOTB);
  bf16x8 qr[4];
  #pragma unroll
  for(int d0=0;d0<4;++d0)qr[d0]=*reinterpret_cast<const bf16x8*>(&Qw[(long)r32*DM+d0*16+hi*8]);
  float mhat=0.f,l_reg=0.f;f32x16 o[4];o[0]=f32x16{};o[1]=f32x16{};o[2]=f32x16{};o[3]=f32x16{};
  const int qrel=wid*QBLK+r32;
  #define CMASK(P0,P1,t) do{int jb_=(t)-(NT-4); if(jb_>=0)cmask(P0,P1,jb_,qrel,hi);}while(0)
  bool resc=false;
  #define START(P0,P1) do{ const float rm=rowmax(P0,P1); resc=false; \
    { const float dl=rm; mhat=fadd_s(mhat,dl); \
      _Pragma("unroll") for(int r=0;r<16;++r){P0[r]=fsub_s(P0[r],dl);P1[r]=fsub_s(P1[r],dl);} } \
    _Pragma("unroll") for(int r=0;r<16;++r)P0[r]=__builtin_amdgcn_exp2f(P0[r]); }while(0)
  #define RESC() do{ if(resc){ asm volatile("s_waitcnt lgkmcnt(0)":::"memory"); \
      _Pragma("unroll") for(int d_=0;d_<4;++d_) _Pragma("unroll") for(int r=0;r<16;++r)o[d_][r]*=wsf[crow(r,hi)]; } }while(0)
  f32x16 pA0,pA1,pB0,pB1;
  int sl_prev=0,sl_cur=0,sl_next=SLOTB;
  #define ROT() do{sl_prev=sl_cur;sl_cur=sl_next;sl_next=(sl_next==(NSLOT-1)*SLOTB)?0:sl_next+SLOTB;}while(0)
  DMA_K(2,2*SLOTB);
  WAIT_BAR(4);
  { const f32x16 zc=f32x16{}; qkt(pA0,pA1,Kbase,qr,zc,r32,hi); }asm volatile("s_nop 15\n\ts_nop 7":"+v"(pA0),"+v"(pA1));CMASK(pA0,pA1,0);
  START(pA0,pA1);
  _Pragma("unroll") for(int r=0;r<16;++r)pA1[r]=__builtin_amdgcn_exp2f(pA1[r]);
  WAIT_BAR(0);
  DMA_K(3,0);DMA_V(1,SLOTB);
  ROT();
  kload8(kf,kp0+sl_cur);
  WAIT_BAR(3);
  s16x4 vlo[8],vhi[8],wlo[8],whi[8]; u32x4 pw0,pw1,pw2,pw3;
  #define PKW(P,B) cvtpk_s(P[B],P[B+1])
  #define PAF(k) __builtin_bit_cast(bf16x8,pw##k)
  #define VFR(i) (bf16x8){vlo[i][0],vlo[i][1],vlo[i][2],vlo[i][3],vhi[i][0],vhi[i][1],vhi[i][2],vhi[i][3]}
  #define WFR(i) (bf16x8){wlo[i][0],wlo[i][1],wlo[i][2],wlo[i][3],whi[i][0],whi[i][1],whi[i][2],whi[i][3]}
  #define PIN(x) asm volatile("":"+v"(x))
  #define MX3(a,b,c) __builtin_fmaxf(__builtin_fmaxf((a),(b)),(c))
  #define GAPA(MF,A0,A1,A2,A3,W0,W1,PW) do{ MF; sacc+=A0; sacc+=A1; sacc+=A2; sacc+=A3; PIN(sacc); W0; W1; PIN(PW); SBAR(); }while(0)
  #define EX(v) __builtin_amdgcn_exp2f(v)
  #define GAPM(MF,OPS) do{ MF; OPS PIN(a_); PIN(b_); SBAR(); }while(0)
  #define GAPX(MF,OPS) do{ MF; OPS SBAR(); }while(0)
  #define VRD(i) do{ vlo[i]=vtr(vp_+(((i)>>2)*4096+((i)&3)*1024)); vhi[i]=vtr(vp_+(((i)>>2)*4096+((i)&3)*1024+512)); }while(0)
  #define VRD2(i) do{ wlo[i]=vtr(vp_+(8192+((i)>>2)*4096+((i)&3)*1024)); whi[i]=vtr(vp_+(8192+((i)>>2)*4096+((i)&3)*1024+512)); }while(0)
  #define KRD(G,j) do{ if(G){ kload2(kf,kp0+sl_next,j); SBAR(); } }while(0)
  #define STEP(C0,C1,P0,P1,t,GK,GV,GL) do{ SBAR(); \
    const lds_cptr vp_=vp0+2*sl_prev; f32x16 zc_; { const float nm_=-mhat; _Pragma("unroll") for(int r=0;r<16;++r)zc_[r]=nm_; }   \
    VRD(0); SBAR(); float sacc=(P0[0]+P0[1]); \
    GAPA(C0=__builtin_amdgcn_mfma_f32_32x32x16_bf16(kf[0],qr[0],zc_,0,0,0), P0[2],P0[3],P0[4],P0[5],     pw0[0]=PKW(P0,0), pw0[1]=PKW(P0,2), pw0); \
    VRD(4); SBAR(); GAPA(C1=__builtin_amdgcn_mfma_f32_32x32x16_bf16(kf[1],qr[0],zc_,0,0,0), P0[6],P0[7],P0[8],P0[9],     pw0[2]=PKW(P0,4), pw0[3]=PKW(P0,6), pw0); \
    VRD(1); SBAR(); GAPA(C0=__builtin_amdgcn_mfma_f32_32x32x16_bf16(kf[2],qr[1],C0,0,0,0),   P0[10],P0[11],P0[12],P0[13], pw1[0]=PKW(P0,8), pw1[1]=PKW(P0,10), pw1); \
    VRD(5); SBAR(); GAPA(C1=__builtin_amdgcn_mfma_f32_32x32x16_bf16(kf[3],qr[1],C1,0,0,0),   P0[14],P0[15],P1[0],P1[1],   pw1[2]=PKW(P0,12),pw1[3]=PKW(P0,14), pw1); \
    VRD(2); SBAR(); GAPA(C0=__builtin_amdgcn_mfma_f32_32x32x16_bf16(kf[4],qr[2],C0,0,0,0),   P1[2],P1[3],P1[4],P1[5],     pw2[0]=PKW(P1,0), pw2[1]=PKW(P1,2), pw2); \
    VRD(6); SBAR(); GAPA(C1=__builtin_amdgcn_mfma_f32_32x32x16_bf16(kf[5],qr[2],C1,0,0,0),   P1[6],P1[7],P1[8],P1[9],     pw2[2]=PKW(P1,4), pw2[3]=PKW(P1,6), pw2); \
    VRD(3); SBAR(); GAPA(C0=__builtin_amdgcn_mfma_f32_32x32x16_bf16(kf[6],qr[3],C0,0,0,0),   P1[10],P1[11],P1[12],P1[13], pw3[0]=PKW(P1,8), pw3[1]=PKW(P1,10), pw3); \
    VRD(7); SBAR(); GAPA(C1=__builtin_amdgcn_mfma_f32_32x32x16_bf16(kf[7],qr[3],C1,0,0,0),   P1[14],P1[15],0.f,0.f,       pw3[2]=PKW(P1,12),pw3[3]=PKW(P1,14), pw3); \
    l_reg+=sacc; \
    if(GK){DMA_K((t)+3,sl_cur);} if(GV){DMA_V((t)+1,sl_next);} \
    CMASK(C0,C1,t); \
    float a_,b_; SBAR(); \
    VRD2(0); SBAR(); GAPM(o[0]=__builtin_amdgcn_mfma_f32_32x32x16_bf16(PAF(0),VFR(0),o[0],0,0,0), a_=MX3(C0[0],C0[1],C1[0]); b_=MX3(C0[2],C0[3],C1[1]); a_=MX3(a_,C1[2],C1[3]); a_=MX3(a_,C0[4],C0[5]);); \
    VRD2(4); SBAR(); GAPM(o[1]=__builtin_amdgcn_mfma_f32_32x32x16_bf16(PAF(0),VFR(4),o[1],0,0,0), b_=MX3(b_,C0[6],C0[7]); a_=MX3(a_,C1[4],C1[5]); b_=MX3(b_,C1[6],C1[7]); a_=MX3(a_,C0[8],C0[9]);); \
    VRD2(1); SBAR(); GAPM(o[0]=__builtin_amdgcn_mfma_f32_32x32x16_bf16(PAF(1),VFR(1),o[0],0,0,0), b_=MX3(b_,C0[10],C0[11]); a_=MX3(a_,C1[8],C1[9]); b_=MX3(b_,C1[10],C1[11]); a_=MX3(a_,C0[12],C0[13]);); \
    VRD2(5); SBAR(); GAPM(o[1]=__builtin_amdgcn_mfma_f32_32x32x16_bf16(PAF(1),VFR(5),o[1],0,0,0), b_=MX3(b_,C0[14],C0[15]); a_=MX3(a_,C1[12],C1[13]); b_=MX3(b_,C1[14],C1[15]);); \
    { float rm=__builtin_fmaxf(a_,b_); { auto rr=__builtin_amdgcn_permlane32_swap(__float_as_uint(rm),__float_as_uint(rm),false,false); rm=__builtin_fmaxf(__uint_as_float(rr[0]),__uint_as_float(rr[1])); } \
      resc=false; \
      if(__builtin_expect(__any(rm>(float)THRL),0)){ const float dl=__builtin_fmaxf(rm,0.f); mhat+=dl; \
        _Pragma("unroll") for(int r=0;r<16;++r){C0[r]-=dl;C1[r]-=dl;} \
        const float f=__builtin_amdgcn_exp2f(-dl); l_reg*=f; if(hi==0)wsf[r32]=f; resc=true; } } \
    SBAR(); \
    VRD2(2); SBAR(); GAPX(o[0]=__builtin_amdgcn_mfma_f32_32x32x16_bf16(PAF(2),VFR(2),o[0],0,0,0), C0[0]=EX(C0[0]); C0[1]=EX(C0[1]); C0[2]=EX(C0[2]); PIN(C0);); \
    VRD2(6); SBAR(); GAPX(o[1]=__builtin_amdgcn_mfma_f32_32x32x16_bf16(PAF(2),VFR(6),o[1],0,0,0), C0[3]=EX(C0[3]); C0[4]=EX(C0[4]); C0[5]=EX(C0[5]); PIN(C0);); \
    VRD2(3); SBAR(); GAPX(o[0]=__builtin_amdgcn_mfma_f32_32x32x16_bf16(PAF(3),VFR(3),o[0],0,0,0), C0[6]=EX(C0[6]); C0[7]=EX(C0[7]); C0[8]=EX(C0[8]); PIN(C0);); \
    VRD2(7); SBAR(); GAPX(o[1]=__builtin_amdgcn_mfma_f32_32x32x16_bf16(PAF(3),VFR(7),o[1],0,0,0), C0[9]=EX(C0[9]); C0[10]=EX(C0[10]); C0[11]=EX(C0[11]); PIN(C0);); \
    GAPX(o[2]=__builtin_amdgcn_mfma_f32_32x32x16_bf16(PAF(0),WFR(0),o[2],0,0,0), C0[12]=EX(C0[12]); C0[13]=EX(C0[13]); C0[14]=EX(C0[14]); PIN(C0);); \
    GAPX(o[3]=__builtin_amdgcn_mfma_f32_32x32x16_bf16(PAF(0),WFR(4),o[3],0,0,0), C0[15]=EX(C0[15]); C1[0]=EX(C1[0]); C1[1]=EX(C1[1]); PIN(C0); PIN(C1);); \
    KRD(GL,0); GAPX(o[2]=__builtin_amdgcn_mfma_f32_32x32x16_bf16(PAF(1),WFR(1),o[2],0,0,0), C1[2]=EX(C1[2]); C1[3]=EX(C1[3]); PIN(C1);); \
    KRD(GL,1); GAPX(o[3]=__builtin_amdgcn_mfma_f32_32x32x16_bf16(PAF(1),WFR(5),o[3],0,0,0), C1[4]=EX(C1[4]); C1[5]=EX(C1[5]); PIN(C1);); \
    KRD(GL,2); GAPX(o[2]=__builtin_amdgcn_mfma_f32_32x32x16_bf16(PAF(2),WFR(2),o[2],0,0,0), C1[6]=EX(C1[6]); C1[7]=EX(C1[7]); PIN(C1);); \
    KRD(GL,3); GAPX(o[3]=__builtin_amdgcn_mfma_f32_32x32x16_bf16(PAF(2),WFR(6),o[3],0,0,0), C1[8]=EX(C1[8]); C1[9]=EX(C1[9]); PIN(C1);); \
    GAPX(o[2]=__builtin_amdgcn_mfma_f32_32x32x16_bf16(PAF(3),WFR(3),o[2],0,0,0), C1[10]=EX(C1[10]); C1[11]=EX(C1[11]); C1[12]=EX(C1[12]); PIN(C1);); \
    GAPX(o[3]=__builtin_amdgcn_mfma_f32_32x32x16_bf16(PAF(3),WFR(7),o[3],0,0,0), C1[13]=EX(C1[13]); C1[14]=EX(C1[14]); C1[15]=EX(C1[15]); PIN(C1);); \
    }while(0)
  int t=1;
  #undef CMASK
  #define CMASK(P0,P1,t) do{}while(0)
  for(;t+5<NT;t+=2){
    STEP(pB0,pB1,pA0,pA1,t,true,true,true);     WAIT_BAR(3); RESC(); ROT();
    STEP(pA0,pA1,pB0,pB1,t+1,true,true,true);   WAIT_BAR(3); RESC(); ROT();
  }
  #undef CMASK
  #define CMASK(P0,P1,t) do{int jb_=(t)-(NT-4); if(jb_>=0)cmask(P0,P1,jb_,qrel,hi);}while(0)
  #define ENDW(tt) do{ if((tt)+3<NT){WAIT_BAR(3);} else if((tt)+2<NT){WAIT_BAR(2);} else {WAIT_BAR(0);} }while(0)
  for(;t+1<NT;t+=2){
    STEP(pB0,pB1,pA0,pA1,t,(t+3<NT),(t+1<NT),(t+1<NT));       ENDW(t);   RESC(); ROT();
    STEP(pA0,pA1,pB0,pB1,t+1,(t+4<NT),(t+2<NT),(t+2<NT));     ENDW(t+1); RESC(); ROT();
  }
  STEP(pB0,pB1,pA0,pA1,NT-1,false,false,false); RESC();
  { float sacc=pB0[0]+pB0[1]; _Pragma("unroll") for(int r=2;r<16;++r)sacc+=pB0[r]; _Pragma("unroll") for(int r=0;r<16;++r)sacc+=pB1[r]; l_reg+=sacc;
    pw0=(u32x4){PKW(pB0,0),PKW(pB0,2),PKW(pB0,4),PKW(pB0,6)};pw1=(u32x4){PKW(pB0,8),PKW(pB0,10),PKW(pB0,12),PKW(pB0,14)};pw2=(u32x4){PKW(pB1,0),PKW(pB1,2),PKW(pB1,4),PKW(pB1,6)};pw3=(u32x4){PKW(pB1,8),PKW(pB1,10),PKW(pB1,12),PKW(pB1,14)};
    SBAR(); pv(o,vb0+2*sl_cur,PAF(0),PAF(1),PAF(2),PAF(3)); }
  #undef PKW
  #undef PAF
  #undef VFR
  #undef WFR
  #undef VRD2
  #undef PIN
  #undef MX3
  #undef GAPA
  #undef GAPM
  #undef GAPX
  #undef EX
  #undef VRD
  #undef KRD
  #undef STEP
  #undef ENDW
  {auto rr=__builtin_amdgcn_permlane32_swap(__float_as_uint(l_reg),__float_as_uint(l_reg),false,false);l_reg=__uint_as_float(rr[0])+__uint_as_float(rr[1]);}
  if(hi==0)wsf[32+r32]=l_reg;asm volatile("s_waitcnt lgkmcnt(0)":::"memory");
  int hi_e=hi,r32_e=r32,lane_e=lane; asm volatile("":"+v"(hi_e),"+v"(r32_e),"+v"(lane_e));
  float rli[16];
  #pragma unroll
  for(int r=0;r<16;++r)rli[r]=__builtin_amdgcn_rcpf(wsf[32+crow(r,hi_e)]);
  bf16*Ow=O+(rowbase+q0+wid*QBLK)*DM+hc*128;
  { bf16*stg=(bf16*)(shm+LDS_OST)+wid*2048;
    #pragma unroll
    for(int ps=0;ps<2;++ps){
    #pragma unroll
    for(int r=0;r<16;++r){const int orow=crow(r,hi_e);
      #pragma unroll
      for(int d0=0;d0<2;++d0)stg[orow*64+d0*32+r32_e]=__float2bfloat16(o[2*ps+d0][r]*rli[r]);}
    asm volatile("s_waitcnt lgkmcnt(0)":::"memory");
    #pragma unroll
    for(int i=0;i<4;++i){const int row=i*8+(lane_e>>3),ch=lane_e&7; const u32x4 v=*(const u32x4*)(stg+row*64+ch*8); ATTN_STORE16(Ow+(long)row*DM+ps*64+ch*8,v);}
    asm volatile("s_waitcnt lgkmcnt(0)":::"memory"); } }
  asm volatile("s_waitcnt lgkmcnt(0)\n\ts_barrier":::"memory");
  #undef DMA_K
  #undef DMA_V
  #undef CMASK
  #undef START
  #undef RESC
  #undef ROT
}
constexpr int ATTN_LDS_BYTES=LDS_BYTES;
struct AttnTensors { const bf16* Q; const bf16* K; const bf16* V; bf16* O; };
struct AttnUnit { int bh; int qb; };
template<class Sched,int THRL=8> __device__ __forceinline__ void attn_phase(char*lds,const AttnTensors&T,const Sched&S,const int tid_in){
  AttnUnit u;
  for(int i=0;S.next(i,u);++i){ S.a_ready(u); attn_unit<THRL>(u.bh>>3,u.bh&7,u.qb,T.Q,T.K,T.V,T.O,lds,tid_in);     S.done(u); }
}
#undef SBAR
#undef WAIT_BAR
}
constexpr int NWAVES = 8;
constexpr int BATCH = 8, SEQ = 4096, DM = 1024, M = BATCH * SEQ;
constexpr int IN_COLS = 2560, PLE_DIM = 256, NEXP = 16384, QCOLS = 2048;
constexpr float EPS = 1e-6f;
#ifndef MK_N_LAUNCHES
#define MK_N_LAUNCHES 1
#endif
constexpr int N_PHASES = 11;
constexpr size_t MiB = 1u << 20;
constexpr size_t WS_CTL = 0, CTL_ZERO_BYTES = 64 * 1024;
constexpr size_t WS_ROPEC = 1 * MiB, WS_ROPES = 1 * MiB + 512 * 1024;
constexpr size_t WS_KEYS = 2 * MiB;
constexpr size_t WS_WPROJ = 3 * MiB;
constexpr size_t WS_WIN = 4 * MiB;
constexpr size_t WS_WOUT = 10 * MiB, WS_WQ = 12 * MiB, WS_WGATE = 16 * MiB;
constexpr size_t WS_SSQ1 = 18 * MiB;
constexpr size_t WS_PB = 24 * MiB;
constexpr size_t WS_E = 40 * MiB;
constexpr size_t WS_UT = 104 * MiB, WS_VT = 120 * MiB;
constexpr size_t WS_SU = 136 * MiB, WS_SV = 137 * MiB;
constexpr size_t WS_XN = 168 * MiB;
constexpr size_t WS_QO = 232 * MiB, WS_K = 296 * MiB, WS_V = 360 * MiB;
constexpr size_t WS_U = 424 * MiB;
constexpr size_t WS_QP = 296 * MiB;
constexpr size_t WS_XN2 = 424 * MiB;
constexpr size_t WS_SM = 138 * MiB, WS_HS = 139 * MiB, WS_SSQ2 = 140 * MiB;
constexpr size_t WS_HQ = 24 * MiB;
constexpr size_t WS_APART = 168 * MiB;
constexpr size_t OUT_QM = 64 * MiB;
constexpr size_t WS_QM = 424 * MiB;
constexpr size_t WS_EID = 488 * MiB, WS_GATE = 496 * MiB;
constexpr size_t WS_END = 512 * MiB;
constexpr int RING_BYTES = 131072, LDS_BYTES = 147456;
constexpr int MISC_OFF = LDS_BYTES - 256;
constexpr int CW_MAP = 512, CW_RB = 1024, CW_RB3 = 1280, CW_LB = 1536;
constexpr int CW_CMAX = 8192, CW_CDONE = 200;
constexpr size_t WS_SHQ = 141 * MiB + 512 * 1024, WS_AMX = 144 * MiB, OUT_H1Q = 96 * MiB;
constexpr size_t WS_SPB = 141 * MiB + 768 * 1024;
constexpr size_t WS_SXN = 141 * MiB, WS_SW = 142 * MiB;
constexpr int CW_BAR = 4096;

#define GAS __attribute__((address_space(1)))
#define LAS __attribute__((address_space(3)))
typedef unsigned short bf16;
typedef unsigned v4u __attribute__((ext_vector_type(4)));
typedef float f32x4 __attribute__((ext_vector_type(4)));
typedef float f32x16 __attribute__((ext_vector_type(16)));
typedef short bf16x8 __attribute__((ext_vector_type(8)));
typedef __bf16 bf16x2_t __attribute__((ext_vector_type(2)));
#define LDS_WAIT() asm volatile("s_waitcnt lgkmcnt(0)" ::: "memory")
#define VM_WAIT() asm volatile("s_waitcnt vmcnt(0)" ::: "memory")
__device__ __forceinline__ unsigned f2bf(float f) { unsigned u = __builtin_bit_cast(unsigned, f); return (u + 0x7fffu + ((u >> 16) & 1u)) >> 16; }
__device__ __forceinline__ unsigned pk2(float lo, float hi) { return f2bf(lo) | (f2bf(hi) << 16); }
__device__ __forceinline__ v4u pk8(const f32x4 a, const f32x4 b) { v4u w; w.x = pk2(a[0], a[1]); w.y = pk2(a[2], a[3]); w.z = pk2(b[0], b[1]); w.w = pk2(b[2], b[3]); return w; }
__device__ __forceinline__ float bflo(unsigned w) { return __uint_as_float(w << 16); }
__device__ __forceinline__ float bfhi(unsigned w) { return __uint_as_float(w & 0xffff0000u); }
__device__ __forceinline__ float dot4s_(const f32x4 a) { return (a[0] * a[0] + a[1] * a[1]) + (a[2] * a[2] + a[3] * a[3]); }
template <int CTRL> __device__ __forceinline__ float dpp_f(float v) { return __int_as_float(__builtin_amdgcn_update_dpp(0, __float_as_int(v), CTRL, 0xF, 0xF, true)); }
__device__ __forceinline__ float wave_sum(float v) {
    v += dpp_f<0xB1>(v); v += dpp_f<0x4E>(v); v += dpp_f<0x141>(v); v += dpp_f<0x128>(v);
    { const auto rr = __builtin_amdgcn_permlane16_swap(__float_as_uint(v), __float_as_uint(v), false, false); v = __uint_as_float(rr[0]) + __uint_as_float(rr[1]); }
    { const auto rr = __builtin_amdgcn_permlane32_swap(__float_as_uint(v), __float_as_uint(v), false, false); v = __uint_as_float(rr[0]) + __uint_as_float(rr[1]); }
    return v;
}
__device__ __forceinline__ float wave_max(float v) {
    v = fmaxf(v, dpp_f<0xB1>(v)); v = fmaxf(v, dpp_f<0x4E>(v)); v = fmaxf(v, dpp_f<0x141>(v)); v = fmaxf(v, dpp_f<0x128>(v));
    { const auto rr = __builtin_amdgcn_permlane16_swap(__float_as_uint(v), __float_as_uint(v), false, false); v = fmaxf(__uint_as_float(rr[0]), __uint_as_float(rr[1])); }
    { const auto rr = __builtin_amdgcn_permlane32_swap(__float_as_uint(v), __float_as_uint(v), false, false); v = fmaxf(__uint_as_float(rr[0]), __uint_as_float(rr[1])); }
    return v;
}
__device__ __forceinline__ float dot2bf(unsigned w, unsigned x, float acc) { return __builtin_amdgcn_fdot2_f32_bf16(__builtin_bit_cast(bf16x2_t, w), __builtin_bit_cast(bf16x2_t, x), acc, false); }

typedef GAS unsigned gu32;
#define RLX_AGENT __ATOMIC_RELAXED, __HIP_MEMORY_SCOPE_AGENT
#define XB_TMO      128
#define XB_XCNT(j)  (256  + 64 * (j))
#define XB_XSUB(j)  (1280 + 64 * (j))
#define XB_XGEN(j)  (2304 + 64 * (j))
#define XB_TOP      3328
#define XB_TOPGEN   3392
#define XCD_BAR_WORDS 3456
#define XB_SPIN_CAP (1u << 18)

__device__ __forceinline__ unsigned xb_ld(unsigned* p)              { return __hip_atomic_load(p, __ATOMIC_RELAXED, __HIP_MEMORY_SCOPE_AGENT); }
__device__ __forceinline__ unsigned xb_add(unsigned* p, unsigned v) { return __hip_atomic_fetch_add(p, v, __ATOMIC_RELAXED, __HIP_MEMORY_SCOPE_AGENT); }
__device__ __forceinline__ unsigned xb_xcc_id() { return (unsigned)__builtin_amdgcn_s_getreg((3 << 11) | 20) & 0xFu; }
#define XB_SPIN(cond, bar) do { unsigned _sp = 0; while (cond) { __builtin_amdgcn_s_sleep(1); \
    if ((++_sp & 255u) == 0u) { if (xb_ld(&(bar)[XB_TMO])) break; if (_sp > XB_SPIN_CAP) { atomicAdd(&(bar)[XB_TMO], 1u); break; } } } } while (0)

struct XcdBarrier {
    unsigned* bar; unsigned x;
    volatile LAS unsigned* st;
};

__device__ __forceinline__ XcdBarrier xcd_barrier_post(unsigned* bar, volatile LAS unsigned* st, const bool leader) {
    XcdBarrier b; b.bar = bar; b.x = xb_xcc_id(); b.st = st;
    if (leader) (void)xb_add(&bar[XB_XCNT(b.x)], 1u);
    return b;
}
__device__ __forceinline__ void xcd_barrier_complete(unsigned* bar, unsigned x, unsigned& nloc, unsigned& nx) {
    const unsigned G = gridDim.x * gridDim.y * gridDim.z;
    unsigned sum, cnt, mine, sp = 0u;
    for (;;) {
        sum = 0u; cnt = 0u; mine = 0u;
#pragma unroll
        for (unsigned j = 0; j < 16; ++j) { const unsigned c = xb_ld(&bar[XB_XCNT(j)]); sum += c; cnt += (c > 0u) ? 1u : 0u; mine = (j == x) ? c : mine; }
        if (sum == G) break;
        __builtin_amdgcn_s_sleep(1);
        if ((++sp & 255u) == 0u) { if (xb_ld(&bar[XB_TMO])) break; if (sp > XB_SPIN_CAP) { atomicAdd(&bar[XB_TMO], 1u); break; } }
    }
    nloc = mine > 0u ? mine : 1u; nx = cnt > 0u ? cnt : 1u;
}

__device__ __forceinline__ void xcd_barrier(const XcdBarrier& b, const bool leader  ) {
    asm volatile("s_waitcnt vmcnt(0)" ::: "memory");
    __syncthreads();
    if (leader) {
        unsigned* bar = b.bar;
        __builtin_amdgcn_s_waitcnt(0);
        unsigned nloc = b.st[0], nx = b.st[1];
        if (nloc == 0u) { xcd_barrier_complete(bar, b.x, nloc, nx); b.st[0] = nloc; b.st[1] = nx; }
        const unsigned old = xb_add(&bar[XB_XSUB(b.x)], 1u);
        const unsigned gen = old / nloc;
        if (old + 1u == (gen + 1u) * nloc) {
            __builtin_amdgcn_fence(__ATOMIC_RELEASE, "agent");
            asm volatile("s_waitcnt vmcnt(0)" ::: "memory");
            const unsigned og = xb_add(&bar[XB_TOP], 1u);
            const unsigned tg = og / nx;
            if (og + 1u == (tg + 1u) * nx) xb_add(&bar[XB_TOPGEN], 1u);
            else XB_SPIN(xb_ld(&bar[XB_TOPGEN]) == tg, bar);
            __builtin_amdgcn_fence(__ATOMIC_ACQUIRE, "agent");
            xb_add(&bar[XB_XGEN(b.x)], 1u);
            asm volatile("s_waitcnt vmcnt(0)" ::: "memory");
        } else {
            XB_SPIN(xb_ld(&bar[XB_XGEN(b.x)]) == gen, bar);
            __builtin_amdgcn_fence(__ATOMIC_ACQUIRE, "agent");
            asm volatile("s_waitcnt vmcnt(0)" ::: "memory");
        }
    }
    __syncthreads();
}

__device__ __forceinline__ void label_barrier(unsigned* ctl, const int label, const bool leader) {
    asm volatile("s_waitcnt vmcnt(0)" ::: "memory");
    __syncthreads();
    if (leader) {
        unsigned* c = ctl + CW_LB + 64 * label;
        const unsigned old = xb_add(c, 1u); const unsigned target = (old / 32u + 1u) * 32u;
        XB_SPIN(xb_ld(c) < target, ctl + CW_BAR);
        __builtin_amdgcn_fence(__ATOMIC_ACQUIRE, "agent");
        asm volatile("s_waitcnt vmcnt(0)" ::: "memory");
    }
    __syncthreads();
}
__device__ __forceinline__ int lane_id() { int l; asm volatile("v_mbcnt_lo_u32_b32 %0, -1, 0\n\tv_mbcnt_hi_u32_b32 %0, -1, %0" : "=v"(l)); return l; }
#if defined(PROBE_A)
#define STAMP(i) do { if (F.wave == 0) { const unsigned long long t_ = __builtin_amdgcn_s_memrealtime(); volatile LAS unsigned* ms_ = (volatile LAS unsigned*)(F.lds + MISC_OFF) + 16 + 2 * (i); ms_[0] = (unsigned)t_; ms_[1] = (unsigned)(t_ >> 32); } } while (0)
#else
#define STAMP(i) do {} while (0)
#endif
#define WG_DEAL(jv, slot, lane_) do { const unsigned j_ = __hip_atomic_fetch_add((LAS unsigned*)(F.lds + MISC_OFF) + (slot), 1u, __ATOMIC_RELAXED, __HIP_MEMORY_SCOPE_WORKGROUP);     \
    jv = (int)(__builtin_amdgcn_readfirstlane(j_) >> 6); } while (0)
struct Frame {
    LAS unsigned char* lds; unsigned char* ldsg;
    int wave, vcu, G;
    float* out; unsigned char* ws;
};
template <int I> __device__ __forceinline__ const float* inptr() {
    const float* p = nullptr;
#if defined(__HIP_DEVICE_COMPILE__)
    const void* ka = (const void*)__builtin_amdgcn_kernarg_segment_ptr();
    asm volatile("s_load_dwordx2 %0, %1, %2\n\ts_waitcnt lgkmcnt(0)" : "=s"(p) : "s"(ka), "i"(I * 8) : "memory");
#endif
    return p;
}
#define INP(i) inptr<i>()

__device__ const double INVREV[32] = {0.15915494309189535, 0.11934937021124886, 0.089499401608891013, 0.067115083005227255, 0.050329212104487035, 0.037741584717419771, 0.028302195830623399, 0.02122365276477766,
    0.015915494309189534, 0.011934937021124886, 0.0089499401608891024, 0.0067115083005227253, 0.0050329212104487037, 0.0037741584717419772, 0.0028302195830623399, 0.0021223652764777662,
    0.0015915494309189536, 0.0011934937021124885, 0.00089499401608891024, 0.0006711508300522726, 0.00050329212104487033, 0.00037741584717419774, 0.00028302195830623395, 0.00021223652764777661,
    0.00015915494309189535, 0.00011934937021124886, 8.9499401608891018e-05, 6.7115083005227254e-05, 5.0329212104487035e-05, 3.7741584717419777e-05, 2.8302195830623396e-05, 2.1223652764777659e-05};
__device__ __forceinline__ int win_rowmap(int n) {
    if (n < 1024) { const int region = n >> 9, r = n & 511, tile = r >> 8, w = r & 255, blk = w >> 6, d = w & 63, bj = d >> 5, dlo = d & 31; return region * 512 + tile * 256 + bj * 128 + blk * 32 + dlo; }
    if (n < 1536) return n;
    const int cc = n - 1536, isg = cc >> 9, ch = cc & 511, j = ch >> 7, c2 = ch & 127; return 1536 + j * 256 + isg * 128 + c2;
}
template <bool MAP>
__device__ __forceinline__ void p0_transpose_item(const float* W, int K, int N, bf16* WT, const float* gk, LAS float* scr, int item, int lane) {
    const int nblk = N / 32, kb = item / nblk, nb = item % nblk, k0 = 64 * kb, n0 = 32 * nb;
    float wv[32];
#pragma unroll
    for (int i = 0; i < 32; ++i) { const int kk = 2 * i + (lane >> 5); wv[i] = W[(size_t)(k0 + kk) * N + n0 + (lane & 31)]; }
    if (gk) {
#pragma unroll
        for (int i = 0; i < 32; ++i) wv[i] *= gk[k0 + 2 * i + (lane >> 5)]; }
#pragma unroll
    for (int i = 0; i < 32; ++i) { const int kk = 2 * i + (lane >> 5); scr[kk * 33 + (lane & 31)] = wv[i]; }
    LDS_WAIT(); asm volatile("" ::: "memory");
    const int c = lane & 7; const int r0 = MAP ? win_rowmap(n0) : n0;
#pragma unroll
    for (int j = 0; j < 4; ++j) { const int n = (lane >> 3) + 8 * j; const LAS float* s = scr + (8 * c) * 33 + n;
        v4u o; o.x = pk2(s[0 * 33], s[1 * 33]); o.y = pk2(s[2 * 33], s[3 * 33]); o.z = pk2(s[4 * 33], s[5 * 33]); o.w = pk2(s[6 * 33], s[7 * 33]);
        *(GAS v4u*)(WT + (size_t)(r0 + n) * K + k0 + 8 * c) = o; }
    LDS_WAIT(); asm volatile("" ::: "memory");
}
__device__ __forceinline__ void p0_absmax_item(const float* W, int N, const float* gk, unsigned* cmax, int item, int lane) {
    const int nblk = N / 64, kb = item / nblk, nb = item % nblk, k0 = 64 * kb, n0 = 64 * nb; float m = 0.f;
#pragma unroll 16
    for (int kk = 0; kk < 64; ++kk) { float v = W[(size_t)(k0 + kk) * N + n0 + lane]; if (gk) v *= gk[k0 + kk]; m = fmaxf(m, __builtin_fabsf(v)); }
    atomicMax(cmax + n0 + lane, __float_as_uint(m));
}
template <bool MAP>
__device__ __forceinline__ void p0_quant_item(const float* W, int K, int N, unsigned char* WT, const float* gk, unsigned* cmax, float* sw, LAS float* scr, int item, int lane) {
    const int nblk = N / 32, kb = item / nblk, nb = item % nblk, k0 = 64 * kb, n0 = 32 * nb;
    float wv[32];
#pragma unroll
    for (int i = 0; i < 32; ++i) { const int kk = 2 * i + (lane >> 5); wv[i] = W[(size_t)(k0 + kk) * N + n0 + (lane & 31)]; }
    if (gk) {
#pragma unroll
        for (int i = 0; i < 32; ++i) wv[i] *= gk[k0 + 2 * i + (lane >> 5)]; }
#pragma unroll
    for (int i = 0; i < 32; ++i) { const int kk = 2 * i + (lane >> 5); scr[kk * 33 + (lane & 31)] = wv[i]; }
    LDS_WAIT(); asm volatile("" ::: "memory");
    const int c = lane & 7; const int r0 = MAP ? win_rowmap(n0) : n0;
#pragma unroll
    for (int j = 0; j < 4; ++j) { const int n = (lane >> 3) + 8 * j; const LAS float* s = scr + (8 * c) * 33 + n;
        const float cm = __uint_as_float(__hip_atomic_load(cmax + n0 + n, __ATOMIC_RELAXED, __HIP_MEMORY_SCOPE_AGENT)); const float inv = 127.f / fmaxf(cm, 1e-30f);
        unsigned lo = 0u, hi = 0u;
#pragma unroll
        for (int e = 0; e < 4; ++e) { lo |= ((unsigned)((int)__builtin_rintf(s[e * 33] * inv) & 0xff)) << (8 * e); hi |= ((unsigned)((int)__builtin_rintf(s[(4 + e) * 33] * inv) & 0xff)) << (8 * e); }
        *(GAS unsigned long long*)(WT + (size_t)(r0 + n) * K + k0 + 8 * c) = (unsigned long long)lo | ((unsigned long long)hi << 32);
        if (kb == 0 && c == 0) sw[r0 + n] = cm * (1.f / 127.f); }
    LDS_WAIT(); asm volatile("" ::: "memory");
}
__device__ __forceinline__ void cvt_stream(const float* src, bf16* dst, size_t n8, int gw, int NGW, int lane) {
    for (size_t c = (size_t)gw * 64 + lane; c < n8; c += (size_t)NGW * 64) { const f32x4 a = *(const GAS f32x4*)(src + c * 8), b = *(const GAS f32x4*)(src + c * 8 + 4); *(GAS v4u*)(dst + c * 8) = pk8(a, b); }
}
__device__ __forceinline__ void p0_pb(Frame& F) {
    const int lane = lane_id();
    { const float* src = INP(1); unsigned* dst = (unsigned*)(F.ws + WS_PB); float* SPB = (float*)(F.ws + WS_SPB);
#pragma unroll 1
      for (int it = 0; it < 2; ++it) { const int m0 = F.vcu * 128 + F.wave * 16 + 8 * it;
          f32x4 v[8];
#pragma unroll
          for (int u = 0; u < 8; ++u) v[u] = *(const GAS f32x4*)(src + (size_t)(m0 + u) * PLE_DIM + 4 * lane);
#pragma unroll
          for (int u = 0; u < 8; ++u) { float amax = fmaxf(fmaxf(__builtin_fabsf(v[u][0]), __builtin_fabsf(v[u][1])), fmaxf(__builtin_fabsf(v[u][2]), __builtin_fabsf(v[u][3])));
              amax = wave_max(amax); const float inv = 127.f / fmaxf(amax, 1e-30f);
              dst[(size_t)(m0 + u) * (PLE_DIM / 4) + lane] = (unsigned)((int)__builtin_rintf(v[u][0] * inv) & 0xff) | ((unsigned)((int)__builtin_rintf(v[u][1] * inv) & 0xff) << 8) | ((unsigned)((int)__builtin_rintf(v[u][2] * inv) & 0xff) << 16) | ((unsigned)(int)__builtin_rintf(v[u][3] * inv) << 24);
              if (lane == 0) SPB[m0 + u] = amax * (1.f / 127.f); } } }
}
__device__ __forceinline__ void p0_tables(Frame& F) {
    const int lane = lane_id(); const int NGW = F.G * NWAVES;
    { const float* ut = INP(17); const float* vt = INP(18); float* SU = (float*)(F.ws + WS_SU); float* SV = (float*)(F.ws + WS_SV);
      for (;;) { int jd; WG_DEAL(jd, 2, lane); if (jd >= (2 * NEXP) / (4 * F.G)) break; const int r0 = F.vcu * NWAVES + (jd & 7) + 4 * NGW * (jd >> 3);
          f32x4 v[4][4];
#pragma unroll
          for (int u = 0; u < 4; ++u) { const int r = r0 + u * NGW; const bool isv = r >= NEXP; const int e = isv ? r - NEXP : r; const float* src = (isv ? vt : ut) + (size_t)e * DM + 16 * lane;
#pragma unroll
              for (int i = 0; i < 4; ++i) v[u][i] = *(const GAS f32x4*)(src + 4 * i); }
#pragma unroll
          for (int u = 0; u < 4; ++u) { const int r = r0 + u * NGW; const bool isv = r >= NEXP; const int e = isv ? r - NEXP : r; float amax = 0.f;
#pragma unroll
              for (int i = 0; i < 4; ++i) amax = fmaxf(amax, fmaxf(fmaxf(__builtin_fabsf(v[u][i][0]), __builtin_fabsf(v[u][i][1])), fmaxf(__builtin_fabsf(v[u][i][2]), __builtin_fabsf(v[u][i][3]))));
              amax = wave_max(amax);
              const float inv = 127.f / fmaxf(amax, 1e-30f); v4u w;
#pragma unroll
              for (int i = 0; i < 4; ++i) { const int a = (int)__builtin_rintf(v[u][i][0] * inv), b = (int)__builtin_rintf(v[u][i][1] * inv), c = (int)__builtin_rintf(v[u][i][2] * inv), d = (int)__builtin_rintf(v[u][i][3] * inv);
                  w[i] = (unsigned)(a & 0xff) | ((unsigned)(b & 0xff) << 8) | ((unsigned)(c & 0xff) << 16) | ((unsigned)d << 24); }
              *(GAS v4u*)(F.ws + (isv ? WS_VT : WS_UT) + ((size_t)(lane >> 3) * NEXP + e) * 128 + 16 * (lane & 7)) = w;
              if (lane == 0) (isv ? SV : SU)[e] = amax * (1.f / 127.f); } } }
}
template <bool MAP, int KT = 64> __device__ __forceinline__ void p0_w8_task(Frame& F, const int task, const float* W, const int N, const float* gk, unsigned char* WT, float* SW) {
    const int tid = F.wave * 64 + lane_id(), kg = tid >> 5, c = tid & 31, n0 = 32 * task, k0 = KT * kg;
    float w[KT]; float m = 0.f;
#pragma unroll
    for (int i = 0; i < KT; ++i) w[i] = W[(size_t)(k0 + i) * N + n0 + c];
    if (gk) {
#pragma unroll
        for (int i = 0; i < KT; ++i) w[i] *= gk[k0 + i]; }
#pragma unroll
    for (int i = 0; i < KT; ++i) m = fmaxf(m, __builtin_fabsf(w[i]));
    LAS float* red = (LAS float*)F.lds;
    red[kg * 32 + c] = m; __syncthreads();
    float cm = 0.f;
#pragma unroll
    for (int g = 0; g < 16; ++g) cm = fmaxf(cm, red[g * 32 + c]);
    const float inv = 127.f / fmaxf(cm, 1e-30f); const int row = (MAP ? win_rowmap(n0) : n0) + c;
#pragma unroll
    for (int q = 0; q < KT / 16; ++q) { v4u o;
#pragma unroll
        for (int e = 0; e < 4; ++e) { const int i = 16 * q + 4 * e;
            o[e] = (unsigned)((int)__builtin_rintf(w[i] * inv) & 0xff) | ((unsigned)((int)__builtin_rintf(w[i + 1] * inv) & 0xff) << 8) | ((unsigned)((int)__builtin_rintf(w[i + 2] * inv) & 0xff) << 16) | ((unsigned)(int)__builtin_rintf(w[i + 3] * inv) << 24); }
        *(GAS v4u*)(WT + (size_t)row * (16 * KT) + k0 + 16 * q) = o; }
    if (kg == 0) SW[row] = cm * (1.f / 127.f);
    __syncthreads();
}
__device__ __forceinline__ void p0_prologue(Frame& F) {
    const int lane = lane_id();
    LAS float* scr = (LAS float*)(F.lds + F.wave * 16384);
    const int gw = F.vcu * NWAVES + F.wave, NGW = F.G * NWAVES;
    bf16* WIN = (bf16*)(F.ws + WS_WIN); bf16* WOUT = (bf16*)(F.ws + WS_WOUT); bf16* WQ = (bf16*)(F.ws + WS_WQ); bf16* WGATE = (bf16*)(F.ws + WS_WGATE); bf16* WPROJ = (bf16*)(F.ws + WS_WPROJ);
    constexpr int I_IN = (DM / 64) * (IN_COLS / 32), I_OUT = (DM / 64) * (DM / 32), I_Q = (DM / 64) * (QCOLS / 32), I_G = I_OUT, I_P = (PLE_DIM / 64) * (DM / 32);
    if ((F.vcu & 31) < 10) p0_w8_task<true>(F, (F.vcu >> 5) * 10 + (F.vcu & 31), INP(3), IN_COLS, nullptr, F.ws + WS_WIN, (float*)(F.ws + WS_SW));
    else if ((F.vcu & 31) >= 18 && (F.vcu & 31) < 22) p0_w8_task<false, 16>(F, (F.vcu >> 5) * 4 + (F.vcu & 31) - 18, INP(21), DM, nullptr, F.ws + WS_WPROJ, (float*)(F.ws + WS_SW) + IN_COLS + QCOLS);
    else if ((F.vcu & 31) < 18) p0_w8_task<false>(F, (F.vcu >> 5) * 8 + (F.vcu & 31) - 10, INP(15), QCOLS, INP(14), F.ws + WS_WQ, (float*)(F.ws + WS_SW) + IN_COLS);
    constexpr int NITEMS = I_OUT + I_G; (void)I_IN; (void)WIN; (void)I_Q; (void)WQ; (void)I_P; (void)WPROJ;
    for (int it = gw; it < NITEMS; it += NGW) {
        int r = it;
        if (r < I_OUT) { p0_transpose_item<false>(INP(13), DM, DM, WOUT, nullptr, scr, r, lane); continue; } r -= I_OUT;
        p0_transpose_item<false>(INP(20), DM, DM, WGATE, INP(19), scr, r, lane);
    }
    cvt_stream(INP(16), (bf16*)(F.ws + WS_KEYS), (size_t)2 * 128 * 128 / 8, gw, NGW, lane);
    { float* rc = (float*)(F.ws + WS_ROPEC); float* rs = (float*)(F.ws + WS_ROPES);
      for (int idx = gw * 64 + lane; idx < SEQ * 32; idx += NGW * 64) { const int pos = idx >> 5, i = idx & 31; const double rev = (double)pos * INVREV[i]; const float fr = (float)(rev - __builtin_floor(rev));
          rc[idx] = __builtin_amdgcn_cosf(fr); rs[idx] = __builtin_amdgcn_sinf(fr); } }
}

__device__ __forceinline__ void p0_xn(Frame& F) {
    const int lane = lane_id();
    { const float* x = INP(0); const float* g = INP(2); unsigned* XN8 = (unsigned*)(F.ws + WS_XN); float* SXN = (float*)(F.ws + WS_SXN);
      f32x4 gv[4];
#pragma unroll
      for (int j = 0; j < 4; ++j) gv[j] = ((const GAS f32x4*)g)[64 * j + lane];
      for (;;) { int jd; WG_DEAL(jd, 3, lane); if (jd >= M / (4 * F.G)) break; const int m0 = F.vcu * 128 + 4 * jd;
          f32x4 v[4][4];
#pragma unroll
          for (int u = 0; u < 4; ++u) { const GAS f32x4* xr = (const GAS f32x4*)(x + (size_t)(m0 + u) * DM) + lane;
#pragma unroll
              for (int j = 0; j < 4; ++j) v[u][j] = xr[64 * j]; }
#pragma unroll
          for (int u = 0; u < 4; ++u) { float s2 = 0.f;
#pragma unroll
              for (int j = 0; j < 4; ++j) s2 += (v[u][j].x * v[u][j].x + v[u][j].y * v[u][j].y) + (v[u][j].z * v[u][j].z + v[u][j].w * v[u][j].w);
              const float rstd = rsqrtf(wave_sum(s2) * (1.f / DM) + EPS); float amax = 0.f;
#pragma unroll
              for (int j = 0; j < 4; ++j) { v[u][j] = v[u][j] * rstd * gv[j]; amax = fmaxf(amax, fmaxf(fmaxf(__builtin_fabsf(v[u][j].x), __builtin_fabsf(v[u][j].y)), fmaxf(__builtin_fabsf(v[u][j].z), __builtin_fabsf(v[u][j].w)))); }
              amax = wave_max(amax);
              const float inv = 127.f / fmaxf(amax, 1e-30f); unsigned* orow = XN8 + (size_t)(m0 + u) * (DM / 4) + lane;
#pragma unroll
              for (int j = 0; j < 4; ++j) { const int a = (int)__builtin_rintf(v[u][j].x * inv), b = (int)__builtin_rintf(v[u][j].y * inv), c = (int)__builtin_rintf(v[u][j].z * inv), d = (int)__builtin_rintf(v[u][j].w * inv);
                  orow[64 * j] = (unsigned)(a & 0xff) | ((unsigned)(b & 0xff) << 8) | ((unsigned)(c & 0xff) << 16) | ((unsigned)d << 24); }
              if (lane == 32) SXN[m0 + u] = amax * (1.f / 127.f); } } }
}

struct AttnOrder {
    int vcu;
    __device__ __forceinline__ bool next(int i, attn_body::AttnUnit& u) const { if (i >= 4) return false; const int s = vcu & 7; u.bh = (vcu >> 5) * 8 + ((vcu >> 3) & 3) * 2 + (i & 1); u.qb = (i < 2) ? 15 - s : s; return true; }
    __device__ __forceinline__ void a_ready(const attn_body::AttnUnit&) const {}
    __device__ __forceinline__ void done(const attn_body::AttnUnit&) const {}
};
__device__ __forceinline__ void p2_attention(Frame& F) {
    { const attn_body::AttnTensors AT{(const attn_body::bf16*)(F.ws + WS_QO), (const attn_body::bf16*)(F.ws + WS_K), (const attn_body::bf16*)(F.ws + WS_V), (attn_body::bf16*)F.out  };
      const AttnOrder S{F.vcu};
      attn_body::attn_phase<AttnOrder>((char*)F.ldsg, AT, S, F.wave * 64 + lane_id()); }
    VM_WAIT(); __syncthreads(); STAMP(12);
    const int lane = lane_id();
    const float s1 = wave_sum(INP(4)[lane] * INP(5)[lane]), s2 = wave_sum(INP(6)[lane] * INP(7)[lane]);
    const float lam = __expf(s1) - __expf(s2) + 0.2f;
    const float* sg = INP(8); const float g0 = sg[2 * lane] * 0.8f, g1 = sg[2 * lane + 1] * 0.8f;
    const unsigned* O32 = (const unsigned*)F.out; unsigned* A2 = (unsigned*)(F.ws + WS_XN);
    const int b = F.vcu >> 5, h = (F.vcu >> 3) & 3, s = F.vcu & 7;
    for (int i = 0; i < 2; ++i) { const int qb = (i == 0) ? 15 - s : s;
        const size_t rbase = (size_t)b * SEQ + (size_t)qb * 256 + F.wave * 32;
        for (int r = 0; r < 32; r += 8) {
            unsigned w0[8], w1[8];
#pragma unroll
            for (int u = 0; u < 8; ++u) { const size_t row = rbase + r + u; w0[u] = __builtin_nontemporal_load(O32 + row * 512 + (h * 4 + 0 + (lane >> 5)) * 32 + (lane & 31)); w1[u] = __builtin_nontemporal_load(O32 + row * 512 + (h * 4 + 2 + (lane >> 5)) * 32 + (lane & 31)); }
#pragma unroll
            for (int u = 0; u < 8; ++u) { const size_t row = rbase + r + u;
                const float d0 = bflo(w0[u]) - lam * bflo(w1[u]), d1 = bfhi(w0[u]) - lam * bfhi(w1[u]);
                const float rstd = rsqrtf(wave_sum(d0 * d0 + d1 * d1) * (1.f / 128.f) + EPS);
                A2[row * 512 + h * 64 + lane] = pk2(d0 * rstd * g0, d1 * rstd * g1); } } }
}
typedef float cf2 __attribute__((ext_vector_type(2)));
__device__ __forceinline__ void p2_conv(Frame& F) {
    const bf16* Ub = (const bf16*)(F.ws + WS_U); bf16* A2 = (bf16*)(F.ws + WS_XN);
    LAS float* yl = (LAS float*)F.lds;
    LAS bf16* ul = (LAS bf16*)(F.lds + 65536);
    const int lane = lane_id(); const int tid = F.wave * 64 + lane; const int cp = tid & 255, th = tid >> 8;
    cf2 w[31];
    { const float* cw = INP(9);
#pragma unroll
      for (int j = 0; j < 31; ++j) w[j] = *(const GAS cf2*)(cw + j * 512 + 2 * cp); }
    const cf2 bias = *(const GAS cf2*)(INP(10) + 2 * cp);
    const float* lng = INP(11); const float* lnb = INP(12);
    const f32x4 lg0 = *(const f32x4*)(lng + 8 * lane), lg1 = *(const f32x4*)(lng + 8 * lane + 4), lb0 = *(const f32x4*)(lnb + 8 * lane), lb1 = *(const f32x4*)(lnb + 8 * lane + 4);
    v4u st[8];
#define CONV_LOAD(tile_) do { const int t0_ = (tile_) * 32, pos0_ = t0_ & (SEQ - 1); _Pragma("unroll") for (int q = 0; q < 8; ++q) { const int ci = tid + 512 * q; st[q] = (v4u){0u, 0u, 0u, 0u}; \
        if (ci < 62 * 64) { const int r = ci >> 6, ch = ci & 63; if (pos0_ - 30 + r >= 0) st[q] = *(const GAS v4u*)(Ub + (size_t)(t0_ - 30 + r) * 512 + ch * 8); } } } while (0)
#define CONV_STORE() do { _Pragma("unroll") for (int q = 0; q < 8; ++q) { const int ci = tid + 512 * q; if (ci < 62 * 64) *(LAS v4u*)(ul + (ci >> 6) * 512 + (ci & 63) * 8) = st[q]; } } while (0)
    int tile = (F.vcu >> 5) * 128 + (F.vcu & 31);
    CONV_LOAD(tile); CONV_STORE();
    __syncthreads();
    for (int k_ = 0; k_ < 4; ++k_, tile += 32) {
        const int t0 = tile * 32;
        const bool more = k_ < 3;
        if (more) CONV_LOAD(tile + 32);
#pragma unroll 1
        for (int ps = 0; ps < 2; ++ps) {
            const int tb = 16 * th + 8 * ps;
            cf2 xin[38];
#pragma unroll
            for (int r = 0; r < 38; ++r) { const unsigned wv = *(const LAS unsigned*)(ul + (tb + r) * 512 + 2 * cp); xin[r] = (cf2){__uint_as_float(wv << 16), __uint_as_float(wv & 0xffff0000u)}; }
#pragma unroll
            for (int t = 0; t < 8; ++t) { cf2 y = bias;
#pragma unroll
                for (int j = 0; j < 31; ++j) y += w[j] * xin[t + j];
                *(LAS cf2*)(yl + (tb + t) * 512 + 2 * cp) = y; }
        }
        __syncthreads();
        if (more) CONV_STORE();
#pragma unroll
        for (int q = 0; q < 4; ++q) { const int t = F.wave * 4 + q;
            const f32x4 a = *(const LAS f32x4*)(yl + t * 512 + 8 * lane), b2 = *(const LAS f32x4*)(yl + t * 512 + 8 * lane + 4);
            const float mean = wave_sum((a[0] + a[1]) + (a[2] + a[3]) + (b2[0] + b2[1]) + (b2[2] + b2[3])) * (1.f / 512.f);
            const f32x4 da = a - mean, db = b2 - mean;
            const float var = wave_sum((da[0] * da[0] + da[1] * da[1]) + (da[2] * da[2] + da[3] * da[3]) + (db[0] * db[0] + db[1] * db[1]) + (db[2] * db[2] + db[3] * db[3])) * (1.f / 512.f);
            const float rstd = rsqrtf(var + EPS);
            f32x4 oa = da * rstd * lg0 + lb0, ob = db * rstd * lg1 + lb1;
#pragma unroll
            for (int e = 0; e < 4; ++e) { oa[e] = oa[e] * __builtin_amdgcn_rcpf(1.0f + __expf(-oa[e])); ob[e] = ob[e] * __builtin_amdgcn_rcpf(1.0f + __expf(-ob[e])); }
            *(GAS v4u*)(A2 + (size_t)(t0 + t) * 1024 + 512 + 8 * lane) = pk8(oa, ob); }
        __syncthreads();
    }
#undef CONV_LOAD
#undef CONV_STORE
}
__device__ __forceinline__ int crow16(int r, int hi) { return (r & 3) + 8 * (r >> 2) + 4 * hi; }
__device__ __forceinline__ float enc_key(float f, unsigned tag, unsigned mask) { return __uint_as_float((__float_as_uint(f) & ~mask) | tag); }
__device__ __forceinline__ float dec_key(float k, unsigned mask) { return __uint_as_float(__float_as_uint(k) & ~mask); }
__device__ __forceinline__ void ce_desc(float& a, float& b) { float mx, mn; asm("v_max_f32 %0, %1, %2" : "=v"(mx) : "v"(a), "v"(b)); asm("v_min_f32 %0, %1, %2" : "=v"(mn) : "v"(a), "v"(b)); a = mx; b = mn; }
template <int K, int J> __device__ __forceinline__ void bitonic_stage16(float (&a)[16]) {
#pragma unroll
    for (int i = 0; i < 16; ++i) { const int l = i ^ J; if (l > i) { if ((i & K) == 0) ce_desc(a[i], a[l]); else ce_desc(a[l], a[i]); } }
}
__device__ __forceinline__ void sort16_desc(float (&a)[16]) {
    ce_desc(a[0], a[1]); ce_desc(a[2], a[3]); ce_desc(a[0], a[2]); ce_desc(a[1], a[3]); ce_desc(a[1], a[2]); ce_desc(a[4], a[5]); ce_desc(a[6], a[7]); ce_desc(a[4], a[6]); ce_desc(a[5], a[7]); ce_desc(a[5], a[6]); ce_desc(a[0], a[4]); ce_desc(a[2], a[6]); ce_desc(a[2], a[4]); ce_desc(a[1], a[5]); ce_desc(a[3], a[7]); ce_desc(a[3], a[5]); ce_desc(a[1], a[2]); ce_desc(a[3], a[4]); ce_desc(a[5], a[6]); ce_desc(a[8], a[9]); ce_desc(a[10], a[11]); ce_desc(a[8], a[10]); ce_desc(a[9], a[11]); ce_desc(a[9], a[10]); ce_desc(a[12], a[13]); ce_desc(a[14], a[15]); ce_desc(a[12], a[14]); ce_desc(a[13], a[15]); ce_desc(a[13], a[14]); ce_desc(a[8], a[12]); ce_desc(a[10], a[14]); ce_desc(a[10], a[12]); ce_desc(a[9], a[13]); ce_desc(a[11], a[15]); ce_desc(a[11], a[13]); ce_desc(a[9], a[10]); ce_desc(a[11], a[12]); ce_desc(a[13], a[14]); ce_desc(a[0], a[8]); ce_desc(a[4], a[12]); ce_desc(a[4], a[8]); ce_desc(a[2], a[10]); ce_desc(a[6], a[14]); ce_desc(a[6], a[10]); ce_desc(a[2], a[4]); ce_desc(a[6], a[8]); ce_desc(a[10], a[12]); ce_desc(a[1], a[9]); ce_desc(a[5], a[13]); ce_desc(a[5], a[9]); ce_desc(a[3], a[11]); ce_desc(a[7], a[15]); ce_desc(a[7], a[11]); ce_desc(a[3], a[5]); ce_desc(a[7], a[9]); ce_desc(a[11], a[13]); ce_desc(a[1], a[2]); ce_desc(a[3], a[4]); ce_desc(a[5], a[6]); ce_desc(a[7], a[8]); ce_desc(a[9], a[10]); ce_desc(a[11], a[12]); ce_desc(a[13], a[14]);
}
__device__ __forceinline__ void merge16_desc(float (&a)[16], const float (&b)[16]) {
#pragma unroll
    for (int i = 0; i < 16; ++i) { float mx; asm("v_max_f32 %0, %1, %2" : "=v"(mx) : "v"(a[i]), "v"(b[15 - i])); a[i] = mx; }
    bitonic_stage16<16, 8>(a); bitonic_stage16<16, 4>(a); bitonic_stage16<16, 2>(a); bitonic_stage16<16, 1>(a);
}
__device__ __forceinline__ void top16_of_64(float (&k)[4][16]) {
    sort16_desc(k[0]); sort16_desc(k[1]); sort16_desc(k[2]); sort16_desc(k[3]);
    merge16_desc(k[0], k[1]); merge16_desc(k[2], k[3]); merge16_desc(k[0], k[2]);
}
__host__ __device__ constexpr int cand_i(int s) { int c = 0; for (int i = 0; i < 16; ++i) { const int nj = 16 / (i + 1); if (s < c + nj) return i; c += nj; } return -1; }
__host__ __device__ constexpr int cand_j(int s) { int c = 0; for (int i = 0; i < 16; ++i) { const int nj = 16 / (i + 1); if (s < c + nj) return s - c; c += nj; } return -1; }
template <int S> __device__ __forceinline__ void cand_fill(float (&c)[4][16], const float (&v0)[16], const float (&v1)[16]) {
    if constexpr (S < 64) { constexpr int i = cand_i(S), j = cand_j(S);
        if constexpr (i >= 0) c[S >> 4][S & 15] = enc_key(v0[i] + v1[j], 255u - (unsigned)(i * 16 + j), 255u); else c[S >> 4][S & 15] = __uint_as_float(0xff800000u);
        cand_fill<S + 1>(c, v0, v1); }
}
__device__ __forceinline__ float gelu_exact(float v) {
    const float av = __builtin_fabsf(v), d = av * 0.2316418882f + 1.0f, t = __builtin_amdgcn_rcpf(d);
    float q = t * 0.5307027145f + (-0.7265760135f); q = q * t + 0.7107068705f; q = q * t + (-0.142248368f); q = q * t + 0.127414796f; q = q * t;
    const float e = __builtin_amdgcn_exp2f((v * v) * (-0.72134752044f)); const float m = v * (q * e); return v < 0.f ? m : v - m;
}
typedef float f32x2 __attribute__((ext_vector_type(2)));
__device__ __forceinline__ float ub0(unsigned w) { return (float)(w & 0xffu); }
__device__ __forceinline__ float ub1(unsigned w) { return (float)((w >> 8) & 0xffu); }
__device__ __forceinline__ float ub2(unsigned w) { return (float)((w >> 16) & 0xffu); }
__device__ __forceinline__ float ub3(unsigned w) { return (float)(w >> 24); }
__device__ __forceinline__ int reduce8(const int (&p)[8], int lane) {
    const bool b0 = lane & 1, b1 = lane & 2, b2 = lane & 4;
    int q[4], r[2];
#pragma unroll
    for (int i = 0; i < 4; ++i) { const int keep = b0 ? p[2 * i + 1] : p[2 * i], send = b0 ? p[2 * i] : p[2 * i + 1]; q[i] = keep + __builtin_amdgcn_update_dpp(0, send, 0xB1, 0xF, 0xF, true); }
#pragma unroll
    for (int i = 0; i < 2; ++i) { const int keep = b1 ? q[2 * i + 1] : q[2 * i], send = b1 ? q[2 * i] : q[2 * i + 1]; r[i] = keep + __builtin_amdgcn_update_dpp(0, send, 0x4E, 0xF, 0xF, true); }
    int s; { const int keep = b2 ? r[1] : r[0], send = b2 ? r[0] : r[1]; s = keep + __builtin_amdgcn_ds_swizzle(send, 0x101F); }
    s += __builtin_amdgcn_ds_swizzle(s, 0x201F); s += __builtin_amdgcn_ds_swizzle(s, 0x401F);
    { const auto rr = __builtin_amdgcn_permlane32_swap((unsigned)s, (unsigned)s, false, false); s = (int)rr[0] + (int)rr[1]; }
    return s;
}
constexpr int P5_TOK = 32;
constexpr int P5_KEYS = 0, P5_LS = 65536, P5_EID = 65536 + 33792, P5_GATE = 65536 + 33792 + 16384;
__device__ __forceinline__ void p5a_topk(Frame& F) {
    const bf16* QP = (const bf16*)(F.ws + WS_QP); const bf16* KEYS = (const bf16*)(F.ws + WS_KEYS);
    LAS unsigned* lsc = (LAS unsigned*)(F.lds + P5_LS) + (F.wave * 32 + (lane_id() & 31)) * 33; LAS unsigned* eidL = (LAS unsigned*)(F.lds + P5_EID); LAS float* gateL = (LAS float*)(F.lds + P5_GATE);
    const int lane = lane_id(), tid = F.wave * 64 + lane, r32 = lane & 31, hi = lane >> 5, h = F.wave;
    const float* gffn = INP(14);
#pragma unroll
    for (int i = 0; i < 8; ++i) { const int q = tid + 512 * i, row = q >> 4, ch = q & 15; *(LAS v4u*)(F.lds + P5_KEYS + row * 256 + ((ch ^ (row & 15)) << 4)) = *(const GAS v4u*)(KEYS + row * 128 + ch * 8); }
    __syncthreads();
    const LAS unsigned char* kl = F.lds + P5_KEYS + r32 * 256;
    for (int tile = (F.vcu >> 5) * 128 + (F.vcu & 31), k_ = 0; k_ < 4; ++k_, tile += 32) {
        const size_t t0 = (size_t)tile * P5_TOK;
        float sv[2][16];
#pragma unroll
        for (int c = 0; c < 2; ++c) {
            bf16x8 qf[8];
#pragma unroll
            for (int ks = 0; ks < 8; ++ks) qf[ks] = *(const bf16x8*)(QP + (size_t)(h >> 2) * ((size_t)M * 1024) + (t0 + r32) * 1024 + (h & 3) * 256 + c * 128 + ks * 16 + hi * 8);
            float key[4][16];
#pragma unroll
            for (int nb = 0; nb < 4; ++nb) { f32x16 acc = {}; asm volatile("" ::: "memory");
#pragma unroll
                for (int ks = 0; ks < 8; ++ks) { const bf16x8 kf = *(const LAS bf16x8*)(kl + (c * 128 + nb * 32) * 256 + (((ks * 2 + hi) ^ (r32 & 15)) << 4)); acc = __builtin_amdgcn_mfma_f32_32x32x16_bf16(kf, qf[ks], acc, 0, 0, 0); }
#pragma unroll
                for (int r = 0; r < 16; ++r) key[nb][r] = enc_key(acc[r], 127u - (unsigned)(nb * 32 + crow16(r, hi)), 127u); }
            top16_of_64(key);
            float other[16];
#pragma unroll
            for (int i = 0; i < 16; ++i) other[i] = __shfl_xor(key[0][i], 32);
            merge16_desc(key[0], other);
#pragma unroll
            for (int i = 0; i < 16; ++i) { sv[c][i] = dec_key(key[0][i], 127u); if (hi == 0) lsc[c * 16 + i] = __float_as_uint(key[0][i]); }
        }
        asm volatile("" ::: "memory");
        float cand[4][16];
        cand_fill<0>(cand, sv[0], sv[1]);
        float mine[2][16];
#pragma unroll
        for (int i = 0; i < 16; ++i) { mine[0][i] = hi ? cand[2][i] : cand[0][i]; mine[1][i] = hi ? cand[3][i] : cand[1][i]; }
        sort16_desc(mine[0]); sort16_desc(mine[1]); merge16_desc(mine[0], mine[1]);
        { float oth[16];
#pragma unroll
          for (int i = 0; i < 16; ++i) oth[i] = __shfl_xor(mine[0][i], 32);
          merge16_desc(mine[0], oth); }
        LDS_WAIT();
        { float wv[16]; float wsum = 0.f; const float mx = dec_key(mine[0][0], 255u);
#pragma unroll
          for (int k = 0; k < 16; ++k) { wv[k] = __expf(dec_key(mine[0][k], 255u) - mx); wsum += wv[k]; }
          const float rs = 1.0f / wsum;
#pragma unroll
          for (int k = 0; k < 16; ++k) { const unsigned id = 255u - (__float_as_uint(mine[0][k]) & 255u); const unsigned k0 = lsc[id >> 4], k1 = lsc[16 + (id & 15u)];
              const unsigned e = (127u - (k0 & 127u)) * 128u + (127u - (k1 & 127u));
              if (hi == 0) { eidL[r32 * 128 + h * 16 + k] = e; gateL[r32 * 128 + h * 16 + k] = wv[k] * rs; } } }
        __syncthreads();
        { const int token = tid >> 4, seg = tid & 15; const LAS unsigned* es = eidL + token * 128 + seg * 8; const LAS float* gs = gateL + token * 128 + seg * 8;
          v4u w; w.x = es[0] | (es[1] << 16); w.y = es[2] | (es[3] << 16); w.z = es[4] | (es[5] << 16); w.w = es[6] | (es[7] << 16);
          *(GAS v4u*)(F.ws + WS_EID + (t0 + token) * 256 + seg * 16) = w;
          *(GAS f32x4*)(F.ws + WS_GATE + (t0 + token) * 512 + seg * 32) = *(const LAS f32x4*)gs; *(GAS f32x4*)(F.ws + WS_GATE + (t0 + token) * 512 + seg * 32 + 16) = *(const LAS f32x4*)(gs + 4); }
        { f32x4 hv[4][4];
#pragma unroll
          for (int j = 0; j < 4; ++j) { const bf16* hrow = (const bf16*)F.out + (t0 + F.wave * 4 + j) * DM + 16 * lane;
              const v4u w0 = *(const GAS v4u*)hrow, w1 = *(const GAS v4u*)(hrow + 8);
              hv[j][0] = (f32x4){bflo(w0.x), bfhi(w0.x), bflo(w0.y), bfhi(w0.y)}; hv[j][1] = (f32x4){bflo(w0.z), bfhi(w0.z), bflo(w0.w), bfhi(w0.w)};
              hv[j][2] = (f32x4){bflo(w1.x), bfhi(w1.x), bflo(w1.y), bfhi(w1.y)}; hv[j][3] = (f32x4){bflo(w1.z), bfhi(w1.z), bflo(w1.w), bfhi(w1.w)}; }
          f32x4 gv[4];
#pragma unroll
          for (int i = 0; i < 4; ++i) gv[i] = *(const f32x4*)(gffn + 16 * lane + 4 * i);
#pragma unroll
          for (int j = 0; j < 4; ++j) { const size_t tok = t0 + F.wave * 4 + j;
            const float rstd1 = rsqrtf(wave_sum(dot4s_(hv[j][0]) + dot4s_(hv[j][1]) + dot4s_(hv[j][2]) + dot4s_(hv[j][3])) * (1.f / DM) + EPS);
            f32x4 mv[4]; float amax = 0.f;
#pragma unroll
            for (int i = 0; i < 4; ++i) { mv[i] = hv[j][i] * rstd1 * gv[i];
                amax = fmaxf(amax, fmaxf(fmaxf(__builtin_fabsf(mv[i][0]), __builtin_fabsf(mv[i][1])), fmaxf(__builtin_fabsf(mv[i][2]), __builtin_fabsf(mv[i][3])))); }
            amax = wave_max(amax); const float inv = 127.f / fmaxf(amax, 1e-30f); v4u qm;
#pragma unroll
            for (int i = 0; i < 4; ++i) { const int a = (int)__builtin_rintf(mv[i][0] * inv), b = (int)__builtin_rintf(mv[i][1] * inv), c = (int)__builtin_rintf(mv[i][2] * inv), d = (int)__builtin_rintf(mv[i][3] * inv);
                qm[i] = (unsigned)(a & 0xff) | ((unsigned)(b & 0xff) << 8) | ((unsigned)(c & 0xff) << 16) | ((unsigned)d << 24); }
            *(GAS v4u*)((unsigned char*)F.out + OUT_QM + ((size_t)(lane >> 3) * M + tok) * 128 + 16 * (lane & 7)) = qm;
            if (lane == 0) ((float*)(F.ws + WS_SM))[tok] = amax * (1.f / 127.f);
          } }
        __syncthreads();
    }
}
__device__ __forceinline__ int xl1(int v) { return __builtin_amdgcn_update_dpp(0, v, 0xB1, 0xF, 0xF, true); }
__device__ __forceinline__ int xl2(int v) { return __builtin_amdgcn_update_dpp(0, v, 0x4E, 0xF, 0xF, true); }
__device__ __forceinline__ int xl4(int v) { return __builtin_amdgcn_update_dpp(0, __builtin_amdgcn_update_dpp(0, v, 0x141, 0xF, 0xF, true), 0x1B, 0xF, 0xF, true); }
__device__ __forceinline__ int xl8(int v) { return __builtin_amdgcn_update_dpp(0, v, 0x128, 0xF, 0xF, true); }
__device__ __forceinline__ int xl16(int v) { return __builtin_amdgcn_ds_swizzle(v, 0x401F); }
__device__ __forceinline__ int xl32(int v, bool hi) { const auto rr = __builtin_amdgcn_permlane32_swap((unsigned)v, (unsigned)v, false, false); return (int)(hi ? rr[0] : rr[1]); }
__device__ __forceinline__ float fxl8(float v) { return __int_as_float(xl8(__float_as_int(v))); }
__device__ __forceinline__ float fxl16(float v) { return __int_as_float(xl16(__float_as_int(v))); }
__device__ __forceinline__ float fxl32(float v, bool hi) { return __int_as_float(xl32(__float_as_int(v), hi)); }
#define TSWAP(dst, src, n, SWAPFN) _Pragma("unroll") for (int ni_ = 0; ni_ < (n) / 2; ++ni_) { const int i_ = (ni_ & 1) | ((ni_ >> 1) << 2); const auto rr_ = SWAPFN((unsigned)src[i_], (unsigned)src[i_ + 2], false, false); dst[ni_] = (int)rr_[0] + (int)rr_[1]; }
#define TSTEP(dst, src, n, c, XF) _Pragma("unroll") for (int ni_ = 0; ni_ < (n) / 2; ++ni_) { const int i_ = (ni_ & 1) | ((ni_ >> 1) << 2); const auto lo_ = src[i_], hi_ = src[i_ + 2]; dst[ni_] = ((c) ? hi_ : lo_) + XF((c) ? lo_ : hi_); }

__device__ __forceinline__ int sdot4_z(int a, int b) { int r; asm("v_dot4_i32_i8 %0, %1, %2, 0" : "=v"(r) : "v"(a), "v"(b)); return r; }
#define ASM_LD16(dst, ptr) asm volatile("global_load_dwordx4 %0, %1, off" : "+v"(dst) : "v"(ptr) : "memory")
#define ASM_LD16S(dst, voff, sbase) asm volatile("global_load_dwordx4 %0, %1, %2" : "+v"(dst) : "v"(voff), "s"(sbase) : "memory")
#define ASM_LD8(dst, ptr) asm volatile("global_load_dwordx2 %0, %1, off" : "+v"(dst) : "v"(ptr) : "memory")
#define ASM_LD4(dst, ptr) asm volatile("global_load_dword %0, %1, off" : "+v"(dst) : "v"(ptr) : "memory")
#define ASM_WAIT4(N, a, b, c, d) asm volatile("s_waitcnt vmcnt(" #N ")" : "+v"(a), "+v"(b), "+v"(c), "+v"(d) :: "memory")
#define ASM_WAIT5(N, a, b, c, d, e) asm volatile("s_waitcnt vmcnt(" #N ")" : "+v"(a), "+v"(b), "+v"(c), "+v"(d), "+v"(e) :: "memory")
__device__ __forceinline__ void p5b_udot(Frame& F) {
    const int lane = lane_id(), g = lane >> 3, s = lane & 7;
    const int x = blockIdx.x & 7, rk = blockIdx.x >> 3, nrk = F.G >> 3;
    const unsigned char* UTb = F.ws + WS_UT + (size_t)x * NEXP * 128; const unsigned l16s = 16u * (unsigned)s;        const unsigned char* QMs = (const unsigned char*)F.out + OUT_QM + (size_t)x * M * 128 + 16 * s; const unsigned char* EIDs = F.ws + WS_EID + 32 * g;
    unsigned* AP = (unsigned*)(F.ws + WS_APART) + (size_t)x * M * 64 + lane;
    const bool c0 = s & 1, c1 = s & 2, c2 = s & 4;
    const int nT = M / nrk; LAS unsigned* qctr = (LAS unsigned*)(F.lds + MISC_OFF) + 62;
#define P5_PULL(jv, tv) do { const unsigned j_ = __hip_atomic_fetch_add(qctr, 1u, __ATOMIC_RELAXED, __HIP_MEMORY_SCOPE_WORKGROUP);     \
        jv = (int)(__builtin_amdgcn_readfirstlane(j_) >> 6); tv = rk + nrk * (jv < nT ? jv : nT - 1); } while (0)
#define P5B_E(i, E0, E1) ((((i) & 1) ? (((i) < 8 ? E0[(i) >> 1] : E1[((i) - 8) >> 1]) >> 16) : (((i) < 8 ? E0[(i) >> 1] : E1[((i) - 8) >> 1]) & 0xffffu)))
#define P5B_LDMETA(E0, E1, Q, tq_, te_) do { ASM_LD16(E0, EIDs + (size_t)(te_) * 256); ASM_LD16(E1, EIDs + (size_t)(te_) * 256 + 16); ASM_LD16(Q, QMs + (size_t)(tq_) * 128); } while (0)
#define P5B_ITER(RR, E0, E1, Q, tcur, tq, te) do { int p_[16]; \
        asm volatile("s_waitcnt vmcnt(19)" : "+v"(E0), "+v"(E1), "+v"(Q) :: "memory"); \
        _Pragma("unroll") for (int b = 0; b < 4; ++b) { \
            ASM_WAIT4(34, RR[4 * b], RR[4 * b + 1], RR[4 * b + 2], RR[4 * b + 3]); __builtin_amdgcn_sched_barrier(0); \
            _Pragma("unroll") for (int j = 0; j < 4; ++j) { const int i = 4 * b + j; p_[i] = __builtin_amdgcn_sdot4((int)RR[i].x, (int)Q.x, __builtin_amdgcn_sdot4((int)RR[i].y, (int)Q.y, __builtin_amdgcn_sdot4((int)RR[i].z, (int)Q.z, sdot4_z((int)RR[i].w, (int)Q.w), false), false), false); } \
            __builtin_amdgcn_sched_barrier(0); \
            _Pragma("unroll") for (int j = 0; j < 4; ++j) { const int i = 4 * b + j; ASM_LD16S(RR[i], (P5B_E(i, E0, E1) << 7) + l16s, UTb); } \
            __builtin_amdgcn_sched_barrier(0); } \
        int a8_[8], a4_[4], a2_[2]; TSTEP(a8_, p_, 16, c0, xl1) TSTEP(a4_, a8_, 8, c1, xl2) TSTEP(a2_, a4_, 4, c2, xl4) \
        *(GAS unsigned*)(AP + (size_t)(tcur) * 64) = ((unsigned)((a2_[0] + 32) >> 6) & 0xffffu) | ((unsigned)((a2_[1] + 32) >> 6) << 16); \
        __builtin_amdgcn_sched_barrier(0); P5B_LDMETA(E0, E1, Q, tq, te); __builtin_amdgcn_sched_barrier(0); } while (0)
    int j0, j1, j2, j3, j4, j5, p0, p1, p2, p3, p4, p5;
    P5_PULL(j0, p0); P5_PULL(j1, p1); P5_PULL(j2, p2); P5_PULL(j3, p3);
    v4u RA[16], RB[16], eA0, eA1, qA, eB0, eB1, qB;
    { const v4u e0 = *(const GAS v4u*)(EIDs + (size_t)p0 * 256), e1 = *(const GAS v4u*)(EIDs + (size_t)p0 * 256 + 16), f0 = *(const GAS v4u*)(EIDs + (size_t)p1 * 256), f1 = *(const GAS v4u*)(EIDs + (size_t)p1 * 256 + 16);
      eA0 = e0; eA1 = e1; qA = e0; eB0 = e0; eB1 = e1; qB = e0;
#pragma unroll
      for (int i = 0; i < 16; ++i) { RA[i] = e0; RB[i] = e0; }
      asm volatile("s_waitcnt vmcnt(0)" ::: "memory");
#pragma unroll
      for (int i = 0; i < 16; ++i) ASM_LD16S(RA[i], (P5B_E(i, e0, e1) << 7) + l16s, UTb);
#pragma unroll
      for (int i = 0; i < 16; ++i) ASM_LD16S(RB[i], (P5B_E(i, f0, f1) << 7) + l16s, UTb); }
    P5B_LDMETA(eA0, eA1, qA, p0, p2); P5B_LDMETA(eB0, eB1, qB, p1, p3);
    asm volatile("s_waitcnt vmcnt(0)" ::: "memory");
#pragma unroll 1
    while (j0 < nT) {
        P5_PULL(j4, p4); P5B_ITER(RA, eA0, eA1, qA, p0, p2, p4);
        P5_PULL(j5, p5); P5B_ITER(RB, eB0, eB1, qB, p1, p3, p5);
        j0 = j2; j1 = j3; j2 = j4; j3 = j5; p0 = p2; p1 = p3; p2 = p4; p3 = p5;
    }
    asm volatile("s_waitcnt vmcnt(0)" ::: "memory");
#undef P5B_E
#undef P5B_LDMETA
#undef P5B_ITER
}
__device__ __forceinline__ void p5b2_gelu(Frame& F) {
    const int lane = lane_id(); const int gw = F.vcu * NWAVES + F.wave, NGW = F.G * NWAVES;
    const float* SU = (const float*)(F.ws + WS_SU); const float* SV = (const float*)(F.ws + WS_SV); const float* SM = (const float*)(F.ws + WS_SM);
    int jd; WG_DEAL(jd, 4, lane);
    while (jd < M / (4 * F.G)) {
        int a0[4], a1[4]; unsigned ew[4]; f32x2 gt[4]; float sm[4]; int tt[4];
#pragma unroll
        for (int u = 0; u < 4; ++u) { const int t = F.vcu * NWAVES + (jd & 7) + NGW * ((jd >> 3) * 4 + u); tt[u] = t; a0[u] = 0; a1[u] = 0;
            ew[u] = *(const GAS unsigned*)(F.ws + WS_EID + (size_t)t * 256 + 4 * lane); gt[u] = *(const GAS f32x2*)(F.ws + WS_GATE + (size_t)t * 512 + 8 * lane); sm[u] = SM[t] * 64.f; }
        float su0[4], su1[4], sv0[4], sv1[4];
#pragma unroll
        for (int u = 0; u < 4; ++u) { const unsigned e0 = ew[u] & 0xffffu, e1 = ew[u] >> 16; su0[u] = SU[e0]; su1[u] = SU[e1]; sv0[u] = SV[e0]; sv1[u] = SV[e1];
#pragma unroll
            for (int xx = 0; xx < 8; ++xx) { const int w = *(const GAS int*)((const int*)(F.ws + WS_APART) + (size_t)xx * M * 64 + (size_t)tt[u] * 64 + lane); a0[u] += (int)(short)(w & 0xffff); a1[u] += w >> 16; } }
#pragma unroll
        for (int u = 0; u < 4; ++u) { const int t = tt[u];
            const float h0 = gelu_exact((float)a0[u] * sm[u] * su0[u]) * gt[u][0] * sv0[u], h1 = gelu_exact((float)a1[u] * sm[u] * su1[u]) * gt[u][1] * sv1[u];
            const float hmax = wave_max(fmaxf(__builtin_fabsf(h0), __builtin_fabsf(h1))); const float inv = 127.f / fmaxf(hmax, 1e-30f);
            const int q0 = (int)__builtin_rintf(h0 * inv), q1 = (int)__builtin_rintf(h1 * inv);
            *(GAS unsigned short*)(F.ws + WS_HQ + (size_t)t * 128 + 2 * lane) = (unsigned short)((q0 & 0xff) | ((q1 & 0xff) << 8));
            if (lane == 32) ((float*)(F.ws + WS_HS))[t] = hmax * (1.f / 127.f); }
        WG_DEAL(jd, 4, lane);
    }
    { const unsigned char* vl = F.ws + WS_VT + (size_t)((int)blockIdx.x & 7) * NEXP * 128 + ((size_t)(((int)blockIdx.x >> 3) * 512 + F.wave * 64 + lane)) * 128;
      const unsigned z = *(const GAS unsigned*)vl; asm volatile("" :: "v"(z)); }
}
__device__ __forceinline__ void p5c_vacc(Frame& F) {
    const int lane = lane_id(), g = lane >> 3, s = lane & 7;
    const int x = blockIdx.x & 7, rk = blockIdx.x >> 3, nrk = F.G >> 3;
    const unsigned char* VTb = F.ws + WS_VT + (size_t)x * NEXP * 128; const unsigned l16s = 16u * (unsigned)s; const unsigned char* EIDs = F.ws + WS_EID + 32 * g; const unsigned char* HQs = F.ws + WS_HQ + 16 * g;
    const float* SH = (const float*)(F.ws + WS_HS); float* ssq2 = (float*)(F.ws + WS_SSQ2); unsigned* H2B = (unsigned*)(F.ws + WS_XN2);
    const int dcol = 128 * x + 16 * s + 2 * g;
    const bool c3 = g & 1, c4 = g & 2, c5 = g & 4; const bool hi32 = lane >= 32;
    const int nT = M / nrk; LAS unsigned* qctr = (LAS unsigned*)(F.lds + MISC_OFF) + 63;
#define P5C_E(i, E0, E1) ((((i) & 1) ? (((i) < 8 ? E0[(i) >> 1] : E1[((i) - 8) >> 1]) >> 16) : (((i) < 8 ? E0[(i) >> 1] : E1[((i) - 8) >> 1]) & 0xffffu)))
#define P5C_LDMETA(E0, E1, HB, H1, SHv, tq_, te_) do { ASM_LD16(E0, EIDs + (size_t)(te_) * 256); ASM_LD16(E1, EIDs + (size_t)(te_) * 256 + 16); \
        ASM_LD16(HB, HQs + (size_t)(tq_) * 128); ASM_LD4(H1, (const unsigned*)F.out + (((size_t)(tq_) * DM + dcol) >> 1)); ASM_LD4(SHv, SH + (tq_)); } while (0)
#define IX32(v) xl32(v, hi32)
#define P5C_ITER(RR, E0, E1, HB, H1, SHv, tcur, vcur, tq, te) do { int yi_[16]; \
        asm volatile("s_waitcnt vmcnt(21)" : "+v"(E0), "+v"(E1), "+v"(HB), "+v"(H1), "+v"(SHv) :: "memory"); \
        _Pragma("unroll") for (int b = 0; b < 4; ++b) { const int hb_ = (int)HB[b]; \
            ASM_WAIT4(38, RR[4 * b], RR[4 * b + 1], RR[4 * b + 2], RR[4 * b + 3]); __builtin_amdgcn_sched_barrier(0); \
            _Pragma("unroll") for (int c = 0; c < 4; ++c) { \
                const unsigned ra_ = RR[4 * b][c], rb_ = RR[4 * b + 1][c], rc_ = RR[4 * b + 2][c], rd_ = RR[4 * b + 3][c]; \
                const unsigned p_ = __builtin_amdgcn_perm(rb_, ra_, 0x05010400u), q_ = __builtin_amdgcn_perm(rb_, ra_, 0x07030602u), r_ = __builtin_amdgcn_perm(rd_, rc_, 0x05010400u), s_ = __builtin_amdgcn_perm(rd_, rc_, 0x07030602u); \
                const int t0_ = (int)__builtin_amdgcn_perm(r_, p_, 0x05040100u), t1_ = (int)__builtin_amdgcn_perm(r_, p_, 0x07060302u), t2_ = (int)__builtin_amdgcn_perm(s_, q_, 0x05040100u), t3_ = (int)__builtin_amdgcn_perm(s_, q_, 0x07060302u); \
                if (b == 0) { yi_[4 * c + 0] = sdot4_z(t0_, hb_); yi_[4 * c + 1] = sdot4_z(t1_, hb_); yi_[4 * c + 2] = sdot4_z(t2_, hb_); yi_[4 * c + 3] = sdot4_z(t3_, hb_); } \
                else { yi_[4 * c + 0] = __builtin_amdgcn_sdot4(t0_, hb_, yi_[4 * c + 0], false); yi_[4 * c + 1] = __builtin_amdgcn_sdot4(t1_, hb_, yi_[4 * c + 1], false); yi_[4 * c + 2] = __builtin_amdgcn_sdot4(t2_, hb_, yi_[4 * c + 2], false); yi_[4 * c + 3] = __builtin_amdgcn_sdot4(t3_, hb_, yi_[4 * c + 3], false); } } \
            __builtin_amdgcn_sched_barrier(0); \
            _Pragma("unroll") for (int j = 0; j < 4; ++j) { const int i = 4 * b + j; ASM_LD16S(RR[i], (P5C_E(i, E0, E1) << 7) + l16s, VTb); } \
            __builtin_amdgcn_sched_barrier(0); } \
        int y8_[8], y4_[4], y2_[2]; TSTEP(y8_, yi_, 16, c3, xl8) TSWAP(y4_, y8_, 8, __builtin_amdgcn_permlane16_swap) TSWAP(y2_, y4_, 4, __builtin_amdgcn_permlane32_swap) \
        const f32x2 n_ = {bflo(H1) + SHv * (float)y2_[0], bfhi(H1) + SHv * (float)y2_[1]}; \
        const float ss_ = wave_sum(n_[0] * n_[0] + n_[1] * n_[1]); \
        if (vcur) { H2B[((size_t)(tcur) * DM + dcol) >> 1] = pk2(n_[0], n_[1]); if (lane == 0) ssq2[(size_t)(tcur) * 8 + x] = ss_; } \
        __builtin_amdgcn_sched_barrier(0); P5C_LDMETA(E0, E1, HB, H1, SHv, tq, te); __builtin_amdgcn_sched_barrier(0); } while (0)
    int j0, j1, j2, j3, j4, j5, p0, p1, p2, p3, p4, p5;
    P5_PULL(j0, p0); P5_PULL(j1, p1); P5_PULL(j2, p2); P5_PULL(j3, p3);
    v4u RA[16], RB[16], eA0, eA1, hbA, eB0, eB1, hbB; unsigned h1A = 0u, h1B = 0u; float shA = 0.f, shB = 0.f;
    { const v4u e0 = *(const GAS v4u*)(EIDs + (size_t)p0 * 256), e1 = *(const GAS v4u*)(EIDs + (size_t)p0 * 256 + 16), f0 = *(const GAS v4u*)(EIDs + (size_t)p1 * 256), f1 = *(const GAS v4u*)(EIDs + (size_t)p1 * 256 + 16);
      eA0 = e0; eA1 = e1; hbA = e0; eB0 = e0; eB1 = e1; hbB = e0;
#pragma unroll
      for (int i = 0; i < 16; ++i) { RA[i] = e0; RB[i] = e0; }
      asm volatile("s_waitcnt vmcnt(0)" ::: "memory");
#pragma unroll
      for (int i = 0; i < 16; ++i) ASM_LD16S(RA[i], (P5C_E(i, e0, e1) << 7) + l16s, VTb);
#pragma unroll
      for (int i = 0; i < 16; ++i) ASM_LD16S(RB[i], (P5C_E(i, f0, f1) << 7) + l16s, VTb); }
    P5C_LDMETA(eA0, eA1, hbA, h1A, shA, p0, p2); P5C_LDMETA(eB0, eB1, hbB, h1B, shB, p1, p3);
    asm volatile("s_waitcnt vmcnt(0)" ::: "memory");
#pragma unroll 1
    while (j0 < nT) {
        P5_PULL(j4, p4); P5C_ITER(RA, eA0, eA1, hbA, h1A, shA, p0, true, p2, p4);
        P5_PULL(j5, p5); P5C_ITER(RB, eB0, eB1, hbB, h1B, shB, p1, (j1 < nT), p3, p5);
        j0 = j2; j1 = j3; j2 = j4; j3 = j5; p0 = p2; p1 = p3; p2 = p4; p3 = p5;
    }
    asm volatile("s_waitcnt vmcnt(0)" ::: "memory");
#undef P5C_E
#undef P5C_LDMETA
#undef P5C_ITER
#undef IX32
}
struct Args { const float* in[23]; float* out; unsigned char* ws; int ph_lo, ph_hi; };
__global__ void __launch_bounds__(NWAVES * 64, 2) hymba_fwd(Args args) {
    extern __shared__ __attribute__((aligned(16))) unsigned char lds[];
    cg::grid_group grid = cg::this_grid();
    Frame F;
    F.lds = (LAS unsigned char*)lds; F.ldsg = lds;
    F.wave = __builtin_amdgcn_readfirstlane(threadIdx.x >> 6);
    F.G = gridDim.x; { const int bx = blockIdx.x; F.vcu = (F.G % 8 == 0) ? (bx % 8) * (F.G / 8) + bx / 8 : bx; }
    F.out = args.out; F.ws = args.ws;
    const int lo = args.ph_lo, hi = args.ph_hi;
#ifdef ONLY_PH
#define IN(k) ((k) == ONLY_PH)
#else
#define IN(k) (lo <= (k) && (k) < hi)
#endif
#define BOTH(k) (IN(k) && IN((k) + 1))
    { const int l0 = lane_id(); if (F.wave == 0) ((volatile LAS unsigned*)(F.lds + MISC_OFF))[l0] = 0u; }
    __syncthreads();
    const XcdBarrier bar = xcd_barrier_post((unsigned*)(F.ws + WS_CTL) + CW_BAR, (volatile LAS unsigned*)(F.lds + MISC_OFF) + 8, F.wave == 0 && lane_id() == 0);
    if (F.wave == 0 && lane_id() == 0) (void)__hip_atomic_fetch_or((unsigned*)(F.ws + WS_CTL) + CW_MAP + 64 * ((int)blockIdx.x & 7), 1u << xb_xcc_id(), __ATOMIC_RELAXED, __HIP_MEMORY_SCOPE_AGENT);
    if (hi > N_PHASES) grid.sync();
#if defined(PROBE_BARSUM)
#define GRID_BAR(k) do { STAMP(20); xcd_barrier(bar, F.wave == 0 && lane_id() == 0); STAMP((k) + 1); \
    if (F.wave == 0 && ((PROBE_BARSUM >> (k)) & 1)) { volatile LAS unsigned* ms_ = (volatile LAS unsigned*)(F.lds + MISC_OFF) + 16; ms_[2 * 21] += ms_[2 * ((k) + 1)] - ms_[2 * 20]; } } while (0)
#else
#define GRID_BAR(k) do { xcd_barrier(bar, F.wave == 0 && lane_id() == 0); STAMP((k) + 1); } while (0)
#endif
    STAMP(0);
    if (IN(0)) { p0_prologue(F); if (BOTH(0)) GRID_BAR(0); }
    bool lbl_ok = false;
    if (BOTH(0)) { unsigned* ctl_ = (unsigned*)(F.ws + WS_CTL); bool ok_ = true;
#pragma unroll
        for (int j = 0; j < 8; ++j) { const unsigned mp_ = xb_ld(ctl_ + CW_MAP + 64 * j); ok_ = ok_ && mp_ != 0u && (mp_ & (mp_ - 1u)) == 0u; }
        lbl_ok = __builtin_amdgcn_readfirstlane((int)ok_) != 0; }
#if defined(PROBE_NOLBL)
    lbl_ok = false;
#endif
    const int grp = lbl_ok ? (((int)blockIdx.x & 7) >> 2) : 0;
    const int tslot = 1 + (((int)blockIdx.x & 3) ^ (grp * 3));
#define LBL_BAR_X() do { if (lbl_ok) label_barrier((unsigned*)(F.ws + WS_CTL), (int)blockIdx.x & 7, F.wave == 0 && lane_id() == 0); else xcd_barrier(bar, F.wave == 0 && lane_id() == 0); } while (0)
#define LBL_BAR(k) do { if (lbl_ok) { label_barrier((unsigned*)(F.ws + WS_CTL), (int)blockIdx.x & 7, F.wave == 0 && lane_id() == 0); STAMP((k) + 1); } else GRID_BAR(k); } while (0)
    if (IN(1)) {
        if (grp == 1) { p0_pb(F); LBL_BAR_X();
        { pg8::Gemm g{(const pg8::bf16_t*)(F.ws + WS_PB), (const pg8::bf16_t*)(F.ws + WS_WPROJ), M, DM, PLE_DIM / 2, (const float*)(F.ws + WS_SPB), 1.f, (const float*)(F.ws + WS_SW) + IN_COLS + QCOLS}; pg8::StaticOrder S; S.init(M, DM, F.G, (int)blockIdx.x);
          pg8::EpiBf16<0> E{(pg8::bf16_t*)(F.ws + WS_E), DM, nullptr, 0, 0, 1.f};
          pg8::gemm_phase<pg8::EpiBf16<0>, pg8::StaticOrder, true, true, true>(F.lds, g, S, E, F.wave); }
        }
        p0_xn(F); LBL_BAR_X();
        { pg8::Gemm g{(const pg8::bf16_t*)(F.ws + WS_XN), (const pg8::bf16_t*)(F.ws + WS_WIN), M, IN_COLS, DM / 2, (const float*)(F.ws + WS_SXN), 1.f, (const float*)(F.ws + WS_SW)};     pg8::StaticOrder S; S.init(M, IN_COLS, F.G, (int)blockIdx.x);
          pg8::EpiIn E{(pg8::bf16_t*)(F.ws + WS_QO), (pg8::bf16_t*)(F.ws + WS_K), (pg8::bf16_t*)(F.ws + WS_V), (pg8::bf16_t*)(F.ws + WS_U), (const float*)(F.ws + WS_ROPEC), (const float*)(F.ws + WS_ROPES), attn_body::C2};
          pg8::gemm_phase<pg8::EpiIn, pg8::StaticOrder, true, true, true>(F.lds, g, S, E, F.wave); }
        if (tslot == 1) { if (grp == 0) p0_pb(F); p0_tables(F); }
        if (BOTH(1)) LBL_BAR(1);
    }
    if (IN(2)) { p2_attention(F); STAMP(13); p2_conv(F); STAMP(14); if (tslot == 2) { if (grp == 0) p0_pb(F); p0_tables(F); } if (BOTH(2)) LBL_BAR(2); }
    if (IN(3)) {
        pg8::Gemm g{(const pg8::bf16_t*)(F.ws + WS_XN), (const pg8::bf16_t*)(F.ws + WS_WOUT), M, DM, DM}; pg8::StaticOrder S; S.init(M, DM, F.G, (int)blockIdx.x);
        const unsigned mp3 = xb_ld((unsigned*)(F.ws + WS_CTL) + CW_MAP + 64 * ((int)blockIdx.x & 7));
        pg8::EpiOutQ E{INP(0), (pg8::bf16_t*)F.out  , (float*)(F.ws + WS_SSQ1), (float*)(F.ws + WS_AMX), (unsigned char*)F.out + OUT_H1Q, (float*)(F.ws + WS_SHQ), (unsigned*)(F.ws + WS_CTL) + CW_RB3, (mp3 & (mp3 - 1u)) != 0u, EPS};
        pg8::gemm_phase<pg8::EpiOutQ, pg8::StaticOrder, true, true>(F.lds, g, S, E, F.wave);
        if (tslot == 3) { if (grp == 0) p0_pb(F); p0_tables(F); }
        if (BOTH(3)) LBL_BAR(3);
    }
    if (IN(4)) {
        pg8::Gemm g{(const pg8::bf16_t*)((unsigned char*)F.out + OUT_H1Q), (const pg8::bf16_t*)(F.ws + WS_WQ), M, QCOLS, DM / 2, (const float*)(F.ws + WS_SHQ), 1.f, (const float*)(F.ws + WS_SW) + IN_COLS};     pg8::StaticOrder S; S.init(M, QCOLS, F.G, (int)blockIdx.x);
        pg8::EpiQS E{(pg8::bf16_t*)(F.ws + WS_QP)};
        pg8::gemm_phase<pg8::EpiQS, pg8::StaticOrder, true, true, true>(F.lds, g, S, E, F.wave);
        if (tslot == 4) { if (grp == 0) p0_pb(F); p0_tables(F); }
        if (BOTH(4)) LBL_BAR(4);
    }
    if (IN(5) && grp == 0) {
        { pg8::Gemm g{(const pg8::bf16_t*)(F.ws + WS_PB), (const pg8::bf16_t*)(F.ws + WS_WPROJ), M, DM, PLE_DIM / 2, (const float*)(F.ws + WS_SPB), 1.f, (const float*)(F.ws + WS_SW) + IN_COLS + QCOLS}; pg8::StaticOrder S; S.init(M, DM, F.G, (int)blockIdx.x);
          pg8::EpiBf16<0> E{(pg8::bf16_t*)(F.ws + WS_E), DM, nullptr, 0, 0, 1.f};
          pg8::gemm_phase<pg8::EpiBf16<0>, pg8::StaticOrder, true, true, true>(F.lds, g, S, E, F.wave); }
    }
    if (IN(5)) { p5a_topk(F); if (BOTH(5)) GRID_BAR(5); }
    if (IN(6)) { p5b_udot(F); if (BOTH(6)) GRID_BAR(6); }
    if (IN(7)) { p5b2_gelu(F); if (BOTH(7)) GRID_BAR(7); }
    if (IN(8)) { p5c_vacc(F); if (BOTH(8)) GRID_BAR(8); }
    if (IN(9)) {
        pg8::Gemm g{(const pg8::bf16_t*)(F.ws + WS_XN2), (const pg8::bf16_t*)(F.ws + WS_WGATE), M, DM, DM}; pg8::StaticOrder S; S.init(M, DM, F.G, (int)blockIdx.x);
        const unsigned mp = xb_ld((unsigned*)(F.ws + WS_CTL) + CW_MAP + 64 * ((int)blockIdx.x & 7));
        pg8::EpiGateNorm E{(const pg8::bf16_t*)(F.ws + WS_XN2), (const pg8::bf16_t*)(F.ws + WS_E), (const float*)(F.ws + WS_SSQ2), EPS, (float*)(F.ws + WS_SSQ1), (unsigned*)(F.ws + WS_CTL) + CW_RB, INP(22), F.out, (mp & (mp - 1u)) != 0u};
        pg8::gemm_phase<pg8::EpiGateNorm, pg8::StaticOrder, true, true>(F.lds, g, S, E, F.wave);
    }
#if defined(MBENCH)
    { xcd_barrier(bar, F.wave == 0 && lane_id() == 0); STAMP(15);
      unsigned r[32]; const unsigned l0 = (unsigned)lane_id();
#pragma unroll
      for (int i = 0; i < 32; ++i) r[i] = l0 * 2654435761u + i;
      float* rf = (float*)r;
#pragma unroll 1
      for (int it = 0; it < 1024; ++it) {
#pragma unroll
          for (int i = 0; i < 32; ++i) {
#if MBENCH == 1
              asm volatile("v_dot4c_i32_i8 %0, %1, %2" : "+v"(r[i]) : "v"(r[(i + 1) & 31]), "v"(r[(i + 2) & 31]));
#elif MBENCH == 2
              asm volatile("v_perm_b32 %0, %1, %2, %3" : "=v"(r[i]) : "v"(r[(i + 1) & 31]), "v"(r[(i + 2) & 31]), "v"(r[(i + 3) & 31]));
#elif MBENCH == 3
              asm volatile("v_fma_f32 %0, %1, %2, %0" : "+v"(r[i]) : "v"(r[(i + 1) & 31]), "v"(r[(i + 2) & 31]));
#elif MBENCH == 4
              asm volatile("v_cvt_f32_ubyte1 %0, %1" : "=v"(r[i]) : "v"(r[(i + 1) & 31]));
#elif MBENCH == 5
              asm volatile("v_pk_fma_f32 %0, %1, %2, %0" : "+v"(*(unsigned long long*)&r[2 * (i & 15)]) : "v"(*(unsigned long long*)&r[2 * ((i + 1) & 15)]), "v"(*(unsigned long long*)&r[2 * ((i + 2) & 15)]));
#elif MBENCH == 6
              asm volatile("v_add_u32 %0, %1, %2" : "=v"(r[i]) : "v"(r[(i + 1) & 31]), "v"(r[(i + 2) & 31]));
#elif MBENCH == 7
              asm volatile("v_mad_i32_i24 %0, %1, %2, %0" : "+v"(r[i]) : "v"(r[(i + 1) & 31]), "v"(r[(i + 2) & 31]));
#endif
          } }
      unsigned acc = 0;
#pragma unroll
      for (int i = 0; i < 32; ++i) acc ^= r[i];
      if (acc == 0x12345678u) ((unsigned*)(F.ws + WS_CTL))[2000 + l0] = acc;
      STAMP(16); }
#endif
#if defined(PROBE_A)
    STAMP(11);
#if !defined(PROBE_BLK)
#define PROBE_BLK 0
#endif
    if (blockIdx.x == PROBE_BLK && F.wave == 0) { volatile LAS unsigned* ms_ = (volatile LAS unsigned*)(F.lds + MISC_OFF) + 16;
        const unsigned long long ta = ((unsigned long long)ms_[2 * PROBE_A + 1] << 32) | ms_[2 * PROBE_A], tb = ((unsigned long long)ms_[2 * PROBE_B + 1] << 32) | ms_[2 * PROBE_B];
#if defined(PROBE_FIXED)
        const unsigned long long span_ = PROBE_FIXED;
#elif defined(PROBE_BARSUM)
        const unsigned long long span_ = ms_[2 * 21];
#else
        const unsigned long long span_ = tb - ta;
#endif
        const unsigned long long t0_ = __builtin_amdgcn_s_memrealtime(); while (__builtin_amdgcn_s_memrealtime() - t0_ < span_) __builtin_amdgcn_s_sleep(8); }
#endif
#undef IN
#undef BOTH
}

extern "C" void kernel_launch(void* const* d_in, const int* in_sizes, int n_in, void* d_out, int out_size, void* d_ws, size_t ws_size, hipStream_t stream) {
    static int grid = 0;
    if (grid == 0) {
        if (n_in != 23 || in_sizes[0] != M * DM || out_size != M * DM || ws_size < WS_END) { fprintf(stderr, "kernel_launch: unexpected shapes (n_in %d, in0 %d, out %d, ws %zu); nothing launched\n", n_in, n_in > 0 ? in_sizes[0] : -1, out_size, ws_size); grid = -1; return; }
        int dev = 0, cus = 0, per_cu = 0;
        if (hipGetDevice(&dev) != hipSuccess || hipDeviceGetAttribute(&cus, hipDeviceAttributeMultiprocessorCount, dev) != hipSuccess) { fprintf(stderr, "kernel_launch: device query failed\n"); grid = -1; return; }
        if (hipFuncSetAttribute((const void*)hymba_fwd, hipFuncAttributeMaxDynamicSharedMemorySize, LDS_BYTES) != hipSuccess) { fprintf(stderr, "kernel_launch: hipFuncSetAttribute failed\n"); grid = -1; return; }
        if (hipOccupancyMaxActiveBlocksPerMultiprocessor(&per_cu, (const void*)hymba_fwd, NWAVES * 64, LDS_BYTES) != hipSuccess || per_cu < 1) { fprintf(stderr, "kernel_launch: occupancy query says %d blocks per CU\n", per_cu); (void)hipGetLastError(); grid = -1; return; }
        grid = cus * per_cu;
        if (grid != 256) { fprintf(stderr, "kernel_launch: this kernel's attention order needs exactly 256 resident workgroups (got %d x %d); nothing launched\n", cus, per_cu); grid = -1; return; }
    }
    if (grid < 0) return;
    if (hipMemsetAsync((char*)d_ws + WS_CTL, 0, CTL_ZERO_BYTES, stream) != hipSuccess) { fprintf(stderr, "kernel_launch: hipMemsetAsync failed\n"); return; }
    Args a{};
    for (int i = 0; i < 23; ++i) a.in[i] = (const float*)d_in[i];
    a.out = (float*)d_out; a.ws = (unsigned char*)d_ws;
#if MK_N_LAUNCHES == 1
    a.ph_lo = 0; a.ph_hi = N_PHASES;
    void* kargs[] = {&a};
    hipError_t e = hipLaunchCooperativeKernel((const void*)hymba_fwd, dim3(grid), dim3(NWAVES * 64), kargs, LDS_BYTES, stream);
    if (e != hipSuccess) fprintf(stderr, "kernel_launch: cooperative launch failed: %s (grid %d)\n", hipGetErrorString(e), grid);
#else
    for (int li = 0; li < N_PHASES; ++li) { a.ph_lo = li; a.ph_hi = li + 1;
        hipLaunchKernelGGL(hymba_fwd, dim3(grid), dim3(NWAVES * 64), LDS_BYTES, stream, a);
        const hipError_t le = hipPeekAtLastError(); if (le != hipSuccess) { fprintf(stderr, "kernel_launch: launch %d failed: %s\n", li, hipGetErrorName(le)); break; } }
#endif
}
```
